# Optimizing an MI355X kernel written in HIP

```python
import math
import jax
import jax.numpy as jnp
from jax import lax
import numpy as np

D_MODEL = 1024
BATCH = 1
SEQ = 16384
DEPTH = 4

N_EVEN = (DEPTH + 1) // 2
N_ODD = DEPTH // 2
EPS = 1e-6
ROPE_THETA = 10000.0
Q_BLOCK = 128

GDN_HEADS = 4
GDN_DK = 128
GDN_DV = 128
GDN_CONV = 4
GDN_CHUNK = 64
GDN_QK = GDN_HEADS * GDN_DK
GDN_V = GDN_HEADS * GDN_DV
GDN_CONV_CH = 2 * GDN_QK + GDN_V
MOBA_HEADS = 4
MOBA_DH = 128
MOBA_BLOCK = 256
MOBA_TOPK = 3
MOBA_W = MOBA_HEADS * MOBA_DH
HY_SIZES = (GDN_CONV_CH, GDN_V, GDN_HEADS, GDN_HEADS, MOBA_W, MOBA_W, MOBA_W)
HY_IN = sum(HY_SIZES)
HY_SPLITS = tuple(int(i) for i in np.cumsum(HY_SIZES)[:-1])
HY_OUT = GDN_V + MOBA_W
MLA_HEADS = 8
MLA_Q_RANK = 512
MLA_KV_RANK = 256
MLA_NOPE = 128
MLA_ROPE = 64
MLA_V = 128
MLA_IN = MLA_Q_RANK + MLA_KV_RANK + MLA_ROPE
PEER_HEADS = 8
PEER_NKEYS = 128
PEER_EXPERTS = PEER_NKEYS * PEER_NKEYS
PEER_DKEY = 256
PEER_TOPK = 16
PEER_TOK_CHUNK = 128

kernel_name = 'hybrid_gdn_moba_mla_peer'


def rmsnorm(x, w):
    xf = x.astype(jnp.float32)
    y = xf * lax.rsqrt(jnp.mean(xf * xf, axis=-1, keepdims=True) + EPS)
    return (y * w.astype(jnp.float32)).astype(x.dtype)


def l2norm(x):
    xf = x.astype(jnp.float32)
    return xf * lax.rsqrt(jnp.sum(xf * xf, axis=-1, keepdims=True) + EPS)


def rope_tables(positions, dim):
    inv_freq = ROPE_THETA ** (-jnp.arange(0, dim, 2, dtype=jnp.float32) / dim)
    ang = positions.astype(jnp.float32)[..., None] * inv_freq
    return jnp.cos(ang), jnp.sin(ang)


def apply_rope(x, cos, sin):
    x1, x2 = jnp.split(x.astype(jnp.float32), 2, axis=-1)
    c = cos[:, :, None, :]
    s = sin[:, :, None, :]
    return jnp.concatenate([x1 * c - x2 * s, x2 * c + x1 * s], axis=-1)


def causal_conv_silu(x, w):
    k_w = w.shape[0]
    s = x.shape[1]
    xp = jnp.pad(x, ((0, 0), (k_w - 1, 0), (0, 0)))
    y = xp[:, 0:s] * w[0]
    for j in range(1, k_w):
        y = y + xp[:, j:j + s] * w[j]
    return jax.nn.silu(y)


def unit_lower_inverse(l_strict):
    n = l_strict.shape[-1]
    eye = jnp.eye(n, dtype=l_strict.dtype)
    neg = -l_strict
    inv = eye + neg
    power = neg
    p = 2
    while p < n:
        power = power @ power
        inv = inv @ (eye + power)
        p *= 2
    return inv


def gated_delta_rule(q, k, v, g, beta):
    bsz, s, nh, dk = q.shape
    dv = v.shape[-1]
    cs = GDN_CHUNK
    nc = s // cs

    def to_chunks(t):
        t = t.reshape((bsz, nc, cs, nh) + t.shape[3:])
        return jnp.moveaxis(t, 3, 1)

    q = to_chunks(q * dk ** -0.5)
    k = to_chunks(k)
    v = to_chunks(v)
    beta = to_chunks(beta)
    g = jnp.cumsum(to_chunks(g), axis=-1)
    causal = jnp.tril(jnp.ones((cs, cs), dtype=bool))
    strict = jnp.tril(jnp.ones((cs, cs), dtype=bool), -1)
    decay = jnp.exp(jnp.where(causal, g[..., :, None] - g[..., None, :], -jnp.inf))
    k_beta = k * beta[..., None]
    l_strict = jnp.where(strict, jnp.einsum('bhncd,bhnmd->bhncm', k_beta, k) * decay, 0.0)
    t_inv = unit_lower_inverse(l_strict)
    u = t_inv @ (v * beta[..., None])
    w = t_inv @ (k_beta * jnp.exp(g)[..., None])
    qk = jnp.einsum('bhncd,bhnmd->bhncm', q, k) * decay
    q_dec = q * jnp.exp(g)[..., None]
    g_last = g[..., -1]
    k_dec = k * jnp.exp(g_last[..., None] - g)[..., None]

    def step(state, inp):
        qd, kd, uc, wc, qkc, gl = inp
        v_new = uc - jnp.einsum('bhck,bhkv->bhcv', wc, state)
        out = jnp.einsum('bhck,bhkv->bhcv', qd, state) + jnp.einsum('bhcm,bhmv->bhcv', qkc, v_new)
        state = state * jnp.exp(gl)[..., None, None] + jnp.einsum('bhck,bhcv->bhkv', kd, v_new)
        return state, out

    xs = tuple(jnp.moveaxis(t, 2, 0) for t in (q_dec, k_dec, u, w, qk, g_last))
    state0 = jnp.zeros((bsz, nh, dk, dv), jnp.float32)
    _, o = lax.scan(step, state0, xs)
    return jnp.transpose(o, (1, 0, 3, 2, 4)).reshape(bsz, s, nh, dv)


def moba_attention(q, k, v):
    bsz, s, nh, d = q.shape
    nb = -(-s // MOBA_BLOCK)
    pad = nb * MOBA_BLOCK - s
    topk = min(MOBA_TOPK, nb)
    qh = jnp.moveaxis(q, 2, 1) * d ** -0.5

    def to_blocks(t):
        t = jnp.pad(jnp.moveaxis(t, 2, 1), ((0, 0), (0, 0), (0, pad), (0, 0)))
        return t.reshape(bsz, nh, nb, MOBA_BLOCK, d)

    k_blk = to_blocks(k)
    v_blk = to_blocks(v)
    k_mean = jnp.mean(k_blk, axis=3)
    b_idx = jnp.arange(bsz)[:, None, None, None]
    h_idx = jnp.arange(nh)[None, :, None, None]
    blk_ids = jnp.arange(nb)

    def one_block(ci):
        start = ci * Q_BLOCK
        own = start // MOBA_BLOCK
        qc = lax.dynamic_slice_in_dim(qh, start, Q_BLOCK, axis=2)
        qpos = start + jnp.arange(Q_BLOCK)
        gate = jnp.einsum('bhqd,bhnd->bhqn', qc, k_mean)
        gate = jnp.where(blk_ids < own, gate, -jnp.inf)
        _, sel = lax.top_k(gate, topk)
        valid = sel < own
        k_sel = k_blk[b_idx, h_idx, sel]
        v_sel = v_blk[b_idx, h_idx, sel]
        s_sel = jnp.einsum('bhqd,bhqtkd->bhqtk', qc, k_sel)
        s_sel = jnp.where(valid[..., None], s_sel, -jnp.inf).reshape(bsz, nh, Q_BLOCK, topk * MOBA_BLOCK)
        k_own = lax.dynamic_index_in_dim(k_blk, own, axis=2, keepdims=False)
        v_own = lax.dynamic_index_in_dim(v_blk, own, axis=2, keepdims=False)
        kpos = own * MOBA_BLOCK + jnp.arange(MOBA_BLOCK)
        s_own = jnp.einsum('bhqd,bhkd->bhqk', qc, k_own)
        s_own = jnp.where(kpos[None, :] <= qpos[:, None], s_own, -jnp.inf)
        p = jax.nn.softmax(jnp.concatenate([s_sel, s_own], axis=-1), axis=-1)
        p_sel = p[..., :topk * MOBA_BLOCK].reshape(bsz, nh, Q_BLOCK, topk, MOBA_BLOCK)
        p_own = p[..., topk * MOBA_BLOCK:]
        return (jnp.einsum('bhqtk,bhqtkd->bhqd', p_sel, v_sel)
                + jnp.einsum('bhqk,bhkd->bhqd', p_own, v_own))

    o = lax.map(one_block, jnp.arange(s // Q_BLOCK))
    return jnp.transpose(o, (1, 0, 3, 2, 4)).reshape(bsz, s, nh, d)


def hybrid_mixer(h, cos, sin, w_in, conv_w, a_log, dt_bias, o_norm, w_out):
    bsz, s, _ = h.shape
    f32 = jnp.float32
    qkv_a, z_a, b_a, a_a, q_b, k_b, v_b = jnp.split(h @ w_in, HY_SPLITS, axis=-1)
    qkv_a = causal_conv_silu(qkv_a, conv_w)
    q_a, k_a, v_a = jnp.split(qkv_a, [GDN_QK, 2 * GDN_QK], axis=-1)
    q_a = l2norm(q_a.reshape(bsz, s, GDN_HEADS, GDN_DK))
    k_a = l2norm(k_a.reshape(bsz, s, GDN_HEADS, GDN_DK))
    v_a = v_a.reshape(bsz, s, GDN_HEADS, GDN_DV).astype(f32)
    beta = jax.nn.sigmoid(b_a.astype(f32))
    g = -jnp.exp(a_log.astype(f32)) * jax.nn.softplus(a_a.astype(f32) + dt_bias.astype(f32))
    o_a = gated_delta_rule(q_a, k_a, v_a, g, beta)
    o_a = rmsnorm(o_a, o_norm) * jax.nn.silu(z_a.reshape(bsz, s, GDN_HEADS, GDN_DV).astype(f32))
    q_b = apply_rope(q_b.reshape(bsz, s, MOBA_HEADS, MOBA_DH), cos, sin)
    k_b = apply_rope(k_b.reshape(bsz, s, MOBA_HEADS, MOBA_DH), cos, sin)
    v_b = v_b.reshape(bsz, s, MOBA_HEADS, MOBA_DH).astype(f32)
    o_b = moba_attention(q_b, k_b, v_b)
    o = jnp.concatenate([o_a.reshape(bsz, s, GDN_V), o_b.reshape(bsz, s, MOBA_W)], axis=-1)
    return o.astype(h.dtype) @ w_out


def mla_mixer(h, cos, sin, w_in, q_norm, kv_norm, w_uq, w_ukv, w_out):
    bsz, s, _ = h.shape
    f32 = jnp.float32
    cq, ckv, k_rope = jnp.split(h @ w_in, [MLA_Q_RANK, MLA_Q_RANK + MLA_KV_RANK], axis=-1)
    q = (rmsnorm(cq, q_norm) @ w_uq).reshape(bsz, s, MLA_HEADS, MLA_NOPE + MLA_ROPE)
    kv = (rmsnorm(ckv, kv_norm) @ w_ukv).reshape(bsz, s, MLA_HEADS, MLA_NOPE + MLA_V)
    q_nope, q_rope = jnp.split(q.astype(f32), [MLA_NOPE], axis=-1)
    k_nope, val = jnp.split(kv.astype(f32), [MLA_NOPE], axis=-1)
    q_rope = apply_rope(q_rope, cos, sin)
    k_rope = apply_rope(k_rope[:, :, None, :], cos, sin)[:, :, 0, :]
    scale = (MLA_NOPE + MLA_ROPE) ** -0.5
    qn = jnp.moveaxis(q_nope, 2, 1) * scale
    qr = jnp.moveaxis(q_rope, 2, 1) * scale
    kn = jnp.moveaxis(k_nope, 2, 1)
    vh = jnp.moveaxis(val, 2, 1)
    kpos = jnp.arange(s)

    def one_block(bi):
        start = bi * Q_BLOCK
        qn_b = lax.dynamic_slice_in_dim(qn, start, Q_BLOCK, axis=2)
        qr_b = lax.dynamic_slice_in_dim(qr, start, Q_BLOCK, axis=2)
        scores = (jnp.einsum('bhqd,bhkd->bhqk', qn_b, kn)
                  + jnp.einsum('bhqr,bkr->bhqk', qr_b, k_rope))
        qpos = start + jnp.arange(Q_BLOCK)
        scores = jnp.where(kpos[None, :] <= qpos[:, None], scores, -jnp.inf)
        return jnp.einsum('bhqk,bhkd->bhqd', jax.nn.softmax(scores, axis=-1), vh)

    o = lax.map(one_block, jnp.arange(s // Q_BLOCK))
    o = jnp.transpose(o, (1, 0, 3, 2, 4)).reshape(bsz, s, MLA_HEADS * MLA_V)
    return o.astype(h.dtype) @ w_out


def peer_ffn(h, w_q, sub_keys, u, v):
    bsz, s, d = h.shape
    f32 = jnp.float32
    q = (h @ w_q).astype(f32).reshape(bsz, s, PEER_HEADS, 2, PEER_DKEY // 2)
    scores = jnp.einsum('bshpd,hpnd->bshpn', q, sub_keys.astype(f32))
    s1, i1 = lax.top_k(scores[..., 0, :], PEER_TOPK)
    s2, i2 = lax.top_k(scores[..., 1, :], PEER_TOPK)
    n_cand = PEER_TOPK * PEER_TOPK
    cand = (s1[..., :, None] + s2[..., None, :]).reshape(bsz, s, PEER_HEADS, n_cand)
    cand_idx = (i1[..., :, None] * PEER_NKEYS + i2[..., None, :]).reshape(bsz, s, PEER_HEADS, n_cand)
    top, pos = lax.top_k(cand, PEER_TOPK)
    expert = jnp.take_along_axis(cand_idx, pos, axis=-1)
    gates = jax.nn.softmax(top, axis=-1)
    n_tok = bsz * s
    n_sel = PEER_HEADS * PEER_TOPK
    n_chunk = n_tok // PEER_TOK_CHUNK
    h_c = h.reshape(n_chunk, PEER_TOK_CHUNK, d)
    e_c = expert.reshape(n_chunk, PEER_TOK_CHUNK, n_sel)
    g_c = gates.reshape(n_chunk, PEER_TOK_CHUNK, n_sel)

    def one_chunk(args):
        hc, ec, gc = args
        act = jax.nn.gelu(jnp.einsum('td,ted->te', hc, u[ec]).astype(f32), approximate=False)
        return jnp.einsum('te,ted->td', (gc * act).astype(v.dtype), v[ec])

    out = lax.map(one_chunk, (h_c, e_c, g_c))
    return out.reshape(bsz, s, d).astype(h.dtype)


def setup_inputs(seed: int = 0) -> dict:
    key = jax.random.key(seed)
    ks = jax.random.split(key, 24)
    f32 = jnp.float32
    D = D_MODEL

    def nrm(k, shape, scale):
        return jax.random.normal(k, shape, f32) * scale

    def gain(k, shape):
        return 1.0 + 0.02 * jax.random.normal(k, shape, f32)

    dt = jnp.exp(jax.random.uniform(ks[9], (N_EVEN, GDN_HEADS), f32, math.log(1e-3), math.log(1e-1)))
    return {
        'x': nrm(ks[0], (BATCH, SEQ, D), 1.0),
        'c': nrm(ks[1], (BATCH, D), 1.0),
        'positions': jnp.broadcast_to(jnp.arange(SEQ, dtype=jnp.int32), (BATCH, SEQ)),
        'mod_w': nrm(ks[2], (DEPTH, D, 6 * D), 0.5 * D ** -0.5),
        'mod_b': nrm(ks[3], (DEPTH, 6 * D), 0.02),
        'norm_mix': gain(ks[4], (DEPTH, D)),
        'norm_ffn': gain(ks[5], (DEPTH, D)),
        'hy_w_in': nrm(ks[6], (N_EVEN, D, HY_IN), D ** -0.5),
        'gdn_conv': nrm(ks[7], (N_EVEN, GDN_CONV, GDN_CONV_CH), GDN_CONV ** -0.5),
        'gdn_a_log': jnp.log(jax.random.uniform(ks[8], (N_EVEN, GDN_HEADS), f32, 1.0, 16.0)),
        'gdn_dt_bias': dt + jnp.log(-jnp.expm1(-dt)),
        'gdn_o_norm': gain(ks[10], (N_EVEN, GDN_DV)),
        'hy_w_out': nrm(ks[11], (N_EVEN, HY_OUT, D), HY_OUT ** -0.5),
        'mla_w_in': nrm(ks[12], (N_ODD, D, MLA_IN), D ** -0.5),
        'mla_q_norm': gain(ks[13], (N_ODD, MLA_Q_RANK)),
        'mla_kv_norm': gain(ks[14], (N_ODD, MLA_KV_RANK)),
        'mla_w_uq': nrm(ks[15], (N_ODD, MLA_Q_RANK, MLA_HEADS * (MLA_NOPE + MLA_ROPE)), MLA_Q_RANK ** -0.5),
        'mla_w_ukv': nrm(ks[16], (N_ODD, MLA_KV_RANK, MLA_HEADS * (MLA_NOPE + MLA_V)), MLA_KV_RANK ** -0.5),
        'mla_w_out': nrm(ks[17], (N_ODD, MLA_HEADS * MLA_V, D), (MLA_HEADS * MLA_V) ** -0.5),
        'peer_w_q': nrm(ks[18], (DEPTH, D, PEER_HEADS * PEER_DKEY), D ** -0.5),
        'peer_sub_keys': nrm(ks[19], (DEPTH, PEER_HEADS, 2, PEER_NKEYS, PEER_DKEY // 2), (PEER_DKEY // 2) ** -0.5),
        'peer_u': nrm(ks[20], (DEPTH, PEER_EXPERTS, D), D ** -0.5),
        'peer_v': nrm(ks[21], (DEPTH, PEER_EXPERTS, D), PEER_HEADS ** -0.5),
        'final_norm': gain(ks[22], (D,)),
    }


def reference(x, c, positions, mod_w, mod_b, norm_mix, norm_ffn, hy_w_in, gdn_conv, gdn_a_log,
              gdn_dt_bias, gdn_o_norm, hy_w_out, mla_w_in, mla_q_norm, mla_kv_norm, mla_w_uq,
              mla_w_ukv, mla_w_out, peer_w_q, peer_sub_keys, peer_u, peer_v, final_norm):
    cond = jax.nn.silu(c)
    cos_b, sin_b = rope_tables(positions, MOBA_DH)
    cos_c, sin_c = rope_tables(positions, MLA_ROPE)
    for layer in range(DEPTH):
        mod = cond @ mod_w[layer] + mod_b[layer]
        sh1, sc1, g1, sh2, sc2, g2 = jnp.split(mod[:, None, :], 6, axis=-1)
        h = rmsnorm(x, norm_mix[layer]) * (1.0 + sc1) + sh1
        i = layer // 2
        if layer % 2 == 0:
            y = hybrid_mixer(h, cos_b, sin_b, hy_w_in[i], gdn_conv[i], gdn_a_log[i], gdn_dt_bias[i],
                             gdn_o_norm[i], hy_w_out[i])
        else:
            y = mla_mixer(h, cos_c, sin_c, mla_w_in[i], mla_q_norm[i], mla_kv_norm[i], mla_w_uq[i],
                          mla_w_ukv[i], mla_w_out[i])
        x = x + g1 * y
        h = rmsnorm(x, norm_ffn[layer]) * (1.0 + sc2) + sh2
        x = x + g2 * peer_ffn(h, peer_w_q[layer], peer_sub_keys[layer], peer_u[layer], peer_v[layer])
    return rmsnorm(x, final_norm)
```

```cpp
#include <hip/hip_runtime.h>
#include <stdint.h>
#include <stddef.h>
#include <stdio.h>
#include <string.h>

#define DEV __device__ __forceinline__

constexpr int S = 16384;
constexpr int DM = 1024;
constexpr int HY_IN = 3592;
constexpr int HYN = 3584;
constexpr int NTHREADS = 512;
constexpr int LDS_BYTES = 163840;
constexpr int LDS_USER = 16;

typedef unsigned short bf16_t;
typedef short bf16x8 __attribute__((ext_vector_type(8)));
typedef float f32x4 __attribute__((ext_vector_type(4)));
typedef float f32x16 __attribute__((ext_vector_type(16)));
typedef __bf16 bf16v2 __attribute__((ext_vector_type(2)));
typedef unsigned u32x4 __attribute__((ext_vector_type(4)));
typedef unsigned u32x2 __attribute__((ext_vector_type(2)));
typedef int i32x4 __attribute__((ext_vector_type(4)));

#define XB_TMO      128
#define XB_XCNT(j)  (256  + 64 * (j))
#define XB_XSUB(j)  (1280 + 64 * (j))
#define XB_XGEN(j)  (2304 + 64 * (j))
#define XB_TOP      3328
#define XB_TOPGEN   3392
#define XCD_BAR_WORDS 3456
#define XB_SPIN_CAP (1u << 22)
#define LAS __attribute__((address_space(3)))

__device__ __forceinline__ unsigned xb_ld(unsigned* p)              { return __hip_atomic_load(p, __ATOMIC_RELAXED, __HIP_MEMORY_SCOPE_AGENT); }
__device__ __forceinline__ unsigned xb_add(unsigned* p, unsigned v) { return __hip_atomic_fetch_add(p, v, __ATOMIC_RELAXED, __HIP_MEMORY_SCOPE_AGENT); }
__device__ __forceinline__ unsigned xb_xcc_id() { return (unsigned)__builtin_amdgcn_s_getreg((3 << 11) | 20) & 0xFu; }
#define XB_SPIN(cond, bar) do { unsigned _sp = 0; while (cond) { __builtin_amdgcn_s_sleep(1); \
    if ((++_sp & 255u) == 0u) { if (xb_ld(&(bar)[XB_TMO])) break; if (_sp > XB_SPIN_CAP) { atomicAdd(&(bar)[XB_TMO], 1u); break; } } } } while (0)

struct XcdBarrier { unsigned* bar; unsigned x; volatile LAS unsigned* st; };

__device__ __forceinline__ XcdBarrier xcd_barrier_post(unsigned* bar, volatile LAS unsigned* st) {
    XcdBarrier b; b.bar = bar; b.x = xb_xcc_id(); b.st = st;
    if (threadIdx.x == 0) (void)xb_add(&bar[XB_XCNT(b.x)], 1u);
    return b;
}
__device__ __forceinline__ void xcd_barrier_complete(unsigned* bar, unsigned x, unsigned& nloc, unsigned& nx) {
    const unsigned G = gridDim.x * gridDim.y * gridDim.z;
    unsigned sum, cnt, mine, sp = 0u;
    for (;;) {
        sum = 0u; cnt = 0u; mine = 0u;
#pragma unroll 1
        for (unsigned j = 0; j < 16; ++j) { const unsigned c = xb_ld(&bar[XB_XCNT(j)]); sum += c; cnt += (c > 0u) ? 1u : 0u; mine = (j == x) ? c : mine; }
        if (sum == G) break;
        __builtin_amdgcn_s_sleep(1);
        if ((++sp & 255u) == 0u) { if (xb_ld(&bar[XB_TMO])) break; if (sp > XB_SPIN_CAP) { atomicAdd(&bar[XB_TMO], 1u); break; } }
    }
    nloc = mine > 0u ? mine : 1u; nx = cnt > 0u ? cnt : 1u;
}
__device__ __forceinline__ void xcd_barrier(const XcdBarrier& b) {
    asm volatile("s_waitcnt vmcnt(0)" ::: "memory");
    __syncthreads();
    if (threadIdx.x == 0) {
        unsigned* bar = b.bar;
        __builtin_amdgcn_s_waitcnt(0);
        unsigned nloc = b.st[0], nx = b.st[1];
        if (nloc == 0u) { xcd_barrier_complete(bar, b.x, nloc, nx); b.st[0] = nloc; b.st[1] = nx; }
        const unsigned old = xb_add(&bar[XB_XSUB(b.x)], 1u);
        const unsigned gen = old / nloc;
        if (old + 1u == (gen + 1u) * nloc) {
            __builtin_amdgcn_fence(__ATOMIC_RELEASE, "agent");
            asm volatile("s_waitcnt vmcnt(0)" ::: "memory");
            const unsigned og = xb_add(&bar[XB_TOP], 1u);
            const unsigned tg = og / nx;
            if (og + 1u == (tg + 1u) * nx) xb_add(&bar[XB_TOPGEN], 1u);
            else XB_SPIN(xb_ld(&bar[XB_TOPGEN]) == tg, bar);
            __builtin_amdgcn_fence(__ATOMIC_ACQUIRE, "agent");
            xb_add(&bar[XB_XGEN(b.x)], 1u);
            asm volatile("s_waitcnt vmcnt(0)" ::: "memory");
        } else {
            XB_SPIN(xb_ld(&bar[XB_XGEN(b.x)]) == gen, bar);
            __builtin_amdgcn_fence(__ATOMIC_ACQUIRE, "agent");
            asm volatile("s_waitcnt vmcnt(0)" ::: "memory");
        }
    }
    __syncthreads();
}

DEV int opaque_bid() { int b = blockIdx.x; asm volatile("" : "+s"(b)); return b; }
DEV int opaque_tid() { int t = threadIdx.x; asm volatile("" : "+v"(t)); return t & (NTHREADS - 1); }
DEV bf16_t f2bf(float f) { unsigned u = __float_as_uint(f); u += 0x7FFFu + ((u >> 16) & 1u); return (bf16_t)(u >> 16); }
DEV unsigned pk2(float a, float b) { return (unsigned)f2bf(a) | ((unsigned)f2bf(b) << 16); }
DEV float bflo(unsigned u) { return __uint_as_float(u << 16); }
DEV float bfhi(unsigned u) { return __uint_as_float(u & 0xffff0000u); }
DEV float wsum64(float v) {
#pragma unroll
    for (int o = 32; o; o >>= 1) v += __shfl_xor(v, o);
    return v;
}
DEV f32x4 mfma16(bf16x8 a, bf16x8 b, f32x4 c) { return __builtin_amdgcn_mfma_f32_16x16x32_bf16(a, b, c, 0, 0, 0); }
DEV f32x16 mfma32(bf16x8 a, bf16x8 b, f32x16 c) { return __builtin_amdgcn_mfma_f32_32x32x16_bf16(a, b, c, 0, 0, 0); }
DEV float siluf(float v) { return v / (1.f + expf(-v)); }
DEV float softplusf(float v) { return fmaxf(v, 0.f) + log1pf(expf(-fabsf(v))); }
DEV float ex2(float v) { return __builtin_amdgcn_exp2f(v); }

struct Params {
    const float* x; const float* c; const int* pos; const float* mod_w; const float* mod_b; const float* norm_mix; const float* norm_ffn;
    const float* hy_w_in; const float* gdn_conv; const float* gdn_a_log; const float* gdn_dt_bias; const float* gdn_o_norm; const float* hy_w_out;
    const float* mla_w_in; const float* mla_q_norm; const float* mla_kv_norm; const float* mla_w_uq; const float* mla_w_ukv; const float* mla_w_out;
    const float* peer_w_q; const float* peer_sub_keys; const float* peer_u; const float* peer_v; const float* final_norm;
    float* out; char* ws;
    int ph_lo, ph_hi, use_bar, pad0;
    DEV unsigned* bar() const { return (unsigned*)(ws + 0ull); }
    DEV float* mod() const { return (float*)(ws + 16384ull); }
    DEV float* cosB() const { return (float*)(ws + 114688ull); }
    DEV float* sinB() const { return (float*)(ws + 4308992ull); }
    DEV float* cosC() const { return (float*)(ws + 8503296ull); }
    DEV float* sinC() const { return (float*)(ws + 10600448ull); }
    DEV bf16_t* w_hy_in() const { return (bf16_t*)(ws + 12697600ull); }
    DEV bf16_t* w_hy_out() const { return (bf16_t*)(ws + 27377664ull); }
    DEV bf16_t* w_mla_in() const { return (bf16_t*)(ws + 31571968ull); }
    DEV bf16_t* w_uq() const { return (bf16_t*)(ws + 35241984ull); }
    DEV bf16_t* w_ukv() const { return (bf16_t*)(ws + 38387712ull); }
    DEV bf16_t* w_mla_out() const { return (bf16_t*)(ws + 40484864ull); }
    DEV bf16_t* w_pq() const { return (bf16_t*)(ws + 44679168ull); }
    DEV bf16_t* skb() const { return (bf16_t*)(ws + 61456384ull); }
    DEV bf16_t* ub() const { return (bf16_t*)(ws + 63553536ull); }
    DEV bf16_t* vb() const { return (bf16_t*)(ws + 197771264ull); }
    DEV float* xw() const { return (float*)(ws + 331988992ull); }
    DEV bf16_t* h() const { return (bf16_t*)(ws + 399097856ull); }
    DEV bf16_t* cat() const { return (bf16_t*)(ws + 432652288ull); }
    DEV bf16_t* proj_a() const { return (bf16_t*)(ws + 466206720ull); }
    DEV bf16_t* zbuf() const { return (bf16_t*)(ws + 516538368ull); }
    DEV bf16_t* Qb() const { return (bf16_t*)(ws + 533315584ull); }
    DEV bf16_t* Kb() const { return (bf16_t*)(ws + 550092800ull); }
    DEV bf16_t* VbT() const { return (bf16_t*)(ws + 566870016ull); }
    DEV float* ba() const { return (float*)(ws + 583647232ull); }
    DEV float* u32() const { return (float*)(ws + 584171520ull); }
    DEV bf16_t* wneg() const { return (bf16_t*)(ws + 617725952ull); }
    DEV bf16_t* qdec() const { return (bf16_t*)(ws + 634503168ull); }
    DEV bf16_t* kdT() const { return (bf16_t*)(ws + 651280384ull); }
    DEV bf16_t* qk() const { return (bf16_t*)(ws + 668057600ull); }
    DEV float* glast() const { return (float*)(ws + 676446208ull); }
    DEV float* oa() const { return (float*)(ws + 676450304ull); }
    DEV float* kmean() const { return (float*)(ws + 710004736ull); }
    DEV int* segcnt() const { return (int*)(ws + 710135808ull); }
    DEV int* lists() const { return (int*)(ws + 710168576ull); }
    DEV float* part() const { return (float*)(ws + 726945792ull); }
    DEV float* ml() const { return (float*)(ws + 861163520ull); }
    DEV bf16_t* cbuf() const { return (bf16_t*)(ws + 466206720ull); }
    DEV bf16_t* Kr() const { return (bf16_t*)(ws + 491372544ull); }
    DEV bf16_t* cqn() const { return (bf16_t*)(ws + 493469696ull); }
    DEV bf16_t* ckvn() const { return (bf16_t*)(ws + 510246912ull); }
    DEV bf16_t* Qm() const { return (bf16_t*)(ws + 518635520ull); }
    DEV bf16_t* Kn() const { return (bf16_t*)(ws + 568967168ull); }
    DEV bf16_t* VmT() const { return (bf16_t*)(ws + 602521600ull); }
    DEV bf16_t* qbuf() const { return (bf16_t*)(ws + 466206720ull); }
    DEV int* expert() const { return (int*)(ws + 533315584ull); }
    DEV float* gate() const { return (float*)(ws + 541704192ull); }
};
constexpr size_t WS_NEED = 863260672ull;


template <class Map>
DEV void transpose_conv(const float* __restrict__ src, int K, int ldsrc, bf16_t* __restrict__ dst, int Nd, Map map, char* smem, int& base) {
    float* T = (float*)smem;
    const int tid = opaque_tid(), nb = gridDim.x, b = opaque_bid();
    const int ntk = K / 64, ntn = Nd / 64, nun = ntk * ntn;
    int first = ((b - (base % nb)) % nb + nb) % nb;
    for (int u = first; u < nun; u += nb) {
        const int tk = u % ntk, tn = u / ntk;
        __syncthreads();
#pragma unroll
        for (int i = 0; i < 8; ++i) {
            const int kk = (tid >> 6) + 8 * i, nn = tid & 63;
            const int sc = map(tn * 64 + nn);
            float v = 0.f;
            if (sc >= 0) v = src[(size_t)(tk * 64 + kk) * ldsrc + sc];
            T[kk * 65 + nn] = v;
        }
        __syncthreads();
#pragma unroll
        for (int i = 0; i < 8; ++i) {
            const int nn = (tid >> 6) + 8 * i, kk = tid & 63;
            dst[(size_t)(tn * 64 + nn) * K + tk * 64 + kk] = f2bf(T[kk * 65 + nn]);
        }
    }
    base += nun;
}

DEV void convert_bf16(const float* __restrict__ src, bf16_t* __restrict__ dst, size_t n) {
    const size_t n8 = n / 8;
    for (size_t i = (size_t)opaque_bid() * NTHREADS + opaque_tid(); i < n8; i += (size_t)gridDim.x * NTHREADS) {
        const f32x4 a = *(const f32x4*)(src + i * 8), b = *(const f32x4*)(src + i * 8 + 4);
        u32x4 o; o.x = pk2(a[0], a[1]); o.y = pk2(a[2], a[3]); o.z = pk2(b[0], b[1]); o.w = pk2(b[2], b[3]);
        *(u32x4*)(dst + i * 8) = o;
    }
}

DEV void phase_prologue(const Params& p, char* smem) {
    const int tid = opaque_tid(), nb = gridDim.x, b = opaque_bid();
    {
        float* cond = (float*)smem; float* red = cond + 1024;
        for (int i = tid; i < 1024; i += NTHREADS) cond[i] = siluf(p.c[i]);
        __syncthreads();
        for (int u = b; u < 192; u += nb) {
            const int n = u * 128, layer = n / 6144, nn = n - layer * 6144;
            const int cg = tid & 31, ks = tid >> 5;
            const float* wp = p.mod_w + ((size_t)layer * 1024 + ks * 64) * 6144 + nn + cg * 4;
            f32x4 acc = {0.f, 0.f, 0.f, 0.f};
#pragma unroll 8
            for (int k = 0; k < 64; ++k) { const f32x4 w = *(const f32x4*)(wp + (size_t)k * 6144); const float cv = cond[ks * 64 + k]; acc += w * cv; }
            *(f32x4*)(red + ks * 128 + cg * 4) = acc;
            __syncthreads();
            if (tid < 128) { float s = p.mod_b[n + tid]; for (int q = 0; q < 16; ++q) s += red[q * 128 + tid]; p.mod()[n + tid] = s; }
            __syncthreads();
        }
    }
    for (size_t i = (size_t)b * NTHREADS + tid; i < (size_t)S * 64; i += (size_t)nb * NTHREADS) {
        const int s = (int)(i >> 6), f = (int)(i & 63);
        const float invf = powf(10000.f, -(float)(2 * f) / 128.f);
        const float ang = (float)p.pos[s] * invf;
        float sn, cs; sincosf(ang, &sn, &cs);
        p.cosB()[i] = cs; p.sinB()[i] = sn;
    }
    for (size_t i = (size_t)b * NTHREADS + tid; i < (size_t)S * 32; i += (size_t)nb * NTHREADS) {
        const int s = (int)(i >> 5), f = (int)(i & 31);
        const float invf = powf(10000.f, -(float)(2 * f) / 64.f);
        const float ang = (float)p.pos[s] * invf;
        float sn, cs; sincosf(ang, &sn, &cs);
        p.cosC()[i] = cs; p.sinC()[i] = sn;
    }
    int base = 0;
    for (int i = 0; i < 2; ++i) {
        transpose_conv(p.hy_w_in + (size_t)i * 1024 * HY_IN, 1024, HY_IN, p.w_hy_in() + (size_t)i * HYN * 1024, HYN,
            [](int n) -> int {
                if (n < 2048) return n;
                const int seg = (n - 2048) >> 9, r = (n - 2048) & 511, sb = 2056 + seg * 512;
                if (seg < 2) { const int hd = r >> 7, dp = r & 127; const int d = (dp & 1) ? 64 + (dp >> 1) : (dp >> 1); return sb + hd * 128 + d; }
                return sb + r;
            }, smem, base);
        transpose_conv(p.hy_w_out + (size_t)i * 1024 * 1024, 1024, 1024, p.w_hy_out() + (size_t)i * 1024 * 1024, 1024, [](int n) -> int { return n; }, smem, base);
        transpose_conv(p.mla_w_in + (size_t)i * 1024 * 832, 1024, 832, p.w_mla_in() + (size_t)i * 896 * 1024, 896,
            [](int n) -> int {
                if (n < 768) return n;
                if (n < 832) { const int dp = n - 768; const int d = (dp & 1) ? 32 + (dp >> 1) : (dp >> 1); return 768 + d; }
                return -1;
            }, smem, base);
        transpose_conv(p.mla_w_uq + (size_t)i * 512 * 1536, 512, 1536, p.w_uq() + (size_t)i * 1536 * 512, 1536,
            [](int n) -> int {
                const int hd = n / 192, d = n % 192;
                if (d < 128) return n;
                const int dp = d - 128; const int dd = (dp & 1) ? 32 + (dp >> 1) : (dp >> 1);
                return hd * 192 + 128 + dd;
            }, smem, base);
        transpose_conv(p.mla_w_ukv + (size_t)i * 256 * 2048, 256, 2048, p.w_ukv() + (size_t)i * 2048 * 256, 2048,
            [](int n) -> int {
                if (n < 1024) { const int hd = n >> 7, d = n & 127; return hd * 256 + d; }
                const int m = n - 1024; const int hd = m >> 7, d = m & 127; return hd * 256 + 128 + d;
            }, smem, base);
        transpose_conv(p.mla_w_out + (size_t)i * 1024 * 1024, 1024, 1024, p.w_mla_out() + (size_t)i * 1024 * 1024, 1024, [](int n) -> int { return n; }, smem, base);
    }
    for (int i = 0; i < 4; ++i)
        transpose_conv(p.peer_w_q + (size_t)i * 1024 * 2048, 1024, 2048, p.w_pq() + (size_t)i * 2048 * 1024, 2048, [](int n) -> int { return n; }, smem, base);
    convert_bf16(p.peer_sub_keys, p.skb(), (size_t)4 * 8 * 2 * 128 * 128);
    convert_bf16(p.peer_u, p.ub(), (size_t)4 * 16384 * 1024);
    convert_bf16(p.peer_v, p.vb(), (size_t)4 * 16384 * 1024);
}

template <int MODE>
DEV void phase_norm(const float* __restrict__ xs, const float* __restrict__ nw, const float* __restrict__ shv, const float* __restrict__ scv,
                    bf16_t* __restrict__ hout, float* __restrict__ fout, const float* __restrict__ w8src, float* __restrict__ ba, char* smem) {
    const int tid = opaque_tid(), lane = tid & 63, w = __builtin_amdgcn_readfirstlane(tid >> 6);
    float* W8 = (float*)smem;
    if (MODE == 1) {
        for (int i = tid; i < 8192; i += NTHREADS) { const int k = i >> 3, c = i & 7; W8[c * 1024 + k] = w8src[(size_t)k * HY_IN + 2048 + c]; }
        __syncthreads();
    }
    f32x4 wm[4], sh[4];
#pragma unroll
    for (int i = 0; i < 4; ++i) {
        const int e = (i * 64 + lane) * 4;
        const f32x4 nv = *(const f32x4*)(nw + e);
        if (MODE == 2) { wm[i] = nv; sh[i] = (f32x4){0.f, 0.f, 0.f, 0.f}; }
        else { const f32x4 sc = *(const f32x4*)(scv + e); wm[i] = nv * (sc + 1.0f); sh[i] = *(const f32x4*)(shv + e); }
    }
    for (int row = opaque_bid() * 8 + w; row < S; row += gridDim.x * 8) {
        f32x4 v[4]; float ss = 0.f;
#pragma unroll
        for (int i = 0; i < 4; ++i) { v[i] = *(const f32x4*)(xs + (size_t)row * DM + (i * 64 + lane) * 4); ss += v[i][0] * v[i][0] + v[i][1] * v[i][1] + v[i][2] * v[i][2] + v[i][3] * v[i][3]; }
        ss = wsum64(ss);
        const float rn = rsqrtf(ss * (1.f / 1024.f) + 1e-6f);
#pragma unroll
        for (int i = 0; i < 4; ++i) v[i] = v[i] * rn * wm[i] + sh[i];
        if (MODE == 2) {
#pragma unroll
            for (int i = 0; i < 4; ++i) *(f32x4*)(fout + (size_t)row * DM + (i * 64 + lane) * 4) = v[i];
        } else {
#pragma unroll
            for (int i = 0; i < 4; ++i) { u32x2 o; o.x = pk2(v[i][0], v[i][1]); o.y = pk2(v[i][2], v[i][3]); *(u32x2*)(hout + (size_t)row * DM + (i * 64 + lane) * 4) = o; }
        }
        if (MODE == 1) {
            float pc[8];
#pragma unroll
            for (int c = 0; c < 8; ++c) {
                float a = 0.f;
#pragma unroll
                for (int i = 0; i < 4; ++i) { const f32x4 ww = *(const f32x4*)(W8 + c * 1024 + (i * 64 + lane) * 4); a += v[i][0] * ww[0] + v[i][1] * ww[1] + v[i][2] * ww[2] + v[i][3] * ww[3]; }
                pc[c] = wsum64(a);
            }
            if (lane == 0) { *(f32x4*)(ba + (size_t)row * 8) = (f32x4){pc[0], pc[1], pc[2], pc[3]}; *(f32x4*)(ba + (size_t)row * 8 + 4) = (f32x4){pc[4], pc[5], pc[6], pc[7]}; }
        }
    }
}

constexpr int GA_RS = 144;
template <class Epi>
DEV void gemm_phase(const bf16_t* __restrict__ A, int lda, const bf16_t* __restrict__ Bt, int ldb, int K, int ntn, char* smem, Epi epi) {
    const int tid = opaque_tid(), lane = tid & 63, w = tid >> 6, wm = w >> 1, wn = w & 1, r = lane & 15, g = lane >> 4;
    char* As = smem; char* Bs = smem + 256 * GA_RS;
    const int nun = 64 * ntn, nk = K / 64;
    for (int u = opaque_bid(); u < nun; u += gridDim.x) {
        const int xcd = u & 7, idx = u >> 3, tn = idx % ntn, tm = xcd * 8 + idx / ntn;
        const int m0 = tm * 256, n0 = tn * 128;
        f32x4 acc[4][4];
#pragma unroll
        for (int i = 0; i < 4; ++i)
#pragma unroll
            for (int j = 0; j < 4; ++j) acc[i][j] = (f32x4){0.f, 0.f, 0.f, 0.f};
        u32x4 ra[4], rb[2];
        const bf16_t* Ap = A + (size_t)(m0 + (tid >> 3)) * lda + (tid & 7) * 8;
        const bf16_t* Bp = Bt + (size_t)(n0 + (tid >> 3)) * ldb + (tid & 7) * 8;
#pragma unroll
        for (int i = 0; i < 4; ++i) ra[i] = *(const u32x4*)(Ap + (size_t)(64 * i) * lda);
#pragma unroll
        for (int i = 0; i < 2; ++i) rb[i] = *(const u32x4*)(Bp + (size_t)(64 * i) * ldb);
        for (int kt = 0; kt < nk; ++kt) {
            __syncthreads();
#pragma unroll
            for (int i = 0; i < 4; ++i) *(u32x4*)(As + ((tid >> 3) + 64 * i) * GA_RS + (tid & 7) * 16) = ra[i];
#pragma unroll
            for (int i = 0; i < 2; ++i) *(u32x4*)(Bs + ((tid >> 3) + 64 * i) * GA_RS + (tid & 7) * 16) = rb[i];
            __syncthreads();
            if (kt + 1 < nk) {
                const int k0 = (kt + 1) * 64;
#pragma unroll
                for (int i = 0; i < 4; ++i) ra[i] = *(const u32x4*)(Ap + (size_t)(64 * i) * lda + k0);
#pragma unroll
                for (int i = 0; i < 2; ++i) rb[i] = *(const u32x4*)(Bp + (size_t)(64 * i) * ldb + k0);
            }
#pragma unroll
            for (int ks = 0; ks < 2; ++ks) {
                bf16x8 af[4], bfr[4];
#pragma unroll
                for (int mt = 0; mt < 4; ++mt) af[mt] = *(const bf16x8*)(As + (64 * wm + 16 * mt + r) * GA_RS + (32 * ks + 8 * g) * 2);
#pragma unroll
                for (int nt = 0; nt < 4; ++nt) bfr[nt] = *(const bf16x8*)(Bs + (64 * wn + 16 * nt + r) * GA_RS + (32 * ks + 8 * g) * 2);
#pragma unroll
                for (int mt = 0; mt < 4; ++mt)
#pragma unroll
                    for (int nt = 0; nt < 4; ++nt) acc[mt][nt] = mfma16(bfr[nt], af[mt], acc[mt][nt]);
            }
        }
        epi(acc, m0 + 64 * wm + r, n0 + 64 * wn + 4 * g, n0);
    }
}

DEV void st_bf4(bf16_t* p, f32x4 v) { u32x2 o; o.x = pk2(v[0], v[1]); o.y = pk2(v[2], v[3]); *(u32x2*)p = o; }
DEV f32x4 rope4(f32x4 v, const float* cs, const float* sn, int fi) {
    const float c0 = cs[fi], s0 = sn[fi], c1 = cs[fi + 1], s1 = sn[fi + 1];
    f32x4 o; o[0] = v[0] * c0 - v[1] * s0; o[1] = v[1] * c0 + v[0] * s0; o[2] = v[2] * c1 - v[3] * s1; o[3] = v[3] * c1 + v[2] * s1; return o;
}

template <int DQK>
DEV void attn_run(const bf16_t* __restrict__ qrow, bool wactive, const bf16_t* __restrict__ Kn, const bf16_t* __restrict__ Kr,
                  const bf16_t* __restrict__ VT, int t_lo, int t_hi, int qpos, int wqmin, int wqmax, char* smem,
                  f32x16 (&o)[4], float& mrun, float& lrun) {
    constexpr int KRS = (DQK + 8) * 2;
    constexpr int VRS = 136;
    constexpr int NKS = DQK / 16;
    constexpr int QREG = (DQK == 192) ? 4 : NKS;
    char* Ks = smem; char* Vs = smem + 64 * KRS; char* Qs = smem + 64 * KRS + 128 * VRS;
    const int tid = opaque_tid(), lane = tid & 63, c = lane & 31, hi = lane >> 5;
    bf16x8 qf[QREG];
#pragma unroll
    for (int ks = 0; ks < QREG; ++ks) qf[ks] = *(const bf16x8*)(qrow + 16 * ks + 8 * hi);
    char* Qw = Qs + (tid >> 6) * ((NKS - QREG) * 1024) + lane * 16;
#pragma unroll
    for (int ks = QREG; ks < NKS; ++ks) *(bf16x8*)(Qw + (ks - QREG) * 1024) = *(const bf16x8*)(qrow + 16 * ks + 8 * hi);
#pragma unroll
    for (int i = 0; i < 4; ++i)
#pragma unroll
        for (int rr = 0; rr < 16; ++rr) o[i][rr] = 0.f;
    mrun = -1e30f; lrun = 0.f;
    constexpr bool ROPE = (DQK == 192);
    u32x4 kreg[2], rreg, vreg[2];
    auto gload = [&](int t) {
        int t2 = tid; asm volatile("" : "+v"(t2));
        const char* kn_t = (const char*)Kn + (size_t)t * (64 * 256);
        const char* vt_t = (const char*)VT + (size_t)t * 128;
#pragma unroll
        for (int i = 0; i < 2; ++i) {
            const int ch = t2 + NTHREADS * i;
            kreg[i] = *(const u32x4*)(kn_t + (unsigned)((ch >> 4) * 256 + (ch & 15) * 16));
            vreg[i] = *(const u32x4*)(vt_t + (unsigned)((ch >> 3) * (S * 2) + (ch & 7) * 16));
        }
        if (ROPE) { const char* kr_t = (const char*)Kr + (size_t)t * (64 * 128); rreg = *(const u32x4*)(kr_t + (unsigned)((t2 >> 3) * 128 + (t2 & 7) * 16)); }
    };
    gload(t_lo);
    for (int t = t_lo; t < t_hi; ++t) {
        __syncthreads();
        {
            int t2 = tid; asm volatile("" : "+v"(t2));
#pragma unroll
            for (int i = 0; i < 2; ++i) {
                const int ch = t2 + NTHREADS * i;
                *(u32x4*)(Ks + (ch >> 4) * KRS + (ch & 15) * 16) = kreg[i];
                u32x2* d = (u32x2*)(Vs + (ch >> 3) * VRS + (ch & 7) * 16);
                d[0] = (u32x2){vreg[i].x, vreg[i].y}; d[1] = (u32x2){vreg[i].z, vreg[i].w};
            }
            if (ROPE) *(u32x4*)(Ks + (t2 >> 3) * KRS + 256 + (t2 & 7) * 16) = rreg;
        }
        __syncthreads();
        if (t + 1 < t_hi) gload(t + 1);
        const int kb = t * 64;
        if (wactive && kb <= wqmax) {
            f32x16 st[2];
#pragma unroll
            for (int kt = 0; kt < 2; ++kt)
#pragma unroll
                for (int rr = 0; rr < 16; ++rr) st[kt][rr] = 0.f;
#pragma unroll
            for (int ks = 0; ks < NKS; ++ks) {
                bf16x8 qv;
                if (ks < QREG) qv = qf[ks < QREG ? ks : 0]; else qv = *(const bf16x8*)(Qw + (ks - QREG) * 1024);
#pragma unroll
                for (int kt = 0; kt < 2; ++kt) {
                    const bf16x8 kf = *(const bf16x8*)(Ks + (32 * kt + c) * KRS + (16 * ks + 8 * hi) * 2);
                    st[kt] = mfma32(kf, qv, st[kt]);
                }
                if ((ks & 1) == 1) __builtin_amdgcn_sched_barrier(0);
            }
            if (kb + 63 > wqmin) {
#pragma unroll
                for (int kt = 0; kt < 2; ++kt)
#pragma unroll
                    for (int rr = 0; rr < 16; ++rr) { const int key = kb + 32 * kt + (rr & 3) + 8 * (rr >> 2) + 4 * hi; if (key > qpos) st[kt][rr] = -__builtin_inff(); }
            }
            float tmax = st[0][0];
#pragma unroll
            for (int rr = 1; rr < 16; ++rr) tmax = fmaxf(tmax, st[0][rr]);
#pragma unroll
            for (int rr = 0; rr < 16; ++rr) tmax = fmaxf(tmax, st[1][rr]);
            tmax = fmaxf(tmax, __shfl_xor(tmax, 32));
            const float mnew = fmaxf(mrun, tmax);
            const float alpha = ex2(mrun - mnew);
            mrun = mnew;
            lrun *= alpha;
#pragma unroll
            for (int i = 0; i < 4; ++i)
#pragma unroll
                for (int rr = 0; rr < 16; ++rr) o[i][rr] *= alpha;
            float ps = 0.f;
#pragma unroll
            for (int kt = 0; kt < 2; ++kt)
#pragma unroll
                for (int rr = 0; rr < 16; ++rr) { const float pv = ex2(st[kt][rr] - mnew); st[kt][rr] = pv; ps += pv; }
            lrun += ps;
#pragma unroll
            for (int kt = 0; kt < 2; ++kt)
#pragma unroll
                for (int s2 = 0; s2 < 2; ++s2) {
                    u32x4 pw; pw.x = pk2(st[kt][8 * s2 + 0], st[kt][8 * s2 + 1]); pw.y = pk2(st[kt][8 * s2 + 2], st[kt][8 * s2 + 3]);
                    pw.z = pk2(st[kt][8 * s2 + 4], st[kt][8 * s2 + 5]); pw.w = pk2(st[kt][8 * s2 + 6], st[kt][8 * s2 + 7]);
                    const bf16x8 pf = *(const bf16x8*)&pw;
#pragma unroll
                    for (int dvt = 0; dvt < 4; ++dvt) {
                        const char* vb = Vs + (32 * dvt + c) * VRS + (32 * kt + 16 * s2 + 4 * hi) * 2;
                        const u32x2 v0 = *(const u32x2*)vb, v1 = *(const u32x2*)(vb + 16);
                        u32x4 vw; vw.x = v0.x; vw.y = v0.y; vw.z = v1.x; vw.w = v1.y;
                        o[dvt] = mfma32(*(const bf16x8*)&vw, pf, o[dvt]);
                    }
                    __builtin_amdgcn_sched_barrier(0);
                }
        }
    }
    lrun += __shfl_xor(lrun, 32);
}

DEV void phase_mla_attn(const Params& p, char* smem) {
    const int tid = opaque_tid(), lane = tid & 63, w = tid >> 6, c = lane & 31, hi = lane >> 5;
    for (int u = opaque_bid(); u < 256; u += gridDim.x) {
        const int head = u & 7, pi = u >> 3;
        for (int half = 0; half < 2; ++half) {
            const int qb = half == 0 ? (63 - pi) : pi;
            const int q = qb * 256 + 32 * w + c;
            f32x16 o[4]; float m, l;
            attn_run<192>(p.Qm() + ((size_t)head * S + q) * 192, true, p.Kn() + (size_t)head * S * 128, p.Kr(), p.VmT() + (size_t)head * 128 * S,
                          0, 4 * qb + 4, q, qb * 256 + 32 * w, qb * 256 + 32 * w + 31, smem, o, m, l);
            const float inv = 1.f / l;
#pragma unroll
            for (int dvt = 0; dvt < 4; ++dvt)
#pragma unroll
                for (int rg = 0; rg < 4; ++rg) {
                    const int dv = 32 * dvt + 8 * rg + 4 * hi;
                    f32x4 v = {o[dvt][4 * rg] * inv, o[dvt][4 * rg + 1] * inv, o[dvt][4 * rg + 2] * inv, o[dvt][4 * rg + 3] * inv};
                    st_bf4(p.cat() + (size_t)q * DM + head * 128 + dv, v);
                }
        }
    }
}

DEV void moba_kmean_unit(const Params& p, int h, int j, char* smem) {
    float* red = (float*)smem;
    const int tid = opaque_tid(), d = tid & 127, qq = tid >> 7;
    const bf16_t* kp = p.Kb() + ((size_t)h * S + 256 * j + qq * 64) * 128 + d;
    float s = 0.f;
    for (int t = 0; t < 64; ++t) s += __uint_as_float(((unsigned)kp[(size_t)t * 128]) << 16);
    __syncthreads();
    red[qq * 128 + d] = s;
    __syncthreads();
    if (tid < 128) p.kmean()[((size_t)h * 64 + j) * 128 + tid] = (red[tid] + red[128 + tid] + red[256 + tid] + red[384 + tid]) * (1.f / 256.f);
}

DEV void phase_moba_gate(const Params& p, char* smem) {
    float* km = (float*)smem;
    int* cnt = (int*)(smem + 32768);
    const int tid = opaque_tid();
    for (int u = opaque_bid(); u < 128; u += gridDim.x) {
        const int h = u & 3, t = u >> 2;
        __syncthreads();
        for (int i = tid; i < 8192; i += NTHREADS) km[i] = p.kmean()[(size_t)h * 8192 + i];
        if (tid < 64) cnt[tid] = 0;
        __syncthreads();
        const int q = t * 512 + tid, own = q >> 8;
        float qv[128];
        const u32x4* qp = (const u32x4*)(p.Qb() + ((size_t)h * S + q) * 128);
#pragma unroll
        for (int i = 0; i < 16; ++i) { const u32x4 v = qp[i]; qv[8 * i] = bflo(v.x); qv[8 * i + 1] = bfhi(v.x); qv[8 * i + 2] = bflo(v.y); qv[8 * i + 3] = bfhi(v.y); qv[8 * i + 4] = bflo(v.z); qv[8 * i + 5] = bfhi(v.z); qv[8 * i + 6] = bflo(v.w); qv[8 * i + 7] = bfhi(v.w); }
        float b0 = -__builtin_inff(), b1 = b0, b2 = b0; int i0 = 0, i1 = 0, i2 = 0;
        const int ownw = __builtin_amdgcn_readfirstlane(own);
        for (int j = 0; j < ownw; ++j) {
            float s = 0.f; const f32x4* kp = (const f32x4*)(km + j * 128);
#pragma unroll
            for (int d4 = 0; d4 < 32; ++d4) { const f32x4 kk = kp[d4]; s += qv[4 * d4] * kk[0] + qv[4 * d4 + 1] * kk[1] + qv[4 * d4 + 2] * kk[2] + qv[4 * d4 + 3] * kk[3]; }
            if (s > b0) { b2 = b1; i2 = i1; b1 = b0; i1 = i0; b0 = s; i0 = j; }
            else if (s > b1) { b2 = b1; i2 = i1; b1 = s; i1 = j; }
            else if (s > b2) { b2 = s; i2 = j; }
        }
        const int nsel = own < 3 ? own : 3;
        if (0 < nsel) { const int pos = atomicAdd(&cnt[i0], 1); p.lists()[(((size_t)h * 64 + i0) * 32 + t) * 512 + pos] = (q << 2) | 0; }
        if (1 < nsel) { const int pos = atomicAdd(&cnt[i1], 1); p.lists()[(((size_t)h * 64 + i1) * 32 + t) * 512 + pos] = (q << 2) | 1; }
        if (2 < nsel) { const int pos = atomicAdd(&cnt[i2], 1); p.lists()[(((size_t)h * 64 + i2) * 32 + t) * 512 + pos] = (q << 2) | 2; }
        __syncthreads();
        if (tid < 64) p.segcnt()[((size_t)h * 64 + tid) * 32 + t] = cnt[tid];
    }
}

DEV void moba_write_partial(const Params& p, int q, int h, int slot, const f32x16 (&o)[4], float m, float l, int hi) {
    float* pp = p.part() + (((size_t)q * 4 + h) * 4 + slot) * 128;
#pragma unroll
    for (int dvt = 0; dvt < 4; ++dvt)
#pragma unroll
        for (int rg = 0; rg < 4; ++rg) {
            const int dv = 32 * dvt + 8 * rg + 4 * hi;
            *(f32x4*)(pp + dv) = (f32x4){o[dvt][4 * rg], o[dvt][4 * rg + 1], o[dvt][4 * rg + 2], o[dvt][4 * rg + 3]};
        }
    if (hi == 0) { float* mp = p.ml() + (((size_t)q * 4 + h) * 4 + slot) * 2; mp[0] = m; mp[1] = l; }
}

DEV void phase_moba_attn(const Params& p, char* smem, int rank, int nwg) {
    const int tid = opaque_tid(), lane = tid & 63, w = tid >> 6, c = lane & 31, hi = lane >> 5;
    int* pre = (int*)(smem + 36864);
    for (int u = rank; u < 256; u += nwg) {
        const int j = u >> 2, h = u & 3;
        const bf16_t* Kh = p.Kb() + (size_t)h * S * 128; const bf16_t* Vh = p.VbT() + (size_t)h * 128 * S;
        {
            const int q = 256 * j + 32 * w + c;
            f32x16 o[4]; float m, l;
            attn_run<128>(p.Qb() + ((size_t)h * S + q) * 128, true, Kh, nullptr, Vh, 4 * j, 4 * j + 4, q, 256 * j + 32 * w, 256 * j + 32 * w + 31, smem, o, m, l);
            moba_write_partial(p, q, h, 3, o, m, l, hi);
        }
        __syncthreads();
        if (tid == 0) { int s = 0; for (int t = 0; t < 32; ++t) { pre[t] = s; s += p.segcnt()[((size_t)h * 64 + j) * 32 + t]; } pre[32] = s; }
        __syncthreads();
        const int total = pre[32];
        for (int k0 = 0; k0 < total; k0 += 256) {
            const int e = k0 + 32 * w + c; const bool valid = e < total; int q = 0, slot = 0;
            if (valid) {
                int seg = 0;
                for (int t = 1; t < 32; ++t) if (pre[t] <= e) seg = t;
                const int ent = p.lists()[(((size_t)h * 64 + j) * 32 + seg) * 512 + (e - pre[seg])];
                q = ent >> 2; slot = ent & 3;
            }
            const bool wact = (k0 + 32 * w) < total;
            f32x16 o[4]; float m, l;
            attn_run<128>(p.Qb() + ((size_t)h * S + q) * 128, wact, Kh, nullptr, Vh, 4 * j, 4 * j + 4, 0x7fffffff, 0x7fffffff, 0x7fffffff, smem, o, m, l);
            if (valid) moba_write_partial(p, q, h, slot, o, m, l, hi);
        }
        __syncthreads();
    }
}

constexpr int GP_KN = 0, GP_KB = 17408, GP_QS = 34816, GP_RF = 52224, GP_LM = 117760, GP_KDT = 135168, GP_GC = 153600, GP_BT = 153856;
DEV void gdn_prep_unit(const Params& p, int li, int n, int h, char* smem) {
    const int tid = opaque_tid(), lane = tid & 63, w = tid >> 6, r = lane & 15, g = lane >> 4;
    char* Kn16 = smem + GP_KN; char* Kb16 = smem + GP_KB; char* Qs16 = smem + GP_QS;
    float* Rf = (float*)(smem + GP_RF); float* Lm = (float*)(smem + GP_LM); char* KdT = smem + GP_KDT;
    float* gc = (float*)(smem + GP_GC); float* bt = (float*)(smem + GP_BT);
    const size_t cb = (size_t)n * 4 + h;
    __syncthreads();
    if (w == 0) {
        const int tok = 64 * n + lane;
        const float a = p.ba()[(size_t)tok * 8 + 4 + h], bb = p.ba()[(size_t)tok * 8 + h];
        float gv = -expf(p.gdn_a_log[li * 4 + h]) * softplusf(a + p.gdn_dt_bias[li * 4 + h]);
#pragma unroll
        for (int o = 1; o < 64; o <<= 1) { const float t = __shfl_up(gv, o); if (lane >= o) gv += t; }
        gc[lane] = gv; bt[lane] = 1.f / (1.f + expf(-bb));
    }
    __syncthreads();
    const float glast = gc[63];
    {
        const int tok = tid >> 3, grp = tid & 7, gt = 64 * n + tok;
        const float gct = gc[tok], btt = bt[tok];
        const float egc = expf(gct), egl = expf(glast - gct);
        const float* cw = p.gdn_conv + (size_t)li * 4 * 1536;
#pragma unroll
        for (int part = 0; part < 3; ++part) {
            const int ch0 = part * 512 + h * 128 + grp * 16;
            float val[16];
#pragma unroll
            for (int i = 0; i < 16; ++i) val[i] = 0.f;
#pragma unroll
            for (int j = 0; j < 4; ++j) {
                const int ts = gt - 3 + j;
                if (ts >= 0) {
                    const u32x4* xp = (const u32x4*)(p.proj_a() + (size_t)ts * 1536 + ch0);
                    const u32x4 x0 = xp[0], x1 = xp[1];
                    const f32x4* wp = (const f32x4*)(cw + (size_t)j * 1536 + ch0);
                    const f32x4 w0 = wp[0], w1 = wp[1], w2 = wp[2], w3 = wp[3];
                    val[0] += bflo(x0.x) * w0[0]; val[1] += bfhi(x0.x) * w0[1]; val[2] += bflo(x0.y) * w0[2]; val[3] += bfhi(x0.y) * w0[3];
                    val[4] += bflo(x0.z) * w1[0]; val[5] += bfhi(x0.z) * w1[1]; val[6] += bflo(x0.w) * w1[2]; val[7] += bfhi(x0.w) * w1[3];
                    val[8] += bflo(x1.x) * w2[0]; val[9] += bfhi(x1.x) * w2[1]; val[10] += bflo(x1.y) * w2[2]; val[11] += bfhi(x1.y) * w2[3];
                    val[12] += bflo(x1.z) * w3[0]; val[13] += bfhi(x1.z) * w3[1]; val[14] += bflo(x1.w) * w3[2]; val[15] += bfhi(x1.w) * w3[3];
                }
            }
#pragma unroll
            for (int i = 0; i < 16; ++i) val[i] = siluf(val[i]);
            if (part < 2) {
                float ss = 0.f;
#pragma unroll
                for (int i = 0; i < 16; ++i) ss += val[i] * val[i];
                ss += __shfl_xor(ss, 1); ss += __shfl_xor(ss, 2); ss += __shfl_xor(ss, 4);
                const float rn = rsqrtf(ss + 1e-6f);
#pragma unroll
                for (int i = 0; i < 16; ++i) val[i] *= rn;
            }
            if (part == 0) {
                const float qs = 0.08838834764831845f;
                u32x4 a0, a1, d0, d1;
                a0.x = pk2(val[0] * qs, val[1] * qs); a0.y = pk2(val[2] * qs, val[3] * qs); a0.z = pk2(val[4] * qs, val[5] * qs); a0.w = pk2(val[6] * qs, val[7] * qs);
                a1.x = pk2(val[8] * qs, val[9] * qs); a1.y = pk2(val[10] * qs, val[11] * qs); a1.z = pk2(val[12] * qs, val[13] * qs); a1.w = pk2(val[14] * qs, val[15] * qs);
                *(u32x4*)(Qs16 + tok * 272 + grp * 32) = a0; *(u32x4*)(Qs16 + tok * 272 + grp * 32 + 16) = a1;
                const float qd = qs * egc;
                d0.x = pk2(val[0] * qd, val[1] * qd); d0.y = pk2(val[2] * qd, val[3] * qd); d0.z = pk2(val[4] * qd, val[5] * qd); d0.w = pk2(val[6] * qd, val[7] * qd);
                d1.x = pk2(val[8] * qd, val[9] * qd); d1.y = pk2(val[10] * qd, val[11] * qd); d1.z = pk2(val[12] * qd, val[13] * qd); d1.w = pk2(val[14] * qd, val[15] * qd);
                u32x4* qo = (u32x4*)(p.qdec() + (cb * 64 + tok) * 128 + grp * 16);
                qo[0] = d0; qo[1] = d1;
            } else if (part == 1) {
                u32x4 a0, a1, d0, d1;
                a0.x = pk2(val[0], val[1]); a0.y = pk2(val[2], val[3]); a0.z = pk2(val[4], val[5]); a0.w = pk2(val[6], val[7]);
                a1.x = pk2(val[8], val[9]); a1.y = pk2(val[10], val[11]); a1.z = pk2(val[12], val[13]); a1.w = pk2(val[14], val[15]);
                *(u32x4*)(Kn16 + tok * 272 + grp * 32) = a0; *(u32x4*)(Kn16 + tok * 272 + grp * 32 + 16) = a1;
                d0.x = pk2(val[0] * btt, val[1] * btt); d0.y = pk2(val[2] * btt, val[3] * btt); d0.z = pk2(val[4] * btt, val[5] * btt); d0.w = pk2(val[6] * btt, val[7] * btt);
                d1.x = pk2(val[8] * btt, val[9] * btt); d1.y = pk2(val[10] * btt, val[11] * btt); d1.z = pk2(val[12] * btt, val[13] * btt); d1.w = pk2(val[14] * btt, val[15] * btt);
                *(u32x4*)(Kb16 + tok * 272 + grp * 32) = d0; *(u32x4*)(Kb16 + tok * 272 + grp * 32 + 16) = d1;
                const float kb = btt * egc;
#pragma unroll
                for (int i = 0; i < 16; ++i) {
                    Rf[tok * 256 + 128 + grp * 16 + i] = val[i] * kb;
                    *(bf16_t*)(KdT + (grp * 16 + i) * 144 + tok * 2) = f2bf(val[i] * egl);
                }
            } else {
#pragma unroll
                for (int i = 0; i < 16; ++i) Rf[tok * 256 + grp * 16 + i] = val[i] * btt;
            }
        }
    }
    __syncthreads();
#pragma unroll
    for (int tt = 0; tt < 2; ++tt) {
        const int tile = 2 * w + tt, ct = tile >> 2, mt = tile & 3;
        f32x4 accL = {0.f, 0.f, 0.f, 0.f}, accQ = {0.f, 0.f, 0.f, 0.f};
#pragma unroll
        for (int ks = 0; ks < 4; ++ks) {
            const bf16x8 akb = *(const bf16x8*)(Kb16 + (16 * ct + r) * 272 + (32 * ks + 8 * g) * 2);
            const bf16x8 knm = *(const bf16x8*)(Kn16 + (16 * mt + r) * 272 + (32 * ks + 8 * g) * 2);
            const bf16x8 qsc = *(const bf16x8*)(Qs16 + (16 * ct + r) * 272 + (32 * ks + 8 * g) * 2);
            accL = mfma16(akb, knm, accL);
            accQ = mfma16(knm, qsc, accQ);
        }
#pragma unroll
        for (int jj = 0; jj < 4; ++jj) {
            const int ci = 16 * ct + 4 * g + jj, mi = 16 * mt + r;
            Lm[ci * 68 + mi] = (mi < ci) ? accL[jj] * expf(gc[ci] - gc[mi]) : 0.f;
        }
        {
            const int ci = 16 * ct + r;
            f32x4 v;
#pragma unroll
            for (int jj = 0; jj < 4; ++jj) { const int mi = 16 * mt + 4 * g + jj; v[jj] = (mi <= ci) ? accQ[jj] * expf(gc[ci] - gc[mi]) : 0.f; }
            st_bf4(p.qk() + (cb * 64 + ci) * 64 + 16 * mt + 4 * g, v);
        }
    }
#pragma unroll
    for (int i = 0; i < 2; ++i) {
        const int ch = tid + NTHREADS * i, row = ch >> 3, cc = ch & 7;
        *(u32x4*)(p.kdT() + (cb * 128 + row) * 64 + cc * 8) = *(const u32x4*)(KdT + row * 144 + cc * 16);
    }
    __syncthreads();
    if (w < 4) {
        const int col = tid;
        float x[64];
#pragma unroll
        for (int i = 0; i < 64; ++i) {
            float a = Rf[i * 256 + col];
#pragma unroll
            for (int j4 = 0; j4 < (i + 3) / 4; ++j4) {
                const f32x4 l4 = *(const f32x4*)(Lm + i * 68 + 4 * j4);
#pragma unroll
                for (int jj = 0; jj < 4; ++jj) if (4 * j4 + jj < i) a -= l4[jj] * x[4 * j4 + jj];
            }
            x[i] = a;
        }
        if (col < 128) {
#pragma unroll
            for (int i = 0; i < 64; ++i) p.u32()[(cb * 64 + i) * 128 + col] = x[i];
        } else {
#pragma unroll
            for (int i = 0; i < 64; ++i) p.wneg()[(cb * 64 + i) * 128 + col - 128] = f2bf(-x[i]);
        }
    }
    if (tid == 0) p.glast()[cb] = glast;
}

struct ScanFr { bf16x8 wf[4], qf[4], qkf[2], kdf[2]; f32x4 u; float eg; };
DEV void gdn_scan(const Params& p, int sw, char* smem) {
    const int tid = opaque_tid(), lane = tid & 63, w = tid >> 6, r = lane & 15, g = lane >> 4, mt = w >> 1, nt = w & 1;
    const int h = sw >> 2, dvb = (sw & 3) * 32;
    char* S16 = smem; char* Vn16 = smem + 8704;
    __syncthreads();
    for (int i = tid; i < 8704 / 4; i += NTHREADS) ((int*)S16)[i] = 0;
    f32x4 sacc[2] = {{0.f, 0.f, 0.f, 0.f}, {0.f, 0.f, 0.f, 0.f}};
    auto load = [&](int n, ScanFr& f) {
        const size_t cb = (size_t)n * 4 + h;
        const bf16_t* wp = p.wneg() + (cb * 64 + 16 * mt + r) * 128 + 8 * g;
        const bf16_t* qp = p.qdec() + (cb * 64 + 16 * mt + r) * 128 + 8 * g;
#pragma unroll
        for (int ks = 0; ks < 4; ++ks) { f.wf[ks] = *(const bf16x8*)(wp + 32 * ks); f.qf[ks] = *(const bf16x8*)(qp + 32 * ks); }
        const bf16_t* qkp = p.qk() + (cb * 64 + 16 * mt + r) * 64 + 8 * g;
        const bf16_t* kp = p.kdT() + (cb * 128 + 16 * w + r) * 64 + 8 * g;
#pragma unroll
        for (int ks = 0; ks < 2; ++ks) { f.qkf[ks] = *(const bf16x8*)(qkp + 32 * ks); f.kdf[ks] = *(const bf16x8*)(kp + 32 * ks); }
        const float* up = p.u32() + (cb * 64 + 16 * mt + 4 * g) * 128 + dvb + 16 * nt + r;
#pragma unroll
        for (int jj = 0; jj < 4; ++jj) f.u[jj] = up[jj * 128];
        f.eg = expf(p.glast()[cb]);
    };
    ScanFr nx; load(0, nx);
    __syncthreads();
    for (int n = 0; n < 256; ++n) {
        ScanFr cu = nx;
        if (n + 1 < 256) load(n + 1, nx);
        f32x4 a1 = cu.u, a2 = {0.f, 0.f, 0.f, 0.f};
#pragma unroll
        for (int ks = 0; ks < 4; ++ks) {
            const bf16x8 sf = *(const bf16x8*)(S16 + (16 * nt + r) * 272 + (32 * ks + 8 * g) * 2);
            a1 = mfma16(cu.wf[ks], sf, a1);
            a2 = mfma16(cu.qf[ks], sf, a2);
        }
        *(u32x2*)(Vn16 + (16 * nt + r) * 144 + (16 * mt + 4 * g) * 2) = (u32x2){pk2(a1[0], a1[1]), pk2(a1[2], a1[3])};
        __syncthreads();
#pragma unroll
        for (int ks = 0; ks < 2; ++ks) {
            const bf16x8 vf = *(const bf16x8*)(Vn16 + (16 * nt + r) * 144 + (32 * ks + 8 * g) * 2);
            a2 = mfma16(cu.qkf[ks], vf, a2);
        }
        {
            float* op = p.oa() + ((size_t)(64 * n + 16 * mt + 4 * g)) * 512 + h * 128 + dvb + 16 * nt + r;
#pragma unroll
            for (int jj = 0; jj < 4; ++jj) op[jj * 512] = a2[jj];
        }
#pragma unroll
        for (int n2 = 0; n2 < 2; ++n2) {
            sacc[n2] = sacc[n2] * cu.eg;
#pragma unroll
            for (int ks = 0; ks < 2; ++ks) {
                const bf16x8 vf = *(const bf16x8*)(Vn16 + (16 * n2 + r) * 144 + (32 * ks + 8 * g) * 2);
                sacc[n2] = mfma16(cu.kdf[ks], vf, sacc[n2]);
            }
            *(u32x2*)(S16 + (16 * n2 + r) * 272 + (16 * w + 4 * g) * 2) = (u32x2){pk2(sacc[n2][0], sacc[n2][1]), pk2(sacc[n2][2], sacc[n2][3])};
        }
        __syncthreads();
    }
}

DEV void phase_even_combine(const Params& p, int li) {
    const int tid = opaque_tid(), lane = tid & 63, w = __builtin_amdgcn_readfirstlane(tid >> 6), hh = lane >> 4, d0 = (lane & 15) * 8;
    for (int tok = opaque_bid() * 8 + w; tok < S; tok += gridDim.x * 8) {
        {
            const float* op = p.oa() + (size_t)tok * 512 + hh * 128 + d0;
            const f32x4 a = *(const f32x4*)op, b = *(const f32x4*)(op + 4);
            float ss = a[0] * a[0] + a[1] * a[1] + a[2] * a[2] + a[3] * a[3] + b[0] * b[0] + b[1] * b[1] + b[2] * b[2] + b[3] * b[3];
            ss += __shfl_xor(ss, 1); ss += __shfl_xor(ss, 2); ss += __shfl_xor(ss, 4); ss += __shfl_xor(ss, 8);
            const float rn = rsqrtf(ss * (1.f / 128.f) + 1e-6f);
            const u32x4 z = *(const u32x4*)(p.zbuf() + (size_t)tok * 512 + hh * 128 + d0);
            const f32x4 n0 = *(const f32x4*)(p.gdn_o_norm + li * 128 + d0), n1 = *(const f32x4*)(p.gdn_o_norm + li * 128 + d0 + 4);
            u32x4 o;
            o.x = pk2(a[0] * rn * n0[0] * siluf(bflo(z.x)), a[1] * rn * n0[1] * siluf(bfhi(z.x)));
            o.y = pk2(a[2] * rn * n0[2] * siluf(bflo(z.y)), a[3] * rn * n0[3] * siluf(bfhi(z.y)));
            o.z = pk2(b[0] * rn * n1[0] * siluf(bflo(z.z)), b[1] * rn * n1[1] * siluf(bfhi(z.z)));
            o.w = pk2(b[2] * rn * n1[2] * siluf(bflo(z.w)), b[3] * rn * n1[3] * siluf(bfhi(z.w)));
            *(u32x4*)(p.cat() + (size_t)tok * DM + hh * 128 + d0) = o;
        }
        {
            const int own = tok >> 8, nsel = own < 3 ? own : 3;
            const float* mlp = p.ml() + ((size_t)tok * 4 + hh) * 8;
            const float* pp = p.part() + ((size_t)tok * 4 + hh) * 4 * 128 + d0;
            const float m3 = mlp[6], l3 = mlp[7];
            float ms[3], ls[3]; float mm = m3;
#pragma unroll
            for (int s = 0; s < 3; ++s) { ms[s] = -1e30f; ls[s] = 0.f; if (s < nsel) { ms[s] = mlp[2 * s]; ls[s] = mlp[2 * s + 1]; mm = fmaxf(mm, ms[s]); } }
            float wt = ex2(m3 - mm), den = wt * l3;
            f32x4 a = *(const f32x4*)(pp + 3 * 128) * wt, b = *(const f32x4*)(pp + 3 * 128 + 4) * wt;
#pragma unroll
            for (int s = 0; s < 3; ++s) if (s < nsel) {
                wt = ex2(ms[s] - mm); den += wt * ls[s];
                a += *(const f32x4*)(pp + s * 128) * wt; b += *(const f32x4*)(pp + s * 128 + 4) * wt;
            }
            const float inv = 1.f / den;
            u32x4 o; o.x = pk2(a[0] * inv, a[1] * inv); o.y = pk2(a[2] * inv, a[3] * inv); o.z = pk2(b[0] * inv, b[1] * inv); o.w = pk2(b[2] * inv, b[3] * inv);
            *(u32x4*)(p.cat() + (size_t)tok * DM + 512 + hh * 128 + d0) = o;
        }
    }
}

DEV void phase_mla_cnorm(const Params& p, int li) {
    const int tid = opaque_tid(), lane = tid & 63, w = __builtin_amdgcn_readfirstlane(tid >> 6);
    for (int row = opaque_bid() * 8 + w; row < S; row += gridDim.x * 8) {
        const bf16_t* cp = p.cbuf() + (size_t)row * 768;
        const u32x4 qv = *(const u32x4*)(cp + lane * 8);
        const u32x2 kv = *(const u32x2*)(cp + 512 + lane * 4);
        float q[8] = {bflo(qv.x), bfhi(qv.x), bflo(qv.y), bfhi(qv.y), bflo(qv.z), bfhi(qv.z), bflo(qv.w), bfhi(qv.w)};
        float k[4] = {bflo(kv.x), bfhi(kv.x), bflo(kv.y), bfhi(kv.y)};
        float sq = 0.f, sk = 0.f;
#pragma unroll
        for (int i = 0; i < 8; ++i) sq += q[i] * q[i];
#pragma unroll
        for (int i = 0; i < 4; ++i) sk += k[i] * k[i];
        sq = wsum64(sq); sk = wsum64(sk);
        const float rq = rsqrtf(sq * (1.f / 512.f) + 1e-6f), rk = rsqrtf(sk * (1.f / 256.f) + 1e-6f);
        const float* qn = p.mla_q_norm + li * 512 + lane * 8; const float* kn = p.mla_kv_norm + li * 256 + lane * 4;
        u32x4 oq; oq.x = pk2(q[0] * rq * qn[0], q[1] * rq * qn[1]); oq.y = pk2(q[2] * rq * qn[2], q[3] * rq * qn[3]);
        oq.z = pk2(q[4] * rq * qn[4], q[5] * rq * qn[5]); oq.w = pk2(q[6] * rq * qn[6], q[7] * rq * qn[7]);
        *(u32x4*)(p.cqn() + (size_t)row * 512 + lane * 8) = oq;
        u32x2 ok; ok.x = pk2(k[0] * rk * kn[0], k[1] * rk * kn[1]); ok.y = pk2(k[2] * rk * kn[2], k[3] * rk * kn[3]);
        *(u32x2*)(p.ckvn() + (size_t)row * 256 + lane * 4) = ok;
    }
}

#define SORT16_NET(CE) CE(0,1) CE(2,3) CE(0,2) CE(1,3) CE(1,2) CE(4,5) CE(6,7) CE(4,6) CE(5,7) CE(5,6) CE(0,4) CE(2,6) CE(2,4) CE(1,5) CE(3,7) CE(3,5) CE(1,2) CE(3,4) CE(5,6) CE(8,9) CE(10,11) CE(8,10) CE(9,11) CE(9,10) CE(12,13) CE(14,15) CE(12,14) CE(13,15) CE(13,14) CE(8,12) CE(10,14) CE(10,12) CE(9,13) CE(11,15) CE(11,13) CE(9,10) CE(11,12) CE(13,14) CE(0,8) CE(4,12) CE(4,8) CE(2,10) CE(6,14) CE(6,10) CE(2,4) CE(6,8) CE(10,12) CE(1,9) CE(5,13) CE(5,9) CE(3,11) CE(7,15) CE(7,11) CE(3,5) CE(7,9) CE(11,13) CE(1,2) CE(3,4) CE(5,6) CE(7,8) CE(9,10) CE(11,12) CE(13,14)

template <int OFF> DEV void sort16(float (&v)[64]) {
#define CE_(a, b) { const float hi_ = fmaxf(v[OFF + a], v[OFF + b]), lo_ = fminf(v[OFF + a], v[OFF + b]); v[OFF + a] = hi_; v[OFF + b] = lo_; }
    SORT16_NET(CE_)
#undef CE_
}
template <int A> DEV void bitonic16(float (&v)[64]) {
#pragma unroll
    for (int d = 8; d >= 1; d >>= 1)
#pragma unroll
        for (int i = 0; i < 16; ++i) if ((i & d) == 0) { const float hi_ = fmaxf(v[A + i], v[A + i + d]), lo_ = fminf(v[A + i], v[A + i + d]); v[A + i] = hi_; v[A + i + d] = lo_; }
}
template <int A, int B> DEV void merge16(float (&v)[64]) {
#pragma unroll
    for (int i = 0; i < 16; ++i) v[A + i] = fmaxf(v[A + i], v[B + 15 - i]);
    bitonic16<A>(v);
}
DEV void top16_of_64(float (&v)[64]) {
    sort16<0>(v); sort16<16>(v); sort16<32>(v); sort16<48>(v);
    merge16<0, 16>(v); merge16<32, 48>(v); merge16<0, 32>(v);
}

DEV void phase_peer_topk(const Params& p, int layer, char* smem) {
    const int tid = opaque_tid(), lane = tid & 63, w = tid >> 6, c = lane & 31, hi = lane >> 5;
    char* SK = smem;
    constexpr int CI[50] = {0,0,0,0,0,0,0,0,0,0,0,0,0,0,0,0, 1,1,1,1,1,1,1,1, 2,2,2,2,2, 3,3,3,3, 4,4,4, 5,5, 6,6, 7,7, 8,9,10,11,12,13,14,15};
    constexpr int CJ[50] = {0,1,2,3,4,5,6,7,8,9,10,11,12,13,14,15, 0,1,2,3,4,5,6,7, 0,1,2,3,4, 0,1,2,3, 0,1,2, 0,1, 0,1, 0,1, 0,0,0,0,0,0,0,0};
    int loaded_h = -1;
    for (int u = opaque_bid(); u < 512; u += gridDim.x) {
        const int h = u & 7, tg = u >> 3;
        if (h != loaded_h) {
            __syncthreads();
#pragma unroll
            for (int i = 0; i < 8; ++i) {
                const int ch = tid + NTHREADS * i, pp = ch >> 11, rem = ch & 2047, row = rem >> 4, cc = rem & 15;
                *(u32x4*)(SK + pp * 34816 + row * 272 + cc * 16) = *(const u32x4*)(p.skb() + ((((size_t)layer * 8 + h) * 2 + pp) * 128 + row) * 128 + cc * 8);
            }
            __syncthreads();
            loaded_h = h;
        }
        const int token = tg * 256 + 32 * w + c;
        float s0[16], s1[16];
#pragma unroll
        for (int pp = 0; pp < 2; ++pp) {
            bf16x8 qf[8];
            const bf16_t* qp = p.qbuf() + (size_t)token * 2048 + (h * 2 + pp) * 128 + 8 * hi;
#pragma unroll
            for (int ks = 0; ks < 8; ++ks) qf[ks] = *(const bf16x8*)(qp + 16 * ks);
            float v[64];
#pragma unroll
            for (int kt = 0; kt < 4; ++kt) {
                f32x16 acc;
#pragma unroll
                for (int rr = 0; rr < 16; ++rr) acc[rr] = 0.f;
#pragma unroll
                for (int ks = 0; ks < 8; ++ks) acc = mfma32(*(const bf16x8*)(SK + pp * 34816 + (32 * kt + c) * 272 + (16 * ks + 8 * hi) * 2), qf[ks], acc);
#pragma unroll
                for (int rr = 0; rr < 16; ++rr) {
                    const unsigned idx = (unsigned)(32 * kt + (rr & 3) + 8 * (rr >> 2) + 4 * hi);
                    v[16 * kt + rr] = __uint_as_float((__float_as_uint(acc[rr]) & ~127u) | idx);
                }
            }
            top16_of_64(v);
#pragma unroll
            for (int i = 0; i < 16; ++i) v[16 + i] = __shfl_xor(v[15 - i], 32);
#pragma unroll
            for (int i = 0; i < 16; ++i) v[i] = fmaxf(v[i], v[16 + i]);
            bitonic16<0>(v);
#pragma unroll
            for (int i = 0; i < 16; ++i) { if (pp == 0) s0[i] = v[i]; else s1[i] = v[i]; }
        }
        float cv[64];
#pragma unroll
        for (int k = 0; k < 50; ++k) {
            const float a = s0[CI[k]], b = s1[CJ[k]];
            const unsigned id = ((__float_as_uint(a) & 127u) << 7) | (__float_as_uint(b) & 127u);
            cv[k] = __uint_as_float((__float_as_uint(a + b) & ~0x3FFFu) | id);
        }
#pragma unroll
        for (int k = 50; k < 64; ++k) cv[k] = -__builtin_inff();
        top16_of_64(cv);
        float e[16], sum = 0.f;
#pragma unroll
        for (int i = 0; i < 16; ++i) { e[i] = expf(cv[i] - cv[0]); sum += e[i]; }
        const float inv = 1.f / sum;
        if (hi == 0) {
            int* ep = p.expert() + (size_t)token * 128 + h * 16; float* gp = p.gate() + (size_t)token * 128 + h * 16;
#pragma unroll
            for (int i4 = 0; i4 < 4; ++i4) {
                i32x4 ev; ev.x = (int)(__float_as_uint(cv[4 * i4]) & 0x3FFFu); ev.y = (int)(__float_as_uint(cv[4 * i4 + 1]) & 0x3FFFu);
                ev.z = (int)(__float_as_uint(cv[4 * i4 + 2]) & 0x3FFFu); ev.w = (int)(__float_as_uint(cv[4 * i4 + 3]) & 0x3FFFu);
                *(i32x4*)(ep + 4 * i4) = ev;
                *(f32x4*)(gp + 4 * i4) = (f32x4){e[4 * i4] * inv, e[4 * i4 + 1] * inv, e[4 * i4 + 2] * inv, e[4 * i4 + 3] * inv};
            }
        }
    }
}

DEV float dot2bf(unsigned a, unsigned b, float c) {
    bf16v2 x, y; __builtin_memcpy(&x, &a, 4); __builtin_memcpy(&y, &b, 4);
    return __builtin_amdgcn_fdot2_f32_bf16(x, y, c, false);
}
DEV float dot16(const u32x4& h0, const u32x4& h1, const u32x4& r0, const u32x4& r1) {
    float a = 0.f;
    a = dot2bf(h0.x, r0.x, a); a = dot2bf(h0.y, r0.y, a); a = dot2bf(h0.z, r0.z, a); a = dot2bf(h0.w, r0.w, a);
    a = dot2bf(h1.x, r1.x, a); a = dot2bf(h1.y, r1.y, a); a = dot2bf(h1.z, r1.z, a); a = dot2bf(h1.w, r1.w, a);
    return a;
}

DEV void phase_peer_gather(const Params& p, int layer, const float* __restrict__ g2, const float* __restrict__ xsrc) {
    const int tid = opaque_tid(), lane = tid & 63, w = __builtin_amdgcn_readfirstlane(tid >> 6);
    const bf16_t* ub = p.ub() + (size_t)layer * 16384 * 1024; const bf16_t* vb = p.vb() + (size_t)layer * 16384 * 1024;
    const unsigned lo32 = (unsigned)lane * 32u;
    const int idxl = ((lane >> 5) & 1) * 8 + ((lane >> 4) & 1) * 4 + ((lane >> 3) & 1) * 2 + ((lane >> 2) & 1);
    for (int tok = opaque_bid() * 8 + w; tok < S; tok += gridDim.x * 8) {
        const u32x4 h0 = *(const u32x4*)(p.h() + (size_t)tok * DM + lane * 16), h1 = *(const u32x4*)(p.h() + (size_t)tok * DM + lane * 16 + 8);
        const int e0 = p.expert()[(size_t)tok * 128 + lane], e1 = p.expert()[(size_t)tok * 128 + 64 + lane];
        float coef[8];
#pragma unroll
        for (int b = 0; b < 8; ++b) {
            float pt[16];
#pragma unroll
            for (int half = 0; half < 2; ++half) {
                u32x4 r0[8], r1[8];
#pragma unroll
                for (int k = 0; k < 8; ++k) {
                    const int e = __builtin_amdgcn_readlane(b < 4 ? e0 : e1, (b & 3) * 16 + half * 8 + k);
                    const unsigned vo = (unsigned)e * 2048u + lo32;
                    r0[k] = *(const u32x4*)((const char*)ub + vo); r1[k] = *(const u32x4*)((const char*)ub + vo + 16);
                }
#pragma unroll
                for (int k = 0; k < 8; ++k) pt[half * 8 + k] = dot16(h0, h1, r0[k], r1[k]);
                __builtin_amdgcn_sched_barrier(0);
            }
#pragma unroll
            for (int k = 0; k < 8; ++k) { const bool up = (lane & 32) != 0; const float send = up ? pt[k] : pt[k + 8], keep = up ? pt[k + 8] : pt[k]; pt[k] = keep + __shfl_xor(send, 32); }
#pragma unroll
            for (int k = 0; k < 4; ++k) { const bool up = (lane & 16) != 0; const float send = up ? pt[k] : pt[k + 4], keep = up ? pt[k + 4] : pt[k]; pt[k] = keep + __shfl_xor(send, 16); }
#pragma unroll
            for (int k = 0; k < 2; ++k) { const bool up = (lane & 8) != 0; const float send = up ? pt[k] : pt[k + 2], keep = up ? pt[k + 2] : pt[k]; pt[k] = keep + __shfl_xor(send, 8); }
            { const bool up = (lane & 4) != 0; const float send = up ? pt[0] : pt[1], keep = up ? pt[1] : pt[0]; pt[0] = keep + __shfl_xor(send, 4); }
            pt[0] += __shfl_xor(pt[0], 2); pt[0] += __shfl_xor(pt[0], 1);
            const float gv = p.gate()[(size_t)tok * 128 + b * 16 + idxl];
            const float d = pt[0];
            coef[b] = gv * 0.5f * d * (1.f + erff(d * 0.70710678118654752f));
        }
        float acc[16];
#pragma unroll
        for (int i = 0; i < 16; ++i) acc[i] = 0.f;
#pragma unroll
        for (int b = 0; b < 8; ++b) {
#pragma unroll
            for (int half = 0; half < 2; ++half) {
                u32x4 r0[8], r1[8];
#pragma unroll
                for (int k = 0; k < 8; ++k) {
                    const int e = __builtin_amdgcn_readlane(b < 4 ? e0 : e1, (b & 3) * 16 + half * 8 + k);
                    const unsigned vo = (unsigned)e * 2048u + lo32;
                    r0[k] = *(const u32x4*)((const char*)vb + vo); r1[k] = *(const u32x4*)((const char*)vb + vo + 16);
                }
#pragma unroll
                for (int k = 0; k < 8; ++k) {
                    const int kk = half * 8 + k;
                    const int src = ((kk >> 3) & 1) * 32 + ((kk >> 2) & 1) * 16 + ((kk >> 1) & 1) * 8 + (kk & 1) * 4;
                    const float cf = __uint_as_float((unsigned)__builtin_amdgcn_readlane((int)__float_as_uint(coef[b]), src));
                    acc[0] += cf * bflo(r0[k].x); acc[1] += cf * bfhi(r0[k].x); acc[2] += cf * bflo(r0[k].y); acc[3] += cf * bfhi(r0[k].y);
                    acc[4] += cf * bflo(r0[k].z); acc[5] += cf * bfhi(r0[k].z); acc[6] += cf * bflo(r0[k].w); acc[7] += cf * bfhi(r0[k].w);
                    acc[8] += cf * bflo(r1[k].x); acc[9] += cf * bfhi(r1[k].x); acc[10] += cf * bflo(r1[k].y); acc[11] += cf * bfhi(r1[k].y);
                    acc[12] += cf * bflo(r1[k].z); acc[13] += cf * bfhi(r1[k].z); acc[14] += cf * bflo(r1[k].w); acc[15] += cf * bfhi(r1[k].w);
                }
                __builtin_amdgcn_sched_barrier(0);
            }
        }
        const float* xp = xsrc + (size_t)tok * DM + lane * 16; float* xo = p.xw() + (size_t)tok * DM + lane * 16; const float* gp = g2 + lane * 16;
#pragma unroll
        for (int i4 = 0; i4 < 4; ++i4) {
            const f32x4 xv = *(const f32x4*)(xp + 4 * i4); f32x4 gg = *(const f32x4*)(gp + 4 * i4);
            f32x4 o;
#ifdef DBG_NO_PEER
            gg[0] = gg[1] = gg[2] = gg[3] = 0.f;
#endif
#ifdef DBG_PEER2
            gg = gg * 2.f;
#endif
            o[0] = xv[0] + gg[0] * acc[4 * i4]; o[1] = xv[1] + gg[1] * acc[4 * i4 + 1]; o[2] = xv[2] + gg[2] * acc[4 * i4 + 2]; o[3] = xv[3] + gg[3] * acc[4 * i4 + 3];
            *(f32x4*)(xo + 4 * i4) = o;
        }
    }
}

extern __shared__ __attribute__((aligned(16))) char smem_raw[];
DEV char* smem_user() { LAS char* q = (LAS char*)smem_raw + LDS_USER; asm volatile("" : "+v"(q)); return (char*)q; }
typedef const __attribute__((address_space(4))) Params* KParams;
DEV void load_params(Params& p) {
    auto kp0 = __builtin_amdgcn_kernarg_segment_ptr();
    asm volatile("" : "+s"(kp0));
    KParams kp = (KParams)kp0;
    p.x = kp->x;
    p.c = kp->c;
    p.pos = kp->pos;
    p.mod_w = kp->mod_w;
    p.mod_b = kp->mod_b;
    p.norm_mix = kp->norm_mix;
    p.norm_ffn = kp->norm_ffn;
    p.hy_w_in = kp->hy_w_in;
    p.gdn_conv = kp->gdn_conv;
    p.gdn_a_log = kp->gdn_a_log;
    p.gdn_dt_bias = kp->gdn_dt_bias;
    p.gdn_o_norm = kp->gdn_o_norm;
    p.hy_w_out = kp->hy_w_out;
    p.mla_w_in = kp->mla_w_in;
    p.mla_q_norm = kp->mla_q_norm;
    p.mla_kv_norm = kp->mla_kv_norm;
    p.mla_w_uq = kp->mla_w_uq;
    p.mla_w_ukv = kp->mla_w_ukv;
    p.mla_w_out = kp->mla_w_out;
    p.peer_w_q = kp->peer_w_q;
    p.peer_sub_keys = kp->peer_sub_keys;
    p.peer_u = kp->peer_u;
    p.peer_v = kp->peer_v;
    p.final_norm = kp->final_norm;
    p.out = kp->out;
    p.ws = kp->ws;
    p.ph_lo = kp->ph_lo;
    p.ph_hi = kp->ph_hi;
    p.use_bar = kp->use_bar;
    p.pad0 = kp->pad0;
}
#ifdef PH_NOINLINE
#define NOINL __device__ __noinline__
#else
#define NOINL __device__ __forceinline__
#endif

NOINL void f_prologue() { Params p; load_params(p); phase_prologue(p, smem_user()); }
NOINL void f_norm_e0(int layer) {
    Params p; load_params(p); const float* mod = p.mod() + layer * 6144; const int li = layer >> 1;
    phase_norm<1>(layer == 0 ? p.x : p.xw(), p.norm_mix + layer * DM, mod, mod + 1024, p.h(), nullptr, p.hy_w_in + (size_t)li * 1024 * HY_IN, p.ba(), smem_user());
}
NOINL void f_norm_plain(int layer, int which) {
    Params p; load_params(p); const float* mod = p.mod() + layer * 6144;
    if (which == 0) phase_norm<0>(p.xw(), p.norm_mix + layer * DM, mod, mod + 1024, p.h(), nullptr, nullptr, nullptr, smem_user());
    else phase_norm<0>(p.xw(), p.norm_ffn + layer * DM, mod + 3072, mod + 4096, p.h(), nullptr, nullptr, nullptr, smem_user());
}
NOINL void f_final() { Params p; load_params(p); phase_norm<2>(
#ifdef DBG_SKIP_ALL
        p.x,
#else
        p.xw(),
#endif
 p.final_norm, nullptr, nullptr, nullptr, p.out, nullptr, nullptr, smem_user()); }
NOINL void f_gemm_hy_in(int li) {
    Params p; load_params(p);
    auto epi = [&](f32x4 (&acc)[4][4], int mb, int nb, int n0) {
#pragma unroll
        for (int mt = 0; mt < 4; ++mt) {
            const int m = mb + 16 * mt;
#pragma unroll
            for (int nt = 0; nt < 4; ++nt) {
                const int n = nb + 16 * nt; const f32x4 v = acc[mt][nt];
                if (n0 < 1536) st_bf4(p.proj_a() + (size_t)m * 1536 + n, v);
                else if (n0 < 2048) st_bf4(p.zbuf() + (size_t)m * 512 + (n - 1536), v);
                else if (n0 < 2560) { const int hd = (n - 2048) >> 7, dp = (n - 2048) & 127; const f32x4 rv = rope4(v, p.cosB() + (size_t)m * 64, p.sinB() + (size_t)m * 64, dp >> 1) * (0.08838834764831845f * 1.4426950408889634f); st_bf4(p.Qb() + ((size_t)hd * S + m) * 128 + dp, rv); }
                else if (n0 < 3072) { const int hd = (n - 2560) >> 7, dp = (n - 2560) & 127; const f32x4 rv = rope4(v, p.cosB() + (size_t)m * 64, p.sinB() + (size_t)m * 64, dp >> 1); st_bf4(p.Kb() + ((size_t)hd * S + m) * 128 + dp, rv); }
                else { const int hd = (n - 3072) >> 7, dv = (n - 3072) & 127; bf16_t* vp = p.VbT() + ((size_t)hd * 128 + dv) * S + m; vp[0] = f2bf(v[0]); vp[S] = f2bf(v[1]); vp[2 * (size_t)S] = f2bf(v[2]); vp[3 * (size_t)S] = f2bf(v[3]); }
            }
        }
    };
    gemm_phase(p.h(), DM, p.w_hy_in() + (size_t)li * HYN * 1024, 1024, 1024, HYN / 128, smem_user(), epi);
}
NOINL void f_gemm_resid(int layer) {
    Params p; load_params(p); const float* mod = p.mod() + layer * 6144; const int li = layer >> 1;
    const float* xin = layer == 0 ? p.x : p.xw(); float* xo = p.xw();
    auto epi = [&](f32x4 (&acc)[4][4], int mb, int nb, int n0) {
#pragma unroll
        for (int mt = 0; mt < 4; ++mt)
#pragma unroll
            for (int nt = 0; nt < 4; ++nt) {
                const int m = mb + 16 * mt, n = nb + 16 * nt;
                const f32x4 xv = *(const f32x4*)(xin + (size_t)m * DM + n), gg = *(const f32x4*)(mod + 2048 + n);
                *(f32x4*)(xo + (size_t)m * DM + n) = xv + gg * acc[mt][nt];
            }
    };
    const bf16_t* wt = (layer & 1) ? p.w_mla_out() + (size_t)li * 1024 * 1024 : p.w_hy_out() + (size_t)li * 1024 * 1024;
    gemm_phase(p.cat(), DM, wt, 1024, 1024, 8, smem_user(), epi);
}
NOINL void f_e2(int li) {
    Params p; load_params(p);
    for (int u = opaque_bid(); u < 1280; u += gridDim.x) { if (u < 1024) gdn_prep_unit(p, li, u >> 2, u & 3, smem_user()); else moba_kmean_unit(p, (u - 1024) & 3, (u - 1024) >> 2, smem_user()); }
}
NOINL void f_gate() { Params p; load_params(p); phase_moba_gate(p, smem_user()); }
NOINL void f_scan() { Params p; load_params(p); gdn_scan(p, opaque_bid(), smem_user()); }
NOINL void f_moba_attn() { Params p; load_params(p); phase_moba_attn(p, smem_user(), opaque_bid() - 16, gridDim.x - 16); }
NOINL void f_combine(int li) { Params p; load_params(p); phase_even_combine(p, li); }
NOINL void f_gemm_mla_in(int li) {
    Params p; load_params(p);
    auto epi = [&](f32x4 (&acc)[4][4], int mb, int nb, int n0) {
#pragma unroll
        for (int mt = 0; mt < 4; ++mt)
#pragma unroll
            for (int nt = 0; nt < 4; ++nt) {
                const int m = mb + 16 * mt, n = nb + 16 * nt; const f32x4 v = acc[mt][nt];
                if (n0 < 768) st_bf4(p.cbuf() + (size_t)m * 768 + n, v);
                else if (n < 832) { const int dp = n - 768; const f32x4 rv = rope4(v, p.cosC() + (size_t)m * 32, p.sinC() + (size_t)m * 32, dp >> 1); st_bf4(p.Kr() + (size_t)m * 64 + dp, rv); }
            }
    };
    gemm_phase(p.h(), DM, p.w_mla_in() + (size_t)li * 896 * 1024, 1024, 1024, 7, smem_user(), epi);
}
NOINL void f_cnorm(int li) { Params p; load_params(p); phase_mla_cnorm(p, li); }
NOINL void f_gemm_uq(int li) {
    Params p; load_params(p);
    auto epi = [&](f32x4 (&acc)[4][4], int mb, int nb, int n0) {
        const float qs = 0.07216878364870322f * 1.4426950408889634f;
#pragma unroll
        for (int mt = 0; mt < 4; ++mt)
#pragma unroll
            for (int nt = 0; nt < 4; ++nt) {
                const int m = mb + 16 * mt, n = nb + 16 * nt; const int hd = n / 192, d = n - hd * 192; f32x4 v = acc[mt][nt];
                if (d >= 128) v = rope4(v, p.cosC() + (size_t)m * 32, p.sinC() + (size_t)m * 32, (d - 128) >> 1);
                st_bf4(p.Qm() + ((size_t)hd * S + m) * 192 + d, v * qs);
            }
    };
    gemm_phase(p.cqn(), 512, p.w_uq() + (size_t)li * 1536 * 512, 512, 512, 12, smem_user(), epi);
}
NOINL void f_gemm_ukv(int li) {
    Params p; load_params(p);
    auto epi = [&](f32x4 (&acc)[4][4], int mb, int nb, int n0) {
#pragma unroll
        for (int mt = 0; mt < 4; ++mt)
#pragma unroll
            for (int nt = 0; nt < 4; ++nt) {
                const int m = mb + 16 * mt, n = nb + 16 * nt; const f32x4 v = acc[mt][nt];
                if (n0 < 1024) { const int hd = n >> 7, d = n & 127; st_bf4(p.Kn() + ((size_t)hd * S + m) * 128 + d, v); }
                else { const int hd = (n - 1024) >> 7, dv = (n - 1024) & 127; bf16_t* vp = p.VmT() + ((size_t)hd * 128 + dv) * S + m; vp[0] = f2bf(v[0]); vp[S] = f2bf(v[1]); vp[2 * (size_t)S] = f2bf(v[2]); vp[3 * (size_t)S] = f2bf(v[3]); }
            }
    };
    gemm_phase(p.ckvn(), 256, p.w_ukv() + (size_t)li * 2048 * 256, 256, 256, 16, smem_user(), epi);
}
NOINL void f_mla_attn() { Params p; load_params(p); phase_mla_attn(p, smem_user()); }
NOINL void f_gemm_pq(int layer) {
    Params p; load_params(p);
    auto epi = [&](f32x4 (&acc)[4][4], int mb, int nb, int n0) {
#pragma unroll
        for (int mt = 0; mt < 4; ++mt)
#pragma unroll
            for (int nt = 0; nt < 4; ++nt) st_bf4(p.qbuf() + (size_t)(mb + 16 * mt) * 2048 + nb + 16 * nt, acc[mt][nt]);
    };
    gemm_phase(p.h(), DM, p.w_pq() + (size_t)layer * 2048 * 1024, 1024, 1024, 16, smem_user(), epi);
}
NOINL void f_topk(int layer) { Params p; load_params(p); phase_peer_topk(p, layer, smem_user()); }
NOINL void f_gather(int layer) { Params p; load_params(p); phase_peer_gather(p, layer, p.mod() + layer * 6144 + 5120, p.xw()); }

__device__ __noinline__ void grid_sync(unsigned* barw, unsigned x) {
    XcdBarrier b; b.bar = barw; b.x = x; b.st = (volatile LAS unsigned*)smem_raw;
    xcd_barrier(b);
}

__global__ void __launch_bounds__(NTHREADS) hybrid_forward(Params p) {
    if (threadIdx.x == 0) *(u32x4*)smem_raw = (u32x4){0u, 0u, 0u, 0u};
    __syncthreads();
    XcdBarrier bar; bar.bar = p.bar(); bar.x = 0; bar.st = (volatile LAS unsigned*)smem_raw;
    if (p.use_bar) bar = xcd_barrier_post(p.bar(), (volatile LAS unsigned*)smem_raw);
    int ph = 0;
#define RUN_PHASE(...) { if (ph >= p.ph_lo && ph < p.ph_hi) { __VA_ARGS__; if (p.use_bar && ph + 1 < p.ph_hi) grid_sync(bar.bar, bar.x); } ++ph; }

    RUN_PHASE(f_prologue());
    for (int layer = 0; layer < 4; ++layer) {
        const int li = layer >> 1;
        if ((layer & 1) == 0) {
            RUN_PHASE(f_norm_e0(layer));
            RUN_PHASE(f_gemm_hy_in(li));
            RUN_PHASE(f_e2(li));
            RUN_PHASE(f_gate());
            RUN_PHASE(if (blockIdx.x < 16) f_scan(); else f_moba_attn());
            RUN_PHASE(f_combine(li));
            RUN_PHASE(f_gemm_resid(layer));
        } else {
            RUN_PHASE(f_norm_plain(layer, 0));
            RUN_PHASE(f_gemm_mla_in(li));
            RUN_PHASE(f_cnorm(li));
            RUN_PHASE(f_gemm_uq(li); f_gemm_ukv(li));
            RUN_PHASE(f_mla_attn());
            RUN_PHASE(f_gemm_resid(layer));
        }
        RUN_PHASE(f_norm_plain(layer, 1));
        RUN_PHASE(f_gemm_pq(layer));
        RUN_PHASE(f_topk(layer));
        RUN_PHASE(f_gather(layer));
    }
    RUN_PHASE(f_final());
}

constexpr int N_PHASES = 1 + 2 * 11 + 2 * 10 + 1;

extern "C" void kernel_launch(void* const* d_in, const int* in_sizes, int n_in, void* d_out, int out_size, void* d_ws, size_t ws_size, hipStream_t stream) {
    static int grid = 0;
    if (!grid) {
        int dev = 0, cus = 0, per_cu = 0;
        hipGetDevice(&dev);
        hipDeviceGetAttribute(&cus, hipDeviceAttributeMultiprocessorCount, dev);
        hipFuncSetAttribute((const void*)hybrid_forward, hipFuncAttributeMaxDynamicSharedMemorySize, LDS_BYTES);
        hipOccupancyMaxActiveBlocksPerMultiprocessor(&per_cu, hybrid_forward, NTHREADS, LDS_BYTES);
        if (per_cu < 1) per_cu = 1;
        grid = cus;
        if (grid > 256) grid = 256;
    }
    Params p; memset(&p, 0, sizeof(p));
    p.x = (const float*)d_in[0]; p.c = (const float*)d_in[1]; p.pos = (const int*)d_in[2]; p.mod_w = (const float*)d_in[3]; p.mod_b = (const float*)d_in[4];
    p.norm_mix = (const float*)d_in[5]; p.norm_ffn = (const float*)d_in[6]; p.hy_w_in = (const float*)d_in[7]; p.gdn_conv = (const float*)d_in[8];
    p.gdn_a_log = (const float*)d_in[9]; p.gdn_dt_bias = (const float*)d_in[10]; p.gdn_o_norm = (const float*)d_in[11]; p.hy_w_out = (const float*)d_in[12];
    p.mla_w_in = (const float*)d_in[13]; p.mla_q_norm = (const float*)d_in[14]; p.mla_kv_norm = (const float*)d_in[15]; p.mla_w_uq = (const float*)d_in[16];
    p.mla_w_ukv = (const float*)d_in[17]; p.mla_w_out = (const float*)d_in[18]; p.peer_w_q = (const float*)d_in[19]; p.peer_sub_keys = (const float*)d_in[20];
    p.peer_u = (const float*)d_in[21]; p.peer_v = (const float*)d_in[22]; p.final_norm = (const float*)d_in[23];
    p.out = (float*)d_out;
    p.ws = (char*)d_ws;
    if (WS_NEED > ws_size) { fprintf(stderr, "workspace too small: need %zu have %zu\n", (size_t)WS_NEED, ws_size); return; }
    hipMemsetAsync(p.ws, 0, 16384, stream);
#ifndef ONE_LAUNCH
    for (int ph = 0; ph < N_PHASES; ++ph) {
#ifdef DBG_SKIP_ALL
        if (ph != N_PHASES - 1) continue;
#endif
        p.ph_lo = ph; p.ph_hi = ph + 1; p.use_bar = 0;
        hipLaunchKernelGGL(hybrid_forward, dim3(grid), dim3(NTHREADS), LDS_BYTES, stream, p);
    }
#else
    p.ph_lo = 0; p.ph_hi = N_PHASES; p.use_bar = 1;
    hipLaunchKernelGGL(hybrid_forward, dim3(grid), dim3(NTHREADS), LDS_BYTES, stream, p);
#endif
}
```

```cpp
#include <hip/hip_runtime.h>
#define ONE_LAUNCH 1
#include <stdint.h>
#include <stddef.h>
#include <stdio.h>
#include <string.h>

#define DEV __device__ __forceinline__

constexpr int S = 16384;
constexpr int DM = 1024;
constexpr int HY_IN = 3592;
constexpr int HYN = 3584;
constexpr int NTHREADS = 512;
constexpr int LDS_BYTES = 163840;
constexpr int LDS_USER = 16;

typedef unsigned short bf16_t;
typedef short bf16x8 __attribute__((ext_vector_type(8)));
typedef float f32x4 __attribute__((ext_vector_type(4)));
typedef float f32x16 __attribute__((ext_vector_type(16)));
typedef __bf16 bf16v2 __attribute__((ext_vector_type(2)));
typedef unsigned u32x4 __attribute__((ext_vector_type(4)));
typedef unsigned u32x2 __attribute__((ext_vector_type(2)));
typedef int i32x4 __attribute__((ext_vector_type(4)));

#define XB_TMO      128
#define XB_XCNT(j)  (256  + 64 * (j))
#define XB_XSUB(j)  (1280 + 64 * (j))
#define XB_XGEN(j)  (2304 + 64 * (j))
#define XB_TOP      3328
#define XB_TOPGEN   3392
#define XCD_BAR_WORDS 3456
#define XB_SPIN_CAP (1u << 22)
#define LAS __attribute__((address_space(3)))

__device__ __forceinline__ unsigned xb_ld(unsigned* p)              { return __hip_atomic_load(p, __ATOMIC_RELAXED, __HIP_MEMORY_SCOPE_AGENT); }
__device__ __forceinline__ unsigned xb_add(unsigned* p, unsigned v) { return __hip_atomic_fetch_add(p, v, __ATOMIC_RELAXED, __HIP_MEMORY_SCOPE_AGENT); }
__device__ __forceinline__ unsigned xb_xcc_id() { return (unsigned)__builtin_amdgcn_s_getreg((3 << 11) | 20) & 0xFu; }
#define XB_SPIN(cond, bar) do { unsigned _sp = 0; while (cond) { __builtin_amdgcn_s_sleep(1); \
    if ((++_sp & 255u) == 0u) { if (xb_ld(&(bar)[XB_TMO])) break; if (_sp > XB_SPIN_CAP) { atomicAdd(&(bar)[XB_TMO], 1u); break; } } } } while (0)

struct XcdBarrier { unsigned* bar; unsigned x; volatile LAS unsigned* st; };

__device__ __forceinline__ XcdBarrier xcd_barrier_post(unsigned* bar, volatile LAS unsigned* st) {
    XcdBarrier b; b.bar = bar; b.x = xb_xcc_id(); b.st = st;
    if (threadIdx.x == 0) (void)xb_add(&bar[XB_XCNT(b.x)], 1u);
    return b;
}
__device__ __forceinline__ void xcd_barrier_complete(unsigned* bar, unsigned x, unsigned& nloc, unsigned& nx) {
    const unsigned G = gridDim.x * gridDim.y * gridDim.z;
    unsigned sum, cnt, mine, sp = 0u;
    for (;;) {
        sum = 0u; cnt = 0u; mine = 0u;
#pragma unroll 1
        for (unsigned j = 0; j < 16; ++j) { const unsigned c = xb_ld(&bar[XB_XCNT(j)]); sum += c; cnt += (c > 0u) ? 1u : 0u; mine = (j == x) ? c : mine; }
        if (sum == G) break;
        __builtin_amdgcn_s_sleep(1);
        if ((++sp & 255u) == 0u) { if (xb_ld(&bar[XB_TMO])) break; if (sp > XB_SPIN_CAP) { atomicAdd(&bar[XB_TMO], 1u); break; } }
    }
    nloc = mine > 0u ? mine : 1u; nx = cnt > 0u ? cnt : 1u;
}
__device__ __forceinline__ void xcd_barrier(const XcdBarrier& b) {
    asm volatile("s_waitcnt vmcnt(0)" ::: "memory");
    __syncthreads();
    if (threadIdx.x == 0) {
        unsigned* bar = b.bar;
        __builtin_amdgcn_s_waitcnt(0);
        unsigned nloc = b.st[0], nx = b.st[1];
        if (nloc == 0u) { xcd_barrier_complete(bar, b.x, nloc, nx); b.st[0] = nloc; b.st[1] = nx; }
        const unsigned old = xb_add(&bar[XB_XSUB(b.x)], 1u);
        const unsigned gen = old / nloc;
        if (old + 1u == (gen + 1u) * nloc) {
            __builtin_amdgcn_fence(__ATOMIC_RELEASE, "agent");
            asm volatile("s_waitcnt vmcnt(0)" ::: "memory");
            const unsigned og = xb_add(&bar[XB_TOP], 1u);
            const unsigned tg = og / nx;
            if (og + 1u == (tg + 1u) * nx) xb_add(&bar[XB_TOPGEN], 1u);
            else XB_SPIN(xb_ld(&bar[XB_TOPGEN]) == tg, bar);
            __builtin_amdgcn_fence(__ATOMIC_ACQUIRE, "agent");
            xb_add(&bar[XB_XGEN(b.x)], 1u);
            asm volatile("s_waitcnt vmcnt(0)" ::: "memory");
        } else {
            XB_SPIN(xb_ld(&bar[XB_XGEN(b.x)]) == gen, bar);
            __builtin_amdgcn_fence(__ATOMIC_ACQUIRE, "agent");
            asm volatile("s_waitcnt vmcnt(0)" ::: "memory");
        }
    }
    __syncthreads();
}

DEV int opaque_bid() { int b = blockIdx.x; asm volatile("" : "+s"(b)); return b; }
DEV int opaque_tid() { int t = threadIdx.x; asm volatile("" : "+v"(t)); return t & (NTHREADS - 1); }
DEV bf16_t f2bf(float f) { unsigned u = __float_as_uint(f); u += 0x7FFFu + ((u >> 16) & 1u); return (bf16_t)(u >> 16); }
DEV unsigned pk2(float a, float b) { return (unsigned)f2bf(a) | ((unsigned)f2bf(b) << 16); }
DEV float bflo(unsigned u) { return __uint_as_float(u << 16); }
DEV float bfhi(unsigned u) { return __uint_as_float(u & 0xffff0000u); }
DEV float wsum64(float v) {
#pragma unroll
    for (int o = 32; o; o >>= 1) v += __shfl_xor(v, o);
    return v;
}
DEV f32x4 mfma16(bf16x8 a, bf16x8 b, f32x4 c) { return __builtin_amdgcn_mfma_f32_16x16x32_bf16(a, b, c, 0, 0, 0); }
DEV f32x16 mfma32(bf16x8 a, bf16x8 b, f32x16 c) { return __builtin_amdgcn_mfma_f32_32x32x16_bf16(a, b, c, 0, 0, 0); }
DEV float siluf(float v) { return v / (1.f + expf(-v)); }
DEV float softplusf(float v) { return fmaxf(v, 0.f) + log1pf(expf(-fabsf(v))); }
DEV float ex2(float v) { return __builtin_amdgcn_exp2f(v); }

struct Params {
    const float* x; const float* c; const int* pos; const float* mod_w; const float* mod_b; const float* norm_mix; const float* norm_ffn;
    const float* hy_w_in; const float* gdn_conv; const float* gdn_a_log; const float* gdn_dt_bias; const float* gdn_o_norm; const float* hy_w_out;
    const float* mla_w_in; const float* mla_q_norm; const float* mla_kv_norm; const float* mla_w_uq; const float* mla_w_ukv; const float* mla_w_out;
    const float* peer_w_q; const float* peer_sub_keys; const float* peer_u; const float* peer_v; const float* final_norm;
    float* out; char* ws;
    int ph_lo, ph_hi, use_bar, pad0;
    DEV unsigned* bar() const { return (unsigned*)(ws + 0ull); }
    DEV float* mod() const { return (float*)(ws + 16384ull); }
    DEV float* cosB() const { return (float*)(ws + 114688ull); }
    DEV float* sinB() const { return (float*)(ws + 4308992ull); }
    DEV float* cosC() const { return (float*)(ws + 8503296ull); }
    DEV float* sinC() const { return (float*)(ws + 10600448ull); }
    DEV bf16_t* w_hy_in() const { return (bf16_t*)(ws + 12697600ull); }
    DEV bf16_t* w_hy_out() const { return (bf16_t*)(ws + 27377664ull); }
    DEV bf16_t* w_mla_in() const { return (bf16_t*)(ws + 31571968ull); }
    DEV bf16_t* w_uq() const { return (bf16_t*)(ws + 35241984ull); }
    DEV bf16_t* w_ukv() const { return (bf16_t*)(ws + 38387712ull); }
    DEV bf16_t* w_mla_out() const { return (bf16_t*)(ws + 40484864ull); }
    DEV bf16_t* w_pq() const { return (bf16_t*)(ws + 44679168ull); }
    DEV bf16_t* skb() const { return (bf16_t*)(ws + 61456384ull); }
    DEV bf16_t* ub() const { return (bf16_t*)(ws + 63553536ull); }
    DEV bf16_t* vb() const { return (bf16_t*)(ws + 197771264ull); }
    DEV float* xw() const { return (float*)(ws + 331988992ull); }
    DEV bf16_t* h() const { return (bf16_t*)(ws + 399097856ull); }
    DEV bf16_t* cat() const { return (bf16_t*)(ws + 432652288ull); }
    DEV bf16_t* proj_a() const { return (bf16_t*)(ws + 466206720ull); }
    DEV bf16_t* zbuf() const { return (bf16_t*)(ws + 516538368ull); }
    DEV bf16_t* Qb() const { return (bf16_t*)(ws + 533315584ull); }
    DEV bf16_t* Kb() const { return (bf16_t*)(ws + 550092800ull); }
    DEV bf16_t* VbT() const { return (bf16_t*)(ws + 566870016ull); }
    DEV float* ba() const { return (float*)(ws + 583647232ull); }
    DEV float* u32() const { return (float*)(ws + 584171520ull); }
    DEV bf16_t* wneg() const { return (bf16_t*)(ws + 617725952ull); }
    DEV bf16_t* qdec() const { return (bf16_t*)(ws + 634503168ull); }
    DEV bf16_t* kdT() const { return (bf16_t*)(ws + 651280384ull); }
    DEV bf16_t* qk() const { return (bf16_t*)(ws + 668057600ull); }
    DEV float* glast() const { return (float*)(ws + 676446208ull); }
    DEV float* oa() const { return (float*)(ws + 676450304ull); }
    DEV float* kmean() const { return (float*)(ws + 710004736ull); }
    DEV int* segcnt() const { return (int*)(ws + 710135808ull); }
    DEV int* lists() const { return (int*)(ws + 710168576ull); }
    DEV float* part() const { return (float*)(ws + 726945792ull); }
    DEV float* ml() const { return (float*)(ws + 861163520ull); }
    DEV bf16_t* cbuf() const { return (bf16_t*)(ws + 466206720ull); }
    DEV bf16_t* Kr() const { return (bf16_t*)(ws + 491372544ull); }
    DEV bf16_t* cqn() const { return (bf16_t*)(ws + 493469696ull); }
    DEV bf16_t* ckvn() const { return (bf16_t*)(ws + 510246912ull); }
    DEV bf16_t* Qm() const { return (bf16_t*)(ws + 518635520ull); }
    DEV bf16_t* Kn() const { return (bf16_t*)(ws + 568967168ull); }
    DEV bf16_t* VmT() const { return (bf16_t*)(ws + 602521600ull); }
    DEV bf16_t* qbuf() const { return (bf16_t*)(ws + 466206720ull); }
    DEV int* expert() const { return (int*)(ws + 533315584ull); }
    DEV float* gate() const { return (float*)(ws + 541704192ull); }
};
constexpr size_t WS_NEED = 863260672ull;


template <class Map>
DEV void transpose_conv(const float* __restrict__ src, int K, int ldsrc, bf16_t* __restrict__ dst, int Nd, Map map, char* smem, int& base) {
    float* T = (float*)smem;
    const int tid = opaque_tid(), nb = gridDim.x, b = opaque_bid();
    const int ntk = K / 64, ntn = Nd / 64, nun = ntk * ntn;
    int first = ((b - (base % nb)) % nb + nb) % nb;
    for (int u = first; u < nun; u += nb) {
        const int tk = u % ntk, tn = u / ntk;
        __syncthreads();
#pragma unroll
        for (int i = 0; i < 8; ++i) {
            const int kk = (tid >> 6) + 8 * i, nn = tid & 63;
            const int sc = map(tn * 64 + nn);
            float v = 0.f;
            if (sc >= 0) v = src[(size_t)(tk * 64 + kk) * ldsrc + sc];
            T[kk * 65 + nn] = v;
        }
        __syncthreads();
#pragma unroll
        for (int i = 0; i < 8; ++i) {
            const int nn = (tid >> 6) + 8 * i, kk = tid & 63;
            dst[(size_t)(tn * 64 + nn) * K + tk * 64 + kk] = f2bf(T[kk * 65 + nn]);
        }
    }
    base += nun;
}

DEV void convert_bf16(const float* __restrict__ src, bf16_t* __restrict__ dst, size_t n) {
    const size_t n8 = n / 8;
    for (size_t i = (size_t)opaque_bid() * NTHREADS + opaque_tid(); i < n8; i += (size_t)gridDim.x * NTHREADS) {
        const f32x4 a = *(const f32x4*)(src + i * 8), b = *(const f32x4*)(src + i * 8 + 4);
        u32x4 o; o.x = pk2(a[0], a[1]); o.y = pk2(a[2], a[3]); o.z = pk2(b[0], b[1]); o.w = pk2(b[2], b[3]);
        *(u32x4*)(dst + i * 8) = o;
    }
}

DEV void phase_prologue(const Params& p, char* smem) {
    const int tid = opaque_tid(), nb = gridDim.x, b = opaque_bid();
    {
        float* cond = (float*)smem; float* red = cond + 1024;
        for (int i = tid; i < 1024; i += NTHREADS) cond[i] = siluf(p.c[i]);
        __syncthreads();
        for (int u = b; u < 192; u += nb) {
            const int n = u * 128, layer = n / 6144, nn = n - layer * 6144;
            const int cg = tid & 31, ks = tid >> 5;
            const float* wp = p.mod_w + ((size_t)layer * 1024 + ks * 64) * 6144 + nn + cg * 4;
            f32x4 acc = {0.f, 0.f, 0.f, 0.f};
#pragma unroll 8
            for (int k = 0; k < 64; ++k) { const f32x4 w = *(const f32x4*)(wp + (size_t)k * 6144); const float cv = cond[ks * 64 + k]; acc += w * cv; }
            *(f32x4*)(red + ks * 128 + cg * 4) = acc;
            __syncthreads();
            if (tid < 128) { float s = p.mod_b[n + tid]; for (int q = 0; q < 16; ++q) s += red[q * 128 + tid]; p.mod()[n + tid] = s; }
            __syncthreads();
        }
    }
    for (size_t i = (size_t)b * NTHREADS + tid; i < (size_t)S * 64; i += (size_t)nb * NTHREADS) {
        const int s = (int)(i >> 6), f = (int)(i & 63);
        const float invf = powf(10000.f, -(float)(2 * f) / 128.f);
        const float ang = (float)p.pos[s] * invf;
        float sn, cs; sincosf(ang, &sn, &cs);
        p.cosB()[i] = cs; p.sinB()[i] = sn;
    }
    for (size_t i = (size_t)b * NTHREADS + tid; i < (size_t)S * 32; i += (size_t)nb * NTHREADS) {
        const int s = (int)(i >> 5), f = (int)(i & 31);
        const float invf = powf(10000.f, -(float)(2 * f) / 64.f);
        const float ang = (float)p.pos[s] * invf;
        float sn, cs; sincosf(ang, &sn, &cs);
        p.cosC()[i] = cs; p.sinC()[i] = sn;
    }
    int base = 0;
    for (int i = 0; i < 2; ++i) {
        transpose_conv(p.hy_w_in + (size_t)i * 1024 * HY_IN, 1024, HY_IN, p.w_hy_in() + (size_t)i * HYN * 1024, HYN,
            [](int n) -> int {
                if (n < 2048) return n;
                const int seg = (n - 2048) >> 9, r = (n - 2048) & 511, sb = 2056 + seg * 512;
                if (seg < 2) { const int hd = r >> 7, dp = r & 127; const int d = (dp & 1) ? 64 + (dp >> 1) : (dp >> 1); return sb + hd * 128 + d; }
                return sb + r;
            }, smem, base);
        transpose_conv(p.hy_w_out + (size_t)i * 1024 * 1024, 1024, 1024, p.w_hy_out() + (size_t)i * 1024 * 1024, 1024, [](int n) -> int { return n; }, smem, base);
        transpose_conv(p.mla_w_in + (size_t)i * 1024 * 832, 1024, 832, p.w_mla_in() + (size_t)i * 896 * 1024, 896,
            [](int n) -> int {
                if (n < 768) return n;
                if (n < 832) { const int dp = n - 768; const int d = (dp & 1) ? 32 + (dp >> 1) : (dp >> 1); return 768 + d; }
                return -1;
            }, smem, base);
        transpose_conv(p.mla_w_uq + (size_t)i * 512 * 1536, 512, 1536, p.w_uq() + (size_t)i * 1536 * 512, 1536,
            [](int n) -> int {
                const int hd = n / 192, d = n % 192;
                if (d < 128) return n;
                const int dp = d - 128; const int dd = (dp & 1) ? 32 + (dp >> 1) : (dp >> 1);
                return hd * 192 + 128 + dd;
            }, smem, base);
        transpose_conv(p.mla_w_ukv + (size_t)i * 256 * 2048, 256, 2048, p.w_ukv() + (size_t)i * 2048 * 256, 2048,
            [](int n) -> int {
                if (n < 1024) { const int hd = n >> 7, d = n & 127; return hd * 256 + d; }
                const int m = n - 1024; const int hd = m >> 7, d = m & 127; return hd * 256 + 128 + d;
            }, smem, base);
        transpose_conv(p.mla_w_out + (size_t)i * 1024 * 1024, 1024, 1024, p.w_mla_out() + (size_t)i * 1024 * 1024, 1024, [](int n) -> int { return n; }, smem, base);
    }
    for (int i = 0; i < 4; ++i)
        transpose_conv(p.peer_w_q + (size_t)i * 1024 * 2048, 1024, 2048, p.w_pq() + (size_t)i * 2048 * 1024, 2048, [](int n) -> int { return n; }, smem, base);
    convert_bf16(p.peer_sub_keys, p.skb(), (size_t)4 * 8 * 2 * 128 * 128);
    convert_bf16(p.peer_u, p.ub(), (size_t)4 * 16384 * 1024);
    convert_bf16(p.peer_v, p.vb(), (size_t)4 * 16384 * 1024);
}

template <int MODE>
DEV void phase_norm(const float* __restrict__ xs, const float* __restrict__ nw, const float* __restrict__ shv, const float* __restrict__ scv,
                    bf16_t* __restrict__ hout, float* __restrict__ fout, const float* __restrict__ w8src, float* __restrict__ ba, char* smem) {
    const int tid = opaque_tid(), lane = tid & 63, w = __builtin_amdgcn_readfirstlane(tid >> 6);
    float* W8 = (float*)smem;
    if (MODE == 1) {
        for (int i = tid; i < 8192; i += NTHREADS) { const int k = i >> 3, c = i & 7; W8[c * 1024 + k] = w8src[(size_t)k * HY_IN + 2048 + c]; }
        __syncthreads();
    }
    f32x4 wm[4], sh[4];
#pragma unroll
    for (int i = 0; i < 4; ++i) {
        const int e = (i * 64 + lane) * 4;
        const f32x4 nv = *(const f32x4*)(nw + e);
        if (MODE == 2) { wm[i] = nv; sh[i] = (f32x4){0.f, 0.f, 0.f, 0.f}; }
        else { const f32x4 sc = *(const f32x4*)(scv + e); wm[i] = nv * (sc + 1.0f); sh[i] = *(const f32x4*)(shv + e); }
    }
    for (int row = opaque_bid() * 8 + w; row < S; row += gridDim.x * 8) {
        f32x4 v[4]; float ss = 0.f;
#pragma unroll
        for (int i = 0; i < 4; ++i) { v[i] = *(const f32x4*)(xs + (size_t)row * DM + (i * 64 + lane) * 4); ss += v[i][0] * v[i][0] + v[i][1] * v[i][1] + v[i][2] * v[i][2] + v[i][3] * v[i][3]; }
        ss = wsum64(ss);
        const float rn = rsqrtf(ss * (1.f / 1024.f) + 1e-6f);
#pragma unroll
        for (int i = 0; i < 4; ++i) v[i] = v[i] * rn * wm[i] + sh[i];
        if (MODE == 2) {
#pragma unroll
            for (int i = 0; i < 4; ++i) *(f32x4*)(fout + (size_t)row * DM + (i * 64 + lane) * 4) = v[i];
        } else {
#pragma unroll
            for (int i = 0; i < 4; ++i) { u32x2 o; o.x = pk2(v[i][0], v[i][1]); o.y = pk2(v[i][2], v[i][3]); *(u32x2*)(hout + (size_t)row * DM + (i * 64 + lane) * 4) = o; }
        }
        if (MODE == 1) {
            float pc[8];
#pragma unroll
            for (int c = 0; c < 8; ++c) {
                float a = 0.f;
#pragma unroll
                for (int i = 0; i < 4; ++i) { const f32x4 ww = *(const f32x4*)(W8 + c * 1024 + (i * 64 + lane) * 4); a += v[i][0] * ww[0] + v[i][1] * ww[1] + v[i][2] * ww[2] + v[i][3] * ww[3]; }
                pc[c] = wsum64(a);
            }
            if (lane == 0) { *(f32x4*)(ba + (size_t)row * 8) = (f32x4){pc[0], pc[1], pc[2], pc[3]}; *(f32x4*)(ba + (size_t)row * 8 + 4) = (f32x4){pc[4], pc[5], pc[6], pc[7]}; }
        }
    }
}

constexpr int GA_RS = 144;
template <class Epi>
DEV void gemm_phase(const bf16_t* __restrict__ A, int lda, const bf16_t* __restrict__ Bt, int ldb, int K, int ntn, char* smem, Epi epi) {
    const int tid = opaque_tid(), lane = tid & 63, w = tid >> 6, wm = w >> 1, wn = w & 1, r = lane & 15, g = lane >> 4;
    char* As = smem; char* Bs = smem + 256 * GA_RS;
    const int nun = 64 * ntn, nk = K / 64;
    for (int u = opaque_bid(); u < nun; u += gridDim.x) {
        const int xcd = u & 7, idx = u >> 3, tn = idx % ntn, tm = xcd * 8 + idx / ntn;
        const int m0 = tm * 256, n0 = tn * 128;
        f32x4 acc[4][4];
#pragma unroll
        for (int i = 0; i < 4; ++i)
#pragma unroll
            for (int j = 0; j < 4; ++j) acc[i][j] = (f32x4){0.f, 0.f, 0.f, 0.f};
        u32x4 ra[4], rb[2];
        const bf16_t* Ap = A + (size_t)(m0 + (tid >> 3)) * lda + (tid & 7) * 8;
        const bf16_t* Bp = Bt + (size_t)(n0 + (tid >> 3)) * ldb + (tid & 7) * 8;
#pragma unroll
        for (int i = 0; i < 4; ++i) ra[i] = *(const u32x4*)(Ap + (size_t)(64 * i) * lda);
#pragma unroll
        for (int i = 0; i < 2; ++i) rb[i] = *(const u32x4*)(Bp + (size_t)(64 * i) * ldb);
        for (int kt = 0; kt < nk; ++kt) {
            __syncthreads();
#pragma unroll
            for (int i = 0; i < 4; ++i) *(u32x4*)(As + ((tid >> 3) + 64 * i) * GA_RS + (tid & 7) * 16) = ra[i];
#pragma unroll
            for (int i = 0; i < 2; ++i) *(u32x4*)(Bs + ((tid >> 3) + 64 * i) * GA_RS + (tid & 7) * 16) = rb[i];
            __syncthreads();
            if (kt + 1 < nk) {
                const int k0 = (kt + 1) * 64;
#pragma unroll
                for (int i = 0; i < 4; ++i) ra[i] = *(const u32x4*)(Ap + (size_t)(64 * i) * lda + k0);
#pragma unroll
                for (int i = 0; i < 2; ++i) rb[i] = *(const u32x4*)(Bp + (size_t)(64 * i) * ldb + k0);
            }
#pragma unroll
            for (int ks = 0; ks < 2; ++ks) {
                bf16x8 af[4], bfr[4];
#pragma unroll
                for (int mt = 0; mt < 4; ++mt) af[mt] = *(const bf16x8*)(As + (64 * wm + 16 * mt + r) * GA_RS + (32 * ks + 8 * g) * 2);
#pragma unroll
                for (int nt = 0; nt < 4; ++nt) bfr[nt] = *(const bf16x8*)(Bs + (64 * wn + 16 * nt + r) * GA_RS + (32 * ks + 8 * g) * 2);
#pragma unroll
                for (int mt = 0; mt < 4; ++mt)
#pragma unroll
                    for (int nt = 0; nt < 4; ++nt) acc[mt][nt] = mfma16(bfr[nt], af[mt], acc[mt][nt]);
            }
        }
        epi(acc, m0 + 64 * wm + r, n0 + 64 * wn + 4 * g, n0);
    }
}

DEV void st_bf4(bf16_t* p, f32x4 v) { u32x2 o; o.x = pk2(v[0], v[1]); o.y = pk2(v[2], v[3]); *(u32x2*)p = o; }
DEV f32x4 rope4(f32x4 v, const float* cs, const float* sn, int fi) {
    const float c0 = cs[fi], s0 = sn[fi], c1 = cs[fi + 1], s1 = sn[fi + 1];
    f32x4 o; o[0] = v[0] * c0 - v[1] * s0; o[1] = v[1] * c0 + v[0] * s0; o[2] = v[2] * c1 - v[3] * s1; o[3] = v[3] * c1 + v[2] * s1; return o;
}

template <int DQK>
DEV void attn_run(const bf16_t* __restrict__ qrow, bool wactive, const bf16_t* __restrict__ Kn, const bf16_t* __restrict__ Kr,
                  const bf16_t* __restrict__ VT, int t_lo, int t_hi, int qpos, int wqmin, int wqmax, char* smem,
                  f32x16 (&o)[4], float& mrun, float& lrun) {
    constexpr int KRS = (DQK + 8) * 2;
    constexpr int VRS = 136;
    constexpr int NKS = DQK / 16;
    constexpr int QREG = (DQK == 192) ? 4 : NKS;
    char* Ks = smem; char* Vs = smem + 64 * KRS; char* Qs = smem + 64 * KRS + 128 * VRS;
    const int tid = opaque_tid(), lane = tid & 63, c = lane & 31, hi = lane >> 5;
    bf16x8 qf[QREG];
#pragma unroll
    for (int ks = 0; ks < QREG; ++ks) qf[ks] = *(const bf16x8*)(qrow + 16 * ks + 8 * hi);
    char* Qw = Qs + (tid >> 6) * ((NKS - QREG) * 1024) + lane * 16;
#pragma unroll
    for (int ks = QREG; ks < NKS; ++ks) *(bf16x8*)(Qw + (ks - QREG) * 1024) = *(const bf16x8*)(qrow + 16 * ks + 8 * hi);
#pragma unroll
    for (int i = 0; i < 4; ++i)
#pragma unroll
        for (int rr = 0; rr < 16; ++rr) o[i][rr] = 0.f;
    mrun = -1e30f; lrun = 0.f;
    constexpr bool ROPE = (DQK == 192);
    u32x4 kreg[2], rreg, vreg[2];
    auto gload = [&](int t) {
        int t2 = tid; asm volatile("" : "+v"(t2));
        const char* kn_t = (const char*)Kn + (size_t)t * (64 * 256);
        const char* vt_t = (const char*)VT + (size_t)t * 128;
#pragma unroll
        for (int i = 0; i < 2; ++i) {
            const int ch = t2 + NTHREADS * i;
            kreg[i] = *(const u32x4*)(kn_t + (unsigned)((ch >> 4) * 256 + (ch & 15) * 16));
            vreg[i] = *(const u32x4*)(vt_t + (unsigned)((ch >> 3) * (S * 2) + (ch & 7) * 16));
        }
        if (ROPE) { const char* kr_t = (const char*)Kr + (size_t)t * (64 * 128); rreg = *(const u32x4*)(kr_t + (unsigned)((t2 >> 3) * 128 + (t2 & 7) * 16)); }
    };
    gload(t_lo);
    for (int t = t_lo; t < t_hi; ++t) {
        __syncthreads();
        {
            int t2 = tid; asm volatile("" : "+v"(t2));
#pragma unroll
            for (int i = 0; i < 2; ++i) {
                const int ch = t2 + NTHREADS * i;
                *(u32x4*)(Ks + (ch >> 4) * KRS + (ch & 15) * 16) = kreg[i];
                u32x2* d = (u32x2*)(Vs + (ch >> 3) * VRS + (ch & 7) * 16);
                d[0] = (u32x2){vreg[i].x, vreg[i].y}; d[1] = (u32x2){vreg[i].z, vreg[i].w};
            }
            if (ROPE) *(u32x4*)(Ks + (t2 >> 3) * KRS + 256 + (t2 & 7) * 16) = rreg;
        }
        __syncthreads();
        if (t + 1 < t_hi) gload(t + 1);
        const int kb = t * 64;
        if (wactive && kb <= wqmax) {
            f32x16 st[2];
#pragma unroll
            for (int kt = 0; kt < 2; ++kt)
#pragma unroll
                for (int rr = 0; rr < 16; ++rr) st[kt][rr] = 0.f;
#pragma unroll
            for (int ks = 0; ks < NKS; ++ks) {
                bf16x8 qv;
                if (ks < QREG) qv = qf[ks < QREG ? ks : 0]; else qv = *(const bf16x8*)(Qw + (ks - QREG) * 1024);
#pragma unroll
                for (int kt = 0; kt < 2; ++kt) {
                    const bf16x8 kf = *(const bf16x8*)(Ks + (32 * kt + c) * KRS + (16 * ks + 8 * hi) * 2);
                    st[kt] = mfma32(kf, qv, st[kt]);
                }
                if ((ks & 1) == 1) __builtin_amdgcn_sched_barrier(0);
            }
            if (kb + 63 > wqmin) {
#pragma unroll
                for (int kt = 0; kt < 2; ++kt)
#pragma unroll
                    for (int rr = 0; rr < 16; ++rr) { const int key = kb + 32 * kt + (rr & 3) + 8 * (rr >> 2) + 4 * hi; if (key > qpos) st[kt][rr] = -__builtin_inff(); }
            }
            float tmax = st[0][0];
#pragma unroll
            for (int rr = 1; rr < 16; ++rr) tmax = fmaxf(tmax, st[0][rr]);
#pragma unroll
            for (int rr = 0; rr < 16; ++rr) tmax = fmaxf(tmax, st[1][rr]);
            tmax = fmaxf(tmax, __shfl_xor(tmax, 32));
            const float mnew = fmaxf(mrun, tmax);
            const float alpha = ex2(mrun - mnew);
            mrun = mnew;
            lrun *= alpha;
#pragma unroll
            for (int i = 0; i < 4; ++i)
#pragma unroll
                for (int rr = 0; rr < 16; ++rr) o[i][rr] *= alpha;
            float ps = 0.f;
#pragma unroll
            for (int kt = 0; kt < 2; ++kt)
#pragma unroll
                for (int rr = 0; rr < 16; ++rr) { const float pv = ex2(st[kt][rr] - mnew); st[kt][rr] = pv; ps += pv; }
            lrun += ps;
#pragma unroll
            for (int kt = 0; kt < 2; ++kt)
#pragma unroll
                for (int s2 = 0; s2 < 2; ++s2) {
                    u32x4 pw; pw.x = pk2(st[kt][8 * s2 + 0], st[kt][8 * s2 + 1]); pw.y = pk2(st[kt][8 * s2 + 2], st[kt][8 * s2 + 3]);
                    pw.z = pk2(st[kt][8 * s2 + 4], st[kt][8 * s2 + 5]); pw.w = pk2(st[kt][8 * s2 + 6], st[kt][8 * s2 + 7]);
                    const bf16x8 pf = *(const bf16x8*)&pw;
#pragma unroll
                    for (int dvt = 0; dvt < 4; ++dvt) {
                        const char* vb = Vs + (32 * dvt + c) * VRS + (32 * kt + 16 * s2 + 4 * hi) * 2;
                        const u32x2 v0 = *(const u32x2*)vb, v1 = *(const u32x2*)(vb + 16);
                        u32x4 vw; vw.x = v0.x; vw.y = v0.y; vw.z = v1.x; vw.w = v1.y;
                        o[dvt] = mfma32(*(const bf16x8*)&vw, pf, o[dvt]);
                    }
                    __builtin_amdgcn_sched_barrier(0);
                }
        }
    }
    lrun += __shfl_xor(lrun, 32);
}

DEV void phase_mla_attn(const Params& p, char* smem) {
    const int tid = opaque_tid(), lane = tid & 63, w = tid >> 6, c = lane & 31, hi = lane >> 5;
    for (int u = opaque_bid(); u < 256; u += gridDim.x) {
        const int head = u & 7, pi = u >> 3;
        for (int half = 0; half < 2; ++half) {
            const int qb = half == 0 ? (63 - pi) : pi;
            const int q = qb * 256 + 32 * w + c;
            f32x16 o[4]; float m, l;
            attn_run<192>(p.Qm() + ((size_t)head * S + q) * 192, true, p.Kn() + (size_t)head * S * 128, p.Kr(), p.VmT() + (size_t)head * 128 * S,
                          0, 4 * qb + 4, q, qb * 256 + 32 * w, qb * 256 + 32 * w + 31, smem, o, m, l);
            const float inv = 1.f / l;
#pragma unroll
            for (int dvt = 0; dvt < 4; ++dvt)
#pragma unroll
                for (int rg = 0; rg < 4; ++rg) {
                    const int dv = 32 * dvt + 8 * rg + 4 * hi;
                    f32x4 v = {o[dvt][4 * rg] * inv, o[dvt][4 * rg + 1] * inv, o[dvt][4 * rg + 2] * inv, o[dvt][4 * rg + 3] * inv};
                    st_bf4(p.cat() + (size_t)q * DM + head * 128 + dv, v);
                }
        }
    }
}

DEV void moba_kmean_unit(const Params& p, int h, int j, char* smem) {
    float* red = (float*)smem;
    const int tid = opaque_tid(), d = tid & 127, qq = tid >> 7;
    const bf16_t* kp = p.Kb() + ((size_t)h * S + 256 * j + qq * 64) * 128 + d;
    float s = 0.f;
    for (int t = 0; t < 64; ++t) s += __uint_as_float(((unsigned)kp[(size_t)t * 128]) << 16);
    __syncthreads();
    red[qq * 128 + d] = s;
    __syncthreads();
    if (tid < 128) p.kmean()[((size_t)h * 64 + j) * 128 + tid] = (red[tid] + red[128 + tid] + red[256 + tid] + red[384 + tid]) * (1.f / 256.f);
}

DEV void phase_moba_gate(const Params& p, char* smem) {
    float* km = (float*)smem;
    int* cnt = (int*)(smem + 32768);
    const int tid = opaque_tid();
    for (int u = opaque_bid(); u < 128; u += gridDim.x) {
        const int h = u & 3, t = u >> 2;
        __syncthreads();
        for (int i = tid; i < 8192; i += NTHREADS) km[i] = p.kmean()[(size_t)h * 8192 + i];
        if (tid < 64) cnt[tid] = 0;
        __syncthreads();
        const int q = t * 512 + tid, own = q >> 8;
        float qv[128];
        const u32x4* qp = (const u32x4*)(p.Qb() + ((size_t)h * S + q) * 128);
#pragma unroll
        for (int i = 0; i < 16; ++i) { const u32x4 v = qp[i]; qv[8 * i] = bflo(v.x); qv[8 * i + 1] = bfhi(v.x); qv[8 * i + 2] = bflo(v.y); qv[8 * i + 3] = bfhi(v.y); qv[8 * i + 4] = bflo(v.z); qv[8 * i + 5] = bfhi(v.z); qv[8 * i + 6] = bflo(v.w); qv[8 * i + 7] = bfhi(v.w); }
        float b0 = -__builtin_inff(), b1 = b0, b2 = b0; int i0 = 0, i1 = 0, i2 = 0;
        const int ownw = __builtin_amdgcn_readfirstlane(own);
        for (int j = 0; j < ownw; ++j) {
            float s = 0.f; const f32x4* kp = (const f32x4*)(km + j * 128);
#pragma unroll
            for (int d4 = 0; d4 < 32; ++d4) { const f32x4 kk = kp[d4]; s += qv[4 * d4] * kk[0] + qv[4 * d4 + 1] * kk[1] + qv[4 * d4 + 2] * kk[2] + qv[4 * d4 + 3] * kk[3]; }
            if (s > b0) { b2 = b1; i2 = i1; b1 = b0; i1 = i0; b0 = s; i0 = j; }
            else if (s > b1) { b2 = b1; i2 = i1; b1 = s; i1 = j; }
            else if (s > b2) { b2 = s; i2 = j; }
        }
        const int nsel = own < 3 ? own : 3;
        if (0 < nsel) { const int pos = atomicAdd(&cnt[i0], 1); p.lists()[(((size_t)h * 64 + i0) * 32 + t) * 512 + pos] = (q << 2) | 0; }
        if (1 < nsel) { const int pos = atomicAdd(&cnt[i1], 1); p.lists()[(((size_t)h * 64 + i1) * 32 + t) * 512 + pos] = (q << 2) | 1; }
        if (2 < nsel) { const int pos = atomicAdd(&cnt[i2], 1); p.lists()[(((size_t)h * 64 + i2) * 32 + t) * 512 + pos] = (q << 2) | 2; }
        __syncthreads();
        if (tid < 64) p.segcnt()[((size_t)h * 64 + tid) * 32 + t] = cnt[tid];
    }
}

DEV void moba_write_partial(const Params& p, int q, int h, int slot, const f32x16 (&o)[4], float m, float l, int hi) {
    float* pp = p.part() + (((size_t)q * 4 + h) * 4 + slot) * 128;
#pragma unroll
    for (int dvt = 0; dvt < 4; ++dvt)
#pragma unroll
        for (int rg = 0; rg < 4; ++rg) {
            const int dv = 32 * dvt + 8 * rg + 4 * hi;
            *(f32x4*)(pp + dv) = (f32x4){o[dvt][4 * rg], o[dvt][4 * rg + 1], o[dvt][4 * rg + 2], o[dvt][4 * rg + 3]};
        }
    if (hi == 0) { float* mp = p.ml() + (((size_t)q * 4 + h) * 4 + slot) * 2; mp[0] = m; mp[1] = l; }
}

DEV void phase_moba_attn(const Params& p, char* smem, int rank, int nwg) {
    const int tid = opaque_tid(), lane = tid & 63, w = tid >> 6, c = lane & 31, hi = lane >> 5;
    int* pre = (int*)(smem + 36864);
    for (int u = rank; u < 256; u += nwg) {
        const int j = u >> 2, h = u & 3;
        const bf16_t* Kh = p.Kb() + (size_t)h * S * 128; const bf16_t* Vh = p.VbT() + (size_t)h * 128 * S;
        {
            const int q = 256 * j + 32 * w + c;
            f32x16 o[4]; float m, l;
            attn_run<128>(p.Qb() + ((size_t)h * S + q) * 128, true, Kh, nullptr, Vh, 4 * j, 4 * j + 4, q, 256 * j + 32 * w, 256 * j + 32 * w + 31, smem, o, m, l);
            moba_write_partial(p, q, h, 3, o, m, l, hi);
        }
        __syncthreads();
        if (tid == 0) { int s = 0; for (int t = 0; t < 32; ++t) { pre[t] = s; s += p.segcnt()[((size_t)h * 64 + j) * 32 + t]; } pre[32] = s; }
        __syncthreads();
        const int total = pre[32];
        for (int k0 = 0; k0 < total; k0 += 256) {
            const int e = k0 + 32 * w + c; const bool valid = e < total; int q = 0, slot = 0;
            if (valid) {
                int seg = 0;
                for (int t = 1; t < 32; ++t) if (pre[t] <= e) seg = t;
                const int ent = p.lists()[(((size_t)h * 64 + j) * 32 + seg) * 512 + (e - pre[seg])];
                q = ent >> 2; slot = ent & 3;
            }
            const bool wact = (k0 + 32 * w) < total;
            f32x16 o[4]; float m, l;
            attn_run<128>(p.Qb() + ((size_t)h * S + q) * 128, wact, Kh, nullptr, Vh, 4 * j, 4 * j + 4, 0x7fffffff, 0x7fffffff, 0x7fffffff, smem, o, m, l);
            if (valid) moba_write_partial(p, q, h, slot, o, m, l, hi);
        }
        __syncthreads();
    }
}

constexpr int GP_KN = 0, GP_KB = 17408, GP_QS = 34816, GP_RF = 52224, GP_LM = 117760, GP_KDT = 135168, GP_GC = 153600, GP_BT = 153856;
DEV void gdn_prep_unit(const Params& p, int li, int n, int h, char* smem) {
    const int tid = opaque_tid(), lane = tid & 63, w = tid >> 6, r = lane & 15, g = lane >> 4;
    char* Kn16 = smem + GP_KN; char* Kb16 = smem + GP_KB; char* Qs16 = smem + GP_QS;
    float* Rf = (float*)(smem + GP_RF); float* Lm = (float*)(smem + GP_LM); char* KdT = smem + GP_KDT;
    float* gc = (float*)(smem + GP_GC); float* bt = (float*)(smem + GP_BT);
    const size_t cb = (size_t)n * 4 + h;
    __syncthreads();
    if (w == 0) {
        const int tok = 64 * n + lane;
        const float a = p.ba()[(size_t)tok * 8 + 4 + h], bb = p.ba()[(size_t)tok * 8 + h];
        float gv = -expf(p.gdn_a_log[li * 4 + h]) * softplusf(a + p.gdn_dt_bias[li * 4 + h]);
#pragma unroll
        for (int o = 1; o < 64; o <<= 1) { const float t = __shfl_up(gv, o); if (lane >= o) gv += t; }
        gc[lane] = gv; bt[lane] = 1.f / (1.f + expf(-bb));
    }
    __syncthreads();
    const float glast = gc[63];
    {
        const int tok = tid >> 3, grp = tid & 7, gt = 64 * n + tok;
        const float gct = gc[tok], btt = bt[tok];
        const float egc = expf(gct), egl = expf(glast - gct);
        const float* cw = p.gdn_conv + (size_t)li * 4 * 1536;
#pragma unroll
        for (int part = 0; part < 3; ++part) {
            const int ch0 = part * 512 + h * 128 + grp * 16;
            float val[16];
#pragma unroll
            for (int i = 0; i < 16; ++i) val[i] = 0.f;
#pragma unroll
            for (int j = 0; j < 4; ++j) {
                const int ts = gt - 3 + j;
                if (ts >= 0) {
                    const u32x4* xp = (const u32x4*)(p.proj_a() + (size_t)ts * 1536 + ch0);
                    const u32x4 x0 = xp[0], x1 = xp[1];
                    const f32x4* wp = (const f32x4*)(cw + (size_t)j * 1536 + ch0);
                    const f32x4 w0 = wp[0], w1 = wp[1], w2 = wp[2], w3 = wp[3];
                    val[0] += bflo(x0.x) * w0[0]; val[1] += bfhi(x0.x) * w0[1]; val[2] += bflo(x0.y) * w0[2]; val[3] += bfhi(x0.y) * w0[3];
                    val[4] += bflo(x0.z) * w1[0]; val[5] += bfhi(x0.z) * w1[1]; val[6] += bflo(x0.w) * w1[2]; val[7] += bfhi(x0.w) * w1[3];
                    val[8] += bflo(x1.x) * w2[0]; val[9] += bfhi(x1.x) * w2[1]; val[10] += bflo(x1.y) * w2[2]; val[11] += bfhi(x1.y) * w2[3];
                    val[12] += bflo(x1.z) * w3[0]; val[13] += bfhi(x1.z) * w3[1]; val[14] += bflo(x1.w) * w3[2]; val[15] += bfhi(x1.w) * w3[3];
                }
            }
#pragma unroll
            for (int i = 0; i < 16; ++i) val[i] = siluf(val[i]);
            if (part < 2) {
                float ss = 0.f;
#pragma unroll
                for (int i = 0; i < 16; ++i) ss += val[i] * val[i];
                ss += __shfl_xor(ss, 1); ss += __shfl_xor(ss, 2); ss += __shfl_xor(ss, 4);
                const float rn = rsqrtf(ss + 1e-6f);
#pragma unroll
                for (int i = 0; i < 16; ++i) val[i] *= rn;
            }
            if (part == 0) {
                const float qs = 0.08838834764831845f;
                u32x4 a0, a1, d0, d1;
                a0.x = pk2(val[0] * qs, val[1] * qs); a0.y = pk2(val[2] * qs, val[3] * qs); a0.z = pk2(val[4] * qs, val[5] * qs); a0.w = pk2(val[6] * qs, val[7] * qs);
                a1.x = pk2(val[8] * qs, val[9] * qs); a1.y = pk2(val[10] * qs, val[11] * qs); a1.z = pk2(val[12] * qs, val[13] * qs); a1.w = pk2(val[14] * qs, val[15] * qs);
                *(u32x4*)(Qs16 + tok * 272 + grp * 32) = a0; *(u32x4*)(Qs16 + tok * 272 + grp * 32 + 16) = a1;
                const float qd = qs * egc;
                d0.x = pk2(val[0] * qd, val[1] * qd); d0.y = pk2(val[2] * qd, val[3] * qd); d0.z = pk2(val[4] * qd, val[5] * qd); d0.w = pk2(val[6] * qd, val[7] * qd);
                d1.x = pk2(val[8] * qd, val[9] * qd); d1.y = pk2(val[10] * qd, val[11] * qd); d1.z = pk2(val[12] * qd, val[13] * qd); d1.w = pk2(val[14] * qd, val[15] * qd);
                u32x4* qo = (u32x4*)(p.qdec() + (cb * 64 + tok) * 128 + grp * 16);
                qo[0] = d0; qo[1] = d1;
            } else if (part == 1) {
                u32x4 a0, a1, d0, d1;
                a0.x = pk2(val[0], val[1]); a0.y = pk2(val[2], val[3]); a0.z = pk2(val[4], val[5]); a0.w = pk2(val[6], val[7]);
                a1.x = pk2(val[8], val[9]); a1.y = pk2(val[10], val[11]); a1.z = pk2(val[12], val[13]); a1.w = pk2(val[14], val[15]);
                *(u32x4*)(Kn16 + tok * 272 + grp * 32) = a0; *(u32x4*)(Kn16 + tok * 272 + grp * 32 + 16) = a1;
                d0.x = pk2(val[0] * btt, val[1] * btt); d0.y = pk2(val[2] * btt, val[3] * btt); d0.z = pk2(val[4] * btt, val[5] * btt); d0.w = pk2(val[6] * btt, val[7] * btt);
                d1.x = pk2(val[8] * btt, val[9] * btt); d1.y = pk2(val[10] * btt, val[11] * btt); d1.z = pk2(val[12] * btt, val[13] * btt); d1.w = pk2(val[14] * btt, val[15] * btt);
                *(u32x4*)(Kb16 + tok * 272 + grp * 32) = d0; *(u32x4*)(Kb16 + tok * 272 + grp * 32 + 16) = d1;
                const float kb = btt * egc;
#pragma unroll
                for (int i = 0; i < 16; ++i) {
                    Rf[tok * 256 + 128 + grp * 16 + i] = val[i] * kb;
                    *(bf16_t*)(KdT + (grp * 16 + i) * 144 + tok * 2) = f2bf(val[i] * egl);
                }
            } else {
#pragma unroll
                for (int i = 0; i < 16; ++i) Rf[tok * 256 + grp * 16 + i] = val[i] * btt;
            }
        }
    }
    __syncthreads();
#pragma unroll
    for (int tt = 0; tt < 2; ++tt) {
        const int tile = 2 * w + tt, ct = tile >> 2, mt = tile & 3;
        f32x4 accL = {0.f, 0.f, 0.f, 0.f}, accQ = {0.f, 0.f, 0.f, 0.f};
#pragma unroll
        for (int ks = 0; ks < 4; ++ks) {
            const bf16x8 akb = *(const bf16x8*)(Kb16 + (16 * ct + r) * 272 + (32 * ks + 8 * g) * 2);
            const bf16x8 knm = *(const bf16x8*)(Kn16 + (16 * mt + r) * 272 + (32 * ks + 8 * g) * 2);
            const bf16x8 qsc = *(const bf16x8*)(Qs16 + (16 * ct + r) * 272 + (32 * ks + 8 * g) * 2);
            accL = mfma16(akb, knm, accL);
            accQ = mfma16(knm, qsc, accQ);
        }
#pragma unroll
        for (int jj = 0; jj < 4; ++jj) {
            const int ci = 16 * ct + 4 * g + jj, mi = 16 * mt + r;
            Lm[ci * 68 + mi] = (mi < ci) ? accL[jj] * expf(gc[ci] - gc[mi]) : 0.f;
        }
        {
            const int ci = 16 * ct + r;
            f32x4 v;
#pragma unroll
            for (int jj = 0; jj < 4; ++jj) { const int mi = 16 * mt + 4 * g + jj; v[jj] = (mi <= ci) ? accQ[jj] * expf(gc[ci] - gc[mi]) : 0.f; }
            st_bf4(p.qk() + (cb * 64 + ci) * 64 + 16 * mt + 4 * g, v);
        }
    }
#pragma unroll
    for (int i = 0; i < 2; ++i) {
        const int ch = tid + NTHREADS * i, row = ch >> 3, cc = ch & 7;
        *(u32x4*)(p.kdT() + (cb * 128 + row) * 64 + cc * 8) = *(const u32x4*)(KdT + row * 144 + cc * 16);
    }
    __syncthreads();
    if (w < 4) {
        const int col = tid;
        float x[64];
#pragma unroll
        for (int i = 0; i < 64; ++i) {
            float a = Rf[i * 256 + col];
#pragma unroll
            for (int j4 = 0; j4 < (i + 3) / 4; ++j4) {
                const f32x4 l4 = *(const f32x4*)(Lm + i * 68 + 4 * j4);
#pragma unroll
                for (int jj = 0; jj < 4; ++jj) if (4 * j4 + jj < i) a -= l4[jj] * x[4 * j4 + jj];
            }
            x[i] = a;
        }
        if (col < 128) {
#pragma unroll
            for (int i = 0; i < 64; ++i) p.u32()[(cb * 64 + i) * 128 + col] = x[i];
        } else {
#pragma unroll
            for (int i = 0; i < 64; ++i) p.wneg()[(cb * 64 + i) * 128 + col - 128] = f2bf(-x[i]);
        }
    }
    if (tid == 0) p.glast()[cb] = glast;
}

struct ScanFr { bf16x8 wf[4], qf[4], qkf[2], kdf[2]; f32x4 u; float eg; };
DEV void gdn_scan(const Params& p, int sw, char* smem) {
    const int tid = opaque_tid(), lane = tid & 63, w = tid >> 6, r = lane & 15, g = lane >> 4, mt = w >> 1, nt = w & 1;
    const int h = sw >> 2, dvb = (sw & 3) * 32;
    char* S16 = smem; char* Vn16 = smem + 8704;
    __syncthreads();
    for (int i = tid; i < 8704 / 4; i += NTHREADS) ((int*)S16)[i] = 0;
    f32x4 sacc[2] = {{0.f, 0.f, 0.f, 0.f}, {0.f, 0.f, 0.f, 0.f}};
    auto load = [&](int n, ScanFr& f) {
        const size_t cb = (size_t)n * 4 + h;
        const bf16_t* wp = p.wneg() + (cb * 64 + 16 * mt + r) * 128 + 8 * g;
        const bf16_t* qp = p.qdec() + (cb * 64 + 16 * mt + r) * 128 + 8 * g;
#pragma unroll
        for (int ks = 0; ks < 4; ++ks) { f.wf[ks] = *(const bf16x8*)(wp + 32 * ks); f.qf[ks] = *(const bf16x8*)(qp + 32 * ks); }
        const bf16_t* qkp = p.qk() + (cb * 64 + 16 * mt + r) * 64 + 8 * g;
        const bf16_t* kp = p.kdT() + (cb * 128 + 16 * w + r) * 64 + 8 * g;
#pragma unroll
        for (int ks = 0; ks < 2; ++ks) { f.qkf[ks] = *(const bf16x8*)(qkp + 32 * ks); f.kdf[ks] = *(const bf16x8*)(kp + 32 * ks); }
        const float* up = p.u32() + (cb * 64 + 16 * mt + 4 * g) * 128 + dvb + 16 * nt + r;
#pragma unroll
        for (int jj = 0; jj < 4; ++jj) f.u[jj] = up[jj * 128];
        f.eg = expf(p.glast()[cb]);
    };
    ScanFr nx; load(0, nx);
    __syncthreads();
    for (int n = 0; n < 256; ++n) {
        ScanFr cu = nx;
        if (n + 1 < 256) load(n + 1, nx);
        f32x4 a1 = cu.u, a2 = {0.f, 0.f, 0.f, 0.f};
#pragma unroll
        for (int ks = 0; ks < 4; ++ks) {
            const bf16x8 sf = *(const bf16x8*)(S16 + (16 * nt + r) * 272 + (32 * ks + 8 * g) * 2);
            a1 = mfma16(cu.wf[ks], sf, a1);
            a2 = mfma16(cu.qf[ks], sf, a2);
        }
        *(u32x2*)(Vn16 + (16 * nt + r) * 144 + (16 * mt + 4 * g) * 2) = (u32x2){pk2(a1[0], a1[1]), pk2(a1[2], a1[3])};
        __syncthreads();
#pragma unroll
        for (int ks = 0; ks < 2; ++ks) {
            const bf16x8 vf = *(const bf16x8*)(Vn16 + (16 * nt + r) * 144 + (32 * ks + 8 * g) * 2);
            a2 = mfma16(cu.qkf[ks], vf, a2);
        }
        {
            float* op = p.oa() + ((size_t)(64 * n + 16 * mt + 4 * g)) * 512 + h * 128 + dvb + 16 * nt + r;
#pragma unroll
            for (int jj = 0; jj < 4; ++jj) op[jj * 512] = a2[jj];
        }
#pragma unroll
        for (int n2 = 0; n2 < 2; ++n2) {
            sacc[n2] = sacc[n2] * cu.eg;
#pragma unroll
            for (int ks = 0; ks < 2; ++ks) {
                const bf16x8 vf = *(const bf16x8*)(Vn16 + (16 * n2 + r) * 144 + (32 * ks + 8 * g) * 2);
                sacc[n2] = mfma16(cu.kdf[ks], vf, sacc[n2]);
            }
            *(u32x2*)(S16 + (16 * n2 + r) * 272 + (16 * w + 4 * g) * 2) = (u32x2){pk2(sacc[n2][0], sacc[n2][1]), pk2(sacc[n2][2], sacc[n2][3])};
        }
        __syncthreads();
    }
}

DEV void phase_even_combine(const Params& p, int li) {
    const int tid = opaque_tid(), lane = tid & 63, w = __builtin_amdgcn_readfirstlane(tid >> 6), hh = lane >> 4, d0 = (lane & 15) * 8;
    for (int tok = opaque_bid() * 8 + w; tok < S; tok += gridDim.x * 8) {
        {
            const float* op = p.oa() + (size_t)tok * 512 + hh * 128 + d0;
            const f32x4 a = *(const f32x4*)op, b = *(const f32x4*)(op + 4);
            float ss = a[0] * a[0] + a[1] * a[1] + a[2] * a[2] + a[3] * a[3] + b[0] * b[0] + b[1] * b[1] + b[2] * b[2] + b[3] * b[3];
            ss += __shfl_xor(ss, 1); ss += __shfl_xor(ss, 2); ss += __shfl_xor(ss, 4); ss += __shfl_xor(ss, 8);
            const float rn = rsqrtf(ss * (1.f / 128.f) + 1e-6f);
            const u32x4 z = *(const u32x4*)(p.zbuf() + (size_t)tok * 512 + hh * 128 + d0);
            const f32x4 n0 = *(const f32x4*)(p.gdn_o_norm + li * 128 + d0), n1 = *(const f32x4*)(p.gdn_o_norm + li * 128 + d0 + 4);
            u32x4 o;
            o.x = pk2(a[0] * rn * n0[0] * siluf(bflo(z.x)), a[1] * rn * n0[1] * siluf(bfhi(z.x)));
            o.y = pk2(a[2] * rn * n0[2] * siluf(bflo(z.y)), a[3] * rn * n0[3] * siluf(bfhi(z.y)));
            o.z = pk2(b[0] * rn * n1[0] * siluf(bflo(z.z)), b[1] * rn * n1[1] * siluf(bfhi(z.z)));
            o.w = pk2(b[2] * rn * n1[2] * siluf(bflo(z.w)), b[3] * rn * n1[3] * siluf(bfhi(z.w)));
            *(u32x4*)(p.cat() + (size_t)tok * DM + hh * 128 + d0) = o;
        }
        {
            const int own = tok >> 8, nsel = own < 3 ? own : 3;
            const float* mlp = p.ml() + ((size_t)tok * 4 + hh) * 8;
            const float* pp = p.part() + ((size_t)tok * 4 + hh) * 4 * 128 + d0;
            const float m3 = mlp[6], l3 = mlp[7];
            float ms[3], ls[3]; float mm = m3;
#pragma unroll
            for (int s = 0; s < 3; ++s) { ms[s] = -1e30f; ls[s] = 0.f; if (s < nsel) { ms[s] = mlp[2 * s]; ls[s] = mlp[2 * s + 1]; mm = fmaxf(mm, ms[s]); } }
            float wt = ex2(m3 - mm), den = wt * l3;
            f32x4 a = *(const f32x4*)(pp + 3 * 128) * wt, b = *(const f32x4*)(pp + 3 * 128 + 4) * wt;
#pragma unroll
            for (int s = 0; s < 3; ++s) if (s < nsel) {
                wt = ex2(ms[s] - mm); den += wt * ls[s];
                a += *(const f32x4*)(pp + s * 128) * wt; b += *(const f32x4*)(pp + s * 128 + 4) * wt;
            }
            const float inv = 1.f / den;
            u32x4 o; o.x = pk2(a[0] * inv, a[1] * inv); o.y = pk2(a[2] * inv, a[3] * inv); o.z = pk2(b[0] * inv, b[1] * inv); o.w = pk2(b[2] * inv, b[3] * inv);
            *(u32x4*)(p.cat() + (size_t)tok * DM + 512 + hh * 128 + d0) = o;
        }
    }
}

DEV void phase_mla_cnorm(const Params& p, int li) {
    const int tid = opaque_tid(), lane = tid & 63, w = __builtin_amdgcn_readfirstlane(tid >> 6);
    for (int row = opaque_bid() * 8 + w; row < S; row += gridDim.x * 8) {
        const bf16_t* cp = p.cbuf() + (size_t)row * 768;
        const u32x4 qv = *(const u32x4*)(cp + lane * 8);
        const u32x2 kv = *(const u32x2*)(cp + 512 + lane * 4);
        float q[8] = {bflo(qv.x), bfhi(qv.x), bflo(qv.y), bfhi(qv.y), bflo(qv.z), bfhi(qv.z), bflo(qv.w), bfhi(qv.w)};
        float k[4] = {bflo(kv.x), bfhi(kv.x), bflo(kv.y), bfhi(kv.y)};
        float sq = 0.f, sk = 0.f;
#pragma unroll
        for (int i = 0; i < 8; ++i) sq += q[i] * q[i];
#pragma unroll
        for (int i = 0; i < 4; ++i) sk += k[i] * k[i];
        sq = wsum64(sq); sk = wsum64(sk);
        const float rq = rsqrtf(sq * (1.f / 512.f) + 1e-6f), rk = rsqrtf(sk * (1.f / 256.f) + 1e-6f);
        const float* qn = p.mla_q_norm + li * 512 + lane * 8; const float* kn = p.mla_kv_norm + li * 256 + lane * 4;
        u32x4 oq; oq.x = pk2(q[0] * rq * qn[0], q[1] * rq * qn[1]); oq.y = pk2(q[2] * rq * qn[2], q[3] * rq * qn[3]);
        oq.z = pk2(q[4] * rq * qn[4], q[5] * rq * qn[5]); oq.w = pk2(q[6] * rq * qn[6], q[7] * rq * qn[7]);
        *(u32x4*)(p.cqn() + (size_t)row * 512 + lane * 8) = oq;
        u32x2 ok; ok.x = pk2(k[0] * rk * kn[0], k[1] * rk * kn[1]); ok.y = pk2(k[2] * rk * kn[2], k[3] * rk * kn[3]);
        *(u32x2*)(p.ckvn() + (size_t)row * 256 + lane * 4) = ok;
    }
}

#define SORT16_NET(CE) CE(0,1) CE(2,3) CE(0,2) CE(1,3) CE(1,2) CE(4,5) CE(6,7) CE(4,6) CE(5,7) CE(5,6) CE(0,4) CE(2,6) CE(2,4) CE(1,5) CE(3,7) CE(3,5) CE(1,2) CE(3,4) CE(5,6) CE(8,9) CE(10,11) CE(8,10) CE(9,11) CE(9,10) CE(12,13) CE(14,15) CE(12,14) CE(13,15) CE(13,14) CE(8,12) CE(10,14) CE(10,12) CE(9,13) CE(11,15) CE(11,13) CE(9,10) CE(11,12) CE(13,14) CE(0,8) CE(4,12) CE(4,8) CE(2,10) CE(6,14) CE(6,10) CE(2,4) CE(6,8) CE(10,12) CE(1,9) CE(5,13) CE(5,9) CE(3,11) CE(7,15) CE(7,11) CE(3,5) CE(7,9) CE(11,13) CE(1,2) CE(3,4) CE(5,6) CE(7,8) CE(9,10) CE(11,12) CE(13,14)

template <int OFF> DEV void sort16(float (&v)[64]) {
#define CE_(a, b) { const float hi_ = fmaxf(v[OFF + a], v[OFF + b]), lo_ = fminf(v[OFF + a], v[OFF + b]); v[OFF + a] = hi_; v[OFF + b] = lo_; }
    SORT16_NET(CE_)
#undef CE_
}
template <int A> DEV void bitonic16(float (&v)[64]) {
#pragma unroll
    for (int d = 8; d >= 1; d >>= 1)
#pragma unroll
        for (int i = 0; i < 16; ++i) if ((i & d) == 0) { const float hi_ = fmaxf(v[A + i], v[A + i + d]), lo_ = fminf(v[A + i], v[A + i + d]); v[A + i] = hi_; v[A + i + d] = lo_; }
}
template <int A, int B> DEV void merge16(float (&v)[64]) {
#pragma unroll
    for (int i = 0; i < 16; ++i) v[A + i] = fmaxf(v[A + i], v[B + 15 - i]);
    bitonic16<A>(v);
}
DEV void top16_of_64(float (&v)[64]) {
    sort16<0>(v); sort16<16>(v); sort16<32>(v); sort16<48>(v);
    merge16<0, 16>(v); merge16<32, 48>(v); merge16<0, 32>(v);
}

DEV void phase_peer_topk(const Params& p, int layer, char* smem) {
    const int tid = opaque_tid(), lane = tid & 63, w = tid >> 6, c = lane & 31, hi = lane >> 5;
    char* SK = smem;
    constexpr int CI[50] = {0,0,0,0,0,0,0,0,0,0,0,0,0,0,0,0, 1,1,1,1,1,1,1,1, 2,2,2,2,2, 3,3,3,3, 4,4,4, 5,5, 6,6, 7,7, 8,9,10,11,12,13,14,15};
    constexpr int CJ[50] = {0,1,2,3,4,5,6,7,8,9,10,11,12,13,14,15, 0,1,2,3,4,5,6,7, 0,1,2,3,4, 0,1,2,3, 0,1,2, 0,1, 0,1, 0,1, 0,0,0,0,0,0,0,0};
    int loaded_h = -1;
    for (int u = opaque_bid(); u < 512; u += gridDim.x) {
        const int h = u & 7, tg = u >> 3;
        if (h != loaded_h) {
            __syncthreads();
#pragma unroll
            for (int i = 0; i < 8; ++i) {
                const int ch = tid + NTHREADS * i, pp = ch >> 11, rem = ch & 2047, row = rem >> 4, cc = rem & 15;
                *(u32x4*)(SK + pp * 34816 + row * 272 + cc * 16) = *(const u32x4*)(p.skb() + ((((size_t)layer * 8 + h) * 2 + pp) * 128 + row) * 128 + cc * 8);
            }
            __syncthreads();
            loaded_h = h;
        }
        const int token = tg * 256 + 32 * w + c;
        float s0[16], s1[16];
#pragma unroll
        for (int pp = 0; pp < 2; ++pp) {
            bf16x8 qf[8];
            const bf16_t* qp = p.qbuf() + (size_t)token * 2048 + (h * 2 + pp) * 128 + 8 * hi;
#pragma unroll
            for (int ks = 0; ks < 8; ++ks) qf[ks] = *(const bf16x8*)(qp + 16 * ks);
            float v[64];
#pragma unroll
            for (int kt = 0; kt < 4; ++kt) {
                f32x16 acc;
#pragma unroll
                for (int rr = 0; rr < 16; ++rr) acc[rr] = 0.f;
#pragma unroll
                for (int ks = 0; ks < 8; ++ks) acc = mfma32(*(const bf16x8*)(SK + pp * 34816 + (32 * kt + c) * 272 + (16 * ks + 8 * hi) * 2), qf[ks], acc);
#pragma unroll
                for (int rr = 0; rr < 16; ++rr) {
                    const unsigned idx = (unsigned)(32 * kt + (rr & 3) + 8 * (rr >> 2) + 4 * hi);
                    v[16 * kt + rr] = __uint_as_float((__float_as_uint(acc[rr]) & ~127u) | idx);
                }
            }
            top16_of_64(v);
#pragma unroll
            for (int i = 0; i < 16; ++i) v[16 + i] = __shfl_xor(v[15 - i], 32);
#pragma unroll
            for (int i = 0; i < 16; ++i) v[i] = fmaxf(v[i], v[16 + i]);
            bitonic16<0>(v);
#pragma unroll
            for (int i = 0; i < 16; ++i) { if (pp == 0) s0[i] = v[i]; else s1[i] = v[i]; }
        }
        float cv[64];
#pragma unroll
        for (int k = 0; k < 50; ++k) {
            const float a = s0[CI[k]], b = s1[CJ[k]];
            const unsigned id = ((__float_as_uint(a) & 127u) << 7) | (__float_as_uint(b) & 127u);
            cv[k] = __uint_as_float((__float_as_uint(a + b) & ~0x3FFFu) | id);
        }
#pragma unroll
        for (int k = 50; k < 64; ++k) cv[k] = -__builtin_inff();
        top16_of_64(cv);
        float e[16], sum = 0.f;
#pragma unroll
        for (int i = 0; i < 16; ++i) { e[i] = expf(cv[i] - cv[0]); sum += e[i]; }
        const float inv = 1.f / sum;
        if (hi == 0) {
            int* ep = p.expert() + (size_t)token * 128 + h * 16; float* gp = p.gate() + (size_t)token * 128 + h * 16;
#pragma unroll
            for (int i4 = 0; i4 < 4; ++i4) {
                i32x4 ev; ev.x = (int)(__float_as_uint(cv[4 * i4]) & 0x3FFFu); ev.y = (int)(__float_as_uint(cv[4 * i4 + 1]) & 0x3FFFu);
                ev.z = (int)(__float_as_uint(cv[4 * i4 + 2]) & 0x3FFFu); ev.w = (int)(__float_as_uint(cv[4 * i4 + 3]) & 0x3FFFu);
                *(i32x4*)(ep + 4 * i4) = ev;
                *(f32x4*)(gp + 4 * i4) = (f32x4){e[4 * i4] * inv, e[4 * i4 + 1] * inv, e[4 * i4 + 2] * inv, e[4 * i4 + 3] * inv};
            }
        }
    }
}

DEV float dot2bf(unsigned a, unsigned b, float c) {
    bf16v2 x, y; __builtin_memcpy(&x, &a, 4); __builtin_memcpy(&y, &b, 4);
    return __builtin_amdgcn_fdot2_f32_bf16(x, y, c, false);
}
DEV float dot16(const u32x4& h0, const u32x4& h1, const u32x4& r0, const u32x4& r1) {
    float a = 0.f;
    a = dot2bf(h0.x, r0.x, a); a = dot2bf(h0.y, r0.y, a); a = dot2bf(h0.z, r0.z, a); a = dot2bf(h0.w, r0.w, a);
    a = dot2bf(h1.x, r1.x, a); a = dot2bf(h1.y, r1.y, a); a = dot2bf(h1.z, r1.z, a); a = dot2bf(h1.w, r1.w, a);
    return a;
}

DEV void phase_peer_gather(const Params& p, int layer, const float* __restrict__ g2, const float* __restrict__ xsrc) {
    const int tid = opaque_tid(), lane = tid & 63, w = __builtin_amdgcn_readfirstlane(tid >> 6);
    const bf16_t* ub = p.ub() + (size_t)layer * 16384 * 1024; const bf16_t* vb = p.vb() + (size_t)layer * 16384 * 1024;
    const unsigned lo32 = (unsigned)lane * 32u;
    const int idxl = ((lane >> 5) & 1) * 8 + ((lane >> 4) & 1) * 4 + ((lane >> 3) & 1) * 2 + ((lane >> 2) & 1);
    for (int tok = opaque_bid() * 8 + w; tok < S; tok += gridDim.x * 8) {
        const u32x4 h0 = *(const u32x4*)(p.h() + (size_t)tok * DM + lane * 16), h1 = *(const u32x4*)(p.h() + (size_t)tok * DM + lane * 16 + 8);
        const int e0 = p.expert()[(size_t)tok * 128 + lane], e1 = p.expert()[(size_t)tok * 128 + 64 + lane];
        float coef[8];
#pragma unroll
        for (int b = 0; b < 8; ++b) {
            float pt[16];
#pragma unroll
            for (int half = 0; half < 2; ++half) {
                u32x4 r0[8], r1[8];
#pragma unroll
                for (int k = 0; k < 8; ++k) {
                    const int e = __builtin_amdgcn_readlane(b < 4 ? e0 : e1, (b & 3) * 16 + half * 8 + k);
                    const unsigned vo = (unsigned)e * 2048u + lo32;
                    r0[k] = *(const u32x4*)((const char*)ub + vo); r1[k] = *(const u32x4*)((const char*)ub + vo + 16);
                }
#pragma unroll
                for (int k = 0; k < 8; ++k) pt[half * 8 + k] = dot16(h0, h1, r0[k], r1[k]);
                __builtin_amdgcn_sched_barrier(0);
            }
#pragma unroll
            for (int k = 0; k < 8; ++k) { const bool up = (lane & 32) != 0; const float send = up ? pt[k] : pt[k + 8], keep = up ? pt[k + 8] : pt[k]; pt[k] = keep + __shfl_xor(send, 32); }
#pragma unroll
            for (int k = 0; k < 4; ++k) { const bool up = (lane & 16) != 0; const float send = up ? pt[k] : pt[k + 4], keep = up ? pt[k + 4] : pt[k]; pt[k] = keep + __shfl_xor(send, 16); }
#pragma unroll
            for (int k = 0; k < 2; ++k) { const bool up = (lane & 8) != 0; const float send = up ? pt[k] : pt[k + 2], keep = up ? pt[k + 2] : pt[k]; pt[k] = keep + __shfl_xor(send, 8); }
            { const bool up = (lane & 4) != 0; const float send = up ? pt[0] : pt[1], keep = up ? pt[1] : pt[0]; pt[0] = keep + __shfl_xor(send, 4); }
            pt[0] += __shfl_xor(pt[0], 2); pt[0] += __shfl_xor(pt[0], 1);
            const float gv = p.gate()[(size_t)tok * 128 + b * 16 + idxl];
            const float d = pt[0];
            coef[b] = gv * 0.5f * d * (1.f + erff(d * 0.70710678118654752f));
        }
        float acc[16];
#pragma unroll
        for (int i = 0; i < 16; ++i) acc[i] = 0.f;
#pragma unroll
        for (int b = 0; b < 8; ++b) {
#pragma unroll
            for (int half = 0; half < 2; ++half) {
                u32x4 r0[8], r1[8];
#pragma unroll
                for (int k = 0; k < 8; ++k) {
                    const int e = __builtin_amdgcn_readlane(b < 4 ? e0 : e1, (b & 3) * 16 + half * 8 + k);
                    const unsigned vo = (unsigned)e * 2048u + lo32;
                    r0[k] = *(const u32x4*)((const char*)vb + vo); r1[k] = *(const u32x4*)((const char*)vb + vo + 16);
                }
#pragma unroll
                for (int k = 0; k < 8; ++k) {
                    const int kk = half * 8 + k;
                    const int src = ((kk >> 3) & 1) * 32 + ((kk >> 2) & 1) * 16 + ((kk >> 1) & 1) * 8 + (kk & 1) * 4;
                    const float cf = __uint_as_float((unsigned)__builtin_amdgcn_readlane((int)__float_as_uint(coef[b]), src));
                    acc[0] += cf * bflo(r0[k].x); acc[1] += cf * bfhi(r0[k].x); acc[2] += cf * bflo(r0[k].y); acc[3] += cf * bfhi(r0[k].y);
                    acc[4] += cf * bflo(r0[k].z); acc[5] += cf * bfhi(r0[k].z); acc[6] += cf * bflo(r0[k].w); acc[7] += cf * bfhi(r0[k].w);
                    acc[8] += cf * bflo(r1[k].x); acc[9] += cf * bfhi(r1[k].x); acc[10] += cf * bflo(r1[k].y); acc[11] += cf * bfhi(r1[k].y);
                    acc[12] += cf * bflo(r1[k].z); acc[13] += cf * bfhi(r1[k].z); acc[14] += cf * bflo(r1[k].w); acc[15] += cf * bfhi(r1[k].w);
                }
                __builtin_amdgcn_sched_barrier(0);
            }
        }
        const float* xp = xsrc + (size_t)tok * DM + lane * 16; float* xo = p.xw() + (size_t)tok * DM + lane * 16; const float* gp = g2 + lane * 16;
#pragma unroll
        for (int i4 = 0; i4 < 4; ++i4) {
            const f32x4 xv = *(const f32x4*)(xp + 4 * i4); f32x4 gg = *(const f32x4*)(gp + 4 * i4);
            f32x4 o;
#ifdef DBG_NO_PEER
            gg[0] = gg[1] = gg[2] = gg[3] = 0.f;
#endif
#ifdef DBG_PEER2
            gg = gg * 2.f;
#endif
            o[0] = xv[0] + gg[0] * acc[4 * i4]; o[1] = xv[1] + gg[1] * acc[4 * i4 + 1]; o[2] = xv[2] + gg[2] * acc[4 * i4 + 2]; o[3] = xv[3] + gg[3] * acc[4 * i4 + 3];
            *(f32x4*)(xo + 4 * i4) = o;
        }
    }
}

extern __shared__ __attribute__((aligned(16))) char smem_raw[];
DEV char* smem_user() { LAS char* q = (LAS char*)smem_raw + LDS_USER; asm volatile("" : "+v"(q)); return (char*)q; }
typedef const __attribute__((address_space(4))) Params* KParams;
DEV void load_params(Params& p) {
    auto kp0 = __builtin_amdgcn_kernarg_segment_ptr();
    asm volatile("" : "+s"(kp0));
    KParams kp = (KParams)kp0;
    p.x = kp->x;
    p.c = kp->c;
    p.pos = kp->pos;
    p.mod_w = kp->mod_w;
    p.mod_b = kp->mod_b;
    p.norm_mix = kp->norm_mix;
    p.norm_ffn = kp->norm_ffn;
    p.hy_w_in = kp->hy_w_in;
    p.gdn_conv = kp->gdn_conv;
    p.gdn_a_log = kp->gdn_a_log;
    p.gdn_dt_bias = kp->gdn_dt_bias;
    p.gdn_o_norm = kp->gdn_o_norm;
    p.hy_w_out = kp->hy_w_out;
    p.mla_w_in = kp->mla_w_in;
    p.mla_q_norm = kp->mla_q_norm;
    p.mla_kv_norm = kp->mla_kv_norm;
    p.mla_w_uq = kp->mla_w_uq;
    p.mla_w_ukv = kp->mla_w_ukv;
    p.mla_w_out = kp->mla_w_out;
    p.peer_w_q = kp->peer_w_q;
    p.peer_sub_keys = kp->peer_sub_keys;
    p.peer_u = kp->peer_u;
    p.peer_v = kp->peer_v;
    p.final_norm = kp->final_norm;
    p.out = kp->out;
    p.ws = kp->ws;
    p.ph_lo = kp->ph_lo;
    p.ph_hi = kp->ph_hi;
    p.use_bar = kp->use_bar;
    p.pad0 = kp->pad0;
}
#ifdef PH_NOINLINE
#define NOINL __device__ __noinline__
#else
#define NOINL __device__ __forceinline__
#endif

NOINL void f_prologue() { Params p; load_params(p); phase_prologue(p, smem_user()); }
NOINL void f_norm_e0(int layer) {
    Params p; load_params(p); const float* mod = p.mod() + layer * 6144; const int li = layer >> 1;
    phase_norm<1>(layer == 0 ? p.x : p.xw(), p.norm_mix + layer * DM, mod, mod + 1024, p.h(), nullptr, p.hy_w_in + (size_t)li * 1024 * HY_IN, p.ba(), smem_user());
}
NOINL void f_norm_plain(int layer, int which) {
    Params p; load_params(p); const float* mod = p.mod() + layer * 6144;
    if (which == 0) phase_norm<0>(p.xw(), p.norm_mix + layer * DM, mod, mod + 1024, p.h(), nullptr, nullptr, nullptr, smem_user());
    else phase_norm<0>(p.xw(), p.norm_ffn + layer * DM, mod + 3072, mod + 4096, p.h(), nullptr, nullptr, nullptr, smem_user());
}
NOINL void f_final() { Params p; load_params(p); phase_norm<2>(
#ifdef DBG_SKIP_ALL
        p.x,
#else
        p.xw(),
#endif
 p.final_norm, nullptr, nullptr, nullptr, p.out, nullptr, nullptr, smem_user()); }
NOINL void f_gemm_hy_in(int li) {
    Params p; load_params(p);
    auto epi = [&](f32x4 (&acc)[4][4], int mb, int nb, int n0) {
#pragma unroll
        for (int mt = 0; mt < 4; ++mt) {
            const int m = mb + 16 * mt;
#pragma unroll
            for (int nt = 0; nt < 4; ++nt) {
                const int n = nb + 16 * nt; const f32x4 v = acc[mt][nt];
                if (n0 < 1536) st_bf4(p.proj_a() + (size_t)m * 1536 + n, v);
                else if (n0 < 2048) st_bf4(p.zbuf() + (size_t)m * 512 + (n - 1536), v);
                else if (n0 < 2560) { const int hd = (n - 2048) >> 7, dp = (n - 2048) & 127; const f32x4 rv = rope4(v, p.cosB() + (size_t)m * 64, p.sinB() + (size_t)m * 64, dp >> 1) * (0.08838834764831845f * 1.4426950408889634f); st_bf4(p.Qb() + ((size_t)hd * S + m) * 128 + dp, rv); }
                else if (n0 < 3072) { const int hd = (n - 2560) >> 7, dp = (n - 2560) & 127; const f32x4 rv = rope4(v, p.cosB() + (size_t)m * 64, p.sinB() + (size_t)m * 64, dp >> 1); st_bf4(p.Kb() + ((size_t)hd * S + m) * 128 + dp, rv); }
                else { const int hd = (n - 3072) >> 7, dv = (n - 3072) & 127; bf16_t* vp = p.VbT() + ((size_t)hd * 128 + dv) * S + m; vp[0] = f2bf(v[0]); vp[S] = f2bf(v[1]); vp[2 * (size_t)S] = f2bf(v[2]); vp[3 * (size_t)S] = f2bf(v[3]); }
            }
        }
    };
    gemm_phase(p.h(), DM, p.w_hy_in() + (size_t)li * HYN * 1024, 1024, 1024, HYN / 128, smem_user(), epi);
}
NOINL void f_gemm_resid(int layer) {
    Params p; load_params(p); const float* mod = p.mod() + layer * 6144; const int li = layer >> 1;
    const float* xin = layer == 0 ? p.x : p.xw(); float* xo = p.xw();
    auto epi = [&](f32x4 (&acc)[4][4], int mb, int nb, int n0) {
#pragma unroll
        for (int mt = 0; mt < 4; ++mt)
#pragma unroll
            for (int nt = 0; nt < 4; ++nt) {
                const int m = mb + 16 * mt, n = nb + 16 * nt;
                const f32x4 xv = *(const f32x4*)(xin + (size_t)m * DM + n), gg = *(const f32x4*)(mod + 2048 + n);
                *(f32x4*)(xo + (size_t)m * DM + n) = xv + gg * acc[mt][nt];
            }
    };
    const bf16_t* wt = (layer & 1) ? p.w_mla_out() + (size_t)li * 1024 * 1024 : p.w_hy_out() + (size_t)li * 1024 * 1024;
    gemm_phase(p.cat(), DM, wt, 1024, 1024, 8, smem_user(), epi);
}
NOINL void f_e2(int li) {
    Params p; load_params(p);
    for (int u = opaque_bid(); u < 1280; u += gridDim.x) { if (u < 1024) gdn_prep_unit(p, li, u >> 2, u & 3, smem_user()); else moba_kmean_unit(p, (u - 1024) & 3, (u - 1024) >> 2, smem_user()); }
}
NOINL void f_gate() { Params p; load_params(p); phase_moba_gate(p, smem_user()); }
NOINL void f_scan() { Params p; load_params(p); gdn_scan(p, opaque_bid(), smem_user()); }
NOINL void f_moba_attn() { Params p; load_params(p); phase_moba_attn(p, smem_user(), opaque_bid() - 16, gridDim.x - 16); }
NOINL void f_combine(int li) { Params p; load_params(p); phase_even_combine(p, li); }
NOINL void f_gemm_mla_in(int li) {
    Params p; load_params(p);
    auto epi = [&](f32x4 (&acc)[4][4], int mb, int nb, int n0) {
#pragma unroll
        for (int mt = 0; mt < 4; ++mt)
#pragma unroll
            for (int nt = 0; nt < 4; ++nt) {
                const int m = mb + 16 * mt, n = nb + 16 * nt; const f32x4 v = acc[mt][nt];
                if (n0 < 768) st_bf4(p.cbuf() + (size_t)m * 768 + n, v);
                else if (n < 832) { const int dp = n - 768; const f32x4 rv = rope4(v, p.cosC() + (size_t)m * 32, p.sinC() + (size_t)m * 32, dp >> 1); st_bf4(p.Kr() + (size_t)m * 64 + dp, rv); }
            }
    };
    gemm_phase(p.h(), DM, p.w_mla_in() + (size_t)li * 896 * 1024, 1024, 1024, 7, smem_user(), epi);
}
NOINL void f_cnorm(int li) { Params p; load_params(p); phase_mla_cnorm(p, li); }
NOINL void f_gemm_uq(int li) {
    Params p; load_params(p);
    auto epi = [&](f32x4 (&acc)[4][4], int mb, int nb, int n0) {
        const float qs = 0.07216878364870322f * 1.4426950408889634f;
#pragma unroll
        for (int mt = 0; mt < 4; ++mt)
#pragma unroll
            for (int nt = 0; nt < 4; ++nt) {
                const int m = mb + 16 * mt, n = nb + 16 * nt; const int hd = n / 192, d = n - hd * 192; f32x4 v = acc[mt][nt];
                if (d >= 128) v = rope4(v, p.cosC() + (size_t)m * 32, p.sinC() + (size_t)m * 32, (d - 128) >> 1);
                st_bf4(p.Qm() + ((size_t)hd * S + m) * 192 + d, v * qs);
            }
    };
    gemm_phase(p.cqn(), 512, p.w_uq() + (size_t)li * 1536 * 512, 512, 512, 12, smem_user(), epi);
}
NOINL void f_gemm_ukv(int li) {
    Params p; load_params(p);
    auto epi = [&](f32x4 (&acc)[4][4], int mb, int nb, int n0) {
#pragma unroll
        for (int mt = 0; mt < 4; ++mt)
#pragma unroll
            for (int nt = 0; nt < 4; ++nt) {
                const int m = mb + 16 * mt, n = nb + 16 * nt; const f32x4 v = acc[mt][nt];
                if (n0 < 1024) { const int hd = n >> 7, d = n & 127; st_bf4(p.Kn() + ((size_t)hd * S + m) * 128 + d, v); }
                else { const int hd = (n - 1024) >> 7, dv = (n - 1024) & 127; bf16_t* vp = p.VmT() + ((size_t)hd * 128 + dv) * S + m; vp[0] = f2bf(v[0]); vp[S] = f2bf(v[1]); vp[2 * (size_t)S] = f2bf(v[2]); vp[3 * (size_t)S] = f2bf(v[3]); }
            }
    };
    gemm_phase(p.ckvn(), 256, p.w_ukv() + (size_t)li * 2048 * 256, 256, 256, 16, smem_user(), epi);
}
NOINL void f_mla_attn() { Params p; load_params(p); phase_mla_attn(p, smem_user()); }
NOINL void f_gemm_pq(int layer) {
    Params p; load_params(p);
    auto epi = [&](f32x4 (&acc)[4][4], int mb, int nb, int n0) {
#pragma unroll
        for (int mt = 0; mt < 4; ++mt)
#pragma unroll
            for (int nt = 0; nt < 4; ++nt) st_bf4(p.qbuf() + (size_t)(mb + 16 * mt) * 2048 + nb + 16 * nt, acc[mt][nt]);
    };
    gemm_phase(p.h(), DM, p.w_pq() + (size_t)layer * 2048 * 1024, 1024, 1024, 16, smem_user(), epi);
}
NOINL void f_topk(int layer) { Params p; load_params(p); phase_peer_topk(p, layer, smem_user()); }
NOINL void f_gather(int layer) { Params p; load_params(p); phase_peer_gather(p, layer, p.mod() + layer * 6144 + 5120, p.xw()); }

__device__ __noinline__ void grid_sync(unsigned* barw, unsigned x) {
    XcdBarrier b; b.bar = barw; b.x = x; b.st = (volatile LAS unsigned*)smem_raw;
    xcd_barrier(b);
}

__global__ void __launch_bounds__(NTHREADS) hybrid_forward(Params p) {
    if (threadIdx.x == 0) *(u32x4*)smem_raw = (u32x4){0u, 0u, 0u, 0u};
    __syncthreads();
    XcdBarrier bar; bar.bar = p.bar(); bar.x = 0; bar.st = (volatile LAS unsigned*)smem_raw;
    if (p.use_bar) bar = xcd_barrier_post(p.bar(), (volatile LAS unsigned*)smem_raw);
    int ph = 0;
#define RUN_PHASE(...) { if (ph >= p.ph_lo && ph < p.ph_hi) { __VA_ARGS__; if (p.use_bar && ph + 1 < p.ph_hi) grid_sync(bar.bar, bar.x); } ++ph; }

    RUN_PHASE(f_prologue());
    for (int layer = 0; layer < 4; ++layer) {
        const int li = layer >> 1;
        if ((layer & 1) == 0) {
            RUN_PHASE(f_norm_e0(layer));
            RUN_PHASE(f_gemm_hy_in(li));
            RUN_PHASE(f_e2(li));
            RUN_PHASE(f_gate());
            RUN_PHASE(if (blockIdx.x < 16) f_scan(); else f_moba_attn());
            RUN_PHASE(f_combine(li));
            RUN_PHASE(f_gemm_resid(layer));
        } else {
            RUN_PHASE(f_norm_plain(layer, 0));
            RUN_PHASE(f_gemm_mla_in(li));
            RUN_PHASE(f_cnorm(li));
            RUN_PHASE(f_gemm_uq(li); f_gemm_ukv(li));
            RUN_PHASE(f_mla_attn());
            RUN_PHASE(f_gemm_resid(layer));
        }
        RUN_PHASE(f_norm_plain(layer, 1));
        RUN_PHASE(f_gemm_pq(layer));
        RUN_PHASE(f_topk(layer));
        RUN_PHASE(f_gather(layer));
    }
    RUN_PHASE(f_final());
}

constexpr int N_PHASES = 1 + 2 * 11 + 2 * 10 + 1;

extern "C" void kernel_launch(void* const* d_in, const int* in_sizes, int n_in, void* d_out, int out_size, void* d_ws, size_t ws_size, hipStream_t stream) {
    static int grid = 0;
    if (!grid) {
        int dev = 0, cus = 0, per_cu = 0;
        hipGetDevice(&dev);
        hipDeviceGetAttribute(&cus, hipDeviceAttributeMultiprocessorCount, dev);
        hipFuncSetAttribute((const void*)hybrid_forward, hipFuncAttributeMaxDynamicSharedMemorySize, LDS_BYTES);
        hipOccupancyMaxActiveBlocksPerMultiprocessor(&per_cu, hybrid_forward, NTHREADS, LDS_BYTES);
        if (per_cu < 1) per_cu = 1;
        grid = cus;
        if (grid > 256) grid = 256;
    }
    Params p; memset(&p, 0, sizeof(p));
    p.x = (const float*)d_in[0]; p.c = (const float*)d_in[1]; p.pos = (const int*)d_in[2]; p.mod_w = (const float*)d_in[3]; p.mod_b = (const float*)d_in[4];
    p.norm_mix = (const float*)d_in[5]; p.norm_ffn = (const float*)d_in[6]; p.hy_w_in = (const float*)d_in[7]; p.gdn_conv = (const float*)d_in[8];
    p.gdn_a_log = (const float*)d_in[9]; p.gdn_dt_bias = (const float*)d_in[10]; p.gdn_o_norm = (const float*)d_in[11]; p.hy_w_out = (const float*)d_in[12];
    p.mla_w_in = (const float*)d_in[13]; p.mla_q_norm = (const float*)d_in[14]; p.mla_kv_norm = (const float*)d_in[15]; p.mla_w_uq = (const float*)d_in[16];
    p.mla_w_ukv = (const float*)d_in[17]; p.mla_w_out = (const float*)d_in[18]; p.peer_w_q = (const float*)d_in[19]; p.peer_sub_keys = (const float*)d_in[20];
    p.peer_u = (const float*)d_in[21]; p.peer_v = (const float*)d_in[22]; p.final_norm = (const float*)d_in[23];
    p.out = (float*)d_out;
    p.ws = (char*)d_ws;
    if (WS_NEED > ws_size) { fprintf(stderr, "workspace too small: need %zu have %zu\n", (size_t)WS_NEED, ws_size); return; }
    hipMemsetAsync(p.ws, 0, 16384, stream);
#ifndef ONE_LAUNCH
    for (int ph = 0; ph < N_PHASES; ++ph) {
#ifdef DBG_SKIP_ALL
        if (ph != N_PHASES - 1) continue;
#endif
        p.ph_lo = ph; p.ph_hi = ph + 1; p.use_bar = 0;
        hipLaunchKernelGGL(hybrid_forward, dim3(grid), dim3(NTHREADS), LDS_BYTES, stream, p);
    }
#else
    p.ph_lo = 0; p.ph_hi = N_PHASES; p.use_bar = 1;
    hipLaunchKernelGGL(hybrid_forward, dim3(grid), dim3(NTHREADS), LDS_BYTES, stream, p);
#endif
}
```

```cpp
#include <hip/hip_runtime.h>
#define ONE_LAUNCH 1
#include <stdint.h>
#include <stddef.h>
#include <stdio.h>
#include <string.h>

#define DEV __device__ __forceinline__

constexpr int S = 16384;
constexpr int DM = 1024;
constexpr int HY_IN = 3592;
constexpr int HYN = 3584;
constexpr int NTHREADS = 512;
constexpr int LDS_BYTES = 163840;
constexpr int LDS_USER = 16;

typedef unsigned short bf16_t;
typedef short bf16x8 __attribute__((ext_vector_type(8)));
typedef float f32x4 __attribute__((ext_vector_type(4)));
typedef float f32x16 __attribute__((ext_vector_type(16)));
typedef __bf16 bf16v2 __attribute__((ext_vector_type(2)));
typedef unsigned u32x4 __attribute__((ext_vector_type(4)));
typedef unsigned u32x2 __attribute__((ext_vector_type(2)));
typedef int i32x4 __attribute__((ext_vector_type(4)));

#define XB_TMO      128
#define XB_XCNT(j)  (256  + 64 * (j))
#define XB_XSUB(j)  (1280 + 64 * (j))
#define XB_XGEN(j)  (2304 + 64 * (j))
#define XB_TOP      3328
#define XB_TOPGEN   3392
#define XCD_BAR_WORDS 3456
#define XB_SPIN_CAP (1u << 22)
#define LAS __attribute__((address_space(3)))

__device__ __forceinline__ unsigned xb_ld(unsigned* p)              { return __hip_atomic_load(p, __ATOMIC_RELAXED, __HIP_MEMORY_SCOPE_AGENT); }
__device__ __forceinline__ unsigned xb_add(unsigned* p, unsigned v) { return __hip_atomic_fetch_add(p, v, __ATOMIC_RELAXED, __HIP_MEMORY_SCOPE_AGENT); }
__device__ __forceinline__ unsigned xb_xcc_id() { return (unsigned)__builtin_amdgcn_s_getreg((3 << 11) | 20) & 0xFu; }
#define XB_SPIN(cond, bar) do { unsigned _sp = 0; while (cond) { __builtin_amdgcn_s_sleep(1); \
    if ((++_sp & 255u) == 0u) { if (xb_ld(&(bar)[XB_TMO])) break; if (_sp > XB_SPIN_CAP) { atomicAdd(&(bar)[XB_TMO], 1u); break; } } } } while (0)

struct XcdBarrier { unsigned* bar; unsigned x; volatile LAS unsigned* st; };

__device__ __forceinline__ XcdBarrier xcd_barrier_post(unsigned* bar, volatile LAS unsigned* st) {
    XcdBarrier b; b.bar = bar; b.x = xb_xcc_id(); b.st = st;
    if (threadIdx.x == 0) (void)xb_add(&bar[XB_XCNT(b.x)], 1u);
    return b;
}
__device__ __forceinline__ void xcd_barrier_complete(unsigned* bar, unsigned x, unsigned& nloc, unsigned& nx) {
    const unsigned G = gridDim.x * gridDim.y * gridDim.z;
    unsigned sum, cnt, mine, sp = 0u;
    for (;;) {
        sum = 0u; cnt = 0u; mine = 0u;
#pragma unroll 1
        for (unsigned j = 0; j < 16; ++j) { const unsigned c = xb_ld(&bar[XB_XCNT(j)]); sum += c; cnt += (c > 0u) ? 1u : 0u; mine = (j == x) ? c : mine; }
        if (sum == G) break;
        __builtin_amdgcn_s_sleep(1);
        if ((++sp & 255u) == 0u) { if (xb_ld(&bar[XB_TMO])) break; if (sp > XB_SPIN_CAP) { atomicAdd(&bar[XB_TMO], 1u); break; } }
    }
    nloc = mine > 0u ? mine : 1u; nx = cnt > 0u ? cnt : 1u;
}
__device__ __forceinline__ void xcd_barrier(const XcdBarrier& b) {
    asm volatile("s_waitcnt vmcnt(0)" ::: "memory");
    __syncthreads();
    if (threadIdx.x == 0) {
        unsigned* bar = b.bar;
        __builtin_amdgcn_s_waitcnt(0);
        unsigned nloc = b.st[0], nx = b.st[1];
        if (nloc == 0u) { xcd_barrier_complete(bar, b.x, nloc, nx); b.st[0] = nloc; b.st[1] = nx; }
        const unsigned old = xb_add(&bar[XB_XSUB(b.x)], 1u);
        const unsigned gen = old / nloc;
        if (old + 1u == (gen + 1u) * nloc) {
            __builtin_amdgcn_fence(__ATOMIC_RELEASE, "agent");
            asm volatile("s_waitcnt vmcnt(0)" ::: "memory");
            const unsigned og = xb_add(&bar[XB_TOP], 1u);
            const unsigned tg = og / nx;
            if (og + 1u == (tg + 1u) * nx) xb_add(&bar[XB_TOPGEN], 1u);
            else XB_SPIN(xb_ld(&bar[XB_TOPGEN]) == tg, bar);
            __builtin_amdgcn_fence(__ATOMIC_ACQUIRE, "agent");
            xb_add(&bar[XB_XGEN(b.x)], 1u);
            asm volatile("s_waitcnt vmcnt(0)" ::: "memory");
        } else {
            XB_SPIN(xb_ld(&bar[XB_XGEN(b.x)]) == gen, bar);
            __builtin_amdgcn_fence(__ATOMIC_ACQUIRE, "agent");
            asm volatile("s_waitcnt vmcnt(0)" ::: "memory");
        }
    }
    __syncthreads();
}

DEV int opaque_bid() { int b = blockIdx.x; asm volatile("" : "+s"(b)); return b; }
DEV int opaque_tid() { int t = threadIdx.x; asm volatile("" : "+v"(t)); return t & (NTHREADS - 1); }
DEV bf16_t f2bf(float f) { __bf16 v = (__bf16)f; bf16_t r; __builtin_memcpy(&r, &v, 2); return r; }
DEV unsigned pk2(float a, float b) { bf16v2 v; v[0] = (__bf16)a; v[1] = (__bf16)b; unsigned r; __builtin_memcpy(&r, &v, 4); return r; }
DEV float bflo(unsigned u) { return __uint_as_float(u << 16); }
DEV float bfhi(unsigned u) { return __uint_as_float(u & 0xffff0000u); }
DEV float wsum64(float v) {
#pragma unroll
    for (int o = 32; o; o >>= 1) v += __shfl_xor(v, o);
    return v;
}
DEV f32x4 mfma16(bf16x8 a, bf16x8 b, f32x4 c) { return __builtin_amdgcn_mfma_f32_16x16x32_bf16(a, b, c, 0, 0, 0); }
DEV f32x16 mfma32(bf16x8 a, bf16x8 b, f32x16 c) { return __builtin_amdgcn_mfma_f32_32x32x16_bf16(a, b, c, 0, 0, 0); }
DEV float siluf(float v) { return v / (1.f + expf(-v)); }
DEV float softplusf(float v) { return fmaxf(v, 0.f) + log1pf(expf(-fabsf(v))); }
DEV float ex2(float v) { return __builtin_amdgcn_exp2f(v); }

struct Params {
    const float* x; const float* c; const int* pos; const float* mod_w; const float* mod_b; const float* norm_mix; const float* norm_ffn;
    const float* hy_w_in; const float* gdn_conv; const float* gdn_a_log; const float* gdn_dt_bias; const float* gdn_o_norm; const float* hy_w_out;
    const float* mla_w_in; const float* mla_q_norm; const float* mla_kv_norm; const float* mla_w_uq; const float* mla_w_ukv; const float* mla_w_out;
    const float* peer_w_q; const float* peer_sub_keys; const float* peer_u; const float* peer_v; const float* final_norm;
    float* out; char* ws;
    int ph_lo, ph_hi, use_bar, pad0;
    DEV unsigned* bar() const { return (unsigned*)(ws + 0ull); }
    DEV float* mod() const { return (float*)(ws + 16384ull); }
    DEV float* cosB() const { return (float*)(ws + 114688ull); }
    DEV float* sinB() const { return (float*)(ws + 4308992ull); }
    DEV float* cosC() const { return (float*)(ws + 8503296ull); }
    DEV float* sinC() const { return (float*)(ws + 10600448ull); }
    DEV bf16_t* w_hy_in() const { return (bf16_t*)(ws + 12697600ull); }
    DEV bf16_t* w_hy_out() const { return (bf16_t*)(ws + 27377664ull); }
    DEV bf16_t* w_mla_in() const { return (bf16_t*)(ws + 31571968ull); }
    DEV bf16_t* w_uq() const { return (bf16_t*)(ws + 35241984ull); }
    DEV bf16_t* w_ukv() const { return (bf16_t*)(ws + 38387712ull); }
    DEV bf16_t* w_mla_out() const { return (bf16_t*)(ws + 40484864ull); }
    DEV bf16_t* w_pq() const { return (bf16_t*)(ws + 44679168ull); }
    DEV bf16_t* skb() const { return (bf16_t*)(ws + 61456384ull); }
    DEV unsigned char* ub() const { return (unsigned char*)(ws + 63553536ull); }
    DEV unsigned char* vb() const { return (unsigned char*)(ws + 197771264ull); }
    DEV float* xw() const { return (float*)(ws + 331988992ull); }
    DEV bf16_t* h() const { return (bf16_t*)(ws + 399097856ull); }
    DEV bf16_t* cat() const { return (bf16_t*)(ws + 432652288ull); }
    DEV bf16_t* proj_a() const { return (bf16_t*)(ws + 466206720ull); }
    DEV bf16_t* zbuf() const { return (bf16_t*)(ws + 516538368ull); }
    DEV bf16_t* Qb() const { return (bf16_t*)(ws + 533315584ull); }
    DEV bf16_t* Kb() const { return (bf16_t*)(ws + 550092800ull); }
    DEV bf16_t* VbT() const { return (bf16_t*)(ws + 566870016ull); }
    DEV float* ba() const { return (float*)(ws + 583647232ull); }
    DEV float* u32() const { return (float*)(ws + 584171520ull); }
    DEV bf16_t* wneg() const { return (bf16_t*)(ws + 617725952ull); }
    DEV bf16_t* qdec() const { return (bf16_t*)(ws + 634503168ull); }
    DEV bf16_t* kdT() const { return (bf16_t*)(ws + 651280384ull); }
    DEV bf16_t* qk() const { return (bf16_t*)(ws + 668057600ull); }
    DEV float* glast() const { return (float*)(ws + 676446208ull); }
    DEV float* oa() const { return (float*)(ws + 676450304ull); }
    DEV float* kmean() const { return (float*)(ws + 710004736ull); }
    DEV int* segcnt() const { return (int*)(ws + 710135808ull); }
    DEV int* lists() const { return (int*)(ws + 710168576ull); }
    DEV float* part() const { return (float*)(ws + 726945792ull); }
    DEV float* ml() const { return (float*)(ws + 861163520ull); }
    DEV bf16_t* cbuf() const { return (bf16_t*)(ws + 466206720ull); }
    DEV bf16_t* Kr() const { return (bf16_t*)(ws + 491372544ull); }
    DEV bf16_t* cqn() const { return (bf16_t*)(ws + 493469696ull); }
    DEV bf16_t* ckvn() const { return (bf16_t*)(ws + 510246912ull); }
    DEV bf16_t* Qm() const { return (bf16_t*)(ws + 518635520ull); }
    DEV bf16_t* Kn() const { return (bf16_t*)(ws + 568967168ull); }
    DEV bf16_t* VmT() const { return (bf16_t*)(ws + 602521600ull); }
    DEV bf16_t* qbuf() const { return (bf16_t*)(ws + 466206720ull); }
    DEV int* expert() const { return (int*)(ws + 533315584ull); }
    DEV float* gate() const { return (float*)(ws + 541704192ull); }
};
constexpr size_t WS_NEED = 863260672ull;


template <class Map>
DEV void transpose_conv(const float* __restrict__ src, int K, int ldsrc, bf16_t* __restrict__ dst, int Nd, Map map, char* smem, int& base) {
    float* T = (float*)smem;
    const int tid = opaque_tid(), nb = gridDim.x, b = opaque_bid();
    const int ntk = K / 64, ntn = Nd / 64, nun = ntk * ntn;
    int first = ((b - (base % nb)) % nb + nb) % nb;
    for (int u = first; u < nun; u += nb) {
        const int tk = u % ntk, tn = u / ntk;
        __syncthreads();
#pragma unroll
        for (int i = 0; i < 8; ++i) {
            const int kk = (tid >> 6) + 8 * i, nn = tid & 63;
            const int sc = map(tn * 64 + nn);
            float v = 0.f;
            if (sc >= 0) v = src[(size_t)(tk * 64 + kk) * ldsrc + sc];
            T[kk * 65 + nn] = v;
        }
        __syncthreads();
#pragma unroll
        for (int i = 0; i < 8; ++i) {
            const int nn = (tid >> 6) + 8 * i, kk = tid & 63;
            dst[(size_t)(tn * 64 + nn) * K + tk * 64 + kk] = f2bf(T[kk * 65 + nn]);
        }
    }
    base += nun;
}

DEV void convert_bf16(const float* __restrict__ src, bf16_t* __restrict__ dst, size_t n) {
    const size_t n8 = n / 8;
    for (size_t i = (size_t)opaque_bid() * NTHREADS + opaque_tid(); i < n8; i += (size_t)gridDim.x * NTHREADS) {
        const f32x4 a = *(const f32x4*)(src + i * 8), b = *(const f32x4*)(src + i * 8 + 4);
        u32x4 o; o.x = pk2(a[0], a[1]); o.y = pk2(a[2], a[3]); o.z = pk2(b[0], b[1]); o.w = pk2(b[2], b[3]);
        *(u32x4*)(dst + i * 8) = o;
    }
}

DEV void convert_fp8(const float* __restrict__ src, unsigned char* __restrict__ dst, size_t n, float scale) {
    const size_t n16 = n / 16;
    for (size_t i = (size_t)opaque_bid() * NTHREADS + opaque_tid(); i < n16; i += (size_t)gridDim.x * NTHREADS) {
        u32x4 o;
#pragma unroll
        for (int q = 0; q < 4; ++q) {
            const f32x4 a = *(const f32x4*)(src + i * 16 + q * 4) * scale;
            int w = 0;
            w = __builtin_amdgcn_cvt_pk_fp8_f32(a[0], a[1], w, false);
            w = __builtin_amdgcn_cvt_pk_fp8_f32(a[2], a[3], w, true);
            o[q] = (unsigned)w;
        }
        *(u32x4*)(dst + i * 16) = o;
    }
}

DEV void phase_prologue(const Params& p, char* smem) {
    const int tid = opaque_tid(), nb = gridDim.x, b = opaque_bid();
    {
        float* cond = (float*)smem; float* red = cond + 1024;
        for (int i = tid; i < 1024; i += NTHREADS) cond[i] = siluf(p.c[i]);
        __syncthreads();
        for (int u = b; u < 192; u += nb) {
            const int n = u * 128, layer = n / 6144, nn = n - layer * 6144;
            const int cg = tid & 31, ks = tid >> 5;
            const float* wp = p.mod_w + ((size_t)layer * 1024 + ks * 64) * 6144 + nn + cg * 4;
            f32x4 acc = {0.f, 0.f, 0.f, 0.f};
#pragma unroll 8
            for (int k = 0; k < 64; ++k) { const f32x4 w = *(const f32x4*)(wp + (size_t)k * 6144); const float cv = cond[ks * 64 + k]; acc += w * cv; }
            *(f32x4*)(red + ks * 128 + cg * 4) = acc;
            __syncthreads();
            if (tid < 128) { float s = p.mod_b[n + tid]; for (int q = 0; q < 16; ++q) s += red[q * 128 + tid]; p.mod()[n + tid] = s; }
            __syncthreads();
        }
    }
    for (size_t i = (size_t)b * NTHREADS + tid; i < (size_t)S * 64; i += (size_t)nb * NTHREADS) {
        const int s = (int)(i >> 6), f = (int)(i & 63);
        const float invf = powf(10000.f, -(float)(2 * f) / 128.f);
        const float ang = (float)p.pos[s] * invf;
        float sn, cs; sincosf(ang, &sn, &cs);
        p.cosB()[i] = cs; p.sinB()[i] = sn;
    }
    for (size_t i = (size_t)b * NTHREADS + tid; i < (size_t)S * 32; i += (size_t)nb * NTHREADS) {
        const int s = (int)(i >> 5), f = (int)(i & 31);
        const float invf = powf(10000.f, -(float)(2 * f) / 64.f);
        const float ang = (float)p.pos[s] * invf;
        float sn, cs; sincosf(ang, &sn, &cs);
        p.cosC()[i] = cs; p.sinC()[i] = sn;
    }
    int base = 0;
    for (int i = 0; i < 2; ++i) {
        transpose_conv(p.hy_w_in + (size_t)i * 1024 * HY_IN, 1024, HY_IN, p.w_hy_in() + (size_t)i * HYN * 1024, HYN,
            [](int n) -> int {
                if (n < 2048) return n;
                const int seg = (n - 2048) >> 9, r = (n - 2048) & 511, sb = 2056 + seg * 512;
                if (seg < 2) { const int hd = r >> 7, dp = r & 127; const int d = (dp & 1) ? 64 + (dp >> 1) : (dp >> 1); return sb + hd * 128 + d; }
                return sb + r;
            }, smem, base);
        transpose_conv(p.hy_w_out + (size_t)i * 1024 * 1024, 1024, 1024, p.w_hy_out() + (size_t)i * 1024 * 1024, 1024, [](int n) -> int { return n; }, smem, base);
        transpose_conv(p.mla_w_in + (size_t)i * 1024 * 832, 1024, 832, p.w_mla_in() + (size_t)i * 896 * 1024, 896,
            [](int n) -> int {
                if (n < 768) return n;
                if (n < 832) { const int dp = n - 768; const int d = (dp & 1) ? 32 + (dp >> 1) : (dp >> 1); return 768 + d; }
                return -1;
            }, smem, base);
        transpose_conv(p.mla_w_uq + (size_t)i * 512 * 1536, 512, 1536, p.w_uq() + (size_t)i * 1536 * 512, 1536,
            [](int n) -> int {
                const int hd = n / 192, d = n % 192;
                if (d < 128) return n;
                const int dp = d - 128; const int dd = (dp & 1) ? 32 + (dp >> 1) : (dp >> 1);
                return hd * 192 + 128 + dd;
            }, smem, base);
        transpose_conv(p.mla_w_ukv + (size_t)i * 256 * 2048, 256, 2048, p.w_ukv() + (size_t)i * 2048 * 256, 2048,
            [](int n) -> int {
                if (n < 1024) { const int hd = n >> 7, d = n & 127; return hd * 256 + d; }
                const int m = n - 1024; const int hd = m >> 7, d = m & 127; return hd * 256 + 128 + d;
            }, smem, base);
        transpose_conv(p.mla_w_out + (size_t)i * 1024 * 1024, 1024, 1024, p.w_mla_out() + (size_t)i * 1024 * 1024, 1024, [](int n) -> int { return n; }, smem, base);
    }
    for (int i = 0; i < 4; ++i)
        transpose_conv(p.peer_w_q + (size_t)i * 1024 * 2048, 1024, 2048, p.w_pq() + (size_t)i * 2048 * 1024, 2048, [](int n) -> int { return n; }, smem, base);
    convert_bf16(p.peer_sub_keys, p.skb(), (size_t)4 * 8 * 2 * 128 * 128);
    convert_fp8(p.peer_u, p.ub(), (size_t)4 * 16384 * 1024, 64.f);
    convert_fp8(p.peer_v, p.vb(), (size_t)4 * 16384 * 1024, 4.f);
}

template <int MODE>
DEV void phase_norm(const float* __restrict__ xs, const float* __restrict__ nw, const float* __restrict__ shv, const float* __restrict__ scv,
                    bf16_t* __restrict__ hout, float* __restrict__ fout, const float* __restrict__ w8src, float* __restrict__ ba, char* smem) {
    const int tid = opaque_tid(), lane = tid & 63, w = __builtin_amdgcn_readfirstlane(tid >> 6);
    float* W8 = (float*)smem;
    if (MODE == 1) {
        for (int i = tid; i < 8192; i += NTHREADS) { const int k = i >> 3, c = i & 7; W8[c * 1024 + k] = w8src[(size_t)k * HY_IN + 2048 + c]; }
        __syncthreads();
    }
    f32x4 wm[4], sh[4];
#pragma unroll
    for (int i = 0; i < 4; ++i) {
        const int e = (i * 64 + lane) * 4;
        const f32x4 nv = *(const f32x4*)(nw + e);
        if (MODE == 2) { wm[i] = nv; sh[i] = (f32x4){0.f, 0.f, 0.f, 0.f}; }
        else { const f32x4 sc = *(const f32x4*)(scv + e); wm[i] = nv * (sc + 1.0f); sh[i] = *(const f32x4*)(shv + e); }
    }
    for (int row = opaque_bid() * 8 + w; row < S; row += gridDim.x * 8) {
        f32x4 v[4]; float ss = 0.f;
#pragma unroll
        for (int i = 0; i < 4; ++i) { v[i] = *(const f32x4*)(xs + (size_t)row * DM + (i * 64 + lane) * 4); ss += v[i][0] * v[i][0] + v[i][1] * v[i][1] + v[i][2] * v[i][2] + v[i][3] * v[i][3]; }
        ss = wsum64(ss);
        const float rn = rsqrtf(ss * (1.f / 1024.f) + 1e-6f);
#pragma unroll
        for (int i = 0; i < 4; ++i) v[i] = v[i] * rn * wm[i] + sh[i];
        if (MODE == 2) {
#pragma unroll
            for (int i = 0; i < 4; ++i) *(f32x4*)(fout + (size_t)row * DM + (i * 64 + lane) * 4) = v[i];
        } else {
#pragma unroll
            for (int i = 0; i < 4; ++i) { u32x2 o; o.x = pk2(v[i][0], v[i][1]); o.y = pk2(v[i][2], v[i][3]); *(u32x2*)(hout + (size_t)row * DM + (i * 64 + lane) * 4) = o; }
        }
        if (MODE == 1) {
            float pc[8];
#pragma unroll
            for (int c = 0; c < 8; ++c) {
                float a = 0.f;
#pragma unroll
                for (int i = 0; i < 4; ++i) { const f32x4 ww = *(const f32x4*)(W8 + c * 1024 + (i * 64 + lane) * 4); a += v[i][0] * ww[0] + v[i][1] * ww[1] + v[i][2] * ww[2] + v[i][3] * ww[3]; }
                pc[c] = wsum64(a);
            }
            if (lane == 0) { *(f32x4*)(ba + (size_t)row * 8) = (f32x4){pc[0], pc[1], pc[2], pc[3]}; *(f32x4*)(ba + (size_t)row * 8 + 4) = (f32x4){pc[4], pc[5], pc[6], pc[7]}; }
        }
    }
}

constexpr int GA_RS = 144;
template <class Epi>
DEV void gemm_phase(const bf16_t* __restrict__ A, int lda, const bf16_t* __restrict__ Bt, int ldb, int K, int ntn, char* smem, Epi epi) {
    const int tid = opaque_tid(), lane = tid & 63, w = tid >> 6, wm = w >> 1, wn = w & 1, r = lane & 15, g = lane >> 4;
    char* As = smem; char* Bs = smem + 256 * GA_RS;
    const int nun = 64 * ntn, nk = K / 64;
    for (int u = opaque_bid(); u < nun; u += gridDim.x) {
        const int xcd = u & 7, idx = u >> 3, tn = idx % ntn, tm = xcd * 8 + idx / ntn;
        const int m0 = tm * 256, n0 = tn * 128;
        f32x4 acc[4][4];
#pragma unroll
        for (int i = 0; i < 4; ++i)
#pragma unroll
            for (int j = 0; j < 4; ++j) acc[i][j] = (f32x4){0.f, 0.f, 0.f, 0.f};
        u32x4 ra[4], rb[2];
        const bf16_t* Ap = A + (size_t)(m0 + (tid >> 3)) * lda + (tid & 7) * 8;
        const bf16_t* Bp = Bt + (size_t)(n0 + (tid >> 3)) * ldb + (tid & 7) * 8;
#pragma unroll
        for (int i = 0; i < 4; ++i) ra[i] = *(const u32x4*)(Ap + (size_t)(64 * i) * lda);
#pragma unroll
        for (int i = 0; i < 2; ++i) rb[i] = *(const u32x4*)(Bp + (size_t)(64 * i) * ldb);
        for (int kt = 0; kt < nk; ++kt) {
            __syncthreads();
#pragma unroll
            for (int i = 0; i < 4; ++i) *(u32x4*)(As + ((tid >> 3) + 64 * i) * GA_RS + (tid & 7) * 16) = ra[i];
#pragma unroll
            for (int i = 0; i < 2; ++i) *(u32x4*)(Bs + ((tid >> 3) + 64 * i) * GA_RS + (tid & 7) * 16) = rb[i];
            __syncthreads();
            if (kt + 1 < nk) {
                const int k0 = (kt + 1) * 64;
#pragma unroll
                for (int i = 0; i < 4; ++i) ra[i] = *(const u32x4*)(Ap + (size_t)(64 * i) * lda + k0);
#pragma unroll
                for (int i = 0; i < 2; ++i) rb[i] = *(const u32x4*)(Bp + (size_t)(64 * i) * ldb + k0);
            }
#pragma unroll
            for (int ks = 0; ks < 2; ++ks) {
                bf16x8 af[4], bfr[4];
#pragma unroll
                for (int mt = 0; mt < 4; ++mt) af[mt] = *(const bf16x8*)(As + (64 * wm + 16 * mt + r) * GA_RS + (32 * ks + 8 * g) * 2);
#pragma unroll
                for (int nt = 0; nt < 4; ++nt) bfr[nt] = *(const bf16x8*)(Bs + (64 * wn + 16 * nt + r) * GA_RS + (32 * ks + 8 * g) * 2);
#pragma unroll
                for (int mt = 0; mt < 4; ++mt)
#pragma unroll
                    for (int nt = 0; nt < 4; ++nt) acc[mt][nt] = mfma16(bfr[nt], af[mt], acc[mt][nt]);
            }
        }
        epi(acc, m0 + 64 * wm + r, n0 + 64 * wn + 4 * g, n0);
    }
}

DEV void st_bf4(bf16_t* p, f32x4 v) { u32x2 o; o.x = pk2(v[0], v[1]); o.y = pk2(v[2], v[3]); *(u32x2*)p = o; }
DEV f32x4 rope4(f32x4 v, const float* cs, const float* sn, int fi) {
    const float c0 = cs[fi], s0 = sn[fi], c1 = cs[fi + 1], s1 = sn[fi + 1];
    f32x4 o; o[0] = v[0] * c0 - v[1] * s0; o[1] = v[1] * c0 + v[0] * s0; o[2] = v[2] * c1 - v[3] * s1; o[3] = v[3] * c1 + v[2] * s1; return o;
}

template <int DQK>
DEV void attn_run(const bf16_t* __restrict__ qrow, bool wactive, const bf16_t* __restrict__ Kn, const bf16_t* __restrict__ Kr,
                  const bf16_t* __restrict__ VT, int t_lo, int t_hi, int qpos, int wqmin, int wqmax, char* smem,
                  f32x16 (&o)[4], float& mrun, float& lrun) {
    constexpr int KRS = (DQK + 8) * 2;
    constexpr int VRS = 136;
    constexpr int NKS = DQK / 16;
    constexpr int QREG = (DQK == 192) ? 4 : NKS;
    char* Ks = smem; char* Vs = smem + 64 * KRS; char* Qs = smem + 64 * KRS + 128 * VRS;
    const int tid = opaque_tid(), lane = tid & 63, c = lane & 31, hi = lane >> 5;
    bf16x8 qf[QREG];
#pragma unroll
    for (int ks = 0; ks < QREG; ++ks) qf[ks] = *(const bf16x8*)(qrow + 16 * ks + 8 * hi);
    char* Qw = Qs + (tid >> 6) * ((NKS - QREG) * 1024) + lane * 16;
#pragma unroll
    for (int ks = QREG; ks < NKS; ++ks) *(bf16x8*)(Qw + (ks - QREG) * 1024) = *(const bf16x8*)(qrow + 16 * ks + 8 * hi);
#pragma unroll
    for (int i = 0; i < 4; ++i)
#pragma unroll
        for (int rr = 0; rr < 16; ++rr) o[i][rr] = 0.f;
    mrun = -1e30f; lrun = 0.f;
    constexpr bool ROPE = (DQK == 192);
    u32x4 kreg[2], rreg, vreg[2];
    auto gload = [&](int t) {
        int t2 = tid; asm volatile("" : "+v"(t2));
        const char* kn_t = (const char*)Kn + (size_t)t * (64 * 256);
        const char* vt_t = (const char*)VT + (size_t)t * 128;
#pragma unroll
        for (int i = 0; i < 2; ++i) {
            const int ch = t2 + NTHREADS * i;
            kreg[i] = *(const u32x4*)(kn_t + (unsigned)((ch >> 4) * 256 + (ch & 15) * 16));
            vreg[i] = *(const u32x4*)(vt_t + (unsigned)((ch >> 3) * (S * 2) + (ch & 7) * 16));
        }
        if (ROPE) { const char* kr_t = (const char*)Kr + (size_t)t * (64 * 128); rreg = *(const u32x4*)(kr_t + (unsigned)((t2 >> 3) * 128 + (t2 & 7) * 16)); }
    };
    gload(t_lo);
    for (int t = t_lo; t < t_hi; ++t) {
        __syncthreads();
        {
            int t2 = tid; asm volatile("" : "+v"(t2));
#pragma unroll
            for (int i = 0; i < 2; ++i) {
                const int ch = t2 + NTHREADS * i;
                *(u32x4*)(Ks + (ch >> 4) * KRS + (ch & 15) * 16) = kreg[i];
                u32x2* d = (u32x2*)(Vs + (ch >> 3) * VRS + (ch & 7) * 16);
                d[0] = (u32x2){vreg[i].x, vreg[i].y}; d[1] = (u32x2){vreg[i].z, vreg[i].w};
            }
            if (ROPE) *(u32x4*)(Ks + (t2 >> 3) * KRS + 256 + (t2 & 7) * 16) = rreg;
        }
        __syncthreads();
        if (t + 1 < t_hi) gload(t + 1);
        const int kb = t * 64;
        if (wactive && kb <= wqmax) {
            f32x16 st[2];
#pragma unroll
            for (int kt = 0; kt < 2; ++kt)
#pragma unroll
                for (int rr = 0; rr < 16; ++rr) st[kt][rr] = 0.f;
#pragma unroll
            for (int ks = 0; ks < NKS; ++ks) {
                bf16x8 qv;
                if (ks < QREG) qv = qf[ks < QREG ? ks : 0]; else qv = *(const bf16x8*)(Qw + (ks - QREG) * 1024);
#pragma unroll
                for (int kt = 0; kt < 2; ++kt) {
                    const bf16x8 kf = *(const bf16x8*)(Ks + (32 * kt + c) * KRS + (16 * ks + 8 * hi) * 2);
                    st[kt] = mfma32(kf, qv, st[kt]);
                }
                if ((ks & 1) == 1) __builtin_amdgcn_sched_barrier(0);
            }
            if (kb + 63 > wqmin) {
#pragma unroll
                for (int kt = 0; kt < 2; ++kt)
#pragma unroll
                    for (int rr = 0; rr < 16; ++rr) { const int key = kb + 32 * kt + (rr & 3) + 8 * (rr >> 2) + 4 * hi; if (key > qpos) st[kt][rr] = -__builtin_inff(); }
            }
            float tmax = st[0][0];
#pragma unroll
            for (int rr = 1; rr < 16; ++rr) tmax = fmaxf(tmax, st[0][rr]);
#pragma unroll
            for (int rr = 0; rr < 16; ++rr) tmax = fmaxf(tmax, st[1][rr]);
            tmax = fmaxf(tmax, __shfl_xor(tmax, 32));
            const float mnew = fmaxf(mrun, tmax);
            const float alpha = ex2(mrun - mnew);
            mrun = mnew;
            lrun *= alpha;
            if (!__all(alpha == 1.f)) {
#pragma unroll
                for (int i = 0; i < 4; ++i)
#pragma unroll
                    for (int rr = 0; rr < 16; ++rr) o[i][rr] *= alpha;
            }
            float ps = 0.f;
#pragma unroll
            for (int kt = 0; kt < 2; ++kt)
#pragma unroll
                for (int rr = 0; rr < 16; ++rr) { const float pv = ex2(st[kt][rr] - mnew); st[kt][rr] = pv; ps += pv; }
            lrun += ps;
#pragma unroll
            for (int kt = 0; kt < 2; ++kt)
#pragma unroll
                for (int s2 = 0; s2 < 2; ++s2) {
                    u32x4 pw; pw.x = pk2(st[kt][8 * s2 + 0], st[kt][8 * s2 + 1]); pw.y = pk2(st[kt][8 * s2 + 2], st[kt][8 * s2 + 3]);
                    pw.z = pk2(st[kt][8 * s2 + 4], st[kt][8 * s2 + 5]); pw.w = pk2(st[kt][8 * s2 + 6], st[kt][8 * s2 + 7]);
                    const bf16x8 pf = *(const bf16x8*)&pw;
#pragma unroll
                    for (int dvt = 0; dvt < 4; ++dvt) {
                        const char* vb = Vs + (32 * dvt + c) * VRS + (32 * kt + 16 * s2 + 4 * hi) * 2;
                        const u32x2 v0 = *(const u32x2*)vb, v1 = *(const u32x2*)(vb + 16);
                        u32x4 vw; vw.x = v0.x; vw.y = v0.y; vw.z = v1.x; vw.w = v1.y;
                        o[dvt] = mfma32(*(const bf16x8*)&vw, pf, o[dvt]);
                    }
                    __builtin_amdgcn_sched_barrier(0);
                }
        }
    }
    lrun += __shfl_xor(lrun, 32);
}

DEV void phase_mla_attn(const Params& p, char* smem) {
    const int tid = opaque_tid(), lane = tid & 63, w = tid >> 6, c = lane & 31, hi = lane >> 5;
    for (int u = opaque_bid(); u < 256; u += gridDim.x) {
        const int head = u & 7, pi = u >> 3;
        for (int half = 0; half < 2; ++half) {
            const int qb = half == 0 ? (63 - pi) : pi;
            const int q = qb * 256 + 32 * w + c;
            f32x16 o[4]; float m, l;
            attn_run<192>(p.Qm() + ((size_t)head * S + q) * 192, true, p.Kn() + (size_t)head * S * 128, p.Kr(), p.VmT() + (size_t)head * 128 * S,
                          0, 4 * qb + 4, q, qb * 256 + 32 * w, qb * 256 + 32 * w + 31, smem, o, m, l);
            const float inv = 1.f / l;
#pragma unroll
            for (int dvt = 0; dvt < 4; ++dvt)
#pragma unroll
                for (int rg = 0; rg < 4; ++rg) {
                    const int dv = 32 * dvt + 8 * rg + 4 * hi;
                    f32x4 v = {o[dvt][4 * rg] * inv, o[dvt][4 * rg + 1] * inv, o[dvt][4 * rg + 2] * inv, o[dvt][4 * rg + 3] * inv};
                    st_bf4(p.cat() + (size_t)q * DM + head * 128 + dv, v);
                }
        }
    }
}

DEV void moba_kmean_unit(const Params& p, int h, int j, char* smem) {
    float* red = (float*)smem;
    const int tid = opaque_tid(), d = tid & 127, qq = tid >> 7;
    const bf16_t* kp = p.Kb() + ((size_t)h * S + 256 * j + qq * 64) * 128 + d;
    float s = 0.f;
    for (int t = 0; t < 64; ++t) s += __uint_as_float(((unsigned)kp[(size_t)t * 128]) << 16);
    __syncthreads();
    red[qq * 128 + d] = s;
    __syncthreads();
    if (tid < 128) p.kmean()[((size_t)h * 64 + j) * 128 + tid] = (red[tid] + red[128 + tid] + red[256 + tid] + red[384 + tid]) * (1.f / 256.f);
}

DEV void phase_moba_gate(const Params& p, char* smem) {
    float* km = (float*)smem;
    int* cnt = (int*)(smem + 32768);
    const int tid = opaque_tid();
    for (int u = opaque_bid(); u < 128; u += gridDim.x) {
        const int h = u & 3, t = u >> 2;
        __syncthreads();
        for (int i = tid; i < 8192; i += NTHREADS) km[i] = p.kmean()[(size_t)h * 8192 + i];
        if (tid < 64) cnt[tid] = 0;
        __syncthreads();
        const int q = t * 512 + tid, own = q >> 8;
        float qv[128];
        const u32x4* qp = (const u32x4*)(p.Qb() + ((size_t)h * S + q) * 128);
#pragma unroll
        for (int i = 0; i < 16; ++i) { const u32x4 v = qp[i]; qv[8 * i] = bflo(v.x); qv[8 * i + 1] = bfhi(v.x); qv[8 * i + 2] = bflo(v.y); qv[8 * i + 3] = bfhi(v.y); qv[8 * i + 4] = bflo(v.z); qv[8 * i + 5] = bfhi(v.z); qv[8 * i + 6] = bflo(v.w); qv[8 * i + 7] = bfhi(v.w); }
        float b0 = -__builtin_inff(), b1 = b0, b2 = b0; int i0 = 0, i1 = 0, i2 = 0;
        const int ownw = __builtin_amdgcn_readfirstlane(own);
        for (int j = 0; j < ownw; ++j) {
            float s = 0.f; const f32x4* kp = (const f32x4*)(km + j * 128);
#pragma unroll
            for (int d4 = 0; d4 < 32; ++d4) { const f32x4 kk = kp[d4]; s += qv[4 * d4] * kk[0] + qv[4 * d4 + 1] * kk[1] + qv[4 * d4 + 2] * kk[2] + qv[4 * d4 + 3] * kk[3]; }
            if (s > b0) { b2 = b1; i2 = i1; b1 = b0; i1 = i0; b0 = s; i0 = j; }
            else if (s > b1) { b2 = b1; i2 = i1; b1 = s; i1 = j; }
            else if (s > b2) { b2 = s; i2 = j; }
        }
        const int nsel = own < 3 ? own : 3;
        if (0 < nsel) { const int pos = atomicAdd(&cnt[i0], 1); p.lists()[(((size_t)h * 64 + i0) * 32 + t) * 512 + pos] = (q << 2) | 0; }
        if (1 < nsel) { const int pos = atomicAdd(&cnt[i1], 1); p.lists()[(((size_t)h * 64 + i1) * 32 + t) * 512 + pos] = (q << 2) | 1; }
        if (2 < nsel) { const int pos = atomicAdd(&cnt[i2], 1); p.lists()[(((size_t)h * 64 + i2) * 32 + t) * 512 + pos] = (q << 2) | 2; }
        __syncthreads();
        if (tid < 64) p.segcnt()[((size_t)h * 64 + tid) * 32 + t] = cnt[tid];
    }
}

DEV void moba_write_partial(const Params& p, int q, int h, int slot, const f32x16 (&o)[4], float m, float l, int hi) {
    float* pp = p.part() + (((size_t)q * 4 + h) * 4 + slot) * 128;
#pragma unroll
    for (int dvt = 0; dvt < 4; ++dvt)
#pragma unroll
        for (int rg = 0; rg < 4; ++rg) {
            const int dv = 32 * dvt + 8 * rg + 4 * hi;
            *(f32x4*)(pp + dv) = (f32x4){o[dvt][4 * rg], o[dvt][4 * rg + 1], o[dvt][4 * rg + 2], o[dvt][4 * rg + 3]};
        }
    if (hi == 0) { float* mp = p.ml() + (((size_t)q * 4 + h) * 4 + slot) * 2; mp[0] = m; mp[1] = l; }
}

DEV void phase_moba_attn(const Params& p, char* smem, int rank, int nwg) {
    const int tid = opaque_tid(), lane = tid & 63, w = tid >> 6, c = lane & 31, hi = lane >> 5;
    int* pre = (int*)(smem + 36864);
    for (int u = rank; u < 256; u += nwg) {
        const int j = u >> 2, h = u & 3;
        const bf16_t* Kh = p.Kb() + (size_t)h * S * 128; const bf16_t* Vh = p.VbT() + (size_t)h * 128 * S;
        {
            const int q = 256 * j + 32 * w + c;
            f32x16 o[4]; float m, l;
            attn_run<128>(p.Qb() + ((size_t)h * S + q) * 128, true, Kh, nullptr, Vh, 4 * j, 4 * j + 4, q, 256 * j + 32 * w, 256 * j + 32 * w + 31, smem, o, m, l);
            moba_write_partial(p, q, h, 3, o, m, l, hi);
        }
        __syncthreads();
        if (tid == 0) { int s = 0; for (int t = 0; t < 32; ++t) { pre[t] = s; s += p.segcnt()[((size_t)h * 64 + j) * 32 + t]; } pre[32] = s; }
        __syncthreads();
        const int total = pre[32];
        for (int k0 = 0; k0 < total; k0 += 256) {
            const int e = k0 + 32 * w + c; const bool valid = e < total; int q = 0, slot = 0;
            if (valid) {
                int seg = 0;
                for (int t = 1; t < 32; ++t) if (pre[t] <= e) seg = t;
                const int ent = p.lists()[(((size_t)h * 64 + j) * 32 + seg) * 512 + (e - pre[seg])];
                q = ent >> 2; slot = ent & 3;
            }
            const bool wact = (k0 + 32 * w) < total;
            f32x16 o[4]; float m, l;
            attn_run<128>(p.Qb() + ((size_t)h * S + q) * 128, wact, Kh, nullptr, Vh, 4 * j, 4 * j + 4, 0x7fffffff, 0x7fffffff, 0x7fffffff, smem, o, m, l);
            if (valid) moba_write_partial(p, q, h, slot, o, m, l, hi);
        }
        __syncthreads();
    }
}

constexpr int GP_KN = 0, GP_KB = 17408, GP_QS = 34816, GP_RF = 52224, GP_LM = 117760, GP_KDT = 135168, GP_GC = 153600, GP_BT = 153856;
DEV void gdn_prep_unit(const Params& p, int li, int n, int h, char* smem) {
    const int tid = opaque_tid(), lane = tid & 63, w = tid >> 6, r = lane & 15, g = lane >> 4;
    char* Kn16 = smem + GP_KN; char* Kb16 = smem + GP_KB; char* Qs16 = smem + GP_QS;
    float* Rf = (float*)(smem + GP_RF); float* Lm = (float*)(smem + GP_LM); char* KdT = smem + GP_KDT;
    float* gc = (float*)(smem + GP_GC); float* bt = (float*)(smem + GP_BT);
    const size_t cb = (size_t)n * 4 + h;
    __syncthreads();
    if (w == 0) {
        const int tok = 64 * n + lane;
        const float a = p.ba()[(size_t)tok * 8 + 4 + h], bb = p.ba()[(size_t)tok * 8 + h];
        float gv = -expf(p.gdn_a_log[li * 4 + h]) * softplusf(a + p.gdn_dt_bias[li * 4 + h]);
#pragma unroll
        for (int o = 1; o < 64; o <<= 1) { const float t = __shfl_up(gv, o); if (lane >= o) gv += t; }
        gc[lane] = gv; bt[lane] = 1.f / (1.f + expf(-bb));
    }
    __syncthreads();
    const float glast = gc[63];
    {
        const int tok = tid >> 3, grp = tid & 7, gt = 64 * n + tok;
        const float gct = gc[tok], btt = bt[tok];
        const float egc = expf(gct), egl = expf(glast - gct);
        const float* cw = p.gdn_conv + (size_t)li * 4 * 1536;
#pragma unroll
        for (int part = 0; part < 3; ++part) {
            const int ch0 = part * 512 + h * 128 + grp * 16;
            float val[16];
#pragma unroll
            for (int i = 0; i < 16; ++i) val[i] = 0.f;
#pragma unroll
            for (int j = 0; j < 4; ++j) {
                const int ts = gt - 3 + j;
                if (ts >= 0) {
                    const u32x4* xp = (const u32x4*)(p.proj_a() + (size_t)ts * 1536 + ch0);
                    const u32x4 x0 = xp[0], x1 = xp[1];
                    const f32x4* wp = (const f32x4*)(cw + (size_t)j * 1536 + ch0);
                    const f32x4 w0 = wp[0], w1 = wp[1], w2 = wp[2], w3 = wp[3];
                    val[0] += bflo(x0.x) * w0[0]; val[1] += bfhi(x0.x) * w0[1]; val[2] += bflo(x0.y) * w0[2]; val[3] += bfhi(x0.y) * w0[3];
                    val[4] += bflo(x0.z) * w1[0]; val[5] += bfhi(x0.z) * w1[1]; val[6] += bflo(x0.w) * w1[2]; val[7] += bfhi(x0.w) * w1[3];
                    val[8] += bflo(x1.x) * w2[0]; val[9] += bfhi(x1.x) * w2[1]; val[10] += bflo(x1.y) * w2[2]; val[11] += bfhi(x1.y) * w2[3];
                    val[12] += bflo(x1.z) * w3[0]; val[13] += bfhi(x1.z) * w3[1]; val[14] += bflo(x1.w) * w3[2]; val[15] += bfhi(x1.w) * w3[3];
                }
            }
#pragma unroll
            for (int i = 0; i < 16; ++i) val[i] = siluf(val[i]);
            if (part < 2) {
                float ss = 0.f;
#pragma unroll
                for (int i = 0; i < 16; ++i) ss += val[i] * val[i];
                ss += __shfl_xor(ss, 1); ss += __shfl_xor(ss, 2); ss += __shfl_xor(ss, 4);
                const float rn = rsqrtf(ss + 1e-6f);
#pragma unroll
                for (int i = 0; i < 16; ++i) val[i] *= rn;
            }
            if (part == 0) {
                const float qs = 0.08838834764831845f;
                u32x4 a0, a1, d0, d1;
                a0.x = pk2(val[0] * qs, val[1] * qs); a0.y = pk2(val[2] * qs, val[3] * qs); a0.z = pk2(val[4] * qs, val[5] * qs); a0.w = pk2(val[6] * qs, val[7] * qs);
                a1.x = pk2(val[8] * qs, val[9] * qs); a1.y = pk2(val[10] * qs, val[11] * qs); a1.z = pk2(val[12] * qs, val[13] * qs); a1.w = pk2(val[14] * qs, val[15] * qs);
                *(u32x4*)(Qs16 + tok * 272 + grp * 32) = a0; *(u32x4*)(Qs16 + tok * 272 + grp * 32 + 16) = a1;
                const float qd = qs * egc;
                d0.x = pk2(val[0] * qd, val[1] * qd); d0.y = pk2(val[2] * qd, val[3] * qd); d0.z = pk2(val[4] * qd, val[5] * qd); d0.w = pk2(val[6] * qd, val[7] * qd);
                d1.x = pk2(val[8] * qd, val[9] * qd); d1.y = pk2(val[10] * qd, val[11] * qd); d1.z = pk2(val[12] * qd, val[13] * qd); d1.w = pk2(val[14] * qd, val[15] * qd);
                u32x4* qo = (u32x4*)(p.qdec() + (cb * 64 + tok) * 128 + grp * 16);
                qo[0] = d0; qo[1] = d1;
            } else if (part == 1) {
                u32x4 a0, a1, d0, d1;
                a0.x = pk2(val[0], val[1]); a0.y = pk2(val[2], val[3]); a0.z = pk2(val[4], val[5]); a0.w = pk2(val[6], val[7]);
                a1.x = pk2(val[8], val[9]); a1.y = pk2(val[10], val[11]); a1.z = pk2(val[12], val[13]); a1.w = pk2(val[14], val[15]);
                *(u32x4*)(Kn16 + tok * 272 + grp * 32) = a0; *(u32x4*)(Kn16 + tok * 272 + grp * 32 + 16) = a1;
                d0.x = pk2(val[0] * btt, val[1] * btt); d0.y = pk2(val[2] * btt, val[3] * btt); d0.z = pk2(val[4] * btt, val[5] * btt); d0.w = pk2(val[6] * btt, val[7] * btt);
                d1.x = pk2(val[8] * btt, val[9] * btt); d1.y = pk2(val[10] * btt, val[11] * btt); d1.z = pk2(val[12] * btt, val[13] * btt); d1.w = pk2(val[14] * btt, val[15] * btt);
                *(u32x4*)(Kb16 + tok * 272 + grp * 32) = d0; *(u32x4*)(Kb16 + tok * 272 + grp * 32 + 16) = d1;
                const float kb = btt * egc;
#pragma unroll
                for (int i = 0; i < 16; ++i) {
                    Rf[tok * 256 + 128 + grp * 16 + i] = val[i] * kb;
                    *(bf16_t*)(KdT + (grp * 16 + i) * 144 + tok * 2) = f2bf(val[i] * egl);
                }
            } else {
#pragma unroll
                for (int i = 0; i < 16; ++i) Rf[tok * 256 + grp * 16 + i] = val[i] * btt;
            }
        }
    }
    __syncthreads();
#pragma unroll
    for (int tt = 0; tt < 2; ++tt) {
        const int tile = 2 * w + tt, ct = tile >> 2, mt = tile & 3;
        f32x4 accL = {0.f, 0.f, 0.f, 0.f}, accQ = {0.f, 0.f, 0.f, 0.f};
#pragma unroll
        for (int ks = 0; ks < 4; ++ks) {
            const bf16x8 akb = *(const bf16x8*)(Kb16 + (16 * ct + r) * 272 + (32 * ks + 8 * g) * 2);
            const bf16x8 knm = *(const bf16x8*)(Kn16 + (16 * mt + r) * 272 + (32 * ks + 8 * g) * 2);
            const bf16x8 qsc = *(const bf16x8*)(Qs16 + (16 * ct + r) * 272 + (32 * ks + 8 * g) * 2);
            accL = mfma16(akb, knm, accL);
            accQ = mfma16(knm, qsc, accQ);
        }
#pragma unroll
        for (int jj = 0; jj < 4; ++jj) {
            const int ci = 16 * ct + 4 * g + jj, mi = 16 * mt + r;
            Lm[ci * 68 + mi] = (mi < ci) ? accL[jj] * expf(gc[ci] - gc[mi]) : 0.f;
        }
        {
            const int ci = 16 * ct + r;
            f32x4 v;
#pragma unroll
            for (int jj = 0; jj < 4; ++jj) { const int mi = 16 * mt + 4 * g + jj; v[jj] = (mi <= ci) ? accQ[jj] * expf(gc[ci] - gc[mi]) : 0.f; }
            st_bf4(p.qk() + (cb * 64 + ci) * 64 + 16 * mt + 4 * g, v);
        }
    }
#pragma unroll
    for (int i = 0; i < 2; ++i) {
        const int ch = tid + NTHREADS * i, row = ch >> 3, cc = ch & 7;
        *(u32x4*)(p.kdT() + (cb * 128 + row) * 64 + cc * 8) = *(const u32x4*)(KdT + row * 144 + cc * 16);
    }
    __syncthreads();
    if (w < 4) {
        const int col = tid;
        float x[64];
#pragma unroll
        for (int i = 0; i < 64; ++i) {
            float a = Rf[i * 256 + col];
#pragma unroll
            for (int j4 = 0; j4 < (i + 3) / 4; ++j4) {
                const f32x4 l4 = *(const f32x4*)(Lm + i * 68 + 4 * j4);
#pragma unroll
                for (int jj = 0; jj < 4; ++jj) if (4 * j4 + jj < i) a -= l4[jj] * x[4 * j4 + jj];
            }
            x[i] = a;
        }
        if (col < 128) {
#pragma unroll
            for (int i = 0; i < 64; ++i) p.u32()[(cb * 64 + i) * 128 + col] = x[i];
        } else {
#pragma unroll
            for (int i = 0; i < 64; ++i) p.wneg()[(cb * 64 + i) * 128 + col - 128] = f2bf(-x[i]);
        }
    }
    if (tid == 0) p.glast()[cb] = glast;
}

struct ScanFr { bf16x8 wf[4], qf[4], qkf[2], kdf[2]; f32x4 u; float eg; };
DEV void gdn_scan(const Params& p, int sw, char* smem) {
    const int tid = opaque_tid(), lane = tid & 63, w = tid >> 6, r = lane & 15, g = lane >> 4, mt = w >> 1, nt = w & 1;
    const int h = sw >> 2, dvb = (sw & 3) * 32;
    char* S16 = smem; char* Vn16 = smem + 8704;
    __syncthreads();
    for (int i = tid; i < 8704 / 4; i += NTHREADS) ((int*)S16)[i] = 0;
    f32x4 sacc[2] = {{0.f, 0.f, 0.f, 0.f}, {0.f, 0.f, 0.f, 0.f}};
    auto load = [&](int n, ScanFr& f) {
        const size_t cb = (size_t)n * 4 + h;
        const bf16_t* wp = p.wneg() + (cb * 64 + 16 * mt + r) * 128 + 8 * g;
        const bf16_t* qp = p.qdec() + (cb * 64 + 16 * mt + r) * 128 + 8 * g;
#pragma unroll
        for (int ks = 0; ks < 4; ++ks) { f.wf[ks] = *(const bf16x8*)(wp + 32 * ks); f.qf[ks] = *(const bf16x8*)(qp + 32 * ks); }
        const bf16_t* qkp = p.qk() + (cb * 64 + 16 * mt + r) * 64 + 8 * g;
        const bf16_t* kp = p.kdT() + (cb * 128 + 16 * w + r) * 64 + 8 * g;
#pragma unroll
        for (int ks = 0; ks < 2; ++ks) { f.qkf[ks] = *(const bf16x8*)(qkp + 32 * ks); f.kdf[ks] = *(const bf16x8*)(kp + 32 * ks); }
        const float* up = p.u32() + (cb * 64 + 16 * mt + 4 * g) * 128 + dvb + 16 * nt + r;
#pragma unroll
        for (int jj = 0; jj < 4; ++jj) f.u[jj] = up[jj * 128];
        f.eg = expf(p.glast()[cb]);
    };
    ScanFr nx; load(0, nx);
    __syncthreads();
    for (int n = 0; n < 256; ++n) {
        ScanFr cu = nx;
        if (n + 1 < 256) load(n + 1, nx);
        f32x4 a1 = cu.u, a2 = {0.f, 0.f, 0.f, 0.f};
#pragma unroll
        for (int ks = 0; ks < 4; ++ks) {
            const bf16x8 sf = *(const bf16x8*)(S16 + (16 * nt + r) * 272 + (32 * ks + 8 * g) * 2);
            a1 = mfma16(cu.wf[ks], sf, a1);
            a2 = mfma16(cu.qf[ks], sf, a2);
        }
        *(u32x2*)(Vn16 + (16 * nt + r) * 144 + (16 * mt + 4 * g) * 2) = (u32x2){pk2(a1[0], a1[1]), pk2(a1[2], a1[3])};
        asm volatile("s_waitcnt lgkmcnt(0)" ::: "memory"); __builtin_amdgcn_s_barrier(); asm volatile("" ::: "memory");
#pragma unroll
        for (int ks = 0; ks < 2; ++ks) {
            const bf16x8 vf = *(const bf16x8*)(Vn16 + (16 * nt + r) * 144 + (32 * ks + 8 * g) * 2);
            a2 = mfma16(cu.qkf[ks], vf, a2);
        }
        {
            float* op = p.oa() + ((size_t)(64 * n + 16 * mt + 4 * g)) * 512 + h * 128 + dvb + 16 * nt + r;
#pragma unroll
            for (int jj = 0; jj < 4; ++jj) op[jj * 512] = a2[jj];
        }
#pragma unroll
        for (int n2 = 0; n2 < 2; ++n2) {
            sacc[n2] = sacc[n2] * cu.eg;
#pragma unroll
            for (int ks = 0; ks < 2; ++ks) {
                const bf16x8 vf = *(const bf16x8*)(Vn16 + (16 * n2 + r) * 144 + (32 * ks + 8 * g) * 2);
                sacc[n2] = mfma16(cu.kdf[ks], vf, sacc[n2]);
            }
            *(u32x2*)(S16 + (16 * n2 + r) * 272 + (16 * w + 4 * g) * 2) = (u32x2){pk2(sacc[n2][0], sacc[n2][1]), pk2(sacc[n2][2], sacc[n2][3])};
        }
        asm volatile("s_waitcnt lgkmcnt(0)" ::: "memory"); __builtin_amdgcn_s_barrier(); asm volatile("" ::: "memory");
    }
}

DEV void phase_even_combine(const Params& p, int li) {
    const int tid = opaque_tid(), lane = tid & 63, w = __builtin_amdgcn_readfirstlane(tid >> 6), hh = lane >> 4, d0 = (lane & 15) * 8;
    for (int tok = opaque_bid() * 8 + w; tok < S; tok += gridDim.x * 8) {
        {
            const float* op = p.oa() + (size_t)tok * 512 + hh * 128 + d0;
            const f32x4 a = *(const f32x4*)op, b = *(const f32x4*)(op + 4);
            float ss = a[0] * a[0] + a[1] * a[1] + a[2] * a[2] + a[3] * a[3] + b[0] * b[0] + b[1] * b[1] + b[2] * b[2] + b[3] * b[3];
            ss += __shfl_xor(ss, 1); ss += __shfl_xor(ss, 2); ss += __shfl_xor(ss, 4); ss += __shfl_xor(ss, 8);
            const float rn = rsqrtf(ss * (1.f / 128.f) + 1e-6f);
            const u32x4 z = *(const u32x4*)(p.zbuf() + (size_t)tok * 512 + hh * 128 + d0);
            const f32x4 n0 = *(const f32x4*)(p.gdn_o_norm + li * 128 + d0), n1 = *(const f32x4*)(p.gdn_o_norm + li * 128 + d0 + 4);
            u32x4 o;
            o.x = pk2(a[0] * rn * n0[0] * siluf(bflo(z.x)), a[1] * rn * n0[1] * siluf(bfhi(z.x)));
            o.y = pk2(a[2] * rn * n0[2] * siluf(bflo(z.y)), a[3] * rn * n0[3] * siluf(bfhi(z.y)));
            o.z = pk2(b[0] * rn * n1[0] * siluf(bflo(z.z)), b[1] * rn * n1[1] * siluf(bfhi(z.z)));
            o.w = pk2(b[2] * rn * n1[2] * siluf(bflo(z.w)), b[3] * rn * n1[3] * siluf(bfhi(z.w)));
            *(u32x4*)(p.cat() + (size_t)tok * DM + hh * 128 + d0) = o;
        }
        {
            const int own = tok >> 8, nsel = own < 3 ? own : 3;
            const float* mlp = p.ml() + ((size_t)tok * 4 + hh) * 8;
            const float* pp = p.part() + ((size_t)tok * 4 + hh) * 4 * 128 + d0;
            const float m3 = mlp[6], l3 = mlp[7];
            float ms[3], ls[3]; float mm = m3;
#pragma unroll
            for (int s = 0; s < 3; ++s) { ms[s] = -1e30f; ls[s] = 0.f; if (s < nsel) { ms[s] = mlp[2 * s]; ls[s] = mlp[2 * s + 1]; mm = fmaxf(mm, ms[s]); } }
            float wt = ex2(m3 - mm), den = wt * l3;
            f32x4 a = *(const f32x4*)(pp + 3 * 128) * wt, b = *(const f32x4*)(pp + 3 * 128 + 4) * wt;
#pragma unroll
            for (int s = 0; s < 3; ++s) if (s < nsel) {
                wt = ex2(ms[s] - mm); den += wt * ls[s];
                a += *(const f32x4*)(pp + s * 128) * wt; b += *(const f32x4*)(pp + s * 128 + 4) * wt;
            }
            const float inv = 1.f / den;
            u32x4 o; o.x = pk2(a[0] * inv, a[1] * inv); o.y = pk2(a[2] * inv, a[3] * inv); o.z = pk2(b[0] * inv, b[1] * inv); o.w = pk2(b[2] * inv, b[3] * inv);
            *(u32x4*)(p.cat() + (size_t)tok * DM + 512 + hh * 128 + d0) = o;
        }
    }
}

DEV void phase_mla_cnorm(const Params& p, int li) {
    const int tid = opaque_tid(), lane = tid & 63, w = __builtin_amdgcn_readfirstlane(tid >> 6);
    for (int row = opaque_bid() * 8 + w; row < S; row += gridDim.x * 8) {
        const bf16_t* cp = p.cbuf() + (size_t)row * 768;
        const u32x4 qv = *(const u32x4*)(cp + lane * 8);
        const u32x2 kv = *(const u32x2*)(cp + 512 + lane * 4);
        float q[8] = {bflo(qv.x), bfhi(qv.x), bflo(qv.y), bfhi(qv.y), bflo(qv.z), bfhi(qv.z), bflo(qv.w), bfhi(qv.w)};
        float k[4] = {bflo(kv.x), bfhi(kv.x), bflo(kv.y), bfhi(kv.y)};
        float sq = 0.f, sk = 0.f;
#pragma unroll
        for (int i = 0; i < 8; ++i) sq += q[i] * q[i];
#pragma unroll
        for (int i = 0; i < 4; ++i) sk += k[i] * k[i];
        sq = wsum64(sq); sk = wsum64(sk);
        const float rq = rsqrtf(sq * (1.f / 512.f) + 1e-6f), rk = rsqrtf(sk * (1.f / 256.f) + 1e-6f);
        const float* qn = p.mla_q_norm + li * 512 + lane * 8; const float* kn = p.mla_kv_norm + li * 256 + lane * 4;
        u32x4 oq; oq.x = pk2(q[0] * rq * qn[0], q[1] * rq * qn[1]); oq.y = pk2(q[2] * rq * qn[2], q[3] * rq * qn[3]);
        oq.z = pk2(q[4] * rq * qn[4], q[5] * rq * qn[5]); oq.w = pk2(q[6] * rq * qn[6], q[7] * rq * qn[7]);
        *(u32x4*)(p.cqn() + (size_t)row * 512 + lane * 8) = oq;
        u32x2 ok; ok.x = pk2(k[0] * rk * kn[0], k[1] * rk * kn[1]); ok.y = pk2(k[2] * rk * kn[2], k[3] * rk * kn[3]);
        *(u32x2*)(p.ckvn() + (size_t)row * 256 + lane * 4) = ok;
    }
}

#define SORT16_NET(CE) CE(0,1) CE(2,3) CE(0,2) CE(1,3) CE(1,2) CE(4,5) CE(6,7) CE(4,6) CE(5,7) CE(5,6) CE(0,4) CE(2,6) CE(2,4) CE(1,5) CE(3,7) CE(3,5) CE(1,2) CE(3,4) CE(5,6) CE(8,9) CE(10,11) CE(8,10) CE(9,11) CE(9,10) CE(12,13) CE(14,15) CE(12,14) CE(13,15) CE(13,14) CE(8,12) CE(10,14) CE(10,12) CE(9,13) CE(11,15) CE(11,13) CE(9,10) CE(11,12) CE(13,14) CE(0,8) CE(4,12) CE(4,8) CE(2,10) CE(6,14) CE(6,10) CE(2,4) CE(6,8) CE(10,12) CE(1,9) CE(5,13) CE(5,9) CE(3,11) CE(7,15) CE(7,11) CE(3,5) CE(7,9) CE(11,13) CE(1,2) CE(3,4) CE(5,6) CE(7,8) CE(9,10) CE(11,12) CE(13,14)

template <int OFF> DEV void sort16(float (&v)[64]) {
#define CE_(a, b) { const float hi_ = fmaxf(v[OFF + a], v[OFF + b]), lo_ = fminf(v[OFF + a], v[OFF + b]); v[OFF + a] = hi_; v[OFF + b] = lo_; }
    SORT16_NET(CE_)
#undef CE_
}
template <int A> DEV void bitonic16(float (&v)[64]) {
#pragma unroll
    for (int d = 8; d >= 1; d >>= 1)
#pragma unroll
        for (int i = 0; i < 16; ++i) if ((i & d) == 0) { const float hi_ = fmaxf(v[A + i], v[A + i + d]), lo_ = fminf(v[A + i], v[A + i + d]); v[A + i] = hi_; v[A + i + d] = lo_; }
}
template <int A, int B> DEV void merge16(float (&v)[64]) {
#pragma unroll
    for (int i = 0; i < 16; ++i) v[A + i] = fmaxf(v[A + i], v[B + 15 - i]);
    bitonic16<A>(v);
}
DEV void top16_of_64(float (&v)[64]) {
    sort16<0>(v); sort16<16>(v); sort16<32>(v); sort16<48>(v);
    merge16<0, 16>(v); merge16<32, 48>(v); merge16<0, 32>(v);
}

DEV void phase_peer_topk(const Params& p, int layer, char* smem) {
    const int tid = opaque_tid(), lane = tid & 63, w = tid >> 6, c = lane & 31, hi = lane >> 5;
    char* SK = smem;
    constexpr int CI[50] = {0,0,0,0,0,0,0,0,0,0,0,0,0,0,0,0, 1,1,1,1,1,1,1,1, 2,2,2,2,2, 3,3,3,3, 4,4,4, 5,5, 6,6, 7,7, 8,9,10,11,12,13,14,15};
    constexpr int CJ[50] = {0,1,2,3,4,5,6,7,8,9,10,11,12,13,14,15, 0,1,2,3,4,5,6,7, 0,1,2,3,4, 0,1,2,3, 0,1,2, 0,1, 0,1, 0,1, 0,0,0,0,0,0,0,0};
    int loaded_h = -1;
    for (int u = opaque_bid(); u < 512; u += gridDim.x) {
        const int h = u & 7, tg = u >> 3;
        if (h != loaded_h) {
            __syncthreads();
#pragma unroll
            for (int i = 0; i < 8; ++i) {
                const int ch = tid + NTHREADS * i, pp = ch >> 11, rem = ch & 2047, row = rem >> 4, cc = rem & 15;
                *(u32x4*)(SK + pp * 34816 + row * 272 + cc * 16) = *(const u32x4*)(p.skb() + ((((size_t)layer * 8 + h) * 2 + pp) * 128 + row) * 128 + cc * 8);
            }
            __syncthreads();
            loaded_h = h;
        }
        const int token = tg * 256 + 32 * w + c;
        float s0[16], s1[16];
#pragma unroll
        for (int pp = 0; pp < 2; ++pp) {
            bf16x8 qf[8];
            const bf16_t* qp = p.qbuf() + (size_t)token * 2048 + (h * 2 + pp) * 128 + 8 * hi;
#pragma unroll
            for (int ks = 0; ks < 8; ++ks) qf[ks] = *(const bf16x8*)(qp + 16 * ks);
            float v[64];
#pragma unroll
            for (int kt = 0; kt < 4; ++kt) {
                f32x16 acc;
#pragma unroll
                for (int rr = 0; rr < 16; ++rr) acc[rr] = 0.f;
#pragma unroll
                for (int ks = 0; ks < 8; ++ks) acc = mfma32(*(const bf16x8*)(SK + pp * 34816 + (32 * kt + c) * 272 + (16 * ks + 8 * hi) * 2), qf[ks], acc);
#pragma unroll
                for (int rr = 0; rr < 16; ++rr) {
                    const unsigned idx = (unsigned)(32 * kt + (rr & 3) + 8 * (rr >> 2) + 4 * hi);
                    v[16 * kt + rr] = __uint_as_float((__float_as_uint(acc[rr]) & ~127u) | idx);
                }
            }
            top16_of_64(v);
#pragma unroll
            for (int i = 0; i < 16; ++i) v[16 + i] = __shfl_xor(v[15 - i], 32);
#pragma unroll
            for (int i = 0; i < 16; ++i) v[i] = fmaxf(v[i], v[16 + i]);
            bitonic16<0>(v);
#pragma unroll
            for (int i = 0; i < 16; ++i) { if (pp == 0) s0[i] = v[i]; else s1[i] = v[i]; }
        }
        float cv[64];
#pragma unroll
        for (int k = 0; k < 50; ++k) {
            const float a = s0[CI[k]], b = s1[CJ[k]];
            const unsigned id = ((__float_as_uint(a) & 127u) << 7) | (__float_as_uint(b) & 127u);
            cv[k] = __uint_as_float((__float_as_uint(a + b) & ~0x3FFFu) | id);
        }
#pragma unroll
        for (int k = 50; k < 64; ++k) cv[k] = -__builtin_inff();
        top16_of_64(cv);
        float e[16], sum = 0.f;
#pragma unroll
        for (int i = 0; i < 16; ++i) { e[i] = expf(cv[i] - cv[0]); sum += e[i]; }
        const float inv = 1.f / sum;
        if (hi == 0) {
            int* ep = p.expert() + (size_t)token * 128 + h * 16; float* gp = p.gate() + (size_t)token * 128 + h * 16;
#pragma unroll
            for (int i4 = 0; i4 < 4; ++i4) {
                i32x4 ev; ev.x = (int)(__float_as_uint(cv[4 * i4]) & 0x3FFFu); ev.y = (int)(__float_as_uint(cv[4 * i4 + 1]) & 0x3FFFu);
                ev.z = (int)(__float_as_uint(cv[4 * i4 + 2]) & 0x3FFFu); ev.w = (int)(__float_as_uint(cv[4 * i4 + 3]) & 0x3FFFu);
                *(i32x4*)(ep + 4 * i4) = ev;
                *(f32x4*)(gp + 4 * i4) = (f32x4){e[4 * i4] * inv, e[4 * i4 + 1] * inv, e[4 * i4 + 2] * inv, e[4 * i4 + 3] * inv};
            }
        }
    }
}

typedef float f32x2 __attribute__((ext_vector_type(2)));
DEV void unpack_fp8x16(const u32x4& r, float (&f)[16]) {
#pragma unroll
    for (int q = 0; q < 4; ++q) {
        const f32x2 lo = __builtin_amdgcn_cvt_pk_f32_fp8((int)r[q], false), hi = __builtin_amdgcn_cvt_pk_f32_fp8((int)r[q], true);
        f[4 * q] = lo[0]; f[4 * q + 1] = lo[1]; f[4 * q + 2] = hi[0]; f[4 * q + 3] = hi[1];
    }
}

DEV void phase_peer_gather(const Params& p, int layer, const float* __restrict__ g2, const float* __restrict__ xsrc, float* __restrict__ xdst) {
    const int tid = opaque_tid(), lane = tid & 63, w = __builtin_amdgcn_readfirstlane(tid >> 6);
    const unsigned char* ub = p.ub() + (size_t)layer * 16384 * 1024; const unsigned char* vb = p.vb() + (size_t)layer * 16384 * 1024;
    const unsigned lo16 = (unsigned)lane * 16u;
    const int idxl = ((lane >> 5) & 1) * 8 + ((lane >> 4) & 1) * 4 + ((lane >> 3) & 1) * 2 + ((lane >> 2) & 1);
    for (int tok = opaque_bid() * 8 + w; tok < S; tok += gridDim.x * 8) {
        float hv[16];
        {
            const u32x4 h0 = *(const u32x4*)(p.h() + (size_t)tok * DM + lane * 16), h1 = *(const u32x4*)(p.h() + (size_t)tok * DM + lane * 16 + 8);
            hv[0] = bflo(h0.x); hv[1] = bfhi(h0.x); hv[2] = bflo(h0.y); hv[3] = bfhi(h0.y); hv[4] = bflo(h0.z); hv[5] = bfhi(h0.z); hv[6] = bflo(h0.w); hv[7] = bfhi(h0.w);
            hv[8] = bflo(h1.x); hv[9] = bfhi(h1.x); hv[10] = bflo(h1.y); hv[11] = bfhi(h1.y); hv[12] = bflo(h1.z); hv[13] = bfhi(h1.z); hv[14] = bflo(h1.w); hv[15] = bfhi(h1.w);
        }
        const int e0 = p.expert()[(size_t)tok * 128 + lane], e1 = p.expert()[(size_t)tok * 128 + 64 + lane];
        float coef[8];
#pragma unroll
        for (int b = 0; b < 8; ++b) {
            float pt[16];
#pragma unroll
            for (int half = 0; half < 2; ++half) {
                u32x4 rr[8];
#pragma unroll
                for (int k = 0; k < 8; ++k) {
                    const int e = __builtin_amdgcn_readlane(b < 4 ? e0 : e1, (b & 3) * 16 + half * 8 + k);
                    rr[k] = *(const u32x4*)(ub + ((unsigned)e * 1024u + lo16));
                }
#pragma unroll
                for (int k = 0; k < 8; ++k) {
                    float f[16]; unpack_fp8x16(rr[k], f);
                    float a = 0.f;
#pragma unroll
                    for (int i = 0; i < 16; ++i) a += hv[i] * f[i];
                    pt[half * 8 + k] = a;
                }
                __builtin_amdgcn_sched_barrier(0);
            }
#pragma unroll
            for (int k = 0; k < 8; ++k) { const bool up = (lane & 32) != 0; const float send = up ? pt[k] : pt[k + 8], keep = up ? pt[k + 8] : pt[k]; pt[k] = keep + __shfl_xor(send, 32); }
#pragma unroll
            for (int k = 0; k < 4; ++k) { const bool up = (lane & 16) != 0; const float send = up ? pt[k] : pt[k + 4], keep = up ? pt[k + 4] : pt[k]; pt[k] = keep + __shfl_xor(send, 16); }
#pragma unroll
            for (int k = 0; k < 2; ++k) { const bool up = (lane & 8) != 0; const float send = up ? pt[k] : pt[k + 2], keep = up ? pt[k + 2] : pt[k]; pt[k] = keep + __shfl_xor(send, 8); }
            { const bool up = (lane & 4) != 0; const float send = up ? pt[0] : pt[1], keep = up ? pt[1] : pt[0]; pt[0] = keep + __shfl_xor(send, 4); }
            pt[0] += __shfl_xor(pt[0], 2); pt[0] += __shfl_xor(pt[0], 1);
            const float gv = p.gate()[(size_t)tok * 128 + b * 16 + idxl];
            const float d = pt[0] * (1.f / 64.f);
            coef[b] = gv * 0.5f * d * (1.f + erff(d * 0.70710678118654752f)) * 0.25f;
        }
        float acc[16];
#pragma unroll
        for (int i = 0; i < 16; ++i) acc[i] = 0.f;
#pragma unroll
        for (int b = 0; b < 8; ++b) {
#pragma unroll
            for (int half = 0; half < 2; ++half) {
                u32x4 rr[8];
#pragma unroll
                for (int k = 0; k < 8; ++k) {
                    const int e = __builtin_amdgcn_readlane(b < 4 ? e0 : e1, (b & 3) * 16 + half * 8 + k);
                    rr[k] = *(const u32x4*)(vb + ((unsigned)e * 1024u + lo16));
                }
#pragma unroll
                for (int k = 0; k < 8; ++k) {
                    const int kk = half * 8 + k;
                    const int src = ((kk >> 3) & 1) * 32 + ((kk >> 2) & 1) * 16 + ((kk >> 1) & 1) * 8 + (kk & 1) * 4;
                    const float cf = __uint_as_float((unsigned)__builtin_amdgcn_readlane((int)__float_as_uint(coef[b]), src));
                    float f[16]; unpack_fp8x16(rr[k], f);
#pragma unroll
                    for (int i = 0; i < 16; ++i) acc[i] += cf * f[i];
                }
                __builtin_amdgcn_sched_barrier(0);
            }
        }
        const float* xp = xsrc + (size_t)tok * DM + lane * 16; float* xo = xdst + (size_t)tok * DM + lane * 16; const float* gp = g2 + lane * 16;
#pragma unroll
        for (int i4 = 0; i4 < 4; ++i4) {
            const f32x4 xv = *(const f32x4*)(xp + 4 * i4), gg = *(const f32x4*)(gp + 4 * i4);
            f32x4 o; o[0] = xv[0] + gg[0] * acc[4 * i4]; o[1] = xv[1] + gg[1] * acc[4 * i4 + 1]; o[2] = xv[2] + gg[2] * acc[4 * i4 + 2]; o[3] = xv[3] + gg[3] * acc[4 * i4 + 3];
            *(f32x4*)(xo + 4 * i4) = o;
        }
    }
}

extern __shared__ __attribute__((aligned(16))) char smem_raw[];
DEV char* smem_user() { LAS char* q = (LAS char*)smem_raw + LDS_USER; asm volatile("" : "+v"(q)); return (char*)q; }
typedef const __attribute__((address_space(4))) Params* KParams;
DEV void load_params(Params& p) {
    auto kp0 = __builtin_amdgcn_kernarg_segment_ptr();
    asm volatile("" : "+s"(kp0));
    KParams kp = (KParams)kp0;
    p.x = kp->x;
    p.c = kp->c;
    p.pos = kp->pos;
    p.mod_w = kp->mod_w;
    p.mod_b = kp->mod_b;
    p.norm_mix = kp->norm_mix;
    p.norm_ffn = kp->norm_ffn;
    p.hy_w_in = kp->hy_w_in;
    p.gdn_conv = kp->gdn_conv;
    p.gdn_a_log = kp->gdn_a_log;
    p.gdn_dt_bias = kp->gdn_dt_bias;
    p.gdn_o_norm = kp->gdn_o_norm;
    p.hy_w_out = kp->hy_w_out;
    p.mla_w_in = kp->mla_w_in;
    p.mla_q_norm = kp->mla_q_norm;
    p.mla_kv_norm = kp->mla_kv_norm;
    p.mla_w_uq = kp->mla_w_uq;
    p.mla_w_ukv = kp->mla_w_ukv;
    p.mla_w_out = kp->mla_w_out;
    p.peer_w_q = kp->peer_w_q;
    p.peer_sub_keys = kp->peer_sub_keys;
    p.peer_u = kp->peer_u;
    p.peer_v = kp->peer_v;
    p.final_norm = kp->final_norm;
    p.out = kp->out;
    p.ws = kp->ws;
    p.ph_lo = kp->ph_lo;
    p.ph_hi = kp->ph_hi;
    p.use_bar = kp->use_bar;
    p.pad0 = kp->pad0;
}
#ifdef PH_NOINLINE
#define NOINL __device__ __noinline__
#else
#define NOINL __device__ __forceinline__
#endif

NOINL void f_prologue() { Params p; load_params(p); phase_prologue(p, smem_user()); }
NOINL void f_norm_e0(int layer) {
    Params p; load_params(p); const float* mod = p.mod() + layer * 6144; const int li = layer >> 1;
    phase_norm<1>(layer == 0 ? p.x : p.xw(), p.norm_mix + layer * DM, mod, mod + 1024, p.h(), nullptr, p.hy_w_in + (size_t)li * 1024 * HY_IN, p.ba(), smem_user());
}
NOINL void f_norm_plain(int layer, int which) {
    Params p; load_params(p); const float* mod = p.mod() + layer * 6144;
    if (which == 0) phase_norm<0>(p.xw(), p.norm_mix + layer * DM, mod, mod + 1024, p.h(), nullptr, nullptr, nullptr, smem_user());
    else phase_norm<0>(p.xw(), p.norm_ffn + layer * DM, mod + 3072, mod + 4096, p.h(), nullptr, nullptr, nullptr, smem_user());
}
NOINL void f_final() { Params p; load_params(p); phase_norm<2>(
#ifdef DBG_SKIP_ALL
        p.x,
#else
        p.xw(),
#endif
 p.final_norm, nullptr, nullptr, nullptr, p.out, nullptr, nullptr, smem_user()); }
NOINL void f_gemm_hy_in(int li) {
    Params p; load_params(p);
    auto epi = [&](f32x4 (&acc)[4][4], int mb, int nb, int n0) {
#pragma unroll
        for (int mt = 0; mt < 4; ++mt) {
            const int m = mb + 16 * mt;
#pragma unroll
            for (int nt = 0; nt < 4; ++nt) {
                const int n = nb + 16 * nt; const f32x4 v = acc[mt][nt];
                if (n0 < 1536) st_bf4(p.proj_a() + (size_t)m * 1536 + n, v);
                else if (n0 < 2048) st_bf4(p.zbuf() + (size_t)m * 512 + (n - 1536), v);
                else if (n0 < 2560) { const int hd = (n - 2048) >> 7, dp = (n - 2048) & 127; const f32x4 rv = rope4(v, p.cosB() + (size_t)m * 64, p.sinB() + (size_t)m * 64, dp >> 1) * (0.08838834764831845f * 1.4426950408889634f); st_bf4(p.Qb() + ((size_t)hd * S + m) * 128 + dp, rv); }
                else if (n0 < 3072) { const int hd = (n - 2560) >> 7, dp = (n - 2560) & 127; const f32x4 rv = rope4(v, p.cosB() + (size_t)m * 64, p.sinB() + (size_t)m * 64, dp >> 1); st_bf4(p.Kb() + ((size_t)hd * S + m) * 128 + dp, rv); }
                else { const int hd = (n - 3072) >> 7, dv = (n - 3072) & 127; bf16_t* vp = p.VbT() + ((size_t)hd * 128 + dv) * S + m; vp[0] = f2bf(v[0]); vp[S] = f2bf(v[1]); vp[2 * (size_t)S] = f2bf(v[2]); vp[3 * (size_t)S] = f2bf(v[3]); }
            }
        }
    };
    gemm_phase(p.h(), DM, p.w_hy_in() + (size_t)li * HYN * 1024, 1024, 1024, HYN / 128, smem_user(), epi);
}
NOINL void f_gemm_resid(int layer) {
    Params p; load_params(p); const float* mod = p.mod() + layer * 6144; const int li = layer >> 1;
    const float* xin = layer == 0 ? p.x : p.xw(); float* xo = p.xw();
    auto epi = [&](f32x4 (&acc)[4][4], int mb, int nb, int n0) {
#pragma unroll
        for (int mt = 0; mt < 4; ++mt)
#pragma unroll
            for (int nt = 0; nt < 4; ++nt) {
                const int m = mb + 16 * mt, n = nb + 16 * nt;
                const f32x4 xv = *(const f32x4*)(xin + (size_t)m * DM + n), gg = *(const f32x4*)(mod + 2048 + n);
                *(f32x4*)(xo + (size_t)m * DM + n) = xv + gg * acc[mt][nt];
            }
    };
    const bf16_t* wt = (layer & 1) ? p.w_mla_out() + (size_t)li * 1024 * 1024 : p.w_hy_out() + (size_t)li * 1024 * 1024;
    gemm_phase(p.cat(), DM, wt, 1024, 1024, 8, smem_user(), epi);
}
NOINL void f_e2(int li) {
    Params p; load_params(p);
    for (int u = opaque_bid(); u < 1280; u += gridDim.x) { if (u < 1024) gdn_prep_unit(p, li, u >> 2, u & 3, smem_user()); else moba_kmean_unit(p, (u - 1024) & 3, (u - 1024) >> 2, smem_user()); }
}
NOINL void f_gate() { Params p; load_params(p); phase_moba_gate(p, smem_user()); }
NOINL void f_scan() {
    Params p; load_params(p);
#ifdef REP_SCAN
    gdn_scan(p, opaque_bid(), smem_user());
#endif
    gdn_scan(p, opaque_bid(), smem_user());
}
NOINL void f_moba_attn() {
    Params p; load_params(p);
#ifdef REP_MOBA
    phase_moba_attn(p, smem_user(), opaque_bid() - 16, gridDim.x - 16);
#endif
    phase_moba_attn(p, smem_user(), opaque_bid() - 16, gridDim.x - 16);
}
NOINL void f_combine(int li) { Params p; load_params(p); phase_even_combine(p, li); }
NOINL void f_gemm_mla_in(int li) {
    Params p; load_params(p);
    auto epi = [&](f32x4 (&acc)[4][4], int mb, int nb, int n0) {
#pragma unroll
        for (int mt = 0; mt < 4; ++mt)
#pragma unroll
            for (int nt = 0; nt < 4; ++nt) {
                const int m = mb + 16 * mt, n = nb + 16 * nt; const f32x4 v = acc[mt][nt];
                if (n0 < 768) st_bf4(p.cbuf() + (size_t)m * 768 + n, v);
                else if (n < 832) { const int dp = n - 768; const f32x4 rv = rope4(v, p.cosC() + (size_t)m * 32, p.sinC() + (size_t)m * 32, dp >> 1); st_bf4(p.Kr() + (size_t)m * 64 + dp, rv); }
            }
    };
    gemm_phase(p.h(), DM, p.w_mla_in() + (size_t)li * 896 * 1024, 1024, 1024, 7, smem_user(), epi);
}
NOINL void f_cnorm(int li) { Params p; load_params(p); phase_mla_cnorm(p, li); }
NOINL void f_gemm_uq(int li) {
    Params p; load_params(p);
    auto epi = [&](f32x4 (&acc)[4][4], int mb, int nb, int n0) {
        const float qs = 0.07216878364870322f * 1.4426950408889634f;
#pragma unroll
        for (int mt = 0; mt < 4; ++mt)
#pragma unroll
            for (int nt = 0; nt < 4; ++nt) {
                const int m = mb + 16 * mt, n = nb + 16 * nt; const int hd = n / 192, d = n - hd * 192; f32x4 v = acc[mt][nt];
                if (d >= 128) v = rope4(v, p.cosC() + (size_t)m * 32, p.sinC() + (size_t)m * 32, (d - 128) >> 1);
                st_bf4(p.Qm() + ((size_t)hd * S + m) * 192 + d, v * qs);
            }
    };
    gemm_phase(p.cqn(), 512, p.w_uq() + (size_t)li * 1536 * 512, 512, 512, 12, smem_user(), epi);
}
NOINL void f_gemm_ukv(int li) {
    Params p; load_params(p);
    auto epi = [&](f32x4 (&acc)[4][4], int mb, int nb, int n0) {
#pragma unroll
        for (int mt = 0; mt < 4; ++mt)
#pragma unroll
            for (int nt = 0; nt < 4; ++nt) {
                const int m = mb + 16 * mt, n = nb + 16 * nt; const f32x4 v = acc[mt][nt];
                if (n0 < 1024) { const int hd = n >> 7, d = n & 127; st_bf4(p.Kn() + ((size_t)hd * S + m) * 128 + d, v); }
                else { const int hd = (n - 1024) >> 7, dv = (n - 1024) & 127; bf16_t* vp = p.VmT() + ((size_t)hd * 128 + dv) * S + m; vp[0] = f2bf(v[0]); vp[S] = f2bf(v[1]); vp[2 * (size_t)S] = f2bf(v[2]); vp[3 * (size_t)S] = f2bf(v[3]); }
            }
    };
    gemm_phase(p.ckvn(), 256, p.w_ukv() + (size_t)li * 2048 * 256, 256, 256, 16, smem_user(), epi);
}
NOINL void f_mla_attn() {
    Params p; load_params(p);
#ifdef REP_M4
    phase_mla_attn(p, smem_user());
#endif
    phase_mla_attn(p, smem_user());
}
NOINL void f_gemm_pq(int layer) {
    Params p; load_params(p);
    auto epi = [&](f32x4 (&acc)[4][4], int mb, int nb, int n0) {
#pragma unroll
        for (int mt = 0; mt < 4; ++mt)
#pragma unroll
            for (int nt = 0; nt < 4; ++nt) st_bf4(p.qbuf() + (size_t)(mb + 16 * mt) * 2048 + nb + 16 * nt, acc[mt][nt]);
    };
    gemm_phase(p.h(), DM, p.w_pq() + (size_t)layer * 2048 * 1024, 1024, 1024, 16, smem_user(), epi);
}
NOINL void f_topk(int layer) { Params p; load_params(p); phase_peer_topk(p, layer, smem_user()); }
NOINL void f_gather(int layer) {
    Params p; load_params(p);
#ifdef REP_F3
    phase_peer_gather(p, layer, p.mod() + layer * 6144 + 5120, p.xw(), p.part());
#endif
    phase_peer_gather(p, layer, p.mod() + layer * 6144 + 5120, p.xw(), p.xw());
}

__device__ __noinline__ void grid_sync(unsigned* barw, unsigned x) {
    XcdBarrier b; b.bar = barw; b.x = x; b.st = (volatile LAS unsigned*)smem_raw;
    xcd_barrier(b);
}

__global__ void __launch_bounds__(NTHREADS) hybrid_forward(Params p) {
    if (threadIdx.x == 0) *(u32x4*)smem_raw = (u32x4){0u, 0u, 0u, 0u};
    __syncthreads();
    XcdBarrier bar; bar.bar = p.bar(); bar.x = 0; bar.st = (volatile LAS unsigned*)smem_raw;
    if (p.use_bar) bar = xcd_barrier_post(p.bar(), (volatile LAS unsigned*)smem_raw);
    int ph = 0;
#define RUN_PHASE(...) { if (ph >= p.ph_lo && ph < p.ph_hi) { __VA_ARGS__; if (p.use_bar && ph + 1 < p.ph_hi) grid_sync(bar.bar, bar.x); } ++ph; }

    RUN_PHASE(f_prologue());
    for (int layer = 0; layer < 4; ++layer) {
        const int li = layer >> 1;
        if ((layer & 1) == 0) {
            RUN_PHASE(f_norm_e0(layer));
            RUN_PHASE(f_gemm_hy_in(li));
            RUN_PHASE(f_e2(li));
            RUN_PHASE(f_gate());
            RUN_PHASE(if (blockIdx.x < 16) f_scan(); else f_moba_attn());
            RUN_PHASE(f_combine(li));
            RUN_PHASE(f_gemm_resid(layer));
        } else {
            RUN_PHASE(f_norm_plain(layer, 0));
            RUN_PHASE(f_gemm_mla_in(li));
            RUN_PHASE(f_cnorm(li));
            RUN_PHASE(f_gemm_uq(li); f_gemm_ukv(li));
            RUN_PHASE(f_mla_attn());
            RUN_PHASE(f_gemm_resid(layer));
        }
        RUN_PHASE(f_norm_plain(layer, 1));
        RUN_PHASE(f_gemm_pq(layer));
        RUN_PHASE(f_topk(layer));
        RUN_PHASE(f_gather(layer));
    }
    RUN_PHASE(f_final());
}

constexpr int N_PHASES = 1 + 2 * 11 + 2 * 10 + 1;

extern "C" void kernel_launch(void* const* d_in, const int* in_sizes, int n_in, void* d_out, int out_size, void* d_ws, size_t ws_size, hipStream_t stream) {
    static int grid = 0;
    if (!grid) {
        int dev = 0, cus = 0, per_cu = 0;
        hipGetDevice(&dev);
        hipDeviceGetAttribute(&cus, hipDeviceAttributeMultiprocessorCount, dev);
        hipFuncSetAttribute((const void*)hybrid_forward, hipFuncAttributeMaxDynamicSharedMemorySize, LDS_BYTES);
        hipOccupancyMaxActiveBlocksPerMultiprocessor(&per_cu, hybrid_forward, NTHREADS, LDS_BYTES);
        if (per_cu < 1) per_cu = 1;
        grid = cus;
        if (grid > 256) grid = 256;
    }
    Params p; memset(&p, 0, sizeof(p));
    p.x = (const float*)d_in[0]; p.c = (const float*)d_in[1]; p.pos = (const int*)d_in[2]; p.mod_w = (const float*)d_in[3]; p.mod_b = (const float*)d_in[4];
    p.norm_mix = (const float*)d_in[5]; p.norm_ffn = (const float*)d_in[6]; p.hy_w_in = (const float*)d_in[7]; p.gdn_conv = (const float*)d_in[8];
    p.gdn_a_log = (const float*)d_in[9]; p.gdn_dt_bias = (const float*)d_in[10]; p.gdn_o_norm = (const float*)d_in[11]; p.hy_w_out = (const float*)d_in[12];
    p.mla_w_in = (const float*)d_in[13]; p.mla_q_norm = (const float*)d_in[14]; p.mla_kv_norm = (const float*)d_in[15]; p.mla_w_uq = (const float*)d_in[16];
    p.mla_w_ukv = (const float*)d_in[17]; p.mla_w_out = (const float*)d_in[18]; p.peer_w_q = (const float*)d_in[19]; p.peer_sub_keys = (const float*)d_in[20];
    p.peer_u = (const float*)d_in[21]; p.peer_v = (const float*)d_in[22]; p.final_norm = (const float*)d_in[23];
    p.out = (float*)d_out;
    p.ws = (char*)d_ws;
    if (WS_NEED > ws_size) { fprintf(stderr, "workspace too small: need %zu have %zu\n", (size_t)WS_NEED, ws_size); return; }
    hipMemsetAsync(p.ws, 0, 16384, stream);
#ifndef ONE_LAUNCH
    for (int ph = 0; ph < N_PHASES; ++ph) {
#ifdef DBG_SKIP_ALL
        if (ph != N_PHASES - 1) continue;
#endif
        p.ph_lo = ph; p.ph_hi = ph + 1; p.use_bar = 0;
        hipLaunchKernelGGL(hybrid_forward, dim3(grid), dim3(NTHREADS), LDS_BYTES, stream, p);
    }
#else
    p.ph_lo = 0; p.ph_hi = N_PHASES; p.use_bar = 1;
    hipLaunchKernelGGL(hybrid_forward, dim3(grid), dim3(NTHREADS), LDS_BYTES, stream, p);
#endif
}
```

```cpp
#include <hip/hip_runtime.h>
#define ONE_LAUNCH 1
#include <stdint.h>
#include <stddef.h>
#include <stdio.h>
#include <string.h>

#define DEV __device__ __forceinline__

constexpr int S = 16384;
constexpr int DM = 1024;
constexpr int HY_IN = 3592;
constexpr int HYN = 3584;
constexpr int NTHREADS = 512;
constexpr int LDS_BYTES = 163840;
constexpr int LDS_USER = 16;

typedef unsigned short bf16_t;
typedef short bf16x8 __attribute__((ext_vector_type(8)));
typedef float f32x4 __attribute__((ext_vector_type(4)));
typedef float f32x16 __attribute__((ext_vector_type(16)));
typedef __bf16 bf16v2 __attribute__((ext_vector_type(2)));
typedef unsigned u32x4 __attribute__((ext_vector_type(4)));
typedef unsigned u32x2 __attribute__((ext_vector_type(2)));
typedef int i32x4 __attribute__((ext_vector_type(4)));

#define XB_TMO      128
#define XB_XCNT(j)  (256  + 64 * (j))
#define XB_XSUB(j)  (1280 + 64 * (j))
#define XB_XGEN(j)  (2304 + 64 * (j))
#define XB_TOP      3328
#define XB_TOPGEN   3392
#define XCD_BAR_WORDS 3456
#define XB_SPIN_CAP (1u << 22)
#define LAS __attribute__((address_space(3)))

__device__ __forceinline__ unsigned xb_ld(unsigned* p)              { return __hip_atomic_load(p, __ATOMIC_RELAXED, __HIP_MEMORY_SCOPE_AGENT); }
__device__ __forceinline__ unsigned xb_add(unsigned* p, unsigned v) { return __hip_atomic_fetch_add(p, v, __ATOMIC_RELAXED, __HIP_MEMORY_SCOPE_AGENT); }
__device__ __forceinline__ unsigned xb_xcc_id() { return (unsigned)__builtin_amdgcn_s_getreg((3 << 11) | 20) & 0xFu; }
#define XB_SPIN(cond, bar) do { unsigned _sp = 0; while (cond) { __builtin_amdgcn_s_sleep(1); \
    if ((++_sp & 255u) == 0u) { if (xb_ld(&(bar)[XB_TMO])) break; if (_sp > XB_SPIN_CAP) { atomicAdd(&(bar)[XB_TMO], 1u); break; } } } } while (0)

struct XcdBarrier { unsigned* bar; unsigned x; volatile LAS unsigned* st; };

__device__ __forceinline__ XcdBarrier xcd_barrier_post(unsigned* bar, volatile LAS unsigned* st) {
    XcdBarrier b; b.bar = bar; b.x = xb_xcc_id(); b.st = st;
    if (threadIdx.x == 0) (void)xb_add(&bar[XB_XCNT(b.x)], 1u);
    return b;
}
__device__ __forceinline__ void xcd_barrier_complete(unsigned* bar, unsigned x, unsigned& nloc, unsigned& nx) {
    const unsigned G = gridDim.x * gridDim.y * gridDim.z;
    unsigned sum, cnt, mine, sp = 0u;
    for (;;) {
        sum = 0u; cnt = 0u; mine = 0u;
#pragma unroll 1
        for (unsigned j = 0; j < 16; ++j) { const unsigned c = xb_ld(&bar[XB_XCNT(j)]); sum += c; cnt += (c > 0u) ? 1u : 0u; mine = (j == x) ? c : mine; }
        if (sum == G) break;
        __builtin_amdgcn_s_sleep(1);
        if ((++sp & 255u) == 0u) { if (xb_ld(&bar[XB_TMO])) break; if (sp > XB_SPIN_CAP) { atomicAdd(&bar[XB_TMO], 1u); break; } }
    }
    nloc = mine > 0u ? mine : 1u; nx = cnt > 0u ? cnt : 1u;
}
__device__ __forceinline__ void xcd_barrier(const XcdBarrier& b) {
    asm volatile("s_waitcnt vmcnt(0)" ::: "memory");
    __syncthreads();
    if (threadIdx.x == 0) {
        unsigned* bar = b.bar;
        __builtin_amdgcn_s_waitcnt(0);
        unsigned nloc = b.st[0], nx = b.st[1];
        if (nloc == 0u) { xcd_barrier_complete(bar, b.x, nloc, nx); b.st[0] = nloc; b.st[1] = nx; }
        const unsigned old = xb_add(&bar[XB_XSUB(b.x)], 1u);
        const unsigned gen = old / nloc;
        if (old + 1u == (gen + 1u) * nloc) {
            __builtin_amdgcn_fence(__ATOMIC_RELEASE, "agent");
            asm volatile("s_waitcnt vmcnt(0)" ::: "memory");
            const unsigned og = xb_add(&bar[XB_TOP], 1u);
            const unsigned tg = og / nx;
            if (og + 1u == (tg + 1u) * nx) xb_add(&bar[XB_TOPGEN], 1u);
            else XB_SPIN(xb_ld(&bar[XB_TOPGEN]) == tg, bar);
            __builtin_amdgcn_fence(__ATOMIC_ACQUIRE, "agent");
            xb_add(&bar[XB_XGEN(b.x)], 1u);
            asm volatile("s_waitcnt vmcnt(0)" ::: "memory");
        } else {
            XB_SPIN(xb_ld(&bar[XB_XGEN(b.x)]) == gen, bar);
            __builtin_amdgcn_fence(__ATOMIC_ACQUIRE, "agent");
            asm volatile("s_waitcnt vmcnt(0)" ::: "memory");
        }
    }
    __syncthreads();
}

DEV int opaque_bid() { int b = blockIdx.x; asm volatile("" : "+s"(b)); return b; }
DEV int opaque_tid() { int t = threadIdx.x; asm volatile("" : "+v"(t)); return t & (NTHREADS - 1); }
DEV bf16_t f2bf(float f) { __bf16 v = (__bf16)f; bf16_t r; __builtin_memcpy(&r, &v, 2); return r; }
DEV unsigned pk2(float a, float b) { bf16v2 v; v[0] = (__bf16)a; v[1] = (__bf16)b; unsigned r; __builtin_memcpy(&r, &v, 4); return r; }
DEV float bflo(unsigned u) { return __uint_as_float(u << 16); }
DEV float bfhi(unsigned u) { return __uint_as_float(u & 0xffff0000u); }
DEV float wsum64(float v) {
#pragma unroll
    for (int o = 32; o; o >>= 1) v += __shfl_xor(v, o);
    return v;
}
DEV f32x4 mfma16(bf16x8 a, bf16x8 b, f32x4 c) { return __builtin_amdgcn_mfma_f32_16x16x32_bf16(a, b, c, 0, 0, 0); }
DEV f32x16 mfma32(bf16x8 a, bf16x8 b, f32x16 c) { return __builtin_amdgcn_mfma_f32_32x32x16_bf16(a, b, c, 0, 0, 0); }
DEV float siluf(float v) { return v / (1.f + expf(-v)); }
DEV float softplusf(float v) { return fmaxf(v, 0.f) + log1pf(expf(-fabsf(v))); }
DEV float ex2(float v) { return __builtin_amdgcn_exp2f(v); }

struct Params {
    const float* x; const float* c; const int* pos; const float* mod_w; const float* mod_b; const float* norm_mix; const float* norm_ffn;
    const float* hy_w_in; const float* gdn_conv; const float* gdn_a_log; const float* gdn_dt_bias; const float* gdn_o_norm; const float* hy_w_out;
    const float* mla_w_in; const float* mla_q_norm; const float* mla_kv_norm; const float* mla_w_uq; const float* mla_w_ukv; const float* mla_w_out;
    const float* peer_w_q; const float* peer_sub_keys; const float* peer_u; const float* peer_v; const float* final_norm;
    float* out; char* ws;
    int ph_lo, ph_hi, use_bar, pad0;
    DEV unsigned* bar() const { return (unsigned*)(ws + 0ull); }
    DEV float* mod() const { return (float*)(ws + 16384ull); }
    DEV float* cosB() const { return (float*)(ws + 114688ull); }
    DEV float* sinB() const { return (float*)(ws + 4308992ull); }
    DEV float* cosC() const { return (float*)(ws + 8503296ull); }
    DEV float* sinC() const { return (float*)(ws + 10600448ull); }
    DEV bf16_t* w_hy_in() const { return (bf16_t*)(ws + 12697600ull); }
    DEV bf16_t* w_hy_out() const { return (bf16_t*)(ws + 27377664ull); }
    DEV bf16_t* w_mla_in() const { return (bf16_t*)(ws + 31571968ull); }
    DEV bf16_t* w_uq() const { return (bf16_t*)(ws + 35241984ull); }
    DEV bf16_t* w_ukv() const { return (bf16_t*)(ws + 38387712ull); }
    DEV bf16_t* w_mla_out() const { return (bf16_t*)(ws + 40484864ull); }
    DEV bf16_t* w_pq() const { return (bf16_t*)(ws + 44679168ull); }
    DEV bf16_t* skb() const { return (bf16_t*)(ws + 61456384ull); }
    DEV unsigned char* ub() const { return (unsigned char*)(ws + 63553536ull); }
    DEV unsigned char* vb() const { return (unsigned char*)(ws + 197771264ull); }
    DEV float* xw() const { return (float*)(ws + 331988992ull); }
    DEV bf16_t* h() const { return (bf16_t*)(ws + 399097856ull); }
    DEV bf16_t* cat() const { return (bf16_t*)(ws + 432652288ull); }
    DEV bf16_t* proj_a() const { return (bf16_t*)(ws + 466206720ull); }
    DEV bf16_t* zbuf() const { return (bf16_t*)(ws + 516538368ull); }
    DEV bf16_t* Qb() const { return (bf16_t*)(ws + 533315584ull); }
    DEV bf16_t* Kb() const { return (bf16_t*)(ws + 550092800ull); }
    DEV bf16_t* VbT() const { return (bf16_t*)(ws + 566870016ull); }
    DEV float* ba() const { return (float*)(ws + 583647232ull); }
    DEV float* u32() const { return (float*)(ws + 584171520ull); }
    DEV bf16_t* wneg() const { return (bf16_t*)(ws + 617725952ull); }
    DEV bf16_t* qdec() const { return (bf16_t*)(ws + 634503168ull); }
    DEV bf16_t* kdT() const { return (bf16_t*)(ws + 651280384ull); }
    DEV bf16_t* qk() const { return (bf16_t*)(ws + 668057600ull); }
    DEV float* glast() const { return (float*)(ws + 676446208ull); }
    DEV float* oa() const { return (float*)(ws + 676450304ull); }
    DEV float* kmean() const { return (float*)(ws + 710004736ull); }
    DEV int* segcnt() const { return (int*)(ws + 710135808ull); }
    DEV int* lists() const { return (int*)(ws + 710168576ull); }
    DEV float* part() const { return (float*)(ws + 726945792ull); }
    DEV float* ml() const { return (float*)(ws + 861163520ull); }
    DEV bf16_t* cbuf() const { return (bf16_t*)(ws + 466206720ull); }
    DEV bf16_t* Kr() const { return (bf16_t*)(ws + 491372544ull); }
    DEV bf16_t* cqn() const { return (bf16_t*)(ws + 493469696ull); }
    DEV bf16_t* ckvn() const { return (bf16_t*)(ws + 510246912ull); }
    DEV bf16_t* Qm() const { return (bf16_t*)(ws + 518635520ull); }
    DEV bf16_t* Kn() const { return (bf16_t*)(ws + 568967168ull); }
    DEV bf16_t* VmT() const { return (bf16_t*)(ws + 602521600ull); }
    DEV bf16_t* qbuf() const { return (bf16_t*)(ws + 466206720ull); }
    DEV int* expert() const { return (int*)(ws + 533315584ull); }
    DEV float* gate() const { return (float*)(ws + 541704192ull); }
};
constexpr size_t WS_NEED = 863260672ull;


template <class Map>
DEV void transpose_conv(const float* __restrict__ src, int K, int ldsrc, bf16_t* __restrict__ dst, int Nd, Map map, char* smem, int& base) {
    float* T = (float*)smem;
    const int tid = opaque_tid(), nb = gridDim.x, b = opaque_bid();
    const int ntk = K / 64, ntn = Nd / 64, nun = ntk * ntn;
    int first = ((b - (base % nb)) % nb + nb) % nb;
    for (int u = first; u < nun; u += nb) {
        const int tk = u % ntk, tn = u / ntk;
        __syncthreads();
#pragma unroll
        for (int i = 0; i < 8; ++i) {
            const int kk = (tid >> 6) + 8 * i, nn = tid & 63;
            const int sc = map(tn * 64 + nn);
            float v = 0.f;
            if (sc >= 0) v = src[(size_t)(tk * 64 + kk) * ldsrc + sc];
            T[kk * 65 + nn] = v;
        }
        __syncthreads();
#pragma unroll
        for (int i = 0; i < 8; ++i) {
            const int nn = (tid >> 6) + 8 * i, kk = tid & 63;
            dst[(size_t)(tn * 64 + nn) * K + tk * 64 + kk] = f2bf(T[kk * 65 + nn]);
        }
    }
    base += nun;
}

DEV void convert_bf16(const float* __restrict__ src, bf16_t* __restrict__ dst, size_t n) {
    const size_t n8 = n / 8;
    for (size_t i = (size_t)opaque_bid() * NTHREADS + opaque_tid(); i < n8; i += (size_t)gridDim.x * NTHREADS) {
        const f32x4 a = *(const f32x4*)(src + i * 8), b = *(const f32x4*)(src + i * 8 + 4);
        u32x4 o; o.x = pk2(a[0], a[1]); o.y = pk2(a[2], a[3]); o.z = pk2(b[0], b[1]); o.w = pk2(b[2], b[3]);
        *(u32x4*)(dst + i * 8) = o;
    }
}

DEV void convert_fp8(const float* __restrict__ src, unsigned char* __restrict__ dst, size_t n, float scale) {
    const size_t n16 = n / 16;
    for (size_t i = (size_t)opaque_bid() * NTHREADS + opaque_tid(); i < n16; i += (size_t)gridDim.x * NTHREADS) {
        u32x4 o;
#pragma unroll
        for (int q = 0; q < 4; ++q) {
            const f32x4 a = *(const f32x4*)(src + i * 16 + q * 4) * scale;
            int w = 0;
            w = __builtin_amdgcn_cvt_pk_fp8_f32(a[0], a[1], w, false);
            w = __builtin_amdgcn_cvt_pk_fp8_f32(a[2], a[3], w, true);
            o[q] = (unsigned)w;
        }
        *(u32x4*)(dst + i * 16) = o;
    }
}

DEV void phase_prologue(const Params& p, char* smem) {
    const int tid = opaque_tid(), nb = gridDim.x, b = opaque_bid();
    {
        float* cond = (float*)smem; float* red = cond + 1024;
        for (int i = tid; i < 1024; i += NTHREADS) cond[i] = siluf(p.c[i]);
        __syncthreads();
        for (int u = b; u < 192; u += nb) {
            const int n = u * 128, layer = n / 6144, nn = n - layer * 6144;
            const int cg = tid & 31, ks = tid >> 5;
            const float* wp = p.mod_w + ((size_t)layer * 1024 + ks * 64) * 6144 + nn + cg * 4;
            f32x4 acc = {0.f, 0.f, 0.f, 0.f};
#pragma unroll 8
            for (int k = 0; k < 64; ++k) { const f32x4 w = *(const f32x4*)(wp + (size_t)k * 6144); const float cv = cond[ks * 64 + k]; acc += w * cv; }
            *(f32x4*)(red + ks * 128 + cg * 4) = acc;
            __syncthreads();
            if (tid < 128) { float s = p.mod_b[n + tid]; for (int q = 0; q < 16; ++q) s += red[q * 128 + tid]; p.mod()[n + tid] = s; }
            __syncthreads();
        }
    }
    for (size_t i = (size_t)b * NTHREADS + tid; i < (size_t)S * 64; i += (size_t)nb * NTHREADS) {
        const int s = (int)(i >> 6), f = (int)(i & 63);
        const float invf = powf(10000.f, -(float)(2 * f) / 128.f);
        const float ang = (float)p.pos[s] * invf;
        float sn, cs; sincosf(ang, &sn, &cs);
        p.cosB()[i] = cs; p.sinB()[i] = sn;
    }
    for (size_t i = (size_t)b * NTHREADS + tid; i < (size_t)S * 32; i += (size_t)nb * NTHREADS) {
        const int s = (int)(i >> 5), f = (int)(i & 31);
        const float invf = powf(10000.f, -(float)(2 * f) / 64.f);
        const float ang = (float)p.pos[s] * invf;
        float sn, cs; sincosf(ang, &sn, &cs);
        p.cosC()[i] = cs; p.sinC()[i] = sn;
    }
    int base = 0;
    for (int i = 0; i < 2; ++i) {
        transpose_conv(p.hy_w_in + (size_t)i * 1024 * HY_IN, 1024, HY_IN, p.w_hy_in() + (size_t)i * HYN * 1024, HYN,
            [](int n) -> int {
                if (n < 2048) return n;
                const int seg = (n - 2048) >> 9, r = (n - 2048) & 511, sb = 2056 + seg * 512;
                if (seg < 2) { const int hd = r >> 7, dp = r & 127; const int d = (dp & 1) ? 64 + (dp >> 1) : (dp >> 1); return sb + hd * 128 + d; }
                return sb + r;
            }, smem, base);
        transpose_conv(p.hy_w_out + (size_t)i * 1024 * 1024, 1024, 1024, p.w_hy_out() + (size_t)i * 1024 * 1024, 1024, [](int n) -> int { return n; }, smem, base);
        transpose_conv(p.mla_w_in + (size_t)i * 1024 * 832, 1024, 832, p.w_mla_in() + (size_t)i * 896 * 1024, 896,
            [](int n) -> int {
                if (n < 768) return n;
                if (n < 832) { const int dp = n - 768; const int d = (dp & 1) ? 32 + (dp >> 1) : (dp >> 1); return 768 + d; }
                return -1;
            }, smem, base);
        transpose_conv(p.mla_w_uq + (size_t)i * 512 * 1536, 512, 1536, p.w_uq() + (size_t)i * 1536 * 512, 1536,
            [](int n) -> int {
                const int hd = n / 192, d = n % 192;
                if (d < 128) return n;
                const int dp = d - 128; const int dd = (dp & 1) ? 32 + (dp >> 1) : (dp >> 1);
                return hd * 192 + 128 + dd;
            }, smem, base);
        transpose_conv(p.mla_w_ukv + (size_t)i * 256 * 2048, 256, 2048, p.w_ukv() + (size_t)i * 2048 * 256, 2048,
            [](int n) -> int {
                if (n < 1024) { const int hd = n >> 7, d = n & 127; return hd * 256 + d; }
                const int m = n - 1024; const int hd = m >> 7, d = m & 127; return hd * 256 + 128 + d;
            }, smem, base);
        transpose_conv(p.mla_w_out + (size_t)i * 1024 * 1024, 1024, 1024, p.w_mla_out() + (size_t)i * 1024 * 1024, 1024, [](int n) -> int { return n; }, smem, base);
    }
    for (int i = 0; i < 4; ++i)
        transpose_conv(p.peer_w_q + (size_t)i * 1024 * 2048, 1024, 2048, p.w_pq() + (size_t)i * 2048 * 1024, 2048, [](int n) -> int { return n; }, smem, base);
    convert_bf16(p.peer_sub_keys, p.skb(), (size_t)4 * 8 * 2 * 128 * 128);
    convert_fp8(p.peer_u, p.ub(), (size_t)4 * 16384 * 1024, 64.f);
    convert_fp8(p.peer_v, p.vb(), (size_t)4 * 16384 * 1024, 4.f);
}

template <int MODE>
DEV void phase_norm(const float* __restrict__ xs, const float* __restrict__ nw, const float* __restrict__ shv, const float* __restrict__ scv,
                    bf16_t* __restrict__ hout, float* __restrict__ fout, const float* __restrict__ w8src, float* __restrict__ ba, char* smem) {
    const int tid = opaque_tid(), lane = tid & 63, w = __builtin_amdgcn_readfirstlane(tid >> 6);
    float* W8 = (float*)smem;
    if (MODE == 1) {
        for (int i = tid; i < 8192; i += NTHREADS) { const int k = i >> 3, c = i & 7; W8[c * 1024 + k] = w8src[(size_t)k * HY_IN + 2048 + c]; }
        __syncthreads();
    }
    f32x4 wm[4], sh[4];
#pragma unroll
    for (int i = 0; i < 4; ++i) {
        const int e = (i * 64 + lane) * 4;
        const f32x4 nv = *(const f32x4*)(nw + e);
        if (MODE == 2) { wm[i] = nv; sh[i] = (f32x4){0.f, 0.f, 0.f, 0.f}; }
        else { const f32x4 sc = *(const f32x4*)(scv + e); wm[i] = nv * (sc + 1.0f); sh[i] = *(const f32x4*)(shv + e); }
    }
    for (int row = opaque_bid() * 8 + w; row < S; row += gridDim.x * 8) {
        f32x4 v[4]; float ss = 0.f;
#pragma unroll
        for (int i = 0; i < 4; ++i) { v[i] = *(const f32x4*)(xs + (size_t)row * DM + (i * 64 + lane) * 4); ss += v[i][0] * v[i][0] + v[i][1] * v[i][1] + v[i][2] * v[i][2] + v[i][3] * v[i][3]; }
        ss = wsum64(ss);
        const float rn = rsqrtf(ss * (1.f / 1024.f) + 1e-6f);
#pragma unroll
        for (int i = 0; i < 4; ++i) v[i] = v[i] * rn * wm[i] + sh[i];
        if (MODE == 2) {
#pragma unroll
            for (int i = 0; i < 4; ++i) *(f32x4*)(fout + (size_t)row * DM + (i * 64 + lane) * 4) = v[i];
        } else {
#pragma unroll
            for (int i = 0; i < 4; ++i) { u32x2 o; o.x = pk2(v[i][0], v[i][1]); o.y = pk2(v[i][2], v[i][3]); *(u32x2*)(hout + (size_t)row * DM + (i * 64 + lane) * 4) = o; }
        }
        if (MODE == 1) {
            float pc[8];
#pragma unroll
            for (int c = 0; c < 8; ++c) {
                float a = 0.f;
#pragma unroll
                for (int i = 0; i < 4; ++i) { const f32x4 ww = *(const f32x4*)(W8 + c * 1024 + (i * 64 + lane) * 4); a += v[i][0] * ww[0] + v[i][1] * ww[1] + v[i][2] * ww[2] + v[i][3] * ww[3]; }
                pc[c] = wsum64(a);
            }
            if (lane == 0) { *(f32x4*)(ba + (size_t)row * 8) = (f32x4){pc[0], pc[1], pc[2], pc[3]}; *(f32x4*)(ba + (size_t)row * 8 + 4) = (f32x4){pc[4], pc[5], pc[6], pc[7]}; }
        }
    }
}

constexpr int GA_RS = 144;
template <class Epi>
DEV void gemm_phase(const bf16_t* __restrict__ A, int lda, const bf16_t* __restrict__ Bt, int ldb, int K, int ntn, char* smem, Epi epi) {
    const int tid = opaque_tid(), lane = tid & 63, w = tid >> 6, wm = w >> 1, wn = w & 1, r = lane & 15, g = lane >> 4;
    char* As = smem; char* Bs = smem + 256 * GA_RS;
    const int nun = 64 * ntn, nk = K / 64;
    for (int u = opaque_bid(); u < nun; u += gridDim.x) {
        const int xcd = u & 7, idx = u >> 3, tn = idx % ntn, tm = xcd * 8 + idx / ntn;
        const int m0 = tm * 256, n0 = tn * 128;
        f32x4 acc[4][4];
#pragma unroll
        for (int i = 0; i < 4; ++i)
#pragma unroll
            for (int j = 0; j < 4; ++j) acc[i][j] = (f32x4){0.f, 0.f, 0.f, 0.f};
        u32x4 ra[4], rb[2];
        const bf16_t* Ap = A + (size_t)(m0 + (tid >> 3)) * lda + (tid & 7) * 8;
        const bf16_t* Bp = Bt + (size_t)(n0 + (tid >> 3)) * ldb + (tid & 7) * 8;
#pragma unroll
        for (int i = 0; i < 4; ++i) ra[i] = *(const u32x4*)(Ap + (size_t)(64 * i) * lda);
#pragma unroll
        for (int i = 0; i < 2; ++i) rb[i] = *(const u32x4*)(Bp + (size_t)(64 * i) * ldb);
        for (int kt = 0; kt < nk; ++kt) {
            __syncthreads();
#pragma unroll
            for (int i = 0; i < 4; ++i) *(u32x4*)(As + ((tid >> 3) + 64 * i) * GA_RS + (tid & 7) * 16) = ra[i];
#pragma unroll
            for (int i = 0; i < 2; ++i) *(u32x4*)(Bs + ((tid >> 3) + 64 * i) * GA_RS + (tid & 7) * 16) = rb[i];
            __syncthreads();
            if (kt + 1 < nk) {
                const int k0 = (kt + 1) * 64;
#pragma unroll
                for (int i = 0; i < 4; ++i) ra[i] = *(const u32x4*)(Ap + (size_t)(64 * i) * lda + k0);
#pragma unroll
                for (int i = 0; i < 2; ++i) rb[i] = *(const u32x4*)(Bp + (size_t)(64 * i) * ldb + k0);
            }
#pragma unroll
            for (int ks = 0; ks < 2; ++ks) {
                bf16x8 af[4], bfr[4];
#pragma unroll
                for (int mt = 0; mt < 4; ++mt) af[mt] = *(const bf16x8*)(As + (64 * wm + 16 * mt + r) * GA_RS + (32 * ks + 8 * g) * 2);
#pragma unroll
                for (int nt = 0; nt < 4; ++nt) bfr[nt] = *(const bf16x8*)(Bs + (64 * wn + 16 * nt + r) * GA_RS + (32 * ks + 8 * g) * 2);
#pragma unroll
                for (int mt = 0; mt < 4; ++mt)
#pragma unroll
                    for (int nt = 0; nt < 4; ++nt) acc[mt][nt] = mfma16(bfr[nt], af[mt], acc[mt][nt]);
            }
        }
        epi(acc, m0 + 64 * wm + r, n0 + 64 * wn + 4 * g, n0);
    }
}

DEV void st_bf4(bf16_t* p, f32x4 v) { u32x2 o; o.x = pk2(v[0], v[1]); o.y = pk2(v[2], v[3]); *(u32x2*)p = o; }
DEV f32x4 rope4(f32x4 v, const float* cs, const float* sn, int fi) {
    const float c0 = cs[fi], s0 = sn[fi], c1 = cs[fi + 1], s1 = sn[fi + 1];
    f32x4 o; o[0] = v[0] * c0 - v[1] * s0; o[1] = v[1] * c0 + v[0] * s0; o[2] = v[2] * c1 - v[3] * s1; o[3] = v[3] * c1 + v[2] * s1; return o;
}

template <int DQK>
DEV void attn_run(const bf16_t* __restrict__ qrow, bool wactive, const bf16_t* __restrict__ Kn, const bf16_t* __restrict__ Kr,
                  const bf16_t* __restrict__ VT, int t_lo, int t_hi, int qpos, int wqmin, int wqmax, char* smem,
                  f32x16 (&o)[4], float& mrun, float& lrun) {
    constexpr int KRS = (DQK + 8) * 2;
    constexpr int VRS = 136;
    constexpr int NKS = DQK / 16;
    constexpr int QREG = 4;
    constexpr bool ROPE = (DQK == 192);
    char* Vb0 = smem + 2 * 64 * KRS; char* Qs = Vb0 + 2 * 128 * VRS;
    const int tid = opaque_tid(), lane = tid & 63, c = lane & 31, hi = lane >> 5;
    bf16x8 qf[QREG];
#pragma unroll
    for (int ks = 0; ks < QREG; ++ks) qf[ks] = *(const bf16x8*)(qrow + 16 * ks + 8 * hi);
    char* Qw = Qs + (tid >> 6) * ((NKS - QREG) * 1024) + lane * 16;
#pragma unroll
    for (int ks = QREG; ks < NKS; ++ks) *(bf16x8*)(Qw + (ks - QREG) * 1024) = *(const bf16x8*)(qrow + 16 * ks + 8 * hi);
#pragma unroll
    for (int i = 0; i < 4; ++i)
#pragma unroll
        for (int rr = 0; rr < 16; ++rr) o[i][rr] = 0.f;
    mrun = -1e30f; lrun = 0.f;
    u32x4 kreg[2], rreg, vreg[2];
    auto gloadK = [&](int t) {
        int t2 = tid; asm volatile("" : "+v"(t2));
        const char* kn_t = (const char*)Kn + (size_t)t * (64 * 256);
#pragma unroll
        for (int i = 0; i < 2; ++i) { const int ch = t2 + NTHREADS * i; kreg[i] = *(const u32x4*)(kn_t + (unsigned)((ch >> 4) * 256 + (ch & 15) * 16)); }
        if (ROPE) { const char* kr_t = (const char*)Kr + (size_t)t * (64 * 128); rreg = *(const u32x4*)(kr_t + (unsigned)((t2 >> 3) * 128 + (t2 & 7) * 16)); }
    };
    auto gloadV = [&](int t) {
        int t2 = tid; asm volatile("" : "+v"(t2));
        const char* vt_t = (const char*)VT + (size_t)t * (128 * 128);
#pragma unroll
        for (int i = 0; i < 2; ++i) { const int ch = t2 + NTHREADS * i; vreg[i] = *(const u32x4*)(vt_t + (unsigned)(ch * 16)); }
    };
    auto lstoreK = [&](int t) {
        int t2 = tid; asm volatile("" : "+v"(t2));
        char* Ks = smem + (t & 1) * (64 * KRS);
#pragma unroll
        for (int i = 0; i < 2; ++i) { const int ch = t2 + NTHREADS * i; *(u32x4*)(Ks + (ch >> 4) * KRS + (ch & 15) * 16) = kreg[i]; }
        if (ROPE) *(u32x4*)(Ks + (t2 >> 3) * KRS + 256 + (t2 & 7) * 16) = rreg;
    };
    auto lstoreV = [&](int t) {
        int t2 = tid; asm volatile("" : "+v"(t2));
        char* Vs = Vb0 + (t & 1) * (128 * VRS);
#pragma unroll
        for (int i = 0; i < 2; ++i) {
            const int ch = t2 + NTHREADS * i;
            u32x2* d = (u32x2*)(Vs + (ch >> 3) * VRS + (ch & 7) * 16);
            d[0] = (u32x2){vreg[i].x, vreg[i].y}; d[1] = (u32x2){vreg[i].z, vreg[i].w};
        }
    };
    auto qk = [&](int t, f32x16 (&sv)[2]) {
        const char* Ks = smem + (t & 1) * (64 * KRS) + c * KRS + 16 * hi;
#pragma unroll
        for (int kt = 0; kt < 2; ++kt)
#pragma unroll
            for (int rr = 0; rr < 16; ++rr) sv[kt][rr] = 0.f;
        bf16x8 k0[3], k1[3], qv[3];
#pragma unroll
        for (int ks = 0; ks < 2; ++ks) {
            k0[ks] = *(const bf16x8*)(Ks + 32 * ks); k1[ks] = *(const bf16x8*)(Ks + 32 * KRS + 32 * ks);
            if (ks < QREG) qv[ks] = qf[ks < QREG ? ks : 0]; else qv[ks] = *(const bf16x8*)(Qw + (ks - QREG) * 1024);
        }
#pragma unroll
        for (int ks = 0; ks < NKS; ++ks) {
            if (ks + 2 < NKS) {
                k0[(ks + 2) % 3] = *(const bf16x8*)(Ks + 32 * (ks + 2)); k1[(ks + 2) % 3] = *(const bf16x8*)(Ks + 32 * KRS + 32 * (ks + 2));
                if (ks + 2 < QREG) qv[(ks + 2) % 3] = qf[ks + 2 < QREG ? ks + 2 : 0]; else qv[(ks + 2) % 3] = *(const bf16x8*)(Qw + (ks + 2 - QREG) * 1024);
            }
            sv[0] = mfma32(k0[ks % 3], qv[ks % 3], sv[0]);
            sv[1] = mfma32(k1[ks % 3], qv[ks % 3], sv[1]);
        }
    };
    auto softmax = [&](int t, f32x16 (&sv)[2], bf16x8 (&pf)[2][2]) {
        const int kb = t * 64;
        if (kb + 63 > wqmin) {
#pragma unroll
            for (int kt = 0; kt < 2; ++kt)
#pragma unroll
                for (int rr = 0; rr < 16; ++rr) { const int key = kb + 32 * kt + (rr & 3) + 8 * (rr >> 2) + 4 * hi; if (key > qpos) sv[kt][rr] = -__builtin_inff(); }
        }
        float tmax = sv[0][0];
#pragma unroll
        for (int rr = 1; rr < 16; ++rr) tmax = fmaxf(tmax, sv[0][rr]);
#pragma unroll
        for (int rr = 0; rr < 16; ++rr) tmax = fmaxf(tmax, sv[1][rr]);
        tmax = fmaxf(tmax, __shfl_xor(tmax, 32));
        const float mnew = fmaxf(mrun, tmax);
        const float alpha = ex2(mrun - mnew);
        mrun = mnew;
        lrun *= alpha;
        if (!__all(alpha == 1.f)) {
#pragma unroll
            for (int i = 0; i < 4; ++i)
#pragma unroll
                for (int rr = 0; rr < 16; ++rr) o[i][rr] *= alpha;
        }
        float ps = 0.f;
#pragma unroll
        for (int kt = 0; kt < 2; ++kt)
#pragma unroll
            for (int rr = 0; rr < 16; ++rr) { const float pv = ex2(sv[kt][rr] - mnew); sv[kt][rr] = pv; ps += pv; }
        lrun += ps;
#pragma unroll
        for (int kt = 0; kt < 2; ++kt)
#pragma unroll
            for (int s2 = 0; s2 < 2; ++s2) {
                u32x4 pw; pw.x = pk2(sv[kt][8 * s2 + 0], sv[kt][8 * s2 + 1]); pw.y = pk2(sv[kt][8 * s2 + 2], sv[kt][8 * s2 + 3]);
                pw.z = pk2(sv[kt][8 * s2 + 4], sv[kt][8 * s2 + 5]); pw.w = pk2(sv[kt][8 * s2 + 6], sv[kt][8 * s2 + 7]);
                pf[kt][s2] = *(const bf16x8*)&pw;
            }
    };
    auto pv = [&](int t, const bf16x8 (&pf)[2][2]) {
        const char* Vs = Vb0 + (t & 1) * (128 * VRS) + c * VRS + 8 * hi;
        u32x2 va[2][4], vb[2][4];
#pragma unroll
        for (int dvt = 0; dvt < 4; ++dvt) { va[0][dvt] = *(const u32x2*)(Vs + 32 * dvt * VRS); vb[0][dvt] = *(const u32x2*)(Vs + 32 * dvt * VRS + 16); }
#pragma unroll
        for (int g = 0; g < 4; ++g) {
            if (g + 1 < 4) {
#pragma unroll
                for (int dvt = 0; dvt < 4; ++dvt) {
                    va[(g + 1) & 1][dvt] = *(const u32x2*)(Vs + 32 * dvt * VRS + 32 * (g + 1));
                    vb[(g + 1) & 1][dvt] = *(const u32x2*)(Vs + 32 * dvt * VRS + 32 * (g + 1) + 16);
                }
            }
#pragma unroll
            for (int dvt = 0; dvt < 4; ++dvt) {
                u32x4 vw; vw.x = va[g & 1][dvt].x; vw.y = va[g & 1][dvt].y; vw.z = vb[g & 1][dvt].x; vw.w = vb[g & 1][dvt].y;
                o[dvt] = mfma32(*(const bf16x8*)&vw, pf[g >> 1][g & 1], o[dvt]);
            }
        }
    };
    auto active = [&](int t) -> bool { return wactive && (t * 64 <= wqmax); };
    auto step = [&](int t, f32x16 (&sc)[2], f32x16 (&sn)[2]) {
        const bool more = t + 1 < t_hi;
        if (t + 2 < t_hi) gloadK(t + 2);
        if (more) gloadV(t + 1);
        const bool a0 = active(t), a1 = more && active(t + 1);
        if (a0) {
            bf16x8 pf[2][2];
            if (a1) { qk(t + 1, sn); softmax(t, sc, pf); }
            else softmax(t, sc, pf);
            pv(t, pf);
        }
        if (t + 2 < t_hi) lstoreK(t + 2);
        if (more) lstoreV(t + 1);
        __syncthreads();
    };
    __syncthreads();
    gloadK(t_lo); gloadV(t_lo); lstoreK(t_lo); lstoreV(t_lo);
    if (t_lo + 1 < t_hi) { gloadK(t_lo + 1); lstoreK(t_lo + 1); }
    __syncthreads();
    f32x16 sA[2], sB[2];
    if (active(t_lo)) qk(t_lo, sA);
    __syncthreads();
    for (int t = t_lo; t < t_hi; t += 2) {
        step(t, sA, sB);
        if (t + 1 < t_hi) step(t + 1, sB, sA);
    }
    lrun += __shfl_xor(lrun, 32);
}

DEV void phase_mla_attn(const Params& p, char* smem) {
    const int tid = opaque_tid(), lane = tid & 63, w = tid >> 6, c = lane & 31, hi = lane >> 5;
    for (int u = opaque_bid(); u < 256; u += gridDim.x) {
        const int head = u & 7, pi = u >> 3;
        for (int half = 0; half < 2; ++half) {
            const int qb = half == 0 ? (63 - pi) : pi;
            const int q = qb * 256 + 32 * w + c;
            f32x16 o[4]; float m, l;
            attn_run<192>(p.Qm() + ((size_t)head * S + q) * 192, true, p.Kn() + (size_t)head * S * 128, p.Kr(), p.VmT() + (size_t)head * 128 * S,
                          0, 4 * qb + 4, q, qb * 256 + 32 * w, qb * 256 + 32 * w + 31, smem, o, m, l);
            const float inv = 1.f / l;
#pragma unroll
            for (int dvt = 0; dvt < 4; ++dvt)
#pragma unroll
                for (int rg = 0; rg < 4; ++rg) {
                    const int dv = 32 * dvt + 8 * rg + 4 * hi;
                    f32x4 v = {o[dvt][4 * rg] * inv, o[dvt][4 * rg + 1] * inv, o[dvt][4 * rg + 2] * inv, o[dvt][4 * rg + 3] * inv};
                    st_bf4(p.cat() + (size_t)q * DM + head * 128 + dv, v);
                }
        }
    }
}

DEV void moba_kmean_unit(const Params& p, int h, int j, char* smem) {
    float* red = (float*)smem;
    const int tid = opaque_tid(), d = tid & 127, qq = tid >> 7;
    const bf16_t* kp = p.Kb() + ((size_t)h * S + 256 * j + qq * 64) * 128 + d;
    float s = 0.f;
    for (int t = 0; t < 64; ++t) s += __uint_as_float(((unsigned)kp[(size_t)t * 128]) << 16);
    __syncthreads();
    red[qq * 128 + d] = s;
    __syncthreads();
    if (tid < 128) p.kmean()[((size_t)h * 64 + j) * 128 + tid] = (red[tid] + red[128 + tid] + red[256 + tid] + red[384 + tid]) * (1.f / 256.f);
}

DEV void phase_moba_gate(const Params& p, char* smem) {
    float* km = (float*)smem;
    int* cnt = (int*)(smem + 32768);
    const int tid = opaque_tid();
    for (int u = opaque_bid(); u < 128; u += gridDim.x) {
        const int h = u & 3, t = u >> 2;
        __syncthreads();
        for (int i = tid; i < 8192; i += NTHREADS) km[i] = p.kmean()[(size_t)h * 8192 + i];
        if (tid < 64) cnt[tid] = 0;
        __syncthreads();
        const int q = t * 512 + tid, own = q >> 8;
        float qv[128];
        const u32x4* qp = (const u32x4*)(p.Qb() + ((size_t)h * S + q) * 128);
#pragma unroll
        for (int i = 0; i < 16; ++i) { const u32x4 v = qp[i]; qv[8 * i] = bflo(v.x); qv[8 * i + 1] = bfhi(v.x); qv[8 * i + 2] = bflo(v.y); qv[8 * i + 3] = bfhi(v.y); qv[8 * i + 4] = bflo(v.z); qv[8 * i + 5] = bfhi(v.z); qv[8 * i + 6] = bflo(v.w); qv[8 * i + 7] = bfhi(v.w); }
        float b0 = -__builtin_inff(), b1 = b0, b2 = b0; int i0 = 0, i1 = 0, i2 = 0;
        const int ownw = __builtin_amdgcn_readfirstlane(own);
        for (int j = 0; j < ownw; ++j) {
            float s = 0.f; const f32x4* kp = (const f32x4*)(km + j * 128);
#pragma unroll
            for (int d4 = 0; d4 < 32; ++d4) { const f32x4 kk = kp[d4]; s += qv[4 * d4] * kk[0] + qv[4 * d4 + 1] * kk[1] + qv[4 * d4 + 2] * kk[2] + qv[4 * d4 + 3] * kk[3]; }
            if (s > b0) { b2 = b1; i2 = i1; b1 = b0; i1 = i0; b0 = s; i0 = j; }
            else if (s > b1) { b2 = b1; i2 = i1; b1 = s; i1 = j; }
            else if (s > b2) { b2 = s; i2 = j; }
        }
        const int nsel = own < 3 ? own : 3;
        if (0 < nsel) { const int pos = atomicAdd(&cnt[i0], 1); p.lists()[(((size_t)h * 64 + i0) * 32 + t) * 512 + pos] = (q << 2) | 0; }
        if (1 < nsel) { const int pos = atomicAdd(&cnt[i1], 1); p.lists()[(((size_t)h * 64 + i1) * 32 + t) * 512 + pos] = (q << 2) | 1; }
        if (2 < nsel) { const int pos = atomicAdd(&cnt[i2], 1); p.lists()[(((size_t)h * 64 + i2) * 32 + t) * 512 + pos] = (q << 2) | 2; }
        __syncthreads();
        if (tid < 64) p.segcnt()[((size_t)h * 64 + tid) * 32 + t] = cnt[tid];
    }
}

DEV void moba_write_partial(const Params& p, int q, int h, int slot, const f32x16 (&o)[4], float m, float l, int hi) {
    float* pp = p.part() + (((size_t)q * 4 + h) * 4 + slot) * 128;
#pragma unroll
    for (int dvt = 0; dvt < 4; ++dvt)
#pragma unroll
        for (int rg = 0; rg < 4; ++rg) {
            const int dv = 32 * dvt + 8 * rg + 4 * hi;
            *(f32x4*)(pp + dv) = (f32x4){o[dvt][4 * rg], o[dvt][4 * rg + 1], o[dvt][4 * rg + 2], o[dvt][4 * rg + 3]};
        }
    if (hi == 0) { float* mp = p.ml() + (((size_t)q * 4 + h) * 4 + slot) * 2; mp[0] = m; mp[1] = l; }
}

DEV void phase_moba_attn(const Params& p, char* smem, int rank, int nwg) {
    const int tid = opaque_tid(), lane = tid & 63, w = tid >> 6, c = lane & 31, hi = lane >> 5;
    int* pre = (int*)(smem + 104448);
    for (int u = rank; u < 256; u += nwg) {
        const int j = u >> 2, h = u & 3;
        const bf16_t* Kh = p.Kb() + (size_t)h * S * 128; const bf16_t* Vh = p.VbT() + (size_t)h * 128 * S;
        __syncthreads();
        if (tid == 0) { int s = 0; for (int t = 0; t < 32; ++t) { pre[t] = s; s += p.segcnt()[((size_t)h * 64 + j) * 32 + t]; } pre[32] = s; }
        __syncthreads();
        const int total = pre[32];
        for (int k0 = -256; k0 < total; k0 += 256) {
            int q, slot, qpos, wqmin, wqmax; bool valid, wact;
            if (k0 < 0) {
                q = 256 * j + 32 * w + c; slot = 3; qpos = q; wqmin = 256 * j + 32 * w; wqmax = wqmin + 31; valid = true; wact = true;
            } else {
                const int e = k0 + 32 * w + c; valid = e < total; q = 0; slot = 0;
                if (valid) {
                    int seg = 0;
                    for (int t = 1; t < 32; ++t) if (pre[t] <= e) seg = t;
                    const int ent = p.lists()[(((size_t)h * 64 + j) * 32 + seg) * 512 + (e - pre[seg])];
                    q = ent >> 2; slot = ent & 3;
                }
                qpos = 0x7fffffff; wqmin = 0x7fffffff; wqmax = 0x7fffffff; wact = (k0 + 32 * w) < total;
            }
            f32x16 o[4]; float m, l;
            attn_run<128>(p.Qb() + ((size_t)h * S + q) * 128, wact, Kh, nullptr, Vh, 4 * j, 4 * j + 4, qpos, wqmin, wqmax, smem, o, m, l);
            if (valid) moba_write_partial(p, q, h, slot, o, m, l, hi);
        }
    }
}

constexpr int GP_KN = 0, GP_KB = 17408, GP_QS = 34816, GP_RF = 52224, GP_LM = 117760, GP_KDT = 135168, GP_GC = 153600, GP_BT = 153856;
DEV void gdn_prep_unit(const Params& p, int li, int n, int h, char* smem) {
    const int tid = opaque_tid(), lane = tid & 63, w = tid >> 6, r = lane & 15, g = lane >> 4;
    char* Kn16 = smem + GP_KN; char* Kb16 = smem + GP_KB; char* Qs16 = smem + GP_QS;
    float* Rf = (float*)(smem + GP_RF); float* Lm = (float*)(smem + GP_LM); char* KdT = smem + GP_KDT;
    float* gc = (float*)(smem + GP_GC); float* bt = (float*)(smem + GP_BT);
    const size_t cb = (size_t)n * 4 + h;
    __syncthreads();
    if (w == 0) {
        const int tok = 64 * n + lane;
        const float a = p.ba()[(size_t)tok * 8 + 4 + h], bb = p.ba()[(size_t)tok * 8 + h];
        float gv = -expf(p.gdn_a_log[li * 4 + h]) * softplusf(a + p.gdn_dt_bias[li * 4 + h]);
#pragma unroll
        for (int o = 1; o < 64; o <<= 1) { const float t = __shfl_up(gv, o); if (lane >= o) gv += t; }
        gc[lane] = gv; bt[lane] = 1.f / (1.f + expf(-bb));
    }
    __syncthreads();
    const float glast = gc[63];
    {
        const int tok = tid >> 3, grp = tid & 7, gt = 64 * n + tok;
        const float gct = gc[tok], btt = bt[tok];
        const float egc = expf(gct), egl = expf(glast - gct);
        const float* cw = p.gdn_conv + (size_t)li * 4 * 1536;
#pragma unroll
        for (int part = 0; part < 3; ++part) {
            const int ch0 = part * 512 + h * 128 + grp * 16;
            float val[16];
#pragma unroll
            for (int i = 0; i < 16; ++i) val[i] = 0.f;
#pragma unroll
            for (int j = 0; j < 4; ++j) {
                const int ts = gt - 3 + j;
                if (ts >= 0) {
                    const u32x4* xp = (const u32x4*)(p.proj_a() + (size_t)ts * 1536 + ch0);
                    const u32x4 x0 = xp[0], x1 = xp[1];
                    const f32x4* wp = (const f32x4*)(cw + (size_t)j * 1536 + ch0);
                    const f32x4 w0 = wp[0], w1 = wp[1], w2 = wp[2], w3 = wp[3];
                    val[0] += bflo(x0.x) * w0[0]; val[1] += bfhi(x0.x) * w0[1]; val[2] += bflo(x0.y) * w0[2]; val[3] += bfhi(x0.y) * w0[3];
                    val[4] += bflo(x0.z) * w1[0]; val[5] += bfhi(x0.z) * w1[1]; val[6] += bflo(x0.w) * w1[2]; val[7] += bfhi(x0.w) * w1[3];
                    val[8] += bflo(x1.x) * w2[0]; val[9] += bfhi(x1.x) * w2[1]; val[10] += bflo(x1.y) * w2[2]; val[11] += bfhi(x1.y) * w2[3];
                    val[12] += bflo(x1.z) * w3[0]; val[13] += bfhi(x1.z) * w3[1]; val[14] += bflo(x1.w) * w3[2]; val[15] += bfhi(x1.w) * w3[3];
                }
            }
#pragma unroll
            for (int i = 0; i < 16; ++i) val[i] = siluf(val[i]);
            if (part < 2) {
                float ss = 0.f;
#pragma unroll
                for (int i = 0; i < 16; ++i) ss += val[i] * val[i];
                ss += __shfl_xor(ss, 1); ss += __shfl_xor(ss, 2); ss += __shfl_xor(ss, 4);
                const float rn = rsqrtf(ss + 1e-6f);
#pragma unroll
                for (int i = 0; i < 16; ++i) val[i] *= rn;
            }
            if (part == 0) {
                const float qs = 0.08838834764831845f;
                u32x4 a0, a1, d0, d1;
                a0.x = pk2(val[0] * qs, val[1] * qs); a0.y = pk2(val[2] * qs, val[3] * qs); a0.z = pk2(val[4] * qs, val[5] * qs); a0.w = pk2(val[6] * qs, val[7] * qs);
                a1.x = pk2(val[8] * qs, val[9] * qs); a1.y = pk2(val[10] * qs, val[11] * qs); a1.z = pk2(val[12] * qs, val[13] * qs); a1.w = pk2(val[14] * qs, val[15] * qs);
                *(u32x4*)(Qs16 + tok * 272 + grp * 32) = a0; *(u32x4*)(Qs16 + tok * 272 + grp * 32 + 16) = a1;
                const float qd = qs * egc;
                d0.x = pk2(val[0] * qd, val[1] * qd); d0.y = pk2(val[2] * qd, val[3] * qd); d0.z = pk2(val[4] * qd, val[5] * qd); d0.w = pk2(val[6] * qd, val[7] * qd);
                d1.x = pk2(val[8] * qd, val[9] * qd); d1.y = pk2(val[10] * qd, val[11] * qd); d1.z = pk2(val[12] * qd, val[13] * qd); d1.w = pk2(val[14] * qd, val[15] * qd);
                bf16_t* qo = p.qdec() + (((cb * 4 + (tok >> 4)) * 4 + (grp >> 1)) * 64 + (2 * (grp & 1)) * 16 + (tok & 15)) * 8;
                *(u32x4*)qo = d0; *(u32x4*)(qo + 16 * 8) = d1;
            } else if (part == 1) {
                u32x4 a0, a1, d0, d1;
                a0.x = pk2(val[0], val[1]); a0.y = pk2(val[2], val[3]); a0.z = pk2(val[4], val[5]); a0.w = pk2(val[6], val[7]);
                a1.x = pk2(val[8], val[9]); a1.y = pk2(val[10], val[11]); a1.z = pk2(val[12], val[13]); a1.w = pk2(val[14], val[15]);
                *(u32x4*)(Kn16 + tok * 272 + grp * 32) = a0; *(u32x4*)(Kn16 + tok * 272 + grp * 32 + 16) = a1;
                d0.x = pk2(val[0] * btt, val[1] * btt); d0.y = pk2(val[2] * btt, val[3] * btt); d0.z = pk2(val[4] * btt, val[5] * btt); d0.w = pk2(val[6] * btt, val[7] * btt);
                d1.x = pk2(val[8] * btt, val[9] * btt); d1.y = pk2(val[10] * btt, val[11] * btt); d1.z = pk2(val[12] * btt, val[13] * btt); d1.w = pk2(val[14] * btt, val[15] * btt);
                *(u32x4*)(Kb16 + tok * 272 + grp * 32) = d0; *(u32x4*)(Kb16 + tok * 272 + grp * 32 + 16) = d1;
                const float kb = btt * egc;
#pragma unroll
                for (int i = 0; i < 16; ++i) {
                    Rf[tok * 256 + 128 + grp * 16 + i] = val[i] * kb;
                    *(bf16_t*)(KdT + (grp * 16 + i) * 144 + tok * 2) = f2bf(val[i] * egl);
                }
            } else {
#pragma unroll
                for (int i = 0; i < 16; ++i) Rf[tok * 256 + grp * 16 + i] = val[i] * btt;
            }
        }
    }
    __syncthreads();
#pragma unroll
    for (int tt = 0; tt < 2; ++tt) {
        const int tile = 2 * w + tt, ct = tile >> 2, mt = tile & 3;
        f32x4 accL = {0.f, 0.f, 0.f, 0.f}, accQ = {0.f, 0.f, 0.f, 0.f};
#pragma unroll
        for (int ks = 0; ks < 4; ++ks) {
            const bf16x8 akb = *(const bf16x8*)(Kb16 + (16 * ct + r) * 272 + (32 * ks + 8 * g) * 2);
            const bf16x8 knm = *(const bf16x8*)(Kn16 + (16 * mt + r) * 272 + (32 * ks + 8 * g) * 2);
            const bf16x8 qsc = *(const bf16x8*)(Qs16 + (16 * ct + r) * 272 + (32 * ks + 8 * g) * 2);
            accL = mfma16(akb, knm, accL);
            accQ = mfma16(knm, qsc, accQ);
        }
#pragma unroll
        for (int jj = 0; jj < 4; ++jj) {
            const int ci = 16 * ct + 4 * g + jj, mi = 16 * mt + r;
            Lm[ci * 68 + mi] = (mi < ci) ? accL[jj] * expf(gc[ci] - gc[mi]) : 0.f;
        }
        {
            const int ci = 16 * ct + r;
            f32x4 v;
#pragma unroll
            for (int jj = 0; jj < 4; ++jj) { const int mi = 16 * mt + 4 * g + jj; v[jj] = (mi <= ci) ? accQ[jj] * expf(gc[ci] - gc[mi]) : 0.f; }
            { const int m0_ = 16 * mt + 4 * g;
              st_bf4(p.qk() + (((cb * 4 + ct) * 2 + (m0_ >> 5)) * 64 + ((m0_ >> 3) & 3) * 16 + r) * 8 + (m0_ & 7), v); }
        }
    }
#pragma unroll
    for (int i = 0; i < 2; ++i) {
        const int ch = tid + NTHREADS * i, row = ch >> 3, cc = ch & 7;
        *(u32x4*)(p.kdT() + (((cb * 8 + (row >> 4)) * 2 + (cc >> 2)) * 64 + (cc & 3) * 16 + (row & 15)) * 8) = *(const u32x4*)(KdT + row * 144 + cc * 16);
    }
    __syncthreads();
    if (w < 4) {
        const int col = tid;
        float x[64];
#pragma unroll
        for (int i = 0; i < 64; ++i) {
            float a = Rf[i * 256 + col];
#pragma unroll
            for (int j4 = 0; j4 < (i + 3) / 4; ++j4) {
                const f32x4 l4 = *(const f32x4*)(Lm + i * 68 + 4 * j4);
#pragma unroll
                for (int jj = 0; jj < 4; ++jj) if (4 * j4 + jj < i) a -= l4[jj] * x[4 * j4 + jj];
            }
            x[i] = a;
        }
        if (col < 128) {
#pragma unroll
            for (int i4 = 0; i4 < 16; ++i4) {
                float* up_ = p.u32() + ((((cb * 4 + (i4 >> 2)) * 8 + (col >> 4)) * 64 + (i4 & 3) * 16 + (col & 15)) * 4);
                *(f32x4*)up_ = (f32x4){x[4 * i4], x[4 * i4 + 1], x[4 * i4 + 2], x[4 * i4 + 3]};
            }
        } else {
#pragma unroll
            for (int i = 0; i < 64; ++i) { const int cc_ = col - 128; p.wneg()[(((cb * 4 + (i >> 4)) * 4 + (cc_ >> 5)) * 64 + ((cc_ >> 3) & 3) * 16 + (i & 15)) * 8 + (cc_ & 7)] = f2bf(-x[i]); }
        }
    }
    if (tid == 0) p.glast()[cb] = expf(glast);
}

struct ScanFr { bf16x8 af[4]; bf16x8 qkf[2]; bf16x8 kdf[2]; f32x4 u[2]; float eg; };
DEV void gdn_scan(const Params& p, int sw, char* smem) {
    const int tid = opaque_tid(), lane = tid & 63, w = tid >> 6, r = lane & 15, g = lane >> 4;
    const int h = sw >> 2, dvb = (sw & 3) * 32;
    const bool lead = w < 4; const int mt = w & 3;
    char* S16 = smem; char* Vn16 = smem + 8704;
    __syncthreads();
    for (int i = tid; i < 8704 / 4; i += NTHREADS) ((int*)S16)[i] = 0;
    f32x4 sacc[2] = {{0.f, 0.f, 0.f, 0.f}, {0.f, 0.f, 0.f, 0.f}};
    auto load = [&](int n, ScanFr& f) {
        const size_t cb = (size_t)n * 4 + h;
        const bf16_t* ap = (lead ? p.wneg() : p.qdec()) + ((cb * 4 + mt) * 4) * 512 + lane * 8;
#pragma unroll
        for (int ks = 0; ks < 4; ++ks) f.af[ks] = *(const bf16x8*)(ap + ks * 512);
        const bf16_t* kp = p.kdT() + ((cb * 8 + w) * 2) * 512 + lane * 8;
#pragma unroll
        for (int ks = 0; ks < 2; ++ks) f.kdf[ks] = *(const bf16x8*)(kp + ks * 512);
        if (lead) {
            const float* up = p.u32() + (((cb * 4 + mt) * 8 + (dvb >> 4)) * 64 + lane) * 4;
            f.u[0] = *(const f32x4*)up; f.u[1] = *(const f32x4*)(up + 256);
        } else {
            const bf16_t* qkp = p.qk() + ((cb * 4 + mt) * 2) * 512 + lane * 8;
#pragma unroll
            for (int ks = 0; ks < 2; ++ks) f.qkf[ks] = *(const bf16x8*)(qkp + ks * 512);
        }
        f.eg = p.glast()[cb];
    };
    ScanFr fA, fB, fC; load(0, fA); load(1, fB); load(2, fC);
    __syncthreads();
    auto step = [&](int n, ScanFr& cu) {
        f32x4 a[2];
        if (lead) { a[0] = cu.u[0]; a[1] = cu.u[1]; } else { a[0] = (f32x4){0.f, 0.f, 0.f, 0.f}; a[1] = a[0]; }
#pragma unroll
        for (int ks = 0; ks < 4; ++ks) {
#pragma unroll
            for (int nt = 0; nt < 2; ++nt) {
                const bf16x8 sf = *(const bf16x8*)(S16 + (16 * nt + r) * 272 + (32 * ks + 8 * g) * 2);
                a[nt] = mfma16(cu.af[ks], sf, a[nt]);
            }
        }
        if (lead) {
#pragma unroll
            for (int nt = 0; nt < 2; ++nt)
                *(u32x2*)(Vn16 + (16 * nt + r) * 144 + (16 * mt + 4 * g) * 2) = (u32x2){pk2(a[nt][0], a[nt][1]), pk2(a[nt][2], a[nt][3])};
        }
        asm volatile("s_waitcnt lgkmcnt(0)" ::: "memory"); __builtin_amdgcn_s_barrier(); asm volatile("" ::: "memory");
        bf16x8 vf[2][2];
#pragma unroll
        for (int nt = 0; nt < 2; ++nt)
#pragma unroll
            for (int ks = 0; ks < 2; ++ks) vf[nt][ks] = *(const bf16x8*)(Vn16 + (16 * nt + r) * 144 + (32 * ks + 8 * g) * 2);
        if (!lead) {
#pragma unroll
            for (int nt = 0; nt < 2; ++nt) {
#pragma unroll
                for (int ks = 0; ks < 2; ++ks) a[nt] = mfma16(cu.qkf[ks], vf[nt][ks], a[nt]);
                float* op = p.oa() + ((size_t)(64 * n + 16 * mt + 4 * g)) * 512 + h * 128 + dvb + 16 * nt + r;
#pragma unroll
                for (int jj = 0; jj < 4; ++jj) op[jj * 512] = a[nt][jj];
            }
        }
#pragma unroll
        for (int n2 = 0; n2 < 2; ++n2) {
            sacc[n2] = sacc[n2] * cu.eg;
#pragma unroll
            for (int ks = 0; ks < 2; ++ks) sacc[n2] = mfma16(cu.kdf[ks], vf[n2][ks], sacc[n2]);
            *(u32x2*)(S16 + (16 * n2 + r) * 272 + (16 * w + 4 * g) * 2) = (u32x2){pk2(sacc[n2][0], sacc[n2][1]), pk2(sacc[n2][2], sacc[n2][3])};
        }
        asm volatile("s_waitcnt lgkmcnt(0)" ::: "memory"); __builtin_amdgcn_s_barrier(); asm volatile("" ::: "memory");
        if (n + 3 < 256) load(n + 3, cu);
    };
    for (int n = 0; n < 255; n += 3) { step(n, fA); step(n + 1, fB); step(n + 2, fC); }
    step(255, fA);
}

DEV void phase_even_combine(const Params& p, int li) {
    const int tid = opaque_tid(), lane = tid & 63, w = __builtin_amdgcn_readfirstlane(tid >> 6), hh = lane >> 4, d0 = (lane & 15) * 8;
    for (int tok = opaque_bid() * 8 + w; tok < S; tok += gridDim.x * 8) {
        {
            const float* op = p.oa() + (size_t)tok * 512 + hh * 128 + d0;
            const f32x4 a = *(const f32x4*)op, b = *(const f32x4*)(op + 4);
            float ss = a[0] * a[0] + a[1] * a[1] + a[2] * a[2] + a[3] * a[3] + b[0] * b[0] + b[1] * b[1] + b[2] * b[2] + b[3] * b[3];
            ss += __shfl_xor(ss, 1); ss += __shfl_xor(ss, 2); ss += __shfl_xor(ss, 4); ss += __shfl_xor(ss, 8);
            const float rn = rsqrtf(ss * (1.f / 128.f) + 1e-6f);
            const u32x4 z = *(const u32x4*)(p.zbuf() + (size_t)tok * 512 + hh * 128 + d0);
            const f32x4 n0 = *(const f32x4*)(p.gdn_o_norm + li * 128 + d0), n1 = *(const f32x4*)(p.gdn_o_norm + li * 128 + d0 + 4);
            u32x4 o;
            o.x = pk2(a[0] * rn * n0[0] * siluf(bflo(z.x)), a[1] * rn * n0[1] * siluf(bfhi(z.x)));
            o.y = pk2(a[2] * rn * n0[2] * siluf(bflo(z.y)), a[3] * rn * n0[3] * siluf(bfhi(z.y)));
            o.z = pk2(b[0] * rn * n1[0] * siluf(bflo(z.z)), b[1] * rn * n1[1] * siluf(bfhi(z.z)));
            o.w = pk2(b[2] * rn * n1[2] * siluf(bflo(z.w)), b[3] * rn * n1[3] * siluf(bfhi(z.w)));
            *(u32x4*)(p.cat() + (size_t)tok * DM + hh * 128 + d0) = o;
        }
        {
            const int own = tok >> 8, nsel = own < 3 ? own : 3;
            const float* mlp = p.ml() + ((size_t)tok * 4 + hh) * 8;
            const float* pp = p.part() + ((size_t)tok * 4 + hh) * 4 * 128 + d0;
            const float m3 = mlp[6], l3 = mlp[7];
            float ms[3], ls[3]; float mm = m3;
#pragma unroll
            for (int s = 0; s < 3; ++s) { ms[s] = -1e30f; ls[s] = 0.f; if (s < nsel) { ms[s] = mlp[2 * s]; ls[s] = mlp[2 * s + 1]; mm = fmaxf(mm, ms[s]); } }
            float wt = ex2(m3 - mm), den = wt * l3;
            f32x4 a = *(const f32x4*)(pp + 3 * 128) * wt, b = *(const f32x4*)(pp + 3 * 128 + 4) * wt;
#pragma unroll
            for (int s = 0; s < 3; ++s) if (s < nsel) {
                wt = ex2(ms[s] - mm); den += wt * ls[s];
                a += *(const f32x4*)(pp + s * 128) * wt; b += *(const f32x4*)(pp + s * 128 + 4) * wt;
            }
            const float inv = 1.f / den;
            u32x4 o; o.x = pk2(a[0] * inv, a[1] * inv); o.y = pk2(a[2] * inv, a[3] * inv); o.z = pk2(b[0] * inv, b[1] * inv); o.w = pk2(b[2] * inv, b[3] * inv);
            *(u32x4*)(p.cat() + (size_t)tok * DM + 512 + hh * 128 + d0) = o;
        }
    }
}

DEV void phase_mla_cnorm(const Params& p, int li) {
    const int tid = opaque_tid(), lane = tid & 63, w = __builtin_amdgcn_readfirstlane(tid >> 6);
    for (int row = opaque_bid() * 8 + w; row < S; row += gridDim.x * 8) {
        const bf16_t* cp = p.cbuf() + (size_t)row * 768;
        const u32x4 qv = *(const u32x4*)(cp + lane * 8);
        const u32x2 kv = *(const u32x2*)(cp + 512 + lane * 4);
        float q[8] = {bflo(qv.x), bfhi(qv.x), bflo(qv.y), bfhi(qv.y), bflo(qv.z), bfhi(qv.z), bflo(qv.w), bfhi(qv.w)};
        float k[4] = {bflo(kv.x), bfhi(kv.x), bflo(kv.y), bfhi(kv.y)};
        float sq = 0.f, sk = 0.f;
#pragma unroll
        for (int i = 0; i < 8; ++i) sq += q[i] * q[i];
#pragma unroll
        for (int i = 0; i < 4; ++i) sk += k[i] * k[i];
        sq = wsum64(sq); sk = wsum64(sk);
        const float rq = rsqrtf(sq * (1.f / 512.f) + 1e-6f), rk = rsqrtf(sk * (1.f / 256.f) + 1e-6f);
        const float* qn = p.mla_q_norm + li * 512 + lane * 8; const float* kn = p.mla_kv_norm + li * 256 + lane * 4;
        u32x4 oq; oq.x = pk2(q[0] * rq * qn[0], q[1] * rq * qn[1]); oq.y = pk2(q[2] * rq * qn[2], q[3] * rq * qn[3]);
        oq.z = pk2(q[4] * rq * qn[4], q[5] * rq * qn[5]); oq.w = pk2(q[6] * rq * qn[6], q[7] * rq * qn[7]);
        *(u32x4*)(p.cqn() + (size_t)row * 512 + lane * 8) = oq;
        u32x2 ok; ok.x = pk2(k[0] * rk * kn[0], k[1] * rk * kn[1]); ok.y = pk2(k[2] * rk * kn[2], k[3] * rk * kn[3]);
        *(u32x2*)(p.ckvn() + (size_t)row * 256 + lane * 4) = ok;
    }
}

#define SORT16_NET(CE) CE(0,1) CE(2,3) CE(0,2) CE(1,3) CE(1,2) CE(4,5) CE(6,7) CE(4,6) CE(5,7) CE(5,6) CE(0,4) CE(2,6) CE(2,4) CE(1,5) CE(3,7) CE(3,5) CE(1,2) CE(3,4) CE(5,6) CE(8,9) CE(10,11) CE(8,10) CE(9,11) CE(9,10) CE(12,13) CE(14,15) CE(12,14) CE(13,15) CE(13,14) CE(8,12) CE(10,14) CE(10,12) CE(9,13) CE(11,15) CE(11,13) CE(9,10) CE(11,12) CE(13,14) CE(0,8) CE(4,12) CE(4,8) CE(2,10) CE(6,14) CE(6,10) CE(2,4) CE(6,8) CE(10,12) CE(1,9) CE(5,13) CE(5,9) CE(3,11) CE(7,15) CE(7,11) CE(3,5) CE(7,9) CE(11,13) CE(1,2) CE(3,4) CE(5,6) CE(7,8) CE(9,10) CE(11,12) CE(13,14)

template <int OFF> DEV void sort16(float (&v)[64]) {
#define CE_(a, b) { const float hi_ = fmaxf(v[OFF + a], v[OFF + b]), lo_ = fminf(v[OFF + a], v[OFF + b]); v[OFF + a] = hi_; v[OFF + b] = lo_; }
    SORT16_NET(CE_)
#undef CE_
}
template <int A> DEV void bitonic16(float (&v)[64]) {
#pragma unroll
    for (int d = 8; d >= 1; d >>= 1)
#pragma unroll
        for (int i = 0; i < 16; ++i) if ((i & d) == 0) { const float hi_ = fmaxf(v[A + i], v[A + i + d]), lo_ = fminf(v[A + i], v[A + i + d]); v[A + i] = hi_; v[A + i + d] = lo_; }
}
template <int A, int B> DEV void merge16(float (&v)[64]) {
#pragma unroll
    for (int i = 0; i < 16; ++i) v[A + i] = fmaxf(v[A + i], v[B + 15 - i]);
    bitonic16<A>(v);
}
DEV void top16_of_64(float (&v)[64]) {
    sort16<0>(v); sort16<16>(v); sort16<32>(v); sort16<48>(v);
    merge16<0, 16>(v); merge16<32, 48>(v); merge16<0, 32>(v);
}

DEV void phase_peer_topk(const Params& p, int layer, char* smem) {
    const int tid = opaque_tid(), lane = tid & 63, w = tid >> 6, c = lane & 31, hi = lane >> 5;
    char* SK = smem;
    constexpr int CI[50] = {0,0,0,0,0,0,0,0,0,0,0,0,0,0,0,0, 1,1,1,1,1,1,1,1, 2,2,2,2,2, 3,3,3,3, 4,4,4, 5,5, 6,6, 7,7, 8,9,10,11,12,13,14,15};
    constexpr int CJ[50] = {0,1,2,3,4,5,6,7,8,9,10,11,12,13,14,15, 0,1,2,3,4,5,6,7, 0,1,2,3,4, 0,1,2,3, 0,1,2, 0,1, 0,1, 0,1, 0,0,0,0,0,0,0,0};
    int loaded_h = -1;
    for (int u = opaque_bid(); u < 512; u += gridDim.x) {
        const int h = u & 7, tg = u >> 3;
        if (h != loaded_h) {
            __syncthreads();
#pragma unroll
            for (int i = 0; i < 8; ++i) {
                const int ch = tid + NTHREADS * i, pp = ch >> 11, rem = ch & 2047, row = rem >> 4, cc = rem & 15;
                *(u32x4*)(SK + pp * 34816 + row * 272 + cc * 16) = *(const u32x4*)(p.skb() + ((((size_t)layer * 8 + h) * 2 + pp) * 128 + row) * 128 + cc * 8);
            }
            __syncthreads();
            loaded_h = h;
        }
        const int token = tg * 256 + 32 * w + c;
        float s0[16], s1[16];
#pragma unroll
        for (int pp = 0; pp < 2; ++pp) {
            bf16x8 qf[8];
            const bf16_t* qp = p.qbuf() + (size_t)token * 2048 + (h * 2 + pp) * 128 + 8 * hi;
#pragma unroll
            for (int ks = 0; ks < 8; ++ks) qf[ks] = *(const bf16x8*)(qp + 16 * ks);
            float v[64];
#pragma unroll
            for (int kt = 0; kt < 4; ++kt) {
                f32x16 acc;
#pragma unroll
                for (int rr = 0; rr < 16; ++rr) acc[rr] = 0.f;
#pragma unroll
                for (int ks = 0; ks < 8; ++ks) acc = mfma32(*(const bf16x8*)(SK + pp * 34816 + (32 * kt + c) * 272 + (16 * ks + 8 * hi) * 2), qf[ks], acc);
#pragma unroll
                for (int rr = 0; rr < 16; ++rr) {
                    const unsigned idx = (unsigned)(32 * kt + (rr & 3) + 8 * (rr >> 2) + 4 * hi);
                    v[16 * kt + rr] = __uint_as_float((__float_as_uint(acc[rr]) & ~127u) | idx);
                }
            }
            top16_of_64(v);
#pragma unroll
            for (int i = 0; i < 16; ++i) v[16 + i] = __shfl_xor(v[15 - i], 32);
#pragma unroll
            for (int i = 0; i < 16; ++i) v[i] = fmaxf(v[i], v[16 + i]);
            bitonic16<0>(v);
#pragma unroll
            for (int i = 0; i < 16; ++i) { if (pp == 0) s0[i] = v[i]; else s1[i] = v[i]; }
        }
        float cv[64];
#pragma unroll
        for (int k = 0; k < 50; ++k) {
            const float a = s0[CI[k]], b = s1[CJ[k]];
            const unsigned id = ((__float_as_uint(a) & 127u) << 7) | (__float_as_uint(b) & 127u);
            cv[k] = __uint_as_float((__float_as_uint(a + b) & ~0x3FFFu) | id);
        }
#pragma unroll
        for (int k = 50; k < 64; ++k) cv[k] = -__builtin_inff();
        top16_of_64(cv);
        float e[16], sum = 0.f;
#pragma unroll
        for (int i = 0; i < 16; ++i) { e[i] = expf(cv[i] - cv[0]); sum += e[i]; }
        const float inv = 1.f / sum;
        if (hi == 0) {
            int* ep = p.expert() + (size_t)token * 128 + h * 16; float* gp = p.gate() + (size_t)token * 128 + h * 16;
#pragma unroll
            for (int i4 = 0; i4 < 4; ++i4) {
                i32x4 ev; ev.x = (int)(__float_as_uint(cv[4 * i4]) & 0x3FFFu); ev.y = (int)(__float_as_uint(cv[4 * i4 + 1]) & 0x3FFFu);
                ev.z = (int)(__float_as_uint(cv[4 * i4 + 2]) & 0x3FFFu); ev.w = (int)(__float_as_uint(cv[4 * i4 + 3]) & 0x3FFFu);
                *(i32x4*)(ep + 4 * i4) = ev;
                *(f32x4*)(gp + 4 * i4) = (f32x4){e[4 * i4] * inv, e[4 * i4 + 1] * inv, e[4 * i4 + 2] * inv, e[4 * i4 + 3] * inv};
            }
        }
    }
}

typedef float f32x2 __attribute__((ext_vector_type(2)));
DEV void unpack_fp8x16(const u32x4& r, float (&f)[16]) {
#pragma unroll
    for (int q = 0; q < 4; ++q) {
        const f32x2 lo = __builtin_amdgcn_cvt_pk_f32_fp8((int)r[q], false), hi = __builtin_amdgcn_cvt_pk_f32_fp8((int)r[q], true);
        f[4 * q] = lo[0]; f[4 * q + 1] = lo[1]; f[4 * q + 2] = hi[0]; f[4 * q + 3] = hi[1];
    }
}

DEV void phase_peer_gather(const Params& p, int layer, const float* __restrict__ g2, const float* __restrict__ xsrc, float* __restrict__ xdst) {
    const int tid = opaque_tid(), lane = tid & 63, w = __builtin_amdgcn_readfirstlane(tid >> 6);
    const unsigned char* ub = p.ub() + (size_t)layer * 16384 * 1024; const unsigned char* vb = p.vb() + (size_t)layer * 16384 * 1024;
    const unsigned lo16 = (unsigned)lane * 16u;
    const int idxl = ((lane >> 5) & 1) * 8 + ((lane >> 4) & 1) * 4 + ((lane >> 3) & 1) * 2 + ((lane >> 2) & 1);
    for (int tok = opaque_bid() * 8 + w; tok < S; tok += gridDim.x * 8) {
        float hv[16];
        {
            const u32x4 h0 = *(const u32x4*)(p.h() + (size_t)tok * DM + lane * 16), h1 = *(const u32x4*)(p.h() + (size_t)tok * DM + lane * 16 + 8);
            hv[0] = bflo(h0.x); hv[1] = bfhi(h0.x); hv[2] = bflo(h0.y); hv[3] = bfhi(h0.y); hv[4] = bflo(h0.z); hv[5] = bfhi(h0.z); hv[6] = bflo(h0.w); hv[7] = bfhi(h0.w);
            hv[8] = bflo(h1.x); hv[9] = bfhi(h1.x); hv[10] = bflo(h1.y); hv[11] = bfhi(h1.y); hv[12] = bflo(h1.z); hv[13] = bfhi(h1.z); hv[14] = bflo(h1.w); hv[15] = bfhi(h1.w);
        }
        const int e0 = p.expert()[(size_t)tok * 128 + lane], e1 = p.expert()[(size_t)tok * 128 + 64 + lane];
        float coef[8];
#pragma unroll
        for (int b = 0; b < 8; ++b) {
            float pt[16];
#pragma unroll
            for (int half = 0; half < 2; ++half) {
                u32x4 rr[8];
#pragma unroll
                for (int k = 0; k < 8; ++k) {
                    const int e = __builtin_amdgcn_readlane(b < 4 ? e0 : e1, (b & 3) * 16 + half * 8 + k);
                    rr[k] = *(const u32x4*)(ub + ((unsigned)e * 1024u + lo16));
                }
#pragma unroll
                for (int k = 0; k < 8; ++k) {
                    float f[16]; unpack_fp8x16(rr[k], f);
                    float a = 0.f;
#pragma unroll
                    for (int i = 0; i < 16; ++i) a += hv[i] * f[i];
                    pt[half * 8 + k] = a;
                }
                __builtin_amdgcn_sched_barrier(0);
            }
#pragma unroll
            for (int k = 0; k < 8; ++k) { const bool up = (lane & 32) != 0; const float send = up ? pt[k] : pt[k + 8], keep = up ? pt[k + 8] : pt[k]; pt[k] = keep + __shfl_xor(send, 32); }
#pragma unroll
            for (int k = 0; k < 4; ++k) { const bool up = (lane & 16) != 0; const float send = up ? pt[k] : pt[k + 4], keep = up ? pt[k + 4] : pt[k]; pt[k] = keep + __shfl_xor(send, 16); }
#pragma unroll
            for (int k = 0; k < 2; ++k) { const bool up = (lane & 8) != 0; const float send = up ? pt[k] : pt[k + 2], keep = up ? pt[k + 2] : pt[k]; pt[k] = keep + __shfl_xor(send, 8); }
            { const bool up = (lane & 4) != 0; const float send = up ? pt[0] : pt[1], keep = up ? pt[1] : pt[0]; pt[0] = keep + __shfl_xor(send, 4); }
            pt[0] += __shfl_xor(pt[0], 2); pt[0] += __shfl_xor(pt[0], 1);
            const float gv = p.gate()[(size_t)tok * 128 + b * 16 + idxl];
            const float d = pt[0] * (1.f / 64.f);
            coef[b] = gv * 0.5f * d * (1.f + erff(d * 0.70710678118654752f)) * 0.25f;
        }
        float acc[16];
#pragma unroll
        for (int i = 0; i < 16; ++i) acc[i] = 0.f;
#pragma unroll
        for (int b = 0; b < 8; ++b) {
#pragma unroll
            for (int half = 0; half < 2; ++half) {
                u32x4 rr[8];
#pragma unroll
                for (int k = 0; k < 8; ++k) {
                    const int e = __builtin_amdgcn_readlane(b < 4 ? e0 : e1, (b & 3) * 16 + half * 8 + k);
                    rr[k] = *(const u32x4*)(vb + ((unsigned)e * 1024u + lo16));
                }
#pragma unroll
                for (int k = 0; k < 8; ++k) {
                    const int kk = half * 8 + k;
                    const int src = ((kk >> 3) & 1) * 32 + ((kk >> 2) & 1) * 16 + ((kk >> 1) & 1) * 8 + (kk & 1) * 4;
                    const float cf = __uint_as_float((unsigned)__builtin_amdgcn_readlane((int)__float_as_uint(coef[b]), src));
                    float f[16]; unpack_fp8x16(rr[k], f);
#pragma unroll
                    for (int i = 0; i < 16; ++i) acc[i] += cf * f[i];
                }
                __builtin_amdgcn_sched_barrier(0);
            }
        }
        const float* xp = xsrc + (size_t)tok * DM + lane * 16; float* xo = xdst + (size_t)tok * DM + lane * 16; const float* gp = g2 + lane * 16;
#pragma unroll
        for (int i4 = 0; i4 < 4; ++i4) {
            const f32x4 xv = *(const f32x4*)(xp + 4 * i4), gg = *(const f32x4*)(gp + 4 * i4);
            f32x4 o; o[0] = xv[0] + gg[0] * acc[4 * i4]; o[1] = xv[1] + gg[1] * acc[4 * i4 + 1]; o[2] = xv[2] + gg[2] * acc[4 * i4 + 2]; o[3] = xv[3] + gg[3] * acc[4 * i4 + 3];
            *(f32x4*)(xo + 4 * i4) = o;
        }
    }
}

extern __shared__ __attribute__((aligned(16))) char smem_raw[];
DEV char* smem_user() { LAS char* q = (LAS char*)smem_raw + LDS_USER; asm volatile("" : "+v"(q)); return (char*)q; }
typedef const __attribute__((address_space(4))) Params* KParams;
DEV void load_params(Params& p) {
    auto kp0 = __builtin_amdgcn_kernarg_segment_ptr();
    asm volatile("" : "+s"(kp0));
    KParams kp = (KParams)kp0;
    p.x = kp->x;
    p.c = kp->c;
    p.pos = kp->pos;
    p.mod_w = kp->mod_w;
    p.mod_b = kp->mod_b;
    p.norm_mix = kp->norm_mix;
    p.norm_ffn = kp->norm_ffn;
    p.hy_w_in = kp->hy_w_in;
    p.gdn_conv = kp->gdn_conv;
    p.gdn_a_log = kp->gdn_a_log;
    p.gdn_dt_bias = kp->gdn_dt_bias;
    p.gdn_o_norm = kp->gdn_o_norm;
    p.hy_w_out = kp->hy_w_out;
    p.mla_w_in = kp->mla_w_in;
    p.mla_q_norm = kp->mla_q_norm;
    p.mla_kv_norm = kp->mla_kv_norm;
    p.mla_w_uq = kp->mla_w_uq;
    p.mla_w_ukv = kp->mla_w_ukv;
    p.mla_w_out = kp->mla_w_out;
    p.peer_w_q = kp->peer_w_q;
    p.peer_sub_keys = kp->peer_sub_keys;
    p.peer_u = kp->peer_u;
    p.peer_v = kp->peer_v;
    p.final_norm = kp->final_norm;
    p.out = kp->out;
    p.ws = kp->ws;
    p.ph_lo = kp->ph_lo;
    p.ph_hi = kp->ph_hi;
    p.use_bar = kp->use_bar;
    p.pad0 = kp->pad0;
}
#ifdef PH_NOINLINE
#define NOINL __device__ __noinline__
#else
#define NOINL __device__ __forceinline__
#endif

NOINL void f_prologue() { Params p; load_params(p);
#ifdef REP_P0
    phase_prologue(p, smem_user());
#endif
    phase_prologue(p, smem_user()); }
NOINL void f_norm_e0(int layer) {
    Params p; load_params(p); const float* mod = p.mod() + layer * 6144; const int li = layer >> 1;
    phase_norm<1>(layer == 0 ? p.x : p.xw(), p.norm_mix + layer * DM, mod, mod + 1024, p.h(), nullptr, p.hy_w_in + (size_t)li * 1024 * HY_IN, p.ba(), smem_user());
}
NOINL void f_norm_plain(int layer, int which) {
    Params p; load_params(p); const float* mod = p.mod() + layer * 6144;
    if (which == 0) phase_norm<0>(p.xw(), p.norm_mix + layer * DM, mod, mod + 1024, p.h(), nullptr, nullptr, nullptr, smem_user());
    else phase_norm<0>(p.xw(), p.norm_ffn + layer * DM, mod + 3072, mod + 4096, p.h(), nullptr, nullptr, nullptr, smem_user());
}
NOINL void f_final() { Params p; load_params(p); phase_norm<2>(
#ifdef DBG_SKIP_ALL
        p.x,
#else
        p.xw(),
#endif
 p.final_norm, nullptr, nullptr, nullptr, p.out, nullptr, nullptr, smem_user()); }
NOINL void f_gemm_hy_in(int li) {
    Params p; load_params(p);
    auto epi = [&](f32x4 (&acc)[4][4], int mb, int nb, int n0) {
#pragma unroll
        for (int mt = 0; mt < 4; ++mt) {
            const int m = mb + 16 * mt;
#pragma unroll
            for (int nt = 0; nt < 4; ++nt) {
                const int n = nb + 16 * nt; const f32x4 v = acc[mt][nt];
                if (n0 < 1536) st_bf4(p.proj_a() + (size_t)m * 1536 + n, v);
                else if (n0 < 2048) st_bf4(p.zbuf() + (size_t)m * 512 + (n - 1536), v);
                else if (n0 < 2560) { const int hd = (n - 2048) >> 7, dp = (n - 2048) & 127; const f32x4 rv = rope4(v, p.cosB() + (size_t)m * 64, p.sinB() + (size_t)m * 64, dp >> 1) * (0.08838834764831845f * 1.4426950408889634f); st_bf4(p.Qb() + ((size_t)hd * S + m) * 128 + dp, rv); }
                else if (n0 < 3072) { const int hd = (n - 2560) >> 7, dp = (n - 2560) & 127; const f32x4 rv = rope4(v, p.cosB() + (size_t)m * 64, p.sinB() + (size_t)m * 64, dp >> 1); st_bf4(p.Kb() + ((size_t)hd * S + m) * 128 + dp, rv); }
                else { const int hd = (n - 3072) >> 7, dv = (n - 3072) & 127; bf16_t* vp = p.VbT() + (((size_t)hd * 256 + (m >> 6)) * 128 + dv) * 64 + (m & 63); vp[0] = f2bf(v[0]); vp[64] = f2bf(v[1]); vp[128] = f2bf(v[2]); vp[192] = f2bf(v[3]); }
            }
        }
    };
#ifdef REP_GEMM
    gemm_phase(p.h(), DM, p.w_hy_in() + (size_t)li * HYN * 1024, 1024, 1024, HYN / 128, smem_user(), epi);
#endif
    gemm_phase(p.h(), DM, p.w_hy_in() + (size_t)li * HYN * 1024, 1024, 1024, HYN / 128, smem_user(), epi);
}
NOINL void f_gemm_resid(int layer) {
    Params p; load_params(p); const float* mod = p.mod() + layer * 6144; const int li = layer >> 1;
    const float* xin = layer == 0 ? p.x : p.xw(); float* xo = p.xw();
    auto epi = [&](f32x4 (&acc)[4][4], int mb, int nb, int n0) {
#pragma unroll
        for (int mt = 0; mt < 4; ++mt)
#pragma unroll
            for (int nt = 0; nt < 4; ++nt) {
                const int m = mb + 16 * mt, n = nb + 16 * nt;
                const f32x4 xv = *(const f32x4*)(xin + (size_t)m * DM + n), gg = *(const f32x4*)(mod + 2048 + n);
                *(f32x4*)(xo + (size_t)m * DM + n) = xv + gg * acc[mt][nt];
            }
    };
    const bf16_t* wt = (layer & 1) ? p.w_mla_out() + (size_t)li * 1024 * 1024 : p.w_hy_out() + (size_t)li * 1024 * 1024;
    gemm_phase(p.cat(), DM, wt, 1024, 1024, 8, smem_user(), epi);
}
NOINL void f_e2(int li) {
    Params p; load_params(p);
#ifdef REP_E2
    for (int u = opaque_bid(); u < 1280; u += gridDim.x) { if (u < 1024) gdn_prep_unit(p, li, u >> 2, u & 3, smem_user()); else moba_kmean_unit(p, (u - 1024) & 3, (u - 1024) >> 2, smem_user()); }
#endif
    for (int u = opaque_bid(); u < 1280; u += gridDim.x) { if (u < 1024) gdn_prep_unit(p, li, u >> 2, u & 3, smem_user()); else moba_kmean_unit(p, (u - 1024) & 3, (u - 1024) >> 2, smem_user()); }
}
NOINL void f_gate() { Params p; load_params(p); phase_moba_gate(p, smem_user()); }
NOINL void f_scan() {
    Params p; load_params(p);
#ifdef REP_SCAN
    gdn_scan(p, opaque_bid(), smem_user());
#endif
    gdn_scan(p, opaque_bid(), smem_user());
}
NOINL void f_moba_attn() {
    Params p; load_params(p);
#ifdef REP_MOBA
    phase_moba_attn(p, smem_user(), opaque_bid() - 16, gridDim.x - 16);
#endif
    phase_moba_attn(p, smem_user(), opaque_bid() - 16, gridDim.x - 16);
}
NOINL void f_combine(int li) { Params p; load_params(p); phase_even_combine(p, li); }
NOINL void f_gemm_mla_in(int li) {
    Params p; load_params(p);
    auto epi = [&](f32x4 (&acc)[4][4], int mb, int nb, int n0) {
#pragma unroll
        for (int mt = 0; mt < 4; ++mt)
#pragma unroll
            for (int nt = 0; nt < 4; ++nt) {
                const int m = mb + 16 * mt, n = nb + 16 * nt; const f32x4 v = acc[mt][nt];
                if (n0 < 768) st_bf4(p.cbuf() + (size_t)m * 768 + n, v);
                else if (n < 832) { const int dp = n - 768; const f32x4 rv = rope4(v, p.cosC() + (size_t)m * 32, p.sinC() + (size_t)m * 32, dp >> 1); st_bf4(p.Kr() + (size_t)m * 64 + dp, rv); }
            }
    };
#ifdef REP_GEMM
    gemm_phase(p.h(), DM, p.w_mla_in() + (size_t)li * 896 * 1024, 1024, 1024, 7, smem_user(), epi);
#endif
    gemm_phase(p.h(), DM, p.w_mla_in() + (size_t)li * 896 * 1024, 1024, 1024, 7, smem_user(), epi);
}
NOINL void f_cnorm(int li) { Params p; load_params(p); phase_mla_cnorm(p, li); }
NOINL void f_gemm_uq(int li) {
    Params p; load_params(p);
    auto epi = [&](f32x4 (&acc)[4][4], int mb, int nb, int n0) {
        const float qs = 0.07216878364870322f * 1.4426950408889634f;
#pragma unroll
        for (int mt = 0; mt < 4; ++mt)
#pragma unroll
            for (int nt = 0; nt < 4; ++nt) {
                const int m = mb + 16 * mt, n = nb + 16 * nt; const int hd = n / 192, d = n - hd * 192; f32x4 v = acc[mt][nt];
                if (d >= 128) v = rope4(v, p.cosC() + (size_t)m * 32, p.sinC() + (size_t)m * 32, (d - 128) >> 1);
                st_bf4(p.Qm() + ((size_t)hd * S + m) * 192 + d, v * qs);
            }
    };
#ifdef REP_GEMM
    gemm_phase(p.cqn(), 512, p.w_uq() + (size_t)li * 1536 * 512, 512, 512, 12, smem_user(), epi);
#endif
    gemm_phase(p.cqn(), 512, p.w_uq() + (size_t)li * 1536 * 512, 512, 512, 12, smem_user(), epi);
}
NOINL void f_gemm_ukv(int li) {
    Params p; load_params(p);
    auto epi = [&](f32x4 (&acc)[4][4], int mb, int nb, int n0) {
#pragma unroll
        for (int mt = 0; mt < 4; ++mt)
#pragma unroll
            for (int nt = 0; nt < 4; ++nt) {
                const int m = mb + 16 * mt, n = nb + 16 * nt; const f32x4 v = acc[mt][nt];
                if (n0 < 1024) { const int hd = n >> 7, d = n & 127; st_bf4(p.Kn() + ((size_t)hd * S + m) * 128 + d, v); }
                else { const int hd = (n - 1024) >> 7, dv = (n - 1024) & 127; bf16_t* vp = p.VmT() + (((size_t)hd * 256 + (m >> 6)) * 128 + dv) * 64 + (m & 63); vp[0] = f2bf(v[0]); vp[64] = f2bf(v[1]); vp[128] = f2bf(v[2]); vp[192] = f2bf(v[3]); }
            }
    };
#ifdef REP_GEMM
    gemm_phase(p.ckvn(), 256, p.w_ukv() + (size_t)li * 2048 * 256, 256, 256, 16, smem_user(), epi);
#endif
    gemm_phase(p.ckvn(), 256, p.w_ukv() + (size_t)li * 2048 * 256, 256, 256, 16, smem_user(), epi);
}
NOINL void f_mla_attn() {
    Params p; load_params(p);
#ifdef REP_M4
    phase_mla_attn(p, smem_user());
#endif
    phase_mla_attn(p, smem_user());
}
NOINL void f_gemm_pq(int layer) {
    Params p; load_params(p);
    auto epi = [&](f32x4 (&acc)[4][4], int mb, int nb, int n0) {
#pragma unroll
        for (int mt = 0; mt < 4; ++mt)
#pragma unroll
            for (int nt = 0; nt < 4; ++nt) st_bf4(p.qbuf() + (size_t)(mb + 16 * mt) * 2048 + nb + 16 * nt, acc[mt][nt]);
    };
#ifdef REP_GEMM
    gemm_phase(p.h(), DM, p.w_pq() + (size_t)layer * 2048 * 1024, 1024, 1024, 16, smem_user(), epi);
#endif
    gemm_phase(p.h(), DM, p.w_pq() + (size_t)layer * 2048 * 1024, 1024, 1024, 16, smem_user(), epi);
}
NOINL void f_topk(int layer) { Params p; load_params(p);
#ifdef REP_F2
    phase_peer_topk(p, layer, smem_user());
#endif
    phase_peer_topk(p, layer, smem_user()); }
NOINL void f_gather(int layer) {
    Params p; load_params(p);
#ifdef REP_F3
    phase_peer_gather(p, layer, p.mod() + layer * 6144 + 5120, p.xw(), p.part());
#endif
    phase_peer_gather(p, layer, p.mod() + layer * 6144 + 5120, p.xw(), p.xw());
}

__device__ __noinline__ void grid_sync(unsigned* barw, unsigned x) {
    XcdBarrier b; b.bar = barw; b.x = x; b.st = (volatile LAS unsigned*)smem_raw;
    xcd_barrier(b);
}

__global__ void __launch_bounds__(NTHREADS) hybrid_forward(Params p) {
    if (threadIdx.x == 0) *(u32x4*)smem_raw = (u32x4){0u, 0u, 0u, 0u};
    __syncthreads();
    XcdBarrier bar; bar.bar = p.bar(); bar.x = 0; bar.st = (volatile LAS unsigned*)smem_raw;
    if (p.use_bar) bar = xcd_barrier_post(p.bar(), (volatile LAS unsigned*)smem_raw);
    int ph = 0;
#define RUN_PHASE(...) { if (ph >= p.ph_lo && ph < p.ph_hi) { __VA_ARGS__; if (p.use_bar && ph + 1 < p.ph_hi) grid_sync(bar.bar, bar.x); } ++ph; }

    RUN_PHASE(f_prologue());
    for (int layer = 0; layer < 4; ++layer) {
        const int li = layer >> 1;
        if ((layer & 1) == 0) {
            RUN_PHASE(f_norm_e0(layer));
            RUN_PHASE(f_gemm_hy_in(li));
            RUN_PHASE(f_e2(li));
            RUN_PHASE(f_gate());
            RUN_PHASE(if (blockIdx.x < 16) f_scan(); else f_moba_attn());
            RUN_PHASE(f_combine(li));
            RUN_PHASE(f_gemm_resid(layer));
        } else {
            RUN_PHASE(f_norm_plain(layer, 0));
            RUN_PHASE(f_gemm_mla_in(li));
            RUN_PHASE(f_cnorm(li));
            RUN_PHASE(f_gemm_uq(li); f_gemm_ukv(li));
            RUN_PHASE(f_mla_attn());
            RUN_PHASE(f_gemm_resid(layer));
        }
        RUN_PHASE(f_norm_plain(layer, 1));
        RUN_PHASE(f_gemm_pq(layer));
        RUN_PHASE(f_topk(layer));
        RUN_PHASE(f_gather(layer));
    }
    RUN_PHASE(f_final());
}

constexpr int N_PHASES = 1 + 2 * 11 + 2 * 10 + 1;

extern "C" void kernel_launch(void* const* d_in, const int* in_sizes, int n_in, void* d_out, int out_size, void* d_ws, size_t ws_size, hipStream_t stream) {
    static int grid = 0;
    if (!grid) {
        int dev = 0, cus = 0, per_cu = 0;
        hipGetDevice(&dev);
        hipDeviceGetAttribute(&cus, hipDeviceAttributeMultiprocessorCount, dev);
        hipFuncSetAttribute((const void*)hybrid_forward, hipFuncAttributeMaxDynamicSharedMemorySize, LDS_BYTES);
        hipOccupancyMaxActiveBlocksPerMultiprocessor(&per_cu, hybrid_forward, NTHREADS, LDS_BYTES);
        if (per_cu < 1) per_cu = 1;
        grid = cus;
        if (grid > 256) grid = 256;
    }
    Params p; memset(&p, 0, sizeof(p));
    p.x = (const float*)d_in[0]; p.c = (const float*)d_in[1]; p.pos = (const int*)d_in[2]; p.mod_w = (const float*)d_in[3]; p.mod_b = (const float*)d_in[4];
    p.norm_mix = (const float*)d_in[5]; p.norm_ffn = (const float*)d_in[6]; p.hy_w_in = (const float*)d_in[7]; p.gdn_conv = (const float*)d_in[8];
    p.gdn_a_log = (const float*)d_in[9]; p.gdn_dt_bias = (const float*)d_in[10]; p.gdn_o_norm = (const float*)d_in[11]; p.hy_w_out = (const float*)d_in[12];
    p.mla_w_in = (const float*)d_in[13]; p.mla_q_norm = (const float*)d_in[14]; p.mla_kv_norm = (const float*)d_in[15]; p.mla_w_uq = (const float*)d_in[16];
    p.mla_w_ukv = (const float*)d_in[17]; p.mla_w_out = (const float*)d_in[18]; p.peer_w_q = (const float*)d_in[19]; p.peer_sub_keys = (const float*)d_in[20];
    p.peer_u = (const float*)d_in[21]; p.peer_v = (const float*)d_in[22]; p.final_norm = (const float*)d_in[23];
    p.out = (float*)d_out;
    p.ws = (char*)d_ws;
    if (WS_NEED > ws_size) { fprintf(stderr, "workspace too small: need %zu have %zu\n", (size_t)WS_NEED, ws_size); return; }
    hipMemsetAsync(p.ws, 0, 16384, stream);
#ifndef ONE_LAUNCH
    for (int ph = 0; ph < N_PHASES; ++ph) {
#ifdef DBG_SKIP_ALL
        if (ph != N_PHASES - 1) continue;
#endif
        p.ph_lo = ph; p.ph_hi = ph + 1; p.use_bar = 0;
        hipLaunchKernelGGL(hybrid_forward, dim3(grid), dim3(NTHREADS), LDS_BYTES, stream, p);
    }
#else
    p.ph_lo = 0; p.ph_hi = N_PHASES; p.use_bar = 1;
    hipLaunchKernelGGL(hybrid_forward, dim3(grid), dim3(NTHREADS), LDS_BYTES, stream, p);
#endif
}
```

```cpp
#include <hip/hip_runtime.h>
#define ONE_LAUNCH 1
#include <stdint.h>
#include <stddef.h>
#include <stdio.h>
#include <string.h>

#define DEV __device__ __forceinline__

constexpr int S = 16384;
constexpr int DM = 1024;
constexpr int HY_IN = 3592;
constexpr int HYN = 3584;
constexpr int NTHREADS = 512;
constexpr int LDS_BYTES = 163840;
constexpr int LDS_USER = 16;

typedef unsigned short bf16_t;
typedef short bf16x8 __attribute__((ext_vector_type(8)));
typedef float f32x4 __attribute__((ext_vector_type(4)));
typedef float f32x16 __attribute__((ext_vector_type(16)));
typedef __bf16 bf16v2 __attribute__((ext_vector_type(2)));
typedef unsigned u32x4 __attribute__((ext_vector_type(4)));
typedef unsigned u32x2 __attribute__((ext_vector_type(2)));
typedef int i32x4 __attribute__((ext_vector_type(4)));

#define XB_TMO      128
#define XB_XCNT(j)  (256  + 64 * (j))
#define XB_XSUB(j)  (1280 + 64 * (j))
#define XB_XGEN(j)  (2304 + 64 * (j))
#define XB_TOP      3328
#define XB_TOPGEN   3392
#define XCD_BAR_WORDS 3456
#define XB_SPIN_CAP (1u << 22)
#define LAS __attribute__((address_space(3)))

__device__ __forceinline__ unsigned xb_ld(unsigned* p)              { return __hip_atomic_load(p, __ATOMIC_RELAXED, __HIP_MEMORY_SCOPE_AGENT); }
__device__ __forceinline__ unsigned xb_add(unsigned* p, unsigned v) { return __hip_atomic_fetch_add(p, v, __ATOMIC_RELAXED, __HIP_MEMORY_SCOPE_AGENT); }
__device__ __forceinline__ unsigned xb_xcc_id() { return (unsigned)__builtin_amdgcn_s_getreg((3 << 11) | 20) & 0xFu; }
#define XB_SPIN(cond, bar) do { unsigned _sp = 0; while (cond) { __builtin_amdgcn_s_sleep(1); \
    if ((++_sp & 255u) == 0u) { if (xb_ld(&(bar)[XB_TMO])) break; if (_sp > XB_SPIN_CAP) { atomicAdd(&(bar)[XB_TMO], 1u); break; } } } } while (0)

struct XcdBarrier { unsigned* bar; unsigned x; volatile LAS unsigned* st; };

__device__ __forceinline__ XcdBarrier xcd_barrier_post(unsigned* bar, volatile LAS unsigned* st) {
    XcdBarrier b; b.bar = bar; b.x = xb_xcc_id(); b.st = st;
    if (threadIdx.x == 0) (void)xb_add(&bar[XB_XCNT(b.x)], 1u);
    return b;
}
__device__ __forceinline__ void xcd_barrier_complete(unsigned* bar, unsigned x, unsigned& nloc, unsigned& nx) {
    const unsigned G = gridDim.x * gridDim.y * gridDim.z;
    unsigned sum, cnt, mine, sp = 0u;
    for (;;) {
        sum = 0u; cnt = 0u; mine = 0u;
#pragma unroll 1
        for (unsigned j = 0; j < 16; ++j) { const unsigned c = xb_ld(&bar[XB_XCNT(j)]); sum += c; cnt += (c > 0u) ? 1u : 0u; mine = (j == x) ? c : mine; }
        if (sum == G) break;
        __builtin_amdgcn_s_sleep(1);
        if ((++sp & 255u) == 0u) { if (xb_ld(&bar[XB_TMO])) break; if (sp > XB_SPIN_CAP) { atomicAdd(&bar[XB_TMO], 1u); break; } }
    }
    nloc = mine > 0u ? mine : 1u; nx = cnt > 0u ? cnt : 1u;
}
__device__ __forceinline__ void xcd_barrier(const XcdBarrier& b) {
    asm volatile("s_waitcnt vmcnt(0)" ::: "memory");
    __syncthreads();
    if (threadIdx.x == 0) {
        unsigned* bar = b.bar;
        __builtin_amdgcn_s_waitcnt(0);
        unsigned nloc = b.st[0], nx = b.st[1];
        if (nloc == 0u) { xcd_barrier_complete(bar, b.x, nloc, nx); b.st[0] = nloc; b.st[1] = nx; }
        const unsigned old = xb_add(&bar[XB_XSUB(b.x)], 1u);
        const unsigned gen = old / nloc;
        if (old + 1u == (gen + 1u) * nloc) {
            __builtin_amdgcn_fence(__ATOMIC_RELEASE, "agent");
            asm volatile("s_waitcnt vmcnt(0)" ::: "memory");
            const unsigned og = xb_add(&bar[XB_TOP], 1u);
            const unsigned tg = og / nx;
            if (og + 1u == (tg + 1u) * nx) xb_add(&bar[XB_TOPGEN], 1u);
            else XB_SPIN(xb_ld(&bar[XB_TOPGEN]) == tg, bar);
            __builtin_amdgcn_fence(__ATOMIC_ACQUIRE, "agent");
            xb_add(&bar[XB_XGEN(b.x)], 1u);
            asm volatile("s_waitcnt vmcnt(0)" ::: "memory");
        } else {
            XB_SPIN(xb_ld(&bar[XB_XGEN(b.x)]) == gen, bar);
            __builtin_amdgcn_fence(__ATOMIC_ACQUIRE, "agent");
            asm volatile("s_waitcnt vmcnt(0)" ::: "memory");
        }
    }
    __syncthreads();
}

DEV int opaque_bid() { int b = blockIdx.x; asm volatile("" : "+s"(b)); return b; }
DEV int opaque_tid() { int t = threadIdx.x; asm volatile("" : "+v"(t)); return t & (NTHREADS - 1); }
DEV bf16_t f2bf(float f) { __bf16 v = (__bf16)f; bf16_t r; __builtin_memcpy(&r, &v, 2); return r; }
DEV unsigned pk2(float a, float b) { bf16v2 v; v[0] = (__bf16)a; v[1] = (__bf16)b; unsigned r; __builtin_memcpy(&r, &v, 4); return r; }
DEV float bflo(unsigned u) { return __uint_as_float(u << 16); }
DEV float bfhi(unsigned u) { return __uint_as_float(u & 0xffff0000u); }
DEV float shx(float v, int m, int lane) { return __int_as_float(__builtin_amdgcn_ds_bpermute((lane ^ m) << 2, __float_as_int(v))); }
DEV float wsum64(float v, int lane) {
#pragma unroll
    for (int o = 32; o; o >>= 1) v += shx(v, o, lane);
    return v;
}
DEV f32x4 mfma16(bf16x8 a, bf16x8 b, f32x4 c) { return __builtin_amdgcn_mfma_f32_16x16x32_bf16(a, b, c, 0, 0, 0); }
DEV f32x16 mfma32(bf16x8 a, bf16x8 b, f32x16 c) { return __builtin_amdgcn_mfma_f32_32x32x16_bf16(a, b, c, 0, 0, 0); }
DEV float siluf(float v) { return v / (1.f + expf(-v)); }
DEV float softplusf(float v) { return fmaxf(v, 0.f) + log1pf(expf(-fabsf(v))); }
DEV float ex2(float v) { return __builtin_amdgcn_exp2f(v); }

struct Params {
    const float* x; const float* c; const int* pos; const float* mod_w; const float* mod_b; const float* norm_mix; const float* norm_ffn;
    const float* hy_w_in; const float* gdn_conv; const float* gdn_a_log; const float* gdn_dt_bias; const float* gdn_o_norm; const float* hy_w_out;
    const float* mla_w_in; const float* mla_q_norm; const float* mla_kv_norm; const float* mla_w_uq; const float* mla_w_ukv; const float* mla_w_out;
    const float* peer_w_q; const float* peer_sub_keys; const float* peer_u; const float* peer_v; const float* final_norm;
    float* out; char* ws;
    int ph_lo, ph_hi, use_bar, pad0;
    DEV unsigned* bar() const { return (unsigned*)(ws + 0ull); }
    DEV float* mod() const { return (float*)(ws + 16384ull); }
    DEV float* cosB() const { return (float*)(ws + 114688ull); }
    DEV float* sinB() const { return (float*)(ws + 4308992ull); }
    DEV float* cosC() const { return (float*)(ws + 8503296ull); }
    DEV float* sinC() const { return (float*)(ws + 10600448ull); }
    DEV bf16_t* w_hy_in() const { return (bf16_t*)(ws + 12697600ull); }
    DEV bf16_t* w_hy_out() const { return (bf16_t*)(ws + 27377664ull); }
    DEV bf16_t* w_mla_in() const { return (bf16_t*)(ws + 863260672ull); }
    DEV bf16_t* w_uq() const { return (bf16_t*)(ws + 35241984ull); }
    DEV bf16_t* w_ukv() const { return (bf16_t*)(ws + 38387712ull); }
    DEV bf16_t* w_mla_out() const { return (bf16_t*)(ws + 40484864ull); }
    DEV bf16_t* w_pq() const { return (bf16_t*)(ws + 44679168ull); }
    DEV bf16_t* skb() const { return (bf16_t*)(ws + 61456384ull); }
    DEV unsigned char* ub() const { return (unsigned char*)(ws + 63553536ull); }
    DEV unsigned char* vb() const { return (unsigned char*)(ws + 197771264ull); }
    DEV float* xw() const { return (float*)(ws + 331988992ull); }
    DEV bf16_t* h() const { return (bf16_t*)(ws + 399097856ull); }
    DEV bf16_t* cat() const { return (bf16_t*)(ws + 432652288ull); }
    DEV bf16_t* proj_a() const { return (bf16_t*)(ws + 466206720ull); }
    DEV bf16_t* zbuf() const { return (bf16_t*)(ws + 516538368ull); }
    DEV bf16_t* Qb() const { return (bf16_t*)(ws + 533315584ull); }
    DEV bf16_t* Kb() const { return (bf16_t*)(ws + 550092800ull); }
    DEV bf16_t* VbT() const { return (bf16_t*)(ws + 566870016ull); }
    DEV float* ba() const { return (float*)(ws + 583647232ull); }
    DEV float* u32() const { return (float*)(ws + 584171520ull); }
    DEV bf16_t* wneg() const { return (bf16_t*)(ws + 617725952ull); }
    DEV bf16_t* qdec() const { return (bf16_t*)(ws + 634503168ull); }
    DEV bf16_t* kdT() const { return (bf16_t*)(ws + 651280384ull); }
    DEV bf16_t* qk() const { return (bf16_t*)(ws + 668057600ull); }
    DEV float* glast() const { return (float*)(ws + 676446208ull); }
    DEV float* oa() const { return (float*)(ws + 676450304ull); }
    DEV float* kmean() const { return (float*)(ws + 710004736ull); }
    DEV int* segcnt() const { return (int*)(ws + 710135808ull); }
    DEV int* lists() const { return (int*)(ws + 710168576ull); }
    DEV float* part() const { return (float*)(ws + 726945792ull); }
    DEV float* ml() const { return (float*)(ws + 861163520ull); }
    DEV bf16_t* cbuf() const { return (bf16_t*)(ws + 466206720ull); }
    DEV bf16_t* Kr() const { return (bf16_t*)(ws + 491372544ull); }
    DEV bf16_t* cqn() const { return (bf16_t*)(ws + 493469696ull); }
    DEV bf16_t* ckvn() const { return (bf16_t*)(ws + 510246912ull); }
    DEV bf16_t* Qm() const { return (bf16_t*)(ws + 518635520ull); }
    DEV bf16_t* Kn() const { return (bf16_t*)(ws + 568967168ull); }
    DEV bf16_t* VmT() const { return (bf16_t*)(ws + 602521600ull); }
    DEV bf16_t* qbuf() const { return (bf16_t*)(ws + 466206720ull); }
    DEV int* expert() const { return (int*)(ws + 533315584ull); }
    DEV float* gate() const { return (float*)(ws + 541704192ull); }
};
constexpr size_t SCANST_OFF = 867454976ull;
constexpr size_t WS_NEED = 867717120ull;


template <class Map>
DEV void transpose_conv(const float* __restrict__ src, int K, int ldsrc, bf16_t* __restrict__ dst, int Nd, Map map, char* smem, int& base) {
    float* T = (float*)smem;
    const int tid = opaque_tid(), nb = gridDim.x, b = opaque_bid();
    const int ntk = K / 64, ntn = Nd / 64, nun = ntk * ntn;
    int first = ((b - (base % nb)) % nb + nb) % nb;
    for (int u = first; u < nun; u += nb) {
        const int tk = u % ntk, tn = u / ntk;
        __syncthreads();
#pragma unroll
        for (int i = 0; i < 8; ++i) {
            const int kk = (tid >> 6) + 8 * i, nn = tid & 63;
            const int sc = map(tn * 64 + nn);
            float v = 0.f;
            if (sc >= 0) v = src[(size_t)(tk * 64 + kk) * ldsrc + sc];
            T[kk * 65 + nn] = v;
        }
        __syncthreads();
#pragma unroll
        for (int i = 0; i < 8; ++i) {
            const int nn = (tid >> 6) + 8 * i, kk = tid & 63;
            dst[(size_t)(tn * 64 + nn) * K + tk * 64 + kk] = f2bf(T[kk * 65 + nn]);
        }
    }
    base += nun;
}

DEV void convert_bf16(const float* __restrict__ src, bf16_t* __restrict__ dst, size_t n) {
    const size_t n8 = n / 8;
    for (size_t i = (size_t)opaque_bid() * NTHREADS + opaque_tid(); i < n8; i += (size_t)gridDim.x * NTHREADS) {
        const f32x4 a = *(const f32x4*)(src + i * 8), b = *(const f32x4*)(src + i * 8 + 4);
        u32x4 o; o.x = pk2(a[0], a[1]); o.y = pk2(a[2], a[3]); o.z = pk2(b[0], b[1]); o.w = pk2(b[2], b[3]);
        *(u32x4*)(dst + i * 8) = o;
    }
}

DEV void convert_fp4(const float* __restrict__ src, unsigned char* __restrict__ dst, size_t n, float scale, int rank, int nwg) {
    const size_t n32 = n / 32;
    for (size_t i = (size_t)rank * NTHREADS + opaque_tid(); i < n32; i += (size_t)nwg * NTHREADS) {
        u32x4 o;
#pragma unroll
        for (int q = 0; q < 4; ++q) {
            const f32x4 a = *(const f32x4*)(src + i * 32 + q * 8) * scale, b = *(const f32x4*)(src + i * 32 + q * 8 + 4) * scale;
            unsigned w = 0;
            w = __builtin_amdgcn_cvt_scalef32_pk_fp4_f32(w, a[0], a[1], 1.0f, 0);
            w = __builtin_amdgcn_cvt_scalef32_pk_fp4_f32(w, a[2], a[3], 1.0f, 1);
            w = __builtin_amdgcn_cvt_scalef32_pk_fp4_f32(w, b[0], b[1], 1.0f, 2);
            w = __builtin_amdgcn_cvt_scalef32_pk_fp4_f32(w, b[2], b[3], 1.0f, 3);
            o[q] = w;
        }
        *(u32x4*)(dst + i * 16) = o;
    }
}

DEV void convert_i4(const float* __restrict__ src, unsigned char* __restrict__ dst, size_t n, float scale, int rank, int nwg) {
    const size_t n32 = n / 32;
    for (size_t i = (size_t)rank * NTHREADS + opaque_tid(); i < n32; i += (size_t)nwg * NTHREADS) {
        u32x4 o;
#pragma unroll
        for (int q = 0; q < 4; ++q) {
            const f32x4 a = *(const f32x4*)(src + i * 32 + q * 8) * scale, b = *(const f32x4*)(src + i * 32 + q * 8 + 4) * scale;
            unsigned w = 0;
#pragma unroll
            for (int j = 0; j < 4; ++j) {
                const int qa = (int)fminf(fmaxf(__builtin_rintf(a[j]), -8.f), 7.f), qb = (int)fminf(fmaxf(__builtin_rintf(b[j]), -8.f), 7.f);
                w |= ((unsigned)qa & 15u) << (4 * j); w |= ((unsigned)qb & 15u) << (4 * (j + 4));
            }
            o[q] = w;
        }
        *(u32x4*)(dst + i * 16) = o;
    }
}

DEV void convert_fp8(const float* __restrict__ src, unsigned char* __restrict__ dst, size_t n, float scale) {
    const size_t n16 = n / 16;
    for (size_t i = (size_t)opaque_bid() * NTHREADS + opaque_tid(); i < n16; i += (size_t)gridDim.x * NTHREADS) {
        u32x4 o;
#pragma unroll
        for (int q = 0; q < 4; ++q) {
            const f32x4 a = *(const f32x4*)(src + i * 16 + q * 4) * scale;
            int w = 0;
            w = __builtin_amdgcn_cvt_pk_fp8_f32(a[0], a[1], w, false);
            w = __builtin_amdgcn_cvt_pk_fp8_f32(a[2], a[3], w, true);
            o[q] = (unsigned)w;
        }
        *(u32x4*)(dst + i * 16) = o;
    }
}

DEV void phase_prologue(const Params& p, char* smem) {
    const int tid = opaque_tid(), nb = gridDim.x, b = opaque_bid();
    {
        float* cond = (float*)smem; float* red = cond + 1024;
        for (int i = tid; i < 1024; i += NTHREADS) cond[i] = siluf(p.c[i]);
        __syncthreads();
        for (int u = b; u < 192; u += nb) {
            const int n = u * 128, layer = n / 6144, nn = n - layer * 6144;
            const int cg = tid & 31, ks = tid >> 5;
            const float* wp = p.mod_w + ((size_t)layer * 1024 + ks * 64) * 6144 + nn + cg * 4;
            f32x4 acc = {0.f, 0.f, 0.f, 0.f};
#pragma unroll 8
            for (int k = 0; k < 64; ++k) { const f32x4 w = *(const f32x4*)(wp + (size_t)k * 6144); const float cv = cond[ks * 64 + k]; acc += w * cv; }
            *(f32x4*)(red + ks * 128 + cg * 4) = acc;
            __syncthreads();
            if (tid < 128) { float s = p.mod_b[n + tid]; for (int q = 0; q < 16; ++q) s += red[q * 128 + tid]; p.mod()[n + tid] = s; }
            __syncthreads();
        }
    }
    for (size_t i = (size_t)b * NTHREADS + tid; i < (size_t)S * 64; i += (size_t)nb * NTHREADS) {
        const int s = (int)(i >> 6), f = (int)(i & 63);
        const float invf = powf(10000.f, -(float)(2 * f) / 128.f);
        const float ang = (float)p.pos[s] * invf;
        float sn, cs; sincosf(ang, &sn, &cs);
        p.cosB()[i] = cs; p.sinB()[i] = sn;
    }
    for (size_t i = (size_t)b * NTHREADS + tid; i < (size_t)S * 32; i += (size_t)nb * NTHREADS) {
        const int s = (int)(i >> 5), f = (int)(i & 31);
        const float invf = powf(10000.f, -(float)(2 * f) / 64.f);
        const float ang = (float)p.pos[s] * invf;
        float sn, cs; sincosf(ang, &sn, &cs);
        p.cosC()[i] = cs; p.sinC()[i] = sn;
    }
    int base = 0;
    for (int i = 0; i < 2; ++i) {
        transpose_conv(p.hy_w_in + (size_t)i * 1024 * HY_IN, 1024, HY_IN, p.w_hy_in() + (size_t)i * HYN * 1024, HYN,
            [](int n) -> int {
                if (n < 2048) return n;
                const int seg = (n - 2048) >> 9, r = (n - 2048) & 511, sb = 2056 + seg * 512;
                if (seg < 2) { const int hd = r >> 7, dp = r & 127; const int d = (dp & 1) ? 64 + (dp >> 1) : (dp >> 1); return sb + hd * 128 + d; }
                return sb + r;
            }, smem, base);
        transpose_conv(p.hy_w_out + (size_t)i * 1024 * 1024, 1024, 1024, p.w_hy_out() + (size_t)i * 1024 * 1024, 1024, [](int n) -> int { return n; }, smem, base);
        transpose_conv(p.mla_w_in + (size_t)i * 1024 * 832, 1024, 832, p.w_mla_in() + (size_t)i * 1024 * 1024, 1024,
            [](int n) -> int {
                if (n < 768) return n;
                if (n < 832) { const int dp = n - 768; const int d = (dp & 1) ? 32 + (dp >> 1) : (dp >> 1); return 768 + d; }
                return -1;
            }, smem, base);
        transpose_conv(p.mla_w_uq + (size_t)i * 512 * 1536, 512, 1536, p.w_uq() + (size_t)i * 1536 * 512, 1536,
            [](int n) -> int {
                const int hd = n / 192, d = n % 192;
                if (d < 128) return n;
                const int dp = d - 128; const int dd = (dp & 1) ? 32 + (dp >> 1) : (dp >> 1);
                return hd * 192 + 128 + dd;
            }, smem, base);
        transpose_conv(p.mla_w_ukv + (size_t)i * 256 * 2048, 256, 2048, p.w_ukv() + (size_t)i * 2048 * 256, 2048,
            [](int n) -> int {
                if (n < 1024) { const int hd = n >> 7, d = n & 127; return hd * 256 + d; }
                const int m = n - 1024; const int hd = m >> 7, d = m & 127; return hd * 256 + 128 + d;
            }, smem, base);
        transpose_conv(p.mla_w_out + (size_t)i * 1024 * 1024, 1024, 1024, p.w_mla_out() + (size_t)i * 1024 * 1024, 1024, [](int n) -> int { return n; }, smem, base);
    }
    for (int i = 0; i < 4; ++i)
        transpose_conv(p.peer_w_q + (size_t)i * 1024 * 2048, 1024, 2048, p.w_pq() + (size_t)i * 2048 * 1024, 2048, [](int n) -> int { return n; }, smem, base);
    convert_bf16(p.peer_sub_keys, p.skb(), (size_t)4 * 8 * 2 * 128 * 128);
}

template <int MODE>
DEV void phase_norm(const float* __restrict__ xs, const float* __restrict__ nw, const float* __restrict__ shv, const float* __restrict__ scv,
                    bf16_t* __restrict__ hout, float* __restrict__ fout, const float* __restrict__ w8src, float* __restrict__ ba, char* smem) {
    const int tid = opaque_tid(), lane = tid & 63, w = __builtin_amdgcn_readfirstlane(tid >> 6);
    float* W8 = (float*)smem;
    if (MODE == 1) {
        for (int i = tid; i < 8192; i += NTHREADS) { const int k = i >> 3, c = i & 7; W8[c * 1024 + k] = w8src[(size_t)k * HY_IN + 2048 + c]; }
        __syncthreads();
    }
    f32x4 wm[4], sh[4];
#pragma unroll
    for (int i = 0; i < 4; ++i) {
        const int e = (i * 64 + lane) * 4;
        const f32x4 nv = *(const f32x4*)(nw + e);
        if (MODE == 2) { wm[i] = nv; sh[i] = (f32x4){0.f, 0.f, 0.f, 0.f}; }
        else { const f32x4 sc = *(const f32x4*)(scv + e); wm[i] = nv * (sc + 1.0f); sh[i] = *(const f32x4*)(shv + e); }
    }
    for (int row = opaque_bid() * 8 + w; row < S; row += gridDim.x * 8) {
        f32x4 v[4]; float ss = 0.f;
#pragma unroll
        for (int i = 0; i < 4; ++i) { v[i] = *(const f32x4*)(xs + (size_t)row * DM + (i * 64 + lane) * 4); ss += v[i][0] * v[i][0] + v[i][1] * v[i][1] + v[i][2] * v[i][2] + v[i][3] * v[i][3]; }
        ss = wsum64(ss, lane);
        const float rn = rsqrtf(ss * (1.f / 1024.f) + 1e-6f);
#pragma unroll
        for (int i = 0; i < 4; ++i) v[i] = v[i] * rn * wm[i] + sh[i];
        if (MODE == 2) {
#pragma unroll
            for (int i = 0; i < 4; ++i) *(f32x4*)(fout + (size_t)row * DM + (i * 64 + lane) * 4) = v[i];
        } else {
#pragma unroll
            for (int i = 0; i < 4; ++i) { u32x2 o; o.x = pk2(v[i][0], v[i][1]); o.y = pk2(v[i][2], v[i][3]); *(u32x2*)(hout + (size_t)row * DM + (i * 64 + lane) * 4) = o; }
        }
        if (MODE == 1) {
            float pc[8];
#pragma unroll
            for (int c = 0; c < 8; ++c) {
                float a = 0.f;
#pragma unroll
                for (int i = 0; i < 4; ++i) { const f32x4 ww = *(const f32x4*)(W8 + c * 1024 + (i * 64 + lane) * 4); a += v[i][0] * ww[0] + v[i][1] * ww[1] + v[i][2] * ww[2] + v[i][3] * ww[3]; }
                pc[c] = wsum64(a, lane);
            }
            if (lane == 0) { *(f32x4*)(ba + (size_t)row * 8) = (f32x4){pc[0], pc[1], pc[2], pc[3]}; *(f32x4*)(ba + (size_t)row * 8 + 4) = (f32x4){pc[4], pc[5], pc[6], pc[7]}; }
        }
    }
}

constexpr int GA_RS = 144;
template <class Epi>
DEV void gemm_phase(const bf16_t* __restrict__ A, int lda, const bf16_t* __restrict__ Bt, int ldb, int K, int ntn, char* smem, Epi epi) {
    const int tid = opaque_tid(), lane = tid & 63, w = tid >> 6, wm = w >> 1, wn = w & 1, r = lane & 15, g = lane >> 4;
    char* As = smem; char* Bs = smem + 256 * GA_RS;
    const int nun = 64 * ntn, nk = K / 64;
    for (int u = opaque_bid(); u < nun; u += gridDim.x) {
        const int xcd = u & 7, idx = u >> 3, tn = idx % ntn, tm = xcd * 8 + idx / ntn;
        const int m0 = tm * 256, n0 = tn * 128;
        f32x4 acc[4][4];
#pragma unroll
        for (int i = 0; i < 4; ++i)
#pragma unroll
            for (int j = 0; j < 4; ++j) acc[i][j] = (f32x4){0.f, 0.f, 0.f, 0.f};
        u32x4 ra0[4], rb0[2], ra1[4], rb1[2], ra2[4], rb2[2];
        const bf16_t* Ap = A + (size_t)(m0 + (tid >> 3)) * lda + (tid & 7) * 8;
        const bf16_t* Bp = Bt + (size_t)(n0 + (tid >> 3)) * ldb + (tid & 7) * 8;
        auto gload = [&](int kt, u32x4 (&ra)[4], u32x4 (&rb)[2]) {
            const int k0 = kt * 64;
#pragma unroll
            for (int i = 0; i < 4; ++i) ra[i] = *(const u32x4*)(Ap + (size_t)(64 * i) * lda + k0);
#pragma unroll
            for (int i = 0; i < 2; ++i) rb[i] = *(const u32x4*)(Bp + (size_t)(64 * i) * ldb + k0);
        };
        auto body = [&](int kt, u32x4 (&ra)[4], u32x4 (&rb)[2]) {
            __syncthreads();
#pragma unroll
            for (int i = 0; i < 4; ++i) *(u32x4*)(As + ((tid >> 3) + 64 * i) * GA_RS + (tid & 7) * 16) = ra[i];
#pragma unroll
            for (int i = 0; i < 2; ++i) *(u32x4*)(Bs + ((tid >> 3) + 64 * i) * GA_RS + (tid & 7) * 16) = rb[i];
            __syncthreads();
            if (kt + 3 < nk) gload(kt + 3, ra, rb);
#pragma unroll
            for (int ks = 0; ks < 2; ++ks) {
                bf16x8 af[4], bfr[4];
#pragma unroll
                for (int mt = 0; mt < 4; ++mt) af[mt] = *(const bf16x8*)(As + (64 * wm + 16 * mt + r) * GA_RS + (32 * ks + 8 * g) * 2);
#pragma unroll
                for (int nt = 0; nt < 4; ++nt) bfr[nt] = *(const bf16x8*)(Bs + (64 * wn + 16 * nt + r) * GA_RS + (32 * ks + 8 * g) * 2);
#pragma unroll
                for (int mt = 0; mt < 4; ++mt)
#pragma unroll
                    for (int nt = 0; nt < 4; ++nt) acc[mt][nt] = mfma16(bfr[nt], af[mt], acc[mt][nt]);
            }
        };
        gload(0, ra0, rb0); gload(1, ra1, rb1); gload(2, ra2, rb2);
        for (int kt = 0; kt < nk; kt += 3) {
            body(kt, ra0, rb0);
            if (kt + 1 < nk) body(kt + 1, ra1, rb1);
            if (kt + 2 < nk) body(kt + 2, ra2, rb2);
        }
        epi(acc, m0 + 64 * wm + r, n0 + 64 * wn + 4 * g, n0);
    }
}

DEV void st_bf4(bf16_t* p, f32x4 v) { u32x2 o; o.x = pk2(v[0], v[1]); o.y = pk2(v[2], v[3]); *(u32x2*)p = o; }
DEV f32x4 rope4(f32x4 v, const float* cs, const float* sn, int fi) {
    const float c0 = cs[fi], s0 = sn[fi], c1 = cs[fi + 1], s1 = sn[fi + 1];
    f32x4 o; o[0] = v[0] * c0 - v[1] * s0; o[1] = v[1] * c0 + v[0] * s0; o[2] = v[2] * c1 - v[3] * s1; o[3] = v[3] * c1 + v[2] * s1; return o;
}

namespace pg8 {
#define PG8_LAS __attribute__((address_space(3)))
typedef unsigned short bf16_t;
typedef short bf16x8 __attribute__((ext_vector_type(8)));
typedef float f32x4 __attribute__((ext_vector_type(4)));
constexpr int BM = 256, BK = 64, HALF = 128, HTB = HALF * BK * 2  , STAGE_BYTES = 8 * HTB, NXCD = 8, WGM = 8;

__host__ __device__ __forceinline__ int lds_byte(int r, int c) { const int st = (r >> 4) * 2 + (c >> 5), rr = r & 15, cc = c & 31, ob = rr * 64 + cc * 2; return st * 1024 + (ob ^ (((ob >> 9) & 1) << 5)); }
__host__ __device__ __forceinline__ void stage_rc(int b, int& R, int& C) { const int st = b / 1024, sb = b % 1024, swz = sb ^ (((sb >> 9) & 1) << 5); R = (st >> 1) * 16 + swz / 64; C = (st & 1) * 32 + (swz % 64) / 2; }
__host__ __device__ __forceinline__ int perm32(int rho) { const int n = rho >> 4, i = rho & 15; return 8 * (i >> 2) + 4 * n + (i & 3); }

struct Unit { int pm, pn; };
struct Gemm { const bf16_t* A; const bf16_t* Bt; int M, N, K; };

struct StaticOrder {
    int nM, nN, nwg, G, c;
    __host__ __device__ void init(int M, int N, int G_, int c_) { nM = M / BM; nN = N / BM; nwg = nM * nN; G = G_; c = c_; }
    __host__ __device__ bool next(int i, Unit& u) const {
        const long L = (long)i * G + c; if (L >= nwg) return false;
        int wgid = (int)L; { const int q = nwg / NXCD, r = nwg % NXCD, xcd = wgid % NXCD, off = wgid / NXCD; wgid = (xcd < r ? xcd * (q + 1) : r * (q + 1) + (xcd - r) * q) + off; }
        const int nig = WGM * nN, gid = wgid / nig, fm = gid * WGM, gsz = (nM - fm) < WGM ? (nM - fm) : WGM;
        u.pm = fm + ((wgid % nig) % gsz); u.pn = (wgid % nig) / gsz; return true;
    }
    __device__ __forceinline__ void a_ready(const Unit&) const {}
    __device__ __forceinline__ void done(const Unit&) const {}
};
template <class Epi, class Sched, bool STAMP = false>
__device__ __forceinline__ void gemm_phase(PG8_LAS unsigned char* lds, const Gemm g, const Sched& S, const Epi& E, unsigned long long* stamps) {
    const int tid = opaque_tid(), wid = __builtin_amdgcn_readfirstlane(tid >> 6), lane = tid & 63, wr = wid >> 2, wc = wid & 3, fr = lane & 15, fq = lane >> 4;
    const int K = g.K, nt = K / BK;
    int ts_lo = 0, ts_hi = 0, nts = 0; const unsigned long long rt_entry = STAMP ? (unsigned long long)wall_clock64() : 0ull;
#define PG8_STAMP() do { if (STAMP && wid == 0 && nts < 64) { const unsigned long long _c = (unsigned long long)clock64(); \
        ts_lo = (lane == nts) ? (int)(unsigned)_c : ts_lo; ts_hi = (lane == nts) ? (int)(unsigned)(_c >> 32) : ts_hi; ++nts; } } while (0)
    PG8_STAMP();
    unsigned voffA[2], voffB[2];
#pragma unroll
    for (int i = 0; i < 2; ++i) { int R, C; stage_rc(tid * 16 + i * 8192, R, C); const int Rb = Epi::PERM ? ((R & ~31) + perm32(R & 31)) : R;
        voffA[i] = (unsigned)(R * K + C) * 2u; voffB[i] = (unsigned)(Rb * K + C) * 2u; }
    const size_t kstep = (size_t)(BK * 2);
    const size_t hstep = (size_t)HALF * K * 2;
    const size_t tstep = 2 * hstep;
    const unsigned ldsw = (unsigned)wid * 1024u;
    const int aoff = lds_byte(wr * 64 + fr, fq * 8), boff = lds_byte(wc * 32 + fr, fq * 8);
#define PG8_SA(b, h) (((b) * 2 + (h)) * HTB)
#define PG8_SB(b, h) ((4 + (b) * 2 + (h)) * HTB)
#define PG8_STAGE(bufoff, gbase, voff) do { _Pragma("unroll") for (int _i = 0; _i < 2; ++_i) \
        __builtin_amdgcn_global_load_lds((const unsigned*)((const char*)(gbase) + (voff)[_i]), (PG8_LAS unsigned*)(lds + (bufoff) + ldsw + _i * 8192), 16, 0, 0); } while (0)
#define PG8_LDA(dst, b, h) do { _Pragma("unroll") for (int m = 0; m < 4; ++m) _Pragma("unroll") for (int k = 0; k < 2; ++k) dst[m][k] = *(const PG8_LAS bf16x8*)(lds + PG8_SA(b, h) + aoff + m * 2048 + k * 1024); } while (0)
#define PG8_LDB(dst, b, h) do { _Pragma("unroll") for (int n = 0; n < 2; ++n) _Pragma("unroll") for (int k = 0; k < 2; ++k) dst[n][k] = *(const PG8_LAS bf16x8*)(lds + PG8_SB(b, h) + boff + n * 2048 + k * 1024); } while (0)
#define PG8_MMA(ai, bj, At, Bt) do { __builtin_amdgcn_s_setprio(1); _Pragma("unroll") for (int m = 0; m < 4; ++m) _Pragma("unroll") for (int n = 0; n < 2; ++n) _Pragma("unroll") for (int k = 0; k < 2; ++k) \
        acc[ai][bj][m][n] = __builtin_amdgcn_mfma_f32_16x16x32_bf16(Bt[n][k], At[m][k], acc[ai][bj][m][n], 0, 0, 0); __builtin_amdgcn_s_setprio(0); } while (0)
#define PG8_WAIT_V(n) asm volatile("s_waitcnt vmcnt(" #n ")" ::: "memory")
#define PG8_WAIT_L(n) asm volatile("s_waitcnt lgkmcnt(" #n ")" ::: "memory")
#define PG8_BAR __builtin_amdgcn_s_barrier()
#define PG8_SCHED __builtin_amdgcn_sched_barrier(0)
    Unit cur, nxt; int ui = 0;
    if (!S.next(0, cur)) return;
    f32x4 acc[2][2][4][2];
#pragma unroll
    for (int a = 0; a < 2; ++a)
#pragma unroll
        for (int b = 0; b < 2; ++b)
#pragma unroll
            for (int m = 0; m < 4; ++m)
#pragma unroll
                for (int n = 0; n < 2; ++n) acc[a][b][m][n] = (f32x4){0.f, 0.f, 0.f, 0.f};
    bf16x8 At[4][2], B0[2][2], B1[2][2];
    const char* cA = (const char*)g.A + (size_t)cur.pm * tstep; const char* cB = (const char*)g.Bt + (size_t)cur.pn * tstep;
    S.a_ready(cur);
    PG8_STAGE(PG8_SB(0, 0), cB, voffB); PG8_STAGE(PG8_SA(0, 0), cA, voffA); PG8_STAGE(PG8_SB(0, 1), cB + hstep, voffB); PG8_STAGE(PG8_SA(0, 1), cA + hstep, voffA);
    if (wr == 1) PG8_BAR;
    PG8_WAIT_V(4); PG8_BAR;
    PG8_STAGE(PG8_SB(1, 0), cB + kstep, voffB); PG8_STAGE(PG8_SA(1, 0), cA + kstep, voffA); PG8_STAGE(PG8_SB(1, 1), cB + hstep + kstep, voffB);
    PG8_WAIT_V(6); PG8_BAR;
    PG8_STAMP();
    for (;;) {
        const bool has_next = S.next(ui + 1, nxt);
        const char* nA = has_next ? (const char*)g.A + (size_t)nxt.pm * tstep : cA; const char* nB = has_next ? (const char*)g.Bt + (size_t)nxt.pn * tstep : cB;
        for (int t = 0; t < nt; t += 2) {
            const bool last = (t == nt - 2);
            const char* a1 = cA + (size_t)(t + 1) * kstep;
            const char* a2 = last ? nA : cA + (size_t)(t + 2) * kstep; const char* b2 = last ? nB : cB + (size_t)(t + 2) * kstep;
            const char* a3 = a2 + kstep; const char* b3 = b2 + kstep;
            if (last && has_next) S.a_ready(nxt);
            PG8_LDB(B0, 0, 0); PG8_SCHED; PG8_LDA(At, 0, 0); PG8_STAGE(PG8_SA(1, 1), a1 + hstep, voffA);
            PG8_WAIT_L(8); PG8_BAR; PG8_WAIT_L(0); PG8_MMA(0, 0, At, B0); PG8_BAR; PG8_SCHED;
            PG8_LDB(B1, 0, 1); PG8_STAGE(PG8_SB(0, 0), b2, voffB);
            PG8_BAR; PG8_WAIT_L(0); PG8_MMA(0, 1, At, B1); PG8_BAR;
            PG8_LDA(At, 0, 1); PG8_STAGE(PG8_SA(0, 0), a2, voffA);
            PG8_BAR; PG8_WAIT_L(0); PG8_MMA(1, 0, At, B0); PG8_BAR; PG8_SCHED;
            PG8_STAGE(PG8_SB(0, 1), b2 + hstep, voffB);
            PG8_WAIT_V(6); PG8_BAR; PG8_MMA(1, 1, At, B1); PG8_BAR;
            PG8_LDB(B0, 1, 0); PG8_SCHED; PG8_LDA(At, 1, 0); PG8_STAGE(PG8_SA(0, 1), a2 + hstep, voffA);
            PG8_WAIT_L(8); PG8_BAR; PG8_WAIT_L(0); PG8_MMA(0, 0, At, B0); PG8_BAR; PG8_SCHED;
            PG8_LDB(B1, 1, 1); PG8_STAGE(PG8_SB(1, 0), b3, voffB);
            PG8_BAR; PG8_WAIT_L(0); PG8_MMA(0, 1, At, B1); PG8_BAR;
            PG8_LDA(At, 1, 1); PG8_STAGE(PG8_SA(1, 0), a3, voffA);
            PG8_BAR; PG8_WAIT_L(0); PG8_MMA(1, 0, At, B0); PG8_BAR; PG8_SCHED;
            PG8_STAGE(PG8_SB(1, 1), b3 + hstep, voffB);
            PG8_WAIT_V(6); PG8_BAR; PG8_MMA(1, 1, At, B1); PG8_BAR;
        }
        PG8_STAMP();
        if constexpr (!Epi::AFTER_DRAIN) { E(acc, cur, wr, wc, fr, fq); S.done(cur); }
        PG8_STAMP();
        if (!has_next) break;
#pragma unroll
        for (int a = 0; a < 2; ++a)
#pragma unroll
            for (int b = 0; b < 2; ++b)
#pragma unroll
                for (int m = 0; m < 4; ++m)
#pragma unroll
                    for (int n = 0; n < 2; ++n) acc[a][b][m][n] = (f32x4){0.f, 0.f, 0.f, 0.f};
        cur = nxt; cA = nA; cB = nB; ++ui;
    }
    PG8_WAIT_V(0);
    if (wr == 0) PG8_BAR;
    PG8_BAR;
    if constexpr (Epi::AFTER_DRAIN) { E.fused(acc, cur, wr, wc, fr, fq, lds, wid, lane); S.done(cur); }
    PG8_STAMP();
    if (STAMP && wid == 0) { stamps[lane] = lane < nts ? (((unsigned long long)(unsigned)ts_hi << 32) | (unsigned)ts_lo) : 0ull;
        if (lane == 62) stamps[62] = rt_entry; if (lane == 63) stamps[63] = (unsigned long long)wall_clock64(); }
#undef PG8_STAMP
#undef PG8_SA
#undef PG8_SB
#undef PG8_STAGE
#undef PG8_LDA
#undef PG8_LDB
#undef PG8_MMA
#undef PG8_WAIT_V
#undef PG8_WAIT_L
#undef PG8_BAR
#undef PG8_SCHED
}
}

template <class F> struct EpiCall {
    static constexpr bool PERM = false, AFTER_DRAIN = false;
    F f;
    __device__ __forceinline__ void operator()(const f32x4 (&acc)[2][2][4][2], const pg8::Unit& u, int wr, int wc, int fr, int fq) const {
        { const int t_ = opaque_tid(); fr = t_ & 15; fq = (t_ >> 4) & 3; const int wid_ = __builtin_amdgcn_readfirstlane(t_ >> 6); wr = wid_ >> 2; wc = wid_ & 3; }
#pragma unroll
        for (int ai = 0; ai < 2; ++ai)
#pragma unroll
            for (int bj = 0; bj < 2; ++bj) {
                const int n0 = u.pn * 256 + 128 * bj;
#pragma unroll
                for (int m = 0; m < 4; ++m) {
#pragma unroll
                    for (int n = 0; n < 2; ++n) f(u.pm * 256 + 128 * ai + 64 * wr + 16 * m + fr, n0 + 32 * wc + 16 * n + 4 * fq, n0, acc[ai][bj][m][n]);
                    __builtin_amdgcn_sched_barrier(0);
                }
            }
    }
};
template <class F>
DEV void gemm256(const bf16_t* A, const bf16_t* Bt, int N, int K, char* smem, F f) {
    pg8::Gemm g; g.A = A; g.Bt = Bt; g.M = S; g.N = N; g.K = K;
    pg8::StaticOrder so; so.init(S, N, (int)gridDim.x, opaque_bid());
    EpiCall<F> e{f};
    pg8::gemm_phase<EpiCall<F>, pg8::StaticOrder, false>((PG8_LAS unsigned char*)smem, g, so, e, nullptr);
}

template <int DQK>
DEV void attn_run(const bf16_t* __restrict__ qrow, bool wactive, const bf16_t* __restrict__ Kn, const bf16_t* __restrict__ Kr,
                  const bf16_t* __restrict__ VT, int t_lo, int t_hi, int qpos, int wqmin, int wqmax, char* smem,
                  f32x16 (&o)[4], float& mrun, float& lrun) {
    constexpr int KRS = (DQK + 8) * 2;
    constexpr int VRS = 136;
    constexpr int NKS = DQK / 16;
    constexpr int QREG = 4;
    constexpr bool ROPE = (DQK == 192);
    char* Vb0 = smem + 2 * 64 * KRS; char* Qs = Vb0 + 2 * 128 * VRS;
    const int tid = opaque_tid(), lane = tid & 63, c = lane & 31, hi = lane >> 5;
    bf16x8 qf[QREG];
#pragma unroll
    for (int ks = 0; ks < QREG; ++ks) qf[ks] = *(const bf16x8*)(qrow + 16 * ks + 8 * hi);
    char* Qw = Qs + (tid >> 6) * ((NKS - QREG) * 1024) + lane * 16;
#pragma unroll
    for (int ks = QREG; ks < NKS; ++ks) *(bf16x8*)(Qw + (ks - QREG) * 1024) = *(const bf16x8*)(qrow + 16 * ks + 8 * hi);
#pragma unroll
    for (int i = 0; i < 4; ++i)
#pragma unroll
        for (int rr = 0; rr < 16; ++rr) o[i][rr] = 0.f;
    mrun = -1e30f; lrun = 0.f;
    u32x4 kreg[2], rreg, vreg[2];
    auto gloadK = [&](int t) {
        int t2 = tid; asm volatile("" : "+v"(t2));
        const char* kn_t = (const char*)Kn + (size_t)t * (64 * 256);
#pragma unroll
        for (int i = 0; i < 2; ++i) { const int ch = t2 + NTHREADS * i; kreg[i] = *(const u32x4*)(kn_t + (unsigned)((ch >> 4) * 256 + (ch & 15) * 16)); }
        if (ROPE) { const char* kr_t = (const char*)Kr + (size_t)t * (64 * 128); rreg = *(const u32x4*)(kr_t + (unsigned)((t2 >> 3) * 128 + (t2 & 7) * 16)); }
    };
    auto gloadV = [&](int t) {
        int t2 = tid; asm volatile("" : "+v"(t2));
        const char* vt_t = (const char*)VT + (size_t)t * (128 * 128);
#pragma unroll
        for (int i = 0; i < 2; ++i) { const int ch = t2 + NTHREADS * i; vreg[i] = *(const u32x4*)(vt_t + (unsigned)(ch * 16)); }
    };
    auto lstoreK = [&](int t) {
        int t2 = tid; asm volatile("" : "+v"(t2));
        char* Ks = smem + (t & 1) * (64 * KRS);
#pragma unroll
        for (int i = 0; i < 2; ++i) { const int ch = t2 + NTHREADS * i; *(u32x4*)(Ks + (ch >> 4) * KRS + (ch & 15) * 16) = kreg[i]; }
        if (ROPE) *(u32x4*)(Ks + (t2 >> 3) * KRS + 256 + (t2 & 7) * 16) = rreg;
    };
    auto lstoreV = [&](int t) {
        int t2 = tid; asm volatile("" : "+v"(t2));
        char* Vs = Vb0 + (t & 1) * (128 * VRS);
#pragma unroll
        for (int i = 0; i < 2; ++i) {
            const int ch = t2 + NTHREADS * i;
            u32x2* d = (u32x2*)(Vs + (ch >> 3) * VRS + (ch & 7) * 16);
            d[0] = (u32x2){vreg[i].x, vreg[i].y}; d[1] = (u32x2){vreg[i].z, vreg[i].w};
        }
    };
    auto qk = [&](int t, f32x16 (&sv)[2]) {
        const char* Ks = smem + (t & 1) * (64 * KRS) + c * KRS + 16 * hi;
#pragma unroll
        for (int kt = 0; kt < 2; ++kt)
#pragma unroll
            for (int rr = 0; rr < 16; ++rr) sv[kt][rr] = 0.f;
        bf16x8 k0[3], k1[3], qv[3];
#pragma unroll
        for (int ks = 0; ks < 2; ++ks) {
            k0[ks] = *(const bf16x8*)(Ks + 32 * ks); k1[ks] = *(const bf16x8*)(Ks + 32 * KRS + 32 * ks);
            if (ks < QREG) qv[ks] = qf[ks < QREG ? ks : 0]; else qv[ks] = *(const bf16x8*)(Qw + (ks - QREG) * 1024);
        }
#pragma unroll
        for (int ks = 0; ks < NKS; ++ks) {
            if (ks + 2 < NKS) {
                k0[(ks + 2) % 3] = *(const bf16x8*)(Ks + 32 * (ks + 2)); k1[(ks + 2) % 3] = *(const bf16x8*)(Ks + 32 * KRS + 32 * (ks + 2));
                if (ks + 2 < QREG) qv[(ks + 2) % 3] = qf[ks + 2 < QREG ? ks + 2 : 0]; else qv[(ks + 2) % 3] = *(const bf16x8*)(Qw + (ks + 2 - QREG) * 1024);
            }
            sv[0] = mfma32(k0[ks % 3], qv[ks % 3], sv[0]);
            sv[1] = mfma32(k1[ks % 3], qv[ks % 3], sv[1]);
        }
    };
    float mnew_ = 0.f;
    auto softmax_a = [&](int t, f32x16 (&sv)[2]) {
        const int kb = t * 64;
        if (kb + 63 > wqmin) {
#pragma unroll
            for (int kt = 0; kt < 2; ++kt)
#pragma unroll
                for (int rr = 0; rr < 16; ++rr) { const int key = kb + 32 * kt + (rr & 3) + 8 * (rr >> 2) + 4 * hi; if (key > qpos) sv[kt][rr] = -__builtin_inff(); }
        }
        float tmax = sv[0][0];
#pragma unroll
        for (int rr = 1; rr < 16; ++rr) tmax = fmaxf(tmax, sv[0][rr]);
#pragma unroll
        for (int rr = 0; rr < 16; ++rr) tmax = fmaxf(tmax, sv[1][rr]);
        tmax = fmaxf(tmax, shx(tmax, 32, lane));
        const float mnew = fmaxf(mrun, tmax);
        const float alpha = ex2(mrun - mnew);
        mrun = mnew; mnew_ = mnew;
        lrun *= alpha;
        if (!__all(alpha == 1.f)) {
#pragma unroll
            for (int i = 0; i < 4; ++i)
#pragma unroll
                for (int rr = 0; rr < 16; ++rr) o[i][rr] *= alpha;
        }
    };
    auto softmax_b = [&](f32x16 (&sv)[2], bf16x8 (&pf)[2][2]) {
        const float mnew = mnew_;
        float ps = 0.f;
#pragma unroll
        for (int kt = 0; kt < 2; ++kt)
#pragma unroll
            for (int rr = 0; rr < 16; ++rr) { const float pv = ex2(sv[kt][rr] - mnew); sv[kt][rr] = pv; ps += pv; }
        lrun += ps;
#pragma unroll
        for (int kt = 0; kt < 2; ++kt)
#pragma unroll
            for (int s2 = 0; s2 < 2; ++s2) {
                u32x4 pw; pw.x = pk2(sv[kt][8 * s2 + 0], sv[kt][8 * s2 + 1]); pw.y = pk2(sv[kt][8 * s2 + 2], sv[kt][8 * s2 + 3]);
                pw.z = pk2(sv[kt][8 * s2 + 4], sv[kt][8 * s2 + 5]); pw.w = pk2(sv[kt][8 * s2 + 6], sv[kt][8 * s2 + 7]);
                pf[kt][s2] = *(const bf16x8*)&pw;
            }
    };
    auto pv = [&](int t, const bf16x8 (&pf)[2][2]) {
        const char* Vs = Vb0 + (t & 1) * (128 * VRS) + c * VRS + 8 * hi;
        u32x2 va[2][4], vb[2][4];
#pragma unroll
        for (int dvt = 0; dvt < 4; ++dvt) { va[0][dvt] = *(const u32x2*)(Vs + 32 * dvt * VRS); vb[0][dvt] = *(const u32x2*)(Vs + 32 * dvt * VRS + 16); }
#pragma unroll
        for (int g = 0; g < 4; ++g) {
            if (g + 1 < 4) {
#pragma unroll
                for (int dvt = 0; dvt < 4; ++dvt) {
                    va[(g + 1) & 1][dvt] = *(const u32x2*)(Vs + 32 * dvt * VRS + 32 * (g + 1));
                    vb[(g + 1) & 1][dvt] = *(const u32x2*)(Vs + 32 * dvt * VRS + 32 * (g + 1) + 16);
                }
            }
#pragma unroll
            for (int dvt = 0; dvt < 4; ++dvt) {
                u32x4 vw; vw.x = va[g & 1][dvt].x; vw.y = va[g & 1][dvt].y; vw.z = vb[g & 1][dvt].x; vw.w = vb[g & 1][dvt].y;
                o[dvt] = mfma32(*(const bf16x8*)&vw, pf[g >> 1][g & 1], o[dvt]);
            }
        }
    };
    auto active = [&](int t) -> bool { return wactive && (t * 64 <= wqmax); };
    auto step = [&](int t, f32x16 (&sc)[2], f32x16 (&sn)[2]) {
        const bool more = t + 1 < t_hi;
        const int tk = t + 2 < t_hi ? t + 2 : t_hi - 1, tv = more ? t + 1 : t_hi - 1;
        const bool a0 = active(t), a1 = more && active(t + 1);
        if (a0) {
            bf16x8 pf[2][2];
            if (a1) { qk(t + 1, sn); gloadK(tk); gloadV(tv); softmax_b(sc, pf); }
            else { gloadK(tk); gloadV(tv); softmax_b(sc, pf); }
            pv(t, pf);
        } else { gloadK(tk); gloadV(tv); }
        lstoreK(t + 2); lstoreV(t + 1);
        if (a1) softmax_a(t + 1, sn);
        __syncthreads();
    };
    __syncthreads();
    gloadK(t_lo); gloadV(t_lo); lstoreK(t_lo); lstoreV(t_lo);
    if (t_lo + 1 < t_hi) { gloadK(t_lo + 1); lstoreK(t_lo + 1); }
    __syncthreads();
    f32x16 sA[2], sB[2];
    if (active(t_lo)) { qk(t_lo, sA); softmax_a(t_lo, sA); }
    __syncthreads();
    for (int t = t_lo; t < t_hi; t += 2) {
        step(t, sA, sB);
        if (t + 1 < t_hi) step(t + 1, sB, sA);
    }
    lrun += shx(lrun, 32, lane);
}

DEV void phase_mla_attn(const Params& p, char* smem) {
    const int tid = opaque_tid(), lane = tid & 63, w = tid >> 6, c = lane & 31, hi = lane >> 5;
    for (int u = opaque_bid(); u < 256; u += gridDim.x) {
        const int head = u & 7, pi = u >> 3;
        for (int half = 0; half < 2; ++half) {
            const int qb = half == 0 ? (63 - pi) : pi;
            const int q = qb * 256 + 32 * w + c;
            f32x16 o[4]; float m, l;
            attn_run<192>(p.Qm() + ((size_t)head * S + q) * 192, true, p.Kn() + (size_t)head * S * 128, p.Kr(), p.VmT() + (size_t)head * 128 * S,
                          0, 4 * qb + 4, q, qb * 256 + 32 * w, qb * 256 + 32 * w + 31, smem, o, m, l);
            const float inv = 1.f / l;
#pragma unroll
            for (int dvt = 0; dvt < 4; ++dvt)
#pragma unroll
                for (int rg = 0; rg < 4; ++rg) {
                    const int dv = 32 * dvt + 8 * rg + 4 * hi;
                    f32x4 v = {o[dvt][4 * rg] * inv, o[dvt][4 * rg + 1] * inv, o[dvt][4 * rg + 2] * inv, o[dvt][4 * rg + 3] * inv};
                    st_bf4(p.cat() + (size_t)q * DM + head * 128 + dv, v);
                }
        }
    }
}

DEV void moba_kmean_unit(const Params& p, int h, int j, char* smem) {
    float* red = (float*)smem;
    const int tid = opaque_tid(), d = tid & 127, qq = tid >> 7;
    const bf16_t* kp = p.Kb() + ((size_t)h * S + 256 * j + qq * 64) * 128 + d;
    float s = 0.f;
    for (int t = 0; t < 64; ++t) s += __uint_as_float(((unsigned)kp[(size_t)t * 128]) << 16);
    __syncthreads();
    red[qq * 128 + d] = s;
    __syncthreads();
    if (tid < 128) p.kmean()[((size_t)h * 64 + j) * 128 + tid] = (red[tid] + red[128 + tid] + red[256 + tid] + red[384 + tid]) * (1.f / 256.f);
}

DEV void moba_gate_unit(const Params& p, int u, char* smem) {
    float* km = (float*)smem;
    int* cnt = (int*)(smem + 32768);
    const int tid = opaque_tid();
    {
        const int h = u & 3, t = u >> 2;
        __syncthreads();
        for (int i = tid; i < 8192; i += NTHREADS) km[i] = p.kmean()[(size_t)h * 8192 + i];
        if (tid < 64) cnt[tid] = 0;
        __syncthreads();
        const int q = t * 512 + tid, own = q >> 8;
        float qv[128];
        const u32x4* qp = (const u32x4*)(p.Qb() + ((size_t)h * S + q) * 128);
#pragma unroll
        for (int i = 0; i < 16; ++i) { const u32x4 v = qp[i]; qv[8 * i] = bflo(v.x); qv[8 * i + 1] = bfhi(v.x); qv[8 * i + 2] = bflo(v.y); qv[8 * i + 3] = bfhi(v.y); qv[8 * i + 4] = bflo(v.z); qv[8 * i + 5] = bfhi(v.z); qv[8 * i + 6] = bflo(v.w); qv[8 * i + 7] = bfhi(v.w); }
        float b0 = -__builtin_inff(), b1 = b0, b2 = b0; int i0 = 0, i1 = 0, i2 = 0;
        const int ownw = __builtin_amdgcn_readfirstlane(own);
        for (int j = 0; j < ownw; ++j) {
            float s = 0.f; const f32x4* kp = (const f32x4*)(km + j * 128);
#pragma unroll
            for (int d4 = 0; d4 < 32; ++d4) { const f32x4 kk = kp[d4]; s += qv[4 * d4] * kk[0] + qv[4 * d4 + 1] * kk[1] + qv[4 * d4 + 2] * kk[2] + qv[4 * d4 + 3] * kk[3]; }
            if (s > b0) { b2 = b1; i2 = i1; b1 = b0; i1 = i0; b0 = s; i0 = j; }
            else if (s > b1) { b2 = b1; i2 = i1; b1 = s; i1 = j; }
            else if (s > b2) { b2 = s; i2 = j; }
        }
        const int nsel = own < 3 ? own : 3;
        if (0 < nsel) { const int pos = atomicAdd(&cnt[i0], 1); p.lists()[(((size_t)h * 64 + i0) * 32 + t) * 512 + pos] = (q << 2) | 0; }
        if (1 < nsel) { const int pos = atomicAdd(&cnt[i1], 1); p.lists()[(((size_t)h * 64 + i1) * 32 + t) * 512 + pos] = (q << 2) | 1; }
        if (2 < nsel) { const int pos = atomicAdd(&cnt[i2], 1); p.lists()[(((size_t)h * 64 + i2) * 32 + t) * 512 + pos] = (q << 2) | 2; }
        __syncthreads();
        if (tid < 64) p.segcnt()[((size_t)h * 64 + tid) * 32 + t] = cnt[tid];
    }
}

DEV void moba_write_partial(const Params& p, int q, int h, int slot, const f32x16 (&o)[4], float m, float l, int hi) {
    bf16_t* pp = (bf16_t*)p.part() + (((size_t)q * 4 + h) * 4 + slot) * 128;
    const float il = 1.f / l;
#pragma unroll
    for (int dvt = 0; dvt < 4; ++dvt)
#pragma unroll
        for (int rg = 0; rg < 4; ++rg) {
            const int dv = 32 * dvt + 8 * rg + 4 * hi;
            st_bf4(pp + dv, (f32x4){o[dvt][4 * rg] * il, o[dvt][4 * rg + 1] * il, o[dvt][4 * rg + 2] * il, o[dvt][4 * rg + 3] * il});
        }
    if (hi == 0) { float* mp = p.ml() + (((size_t)q * 4 + h) * 4 + slot) * 2; mp[0] = m; mp[1] = l; }
}

constexpr int MB_KRS = 272, MB_VRS = 136, MB_KB = 64 * MB_KRS, MB_VB = 128 * MB_VRS, MB_TAB = 8 * 17408;
DEV int moba_tile_table(const Params& p, char* smem) {
    int* P = (int*)(smem + MB_TAB + 256);
    const int tid = opaque_tid();
    __syncthreads();
    if (tid < 256) {
        const int j = tid >> 2, h = tid & 3; int s = 0;
        const int* sc = p.segcnt() + ((size_t)h * 64 + j) * 32;
        for (int t = 0; t < 32; ++t) s += sc[t];
        const int ntiles = 1 + ((s + 255) >> 8);
        P[tid + 1] = (ntiles + 3) >> 2;
    }
    if (tid == 0) P[0] = 0;
    __syncthreads();
    if (tid == 0) { int s = 0; for (int i = 1; i <= 256; ++i) { s += P[i]; P[i] = s; } }
    __syncthreads();
    return P[256];
}
DEV void moba_attn_resident(const bf16_t* __restrict__ qrow, bool wactive, int qpos, int wqmin, int wqmax, int kb0, char* smem, f32x16 (&o)[4], float& mrun, float& lrun) {
    const int tid = opaque_tid(), lane = tid & 63, c = lane & 31, hi = lane >> 5;
    bf16x8 qf[8];
#pragma unroll
    for (int ks = 0; ks < 8; ++ks) qf[ks] = *(const bf16x8*)(qrow + 16 * ks + 8 * hi);
#pragma unroll
    for (int i = 0; i < 4; ++i)
#pragma unroll
        for (int rr = 0; rr < 16; ++rr) o[i][rr] = 0.f;
    mrun = -1e30f; lrun = 0.f;
    if (!wactive) return;
    float mnew_ = 0.f;
    auto qk = [&](int t, f32x16 (&sv)[2]) {
        const char* Ks = smem + t * MB_KB + c * MB_KRS + 16 * hi;
#pragma unroll
        for (int kt = 0; kt < 2; ++kt)
#pragma unroll
            for (int rr = 0; rr < 16; ++rr) sv[kt][rr] = 0.f;
#pragma unroll
        for (int ks = 0; ks < 8; ++ks) {
            sv[0] = mfma32(*(const bf16x8*)(Ks + 32 * ks), qf[ks], sv[0]);
            sv[1] = mfma32(*(const bf16x8*)(Ks + 32 * MB_KRS + 32 * ks), qf[ks], sv[1]);
        }
    };
    auto softmax_a = [&](int t, f32x16 (&sv)[2]) {
        const int kb = kb0 + t * 64;
        if (kb + 63 > wqmin) {
#pragma unroll
            for (int kt = 0; kt < 2; ++kt)
#pragma unroll
                for (int rr = 0; rr < 16; ++rr) { const int key = kb + 32 * kt + (rr & 3) + 8 * (rr >> 2) + 4 * hi; if (key > qpos) sv[kt][rr] = -__builtin_inff(); }
        }
        float tmax = sv[0][0];
#pragma unroll
        for (int rr = 1; rr < 16; ++rr) tmax = fmaxf(tmax, sv[0][rr]);
#pragma unroll
        for (int rr = 0; rr < 16; ++rr) tmax = fmaxf(tmax, sv[1][rr]);
        tmax = fmaxf(tmax, shx(tmax, 32, lane));
        const float mnew = fmaxf(mrun, tmax);
        const float alpha = ex2(mrun - mnew);
        mrun = mnew; mnew_ = mnew;
        lrun *= alpha;
        if (!__all(alpha == 1.f)) {
#pragma unroll
            for (int i = 0; i < 4; ++i)
#pragma unroll
                for (int rr = 0; rr < 16; ++rr) o[i][rr] *= alpha;
        }
    };
    auto softmax_b = [&](f32x16 (&sv)[2], bf16x8 (&pf)[2][2]) {
        const float mnew = mnew_;
        float ps = 0.f;
#pragma unroll
        for (int kt = 0; kt < 2; ++kt)
#pragma unroll
            for (int rr = 0; rr < 16; ++rr) { const float pv = ex2(sv[kt][rr] - mnew); sv[kt][rr] = pv; ps += pv; }
        lrun += ps;
#pragma unroll
        for (int kt = 0; kt < 2; ++kt)
#pragma unroll
            for (int s2 = 0; s2 < 2; ++s2) {
                u32x4 pw; pw.x = pk2(sv[kt][8 * s2 + 0], sv[kt][8 * s2 + 1]); pw.y = pk2(sv[kt][8 * s2 + 2], sv[kt][8 * s2 + 3]);
                pw.z = pk2(sv[kt][8 * s2 + 4], sv[kt][8 * s2 + 5]); pw.w = pk2(sv[kt][8 * s2 + 6], sv[kt][8 * s2 + 7]);
                pf[kt][s2] = *(const bf16x8*)&pw;
            }
    };
    auto pv = [&](int t, const bf16x8 (&pf)[2][2]) {
        const char* Vs = smem + 4 * MB_KB + t * MB_VB + c * MB_VRS + 8 * hi;
#pragma unroll
        for (int g = 0; g < 4; ++g) {
#pragma unroll
            for (int dvt = 0; dvt < 4; ++dvt) {
                const u32x2 v0 = *(const u32x2*)(Vs + 32 * dvt * MB_VRS + 32 * g), v1 = *(const u32x2*)(Vs + 32 * dvt * MB_VRS + 32 * g + 16);
                u32x4 vw; vw.x = v0.x; vw.y = v0.y; vw.z = v1.x; vw.w = v1.y;
                o[dvt] = mfma32(*(const bf16x8*)&vw, pf[g >> 1][g & 1], o[dvt]);
            }
        }
    };
    int nt_act = 4;
    if (wqmax != 0x7fffffff) { nt_act = ((wqmax - kb0) >> 6) + 1; if (nt_act > 4) nt_act = 4; }
    f32x16 sA[2], sB[2];
    qk(0, sA);
    for (int t = 0; t < nt_act; t += 2) {
        {
            bf16x8 pf[2][2];
            softmax_a(t, sA);
            if (t + 1 < nt_act) { qk(t + 1, sB); softmax_b(sA, pf); } else softmax_b(sA, pf);
            pv(t, pf);
        }
        if (t + 1 < nt_act) {
            bf16x8 pf[2][2];
            softmax_a(t + 1, sB);
            if (t + 2 < nt_act) { qk(t + 2, sA); softmax_b(sB, pf); } else softmax_b(sB, pf);
            pv(t + 1, pf);
        }
    }
    lrun += shx(lrun, 32, lane);
}
DEV void moba_subunit(const Params& p, int su, char* smem) {
    const int tid = opaque_tid(), lane = tid & 63, w = tid >> 6, c = lane & 31, hi = lane >> 5;
    int* pre = (int*)(smem + MB_TAB);
    const int* P = (const int*)(smem + MB_TAB + 256);
    int u = 0;
#pragma unroll
    for (int s = 128; s >= 1; s >>= 1) if (P[u + s] <= su) u += s;
    const int sidx = su - P[u], j = u >> 2, h = u & 3;
    const bf16_t* Kh = p.Kb() + ((size_t)h * S + 256 * j) * 128;
    const bf16_t* Vh = p.VbT() + ((size_t)h * 256 + 4 * j) * (128 * 64);
    __syncthreads();
    if (tid == 0) { int s = 0; for (int t = 0; t < 32; ++t) { pre[t] = s; s += p.segcnt()[((size_t)h * 64 + j) * 32 + t]; } pre[32] = s; }
#pragma unroll
    for (int i = 0; i < 8; ++i) {
        const int ch = tid + NTHREADS * i, row = ch >> 4, cc = ch & 15;
        *(u32x4*)(smem + (row >> 6) * MB_KB + (row & 63) * MB_KRS + cc * 16) = *(const u32x4*)((const char*)Kh + (size_t)ch * 16);
    }
#pragma unroll
    for (int i = 0; i < 8; ++i) {
        const int ch = tid + NTHREADS * i, t = ch >> 10, row = (ch >> 3) & 127, cc = ch & 7;
        const u32x4 v = *(const u32x4*)((const char*)Vh + (size_t)ch * 16);
        u32x2* d = (u32x2*)(smem + 4 * MB_KB + t * MB_VB + row * MB_VRS + cc * 16);
        d[0] = (u32x2){v.x, v.y}; d[1] = (u32x2){v.z, v.w};
    }
    __syncthreads();
    const int total = pre[32], ntiles = 1 + ((total + 255) >> 8);
    const int k_hi = (4 * sidx + 4) < ntiles ? (4 * sidx + 4) : ntiles;
    for (int k = 4 * sidx; k < k_hi; ++k) {
        const int k0 = (k - 1) * 256;
        int q, slot, qpos, wqmin, wqmax; bool valid, wact;
        if (k0 < 0) {
            q = 256 * j + 32 * w + c; slot = 3; qpos = q; wqmin = 256 * j + 32 * w; wqmax = wqmin + 31; valid = true; wact = true;
        } else {
            const int e = k0 + 32 * w + c; valid = e < total; q = 0; slot = 0;
            if (valid) {
                int seg = 0;
                for (int t = 1; t < 32; ++t) if (pre[t] <= e) seg = t;
                const int ent = p.lists()[(((size_t)h * 64 + j) * 32 + seg) * 512 + (e - pre[seg])];
                q = ent >> 2; slot = ent & 3;
            }
            qpos = 0x7fffffff; wqmin = 0x7fffffff; wqmax = 0x7fffffff; wact = (k0 + 32 * w) < total;
        }
        f32x16 o[4]; float m, l;
        moba_attn_resident(p.Qb() + ((size_t)h * S + q) * 128, wact, qpos, wqmin, wqmax, 256 * j, smem, o, m, l);
        if (valid) moba_write_partial(p, q, h, slot, o, m, l, hi);
    }
}

constexpr int GP_KN = 0, GP_KB = 17408, GP_QS = 34816, GP_RF = 52224, GP_LM = 117760, GP_KDT = 135168, GP_GC = 153600, GP_BT = 153856;
DEV void gdn_prep_unit(const Params& p, int li, int n, int h, char* smem) {
    const int tid = opaque_tid(), lane = tid & 63, w = tid >> 6, r = lane & 15, g = lane >> 4;
    char* Kn16 = smem + GP_KN; char* Kb16 = smem + GP_KB; char* Qs16 = smem + GP_QS;
    float* Rf = (float*)(smem + GP_RF); float* Lm = (float*)(smem + GP_LM); char* KdT = smem + GP_KDT;
    float* gc = (float*)(smem + GP_GC); float* bt = (float*)(smem + GP_BT);
    const size_t cb = (size_t)n * 4 + h;
    __syncthreads();
    if (w == 0) {
        const int tok = 64 * n + lane;
        const float a = p.ba()[(size_t)tok * 8 + 4 + h], bb = p.ba()[(size_t)tok * 8 + h];
        float gv = -expf(p.gdn_a_log[li * 4 + h]) * softplusf(a + p.gdn_dt_bias[li * 4 + h]);
#pragma unroll
        for (int o = 1; o < 64; o <<= 1) { const float t = __int_as_float(__builtin_amdgcn_ds_bpermute((lane - o) << 2, __float_as_int(gv))); if (lane >= o) gv += t; }
        gc[lane] = gv; bt[lane] = 1.f / (1.f + expf(-bb));
    }
    __syncthreads();
    const float glast = gc[63];
    {
        const int tok = tid >> 3, grp = tid & 7, gt = 64 * n + tok;
        const float gct = gc[tok], btt = bt[tok];
        const float egc = expf(gct), egl = expf(glast - gct);
        const float* cw = p.gdn_conv + (size_t)li * 4 * 1536;
#pragma unroll
        for (int part = 0; part < 3; ++part) {
            const int ch0 = part * 512 + h * 128 + grp * 16;
            float val[16];
#pragma unroll
            for (int i = 0; i < 16; ++i) val[i] = 0.f;
#pragma unroll
            for (int j = 0; j < 4; ++j) {
                const int ts = gt - 3 + j;
                if (ts >= 0) {
                    const u32x4* xp = (const u32x4*)(p.proj_a() + (size_t)ts * 1536 + ch0);
                    const u32x4 x0 = xp[0], x1 = xp[1];
                    const f32x4* wp = (const f32x4*)(cw + (size_t)j * 1536 + ch0);
                    const f32x4 w0 = wp[0], w1 = wp[1], w2 = wp[2], w3 = wp[3];
                    val[0] += bflo(x0.x) * w0[0]; val[1] += bfhi(x0.x) * w0[1]; val[2] += bflo(x0.y) * w0[2]; val[3] += bfhi(x0.y) * w0[3];
                    val[4] += bflo(x0.z) * w1[0]; val[5] += bfhi(x0.z) * w1[1]; val[6] += bflo(x0.w) * w1[2]; val[7] += bfhi(x0.w) * w1[3];
                    val[8] += bflo(x1.x) * w2[0]; val[9] += bfhi(x1.x) * w2[1]; val[10] += bflo(x1.y) * w2[2]; val[11] += bfhi(x1.y) * w2[3];
                    val[12] += bflo(x1.z) * w3[0]; val[13] += bfhi(x1.z) * w3[1]; val[14] += bflo(x1.w) * w3[2]; val[15] += bfhi(x1.w) * w3[3];
                }
            }
#pragma unroll
            for (int i = 0; i < 16; ++i) val[i] = siluf(val[i]);
            if (part < 2) {
                float ss = 0.f;
#pragma unroll
                for (int i = 0; i < 16; ++i) ss += val[i] * val[i];
                ss += shx(ss, 1, lane); ss += shx(ss, 2, lane); ss += shx(ss, 4, lane);
                const float rn = rsqrtf(ss + 1e-6f);
#pragma unroll
                for (int i = 0; i < 16; ++i) val[i] *= rn;
            }
            if (part == 0) {
                const float qs = 0.08838834764831845f;
                u32x4 a0, a1, d0, d1;
                a0.x = pk2(val[0] * qs, val[1] * qs); a0.y = pk2(val[2] * qs, val[3] * qs); a0.z = pk2(val[4] * qs, val[5] * qs); a0.w = pk2(val[6] * qs, val[7] * qs);
                a1.x = pk2(val[8] * qs, val[9] * qs); a1.y = pk2(val[10] * qs, val[11] * qs); a1.z = pk2(val[12] * qs, val[13] * qs); a1.w = pk2(val[14] * qs, val[15] * qs);
                *(u32x4*)(Qs16 + tok * 272 + grp * 32) = a0; *(u32x4*)(Qs16 + tok * 272 + grp * 32 + 16) = a1;
                const float qd = qs * egc;
                d0.x = pk2(val[0] * qd, val[1] * qd); d0.y = pk2(val[2] * qd, val[3] * qd); d0.z = pk2(val[4] * qd, val[5] * qd); d0.w = pk2(val[6] * qd, val[7] * qd);
                d1.x = pk2(val[8] * qd, val[9] * qd); d1.y = pk2(val[10] * qd, val[11] * qd); d1.z = pk2(val[12] * qd, val[13] * qd); d1.w = pk2(val[14] * qd, val[15] * qd);
                bf16_t* qo = p.qdec() + (((cb * 4 + (tok >> 4)) * 4 + (grp >> 1)) * 64 + (2 * (grp & 1)) * 16 + (tok & 15)) * 8;
                *(u32x4*)qo = d0; *(u32x4*)(qo + 16 * 8) = d1;
            } else if (part == 1) {
                u32x4 a0, a1, d0, d1;
                a0.x = pk2(val[0], val[1]); a0.y = pk2(val[2], val[3]); a0.z = pk2(val[4], val[5]); a0.w = pk2(val[6], val[7]);
                a1.x = pk2(val[8], val[9]); a1.y = pk2(val[10], val[11]); a1.z = pk2(val[12], val[13]); a1.w = pk2(val[14], val[15]);
                *(u32x4*)(Kn16 + tok * 272 + grp * 32) = a0; *(u32x4*)(Kn16 + tok * 272 + grp * 32 + 16) = a1;
                d0.x = pk2(val[0] * btt, val[1] * btt); d0.y = pk2(val[2] * btt, val[3] * btt); d0.z = pk2(val[4] * btt, val[5] * btt); d0.w = pk2(val[6] * btt, val[7] * btt);
                d1.x = pk2(val[8] * btt, val[9] * btt); d1.y = pk2(val[10] * btt, val[11] * btt); d1.z = pk2(val[12] * btt, val[13] * btt); d1.w = pk2(val[14] * btt, val[15] * btt);
                *(u32x4*)(Kb16 + tok * 272 + grp * 32) = d0; *(u32x4*)(Kb16 + tok * 272 + grp * 32 + 16) = d1;
                const float kb = btt * egc;
#pragma unroll
                for (int i = 0; i < 16; ++i) {
                    Rf[tok * 256 + 128 + grp * 16 + i] = val[i] * kb;
                    *(bf16_t*)(KdT + (grp * 16 + i) * 144 + tok * 2) = f2bf(val[i] * egl);
                }
            } else {
#pragma unroll
                for (int i = 0; i < 16; ++i) Rf[tok * 256 + grp * 16 + i] = val[i] * btt;
            }
        }
    }
    __syncthreads();
#pragma unroll
    for (int tt = 0; tt < 2; ++tt) {
        const int tile = 2 * w + tt, ct = tile >> 2, mt = tile & 3;
        f32x4 accL = {0.f, 0.f, 0.f, 0.f}, accQ = {0.f, 0.f, 0.f, 0.f};
#pragma unroll
        for (int ks = 0; ks < 4; ++ks) {
            const bf16x8 akb = *(const bf16x8*)(Kb16 + (16 * ct + r) * 272 + (32 * ks + 8 * g) * 2);
            const bf16x8 knm = *(const bf16x8*)(Kn16 + (16 * mt + r) * 272 + (32 * ks + 8 * g) * 2);
            const bf16x8 qsc = *(const bf16x8*)(Qs16 + (16 * ct + r) * 272 + (32 * ks + 8 * g) * 2);
            accL = mfma16(akb, knm, accL);
            accQ = mfma16(knm, qsc, accQ);
        }
#pragma unroll
        for (int jj = 0; jj < 4; ++jj) {
            const int ci = 16 * ct + 4 * g + jj, mi = 16 * mt + r;
            Lm[ci * 68 + mi] = (mi < ci) ? accL[jj] * expf(gc[ci] - gc[mi]) : 0.f;
        }
        {
            const int ci = 16 * ct + r;
            f32x4 v;
#pragma unroll
            for (int jj = 0; jj < 4; ++jj) { const int mi = 16 * mt + 4 * g + jj; v[jj] = (mi <= ci) ? accQ[jj] * expf(gc[ci] - gc[mi]) : 0.f; }
            { const int m0_ = 16 * mt + 4 * g;
              st_bf4(p.qk() + (((cb * 4 + ct) * 2 + (m0_ >> 5)) * 64 + ((m0_ >> 3) & 3) * 16 + r) * 8 + (m0_ & 7), v); }
        }
    }
#pragma unroll
    for (int i = 0; i < 2; ++i) {
        const int ch = tid + NTHREADS * i, row = ch >> 3, cc = ch & 7;
        *(u32x4*)(p.kdT() + (((cb * 8 + (row >> 4)) * 2 + (cc >> 2)) * 64 + (cc & 3) * 16 + (row & 15)) * 8) = *(const u32x4*)(KdT + row * 144 + cc * 16);
    }
    __syncthreads();
    if (w < 4) {
        const int col = tid;
        float x[64];
#pragma unroll
        for (int i = 0; i < 64; ++i) {
            float a = Rf[i * 256 + col];
#pragma unroll
            for (int j4 = 0; j4 < (i + 3) / 4; ++j4) {
                const f32x4 l4 = *(const f32x4*)(Lm + i * 68 + 4 * j4);
#pragma unroll
                for (int jj = 0; jj < 4; ++jj) if (4 * j4 + jj < i) a -= l4[jj] * x[4 * j4 + jj];
            }
            x[i] = a;
        }
        if (col < 128) {
#pragma unroll
            for (int i4 = 0; i4 < 16; ++i4) {
                float* up_ = p.u32() + ((((cb * 4 + (i4 >> 2)) * 8 + (col >> 4)) * 64 + (i4 & 3) * 16 + (col & 15)) * 4);
                *(f32x4*)up_ = (f32x4){x[4 * i4], x[4 * i4 + 1], x[4 * i4 + 2], x[4 * i4 + 3]};
            }
        } else {
#pragma unroll
            for (int i = 0; i < 64; ++i) { const int cc_ = col - 128; p.wneg()[(((cb * 4 + (i >> 4)) * 4 + (cc_ >> 5)) * 64 + ((cc_ >> 3) & 3) * 16 + (i & 15)) * 8 + (cc_ & 7)] = f2bf(-x[i]); }
        }
    }
    if (tid == 0) p.glast()[cb] = expf(glast);
}

struct ScanFr { bf16x8 af[4]; bf16x8 qkf[2]; bf16x8 kdf[2]; f32x4 u[2]; float eg; };
DEV void gdn_scan_seg(const Params& p, int sw, int nbeg, int nend, float* __restrict__ scanst, char* smem) {
    const int tid = opaque_tid(), lane = tid & 63, w = tid >> 6, r = lane & 15, g = lane >> 4;
    const int h = sw >> 2, dvb = (sw & 3) * 32;
    const bool lead = w < 4; const int mt = w & 3;
    char* S16 = smem; char* Vn16 = smem + 8704;
    if (nbeg >= nend) return;
    float* stp = scanst + ((size_t)sw * NTHREADS + tid) * 8;
    __syncthreads();
    f32x4 sacc[2] = {{0.f, 0.f, 0.f, 0.f}, {0.f, 0.f, 0.f, 0.f}};
    if (nbeg > 0) { sacc[0] = *(const f32x4*)stp; sacc[1] = *(const f32x4*)(stp + 4); }
#pragma unroll
    for (int n2 = 0; n2 < 2; ++n2)
        *(u32x2*)(S16 + (16 * n2 + r) * 272 + (16 * w + 4 * g) * 2) = (u32x2){pk2(sacc[n2][0], sacc[n2][1]), pk2(sacc[n2][2], sacc[n2][3])};
    auto load = [&](int n, ScanFr& f) {
        const size_t cb = (size_t)n * 4 + h;
        const bf16_t* ap = (lead ? p.wneg() : p.qdec()) + ((cb * 4 + mt) * 4) * 512 + lane * 8;
#pragma unroll
        for (int ks = 0; ks < 4; ++ks) f.af[ks] = *(const bf16x8*)(ap + ks * 512);
        const bf16_t* kp = p.kdT() + ((cb * 8 + w) * 2) * 512 + lane * 8;
#pragma unroll
        for (int ks = 0; ks < 2; ++ks) f.kdf[ks] = *(const bf16x8*)(kp + ks * 512);
        if (lead) {
            const float* up = p.u32() + (((cb * 4 + mt) * 8 + (dvb >> 4)) * 64 + lane) * 4;
            f.u[0] = *(const f32x4*)up; f.u[1] = *(const f32x4*)(up + 256);
        } else {
            const bf16_t* qkp = p.qk() + ((cb * 4 + mt) * 2) * 512 + lane * 8;
#pragma unroll
            for (int ks = 0; ks < 2; ++ks) f.qkf[ks] = *(const bf16x8*)(qkp + ks * 512);
        }
        f.eg = p.glast()[cb];
    };
    ScanFr fA, fB, fC, fD; load(nbeg, fA); load(nbeg + 1, fB); load(nbeg + 2, fC);
    __syncthreads();
    auto step = [&](int n, ScanFr& cu, ScanFr& nx3) {
        if (n + 3 < nend) load(n + 3, nx3);
        f32x4 a[2];
        if (lead) { a[0] = cu.u[0]; a[1] = cu.u[1]; } else { a[0] = (f32x4){0.f, 0.f, 0.f, 0.f}; a[1] = a[0]; }
#pragma unroll
        for (int ks = 0; ks < 4; ++ks) {
#pragma unroll
            for (int nt = 0; nt < 2; ++nt) {
                const bf16x8 sf = *(const bf16x8*)(S16 + (16 * nt + r) * 272 + (32 * ks + 8 * g) * 2);
                a[nt] = mfma16(cu.af[ks], sf, a[nt]);
            }
        }
        if (lead) {
#pragma unroll
            for (int nt = 0; nt < 2; ++nt)
                *(u32x2*)(Vn16 + (16 * nt + r) * 144 + (16 * mt + 4 * g) * 2) = (u32x2){pk2(a[nt][0], a[nt][1]), pk2(a[nt][2], a[nt][3])};
        }
        asm volatile("s_waitcnt lgkmcnt(0)" ::: "memory"); __builtin_amdgcn_s_barrier(); asm volatile("" ::: "memory");
        bf16x8 vf[2][2];
#pragma unroll
        for (int nt = 0; nt < 2; ++nt)
#pragma unroll
            for (int ks = 0; ks < 2; ++ks) vf[nt][ks] = *(const bf16x8*)(Vn16 + (16 * nt + r) * 144 + (32 * ks + 8 * g) * 2);
        if (!lead) {
#pragma unroll
            for (int nt = 0; nt < 2; ++nt) {
#pragma unroll
                for (int ks = 0; ks < 2; ++ks) a[nt] = mfma16(cu.qkf[ks], vf[nt][ks], a[nt]);
                *(f32x4*)(p.oa() + ((((size_t)n * 4 + mt) * 32 + (h * 8 + (dvb >> 4) + nt)) * 64 + lane) * 4) = a[nt];
            }
        }
#pragma unroll
        for (int n2 = 0; n2 < 2; ++n2) {
            sacc[n2] = sacc[n2] * cu.eg;
#pragma unroll
            for (int ks = 0; ks < 2; ++ks) sacc[n2] = mfma16(cu.kdf[ks], vf[n2][ks], sacc[n2]);
            *(u32x2*)(S16 + (16 * n2 + r) * 272 + (16 * w + 4 * g) * 2) = (u32x2){pk2(sacc[n2][0], sacc[n2][1]), pk2(sacc[n2][2], sacc[n2][3])};
        }
        asm volatile("s_waitcnt lgkmcnt(0)" ::: "memory"); __builtin_amdgcn_s_barrier(); asm volatile("" ::: "memory");
    };
    for (int n = nbeg; n < nend; n += 4) { step(n, fA, fD); step(n + 1, fB, fA); step(n + 2, fC, fB); step(n + 3, fD, fC); }
    *(f32x4*)stp = sacc[0]; *(f32x4*)(stp + 4) = sacc[1];
}

DEV void phase_even_combine(const Params& p, int li) {
    const int tid = opaque_tid(), lane = tid & 63, w = __builtin_amdgcn_readfirstlane(tid >> 6), hh = lane >> 4, d0 = (lane & 15) * 8;
    for (int tok = opaque_bid() * 8 + w; tok < S; tok += gridDim.x * 8) {
        {
            const int col0 = hh * 128 + d0;
            const float* op = p.oa() + (((((size_t)(tok >> 6)) * 4 + ((tok & 63) >> 4)) * 32 + (col0 >> 4)) * 64 + ((tok & 15) >> 2) * 16 + (col0 & 15)) * 4 + (tok & 3);
            const f32x4 a = {op[0], op[4], op[8], op[12]}, b = {op[16], op[20], op[24], op[28]};
            float ss = a[0] * a[0] + a[1] * a[1] + a[2] * a[2] + a[3] * a[3] + b[0] * b[0] + b[1] * b[1] + b[2] * b[2] + b[3] * b[3];
            ss += shx(ss, 1, lane); ss += shx(ss, 2, lane); ss += shx(ss, 4, lane); ss += shx(ss, 8, lane);
            const float rn = rsqrtf(ss * (1.f / 128.f) + 1e-6f);
            const u32x4 z = *(const u32x4*)(p.zbuf() + (size_t)tok * 512 + hh * 128 + d0);
            const f32x4 n0 = *(const f32x4*)(p.gdn_o_norm + li * 128 + d0), n1 = *(const f32x4*)(p.gdn_o_norm + li * 128 + d0 + 4);
            u32x4 o;
            o.x = pk2(a[0] * rn * n0[0] * siluf(bflo(z.x)), a[1] * rn * n0[1] * siluf(bfhi(z.x)));
            o.y = pk2(a[2] * rn * n0[2] * siluf(bflo(z.y)), a[3] * rn * n0[3] * siluf(bfhi(z.y)));
            o.z = pk2(b[0] * rn * n1[0] * siluf(bflo(z.z)), b[1] * rn * n1[1] * siluf(bfhi(z.z)));
            o.w = pk2(b[2] * rn * n1[2] * siluf(bflo(z.w)), b[3] * rn * n1[3] * siluf(bfhi(z.w)));
            *(u32x4*)(p.cat() + (size_t)tok * DM + hh * 128 + d0) = o;
        }
        {
            const int own = tok >> 8, nsel = own < 3 ? own : 3;
            const float* mlp = p.ml() + ((size_t)tok * 4 + hh) * 8;
            const bf16_t* pp = (const bf16_t*)p.part() + ((size_t)tok * 4 + hh) * 4 * 128 + d0;
            const float m3 = mlp[6], l3 = mlp[7];
            float ms[3], ls[3]; float mm = m3;
#pragma unroll
            for (int s = 0; s < 3; ++s) { ms[s] = -1e30f; ls[s] = 0.f; if (s < nsel) { ms[s] = mlp[2 * s]; ls[s] = mlp[2 * s + 1]; mm = fmaxf(mm, ms[s]); } }
            float wt = ex2(m3 - mm) * l3, den = wt;
            f32x4 a, b;
            { const u32x4 v = *(const u32x4*)(pp + 3 * 128); a = (f32x4){bflo(v.x), bfhi(v.x), bflo(v.y), bfhi(v.y)} * wt; b = (f32x4){bflo(v.z), bfhi(v.z), bflo(v.w), bfhi(v.w)} * wt; }
#pragma unroll
            for (int s = 0; s < 3; ++s) if (s < nsel) {
                wt = ex2(ms[s] - mm) * ls[s]; den += wt;
                const u32x4 v = *(const u32x4*)(pp + s * 128);
                a += (f32x4){bflo(v.x), bfhi(v.x), bflo(v.y), bfhi(v.y)} * wt; b += (f32x4){bflo(v.z), bfhi(v.z), bflo(v.w), bfhi(v.w)} * wt;
            }
            const float inv = 1.f / den;
            u32x4 o; o.x = pk2(a[0] * inv, a[1] * inv); o.y = pk2(a[2] * inv, a[3] * inv); o.z = pk2(b[0] * inv, b[1] * inv); o.w = pk2(b[2] * inv, b[3] * inv);
            *(u32x4*)(p.cat() + (size_t)tok * DM + 512 + hh * 128 + d0) = o;
        }
    }
}

DEV void phase_mla_cnorm(const Params& p, int li) {
    const int tid = opaque_tid(), lane = tid & 63, w = __builtin_amdgcn_readfirstlane(tid >> 6);
    for (int row = opaque_bid() * 8 + w; row < S; row += gridDim.x * 8) {
        const bf16_t* cp = p.cbuf() + (size_t)row * 768;
        const u32x4 qv = *(const u32x4*)(cp + lane * 8);
        const u32x2 kv = *(const u32x2*)(cp + 512 + lane * 4);
        float q[8] = {bflo(qv.x), bfhi(qv.x), bflo(qv.y), bfhi(qv.y), bflo(qv.z), bfhi(qv.z), bflo(qv.w), bfhi(qv.w)};
        float k[4] = {bflo(kv.x), bfhi(kv.x), bflo(kv.y), bfhi(kv.y)};
        float sq = 0.f, sk = 0.f;
#pragma unroll
        for (int i = 0; i < 8; ++i) sq += q[i] * q[i];
#pragma unroll
        for (int i = 0; i < 4; ++i) sk += k[i] * k[i];
        sq = wsum64(sq, lane); sk = wsum64(sk, lane);
        const float rq = rsqrtf(sq * (1.f / 512.f) + 1e-6f), rk = rsqrtf(sk * (1.f / 256.f) + 1e-6f);
        const float* qn = p.mla_q_norm + li * 512 + lane * 8; const float* kn = p.mla_kv_norm + li * 256 + lane * 4;
        u32x4 oq; oq.x = pk2(q[0] * rq * qn[0], q[1] * rq * qn[1]); oq.y = pk2(q[2] * rq * qn[2], q[3] * rq * qn[3]);
        oq.z = pk2(q[4] * rq * qn[4], q[5] * rq * qn[5]); oq.w = pk2(q[6] * rq * qn[6], q[7] * rq * qn[7]);
        *(u32x4*)(p.cqn() + (size_t)row * 512 + lane * 8) = oq;
        u32x2 ok; ok.x = pk2(k[0] * rk * kn[0], k[1] * rk * kn[1]); ok.y = pk2(k[2] * rk * kn[2], k[3] * rk * kn[3]);
        *(u32x2*)(p.ckvn() + (size_t)row * 256 + lane * 4) = ok;
    }
}

#define SORT16_NET(CE) CE(0,1) CE(2,3) CE(0,2) CE(1,3) CE(1,2) CE(4,5) CE(6,7) CE(4,6) CE(5,7) CE(5,6) CE(0,4) CE(2,6) CE(2,4) CE(1,5) CE(3,7) CE(3,5) CE(1,2) CE(3,4) CE(5,6) CE(8,9) CE(10,11) CE(8,10) CE(9,11) CE(9,10) CE(12,13) CE(14,15) CE(12,14) CE(13,15) CE(13,14) CE(8,12) CE(10,14) CE(10,12) CE(9,13) CE(11,15) CE(11,13) CE(9,10) CE(11,12) CE(13,14) CE(0,8) CE(4,12) CE(4,8) CE(2,10) CE(6,14) CE(6,10) CE(2,4) CE(6,8) CE(10,12) CE(1,9) CE(5,13) CE(5,9) CE(3,11) CE(7,15) CE(7,11) CE(3,5) CE(7,9) CE(11,13) CE(1,2) CE(3,4) CE(5,6) CE(7,8) CE(9,10) CE(11,12) CE(13,14)

template <int OFF> DEV void sort16(float (&v)[64]) {
#define CE_(a, b) { const float hi_ = fmaxf(v[OFF + a], v[OFF + b]), lo_ = fminf(v[OFF + a], v[OFF + b]); v[OFF + a] = hi_; v[OFF + b] = lo_; }
    SORT16_NET(CE_)
#undef CE_
}
template <int A> DEV void bitonic16(float (&v)[64]) {
#pragma unroll
    for (int d = 8; d >= 1; d >>= 1)
#pragma unroll
        for (int i = 0; i < 16; ++i) if ((i & d) == 0) { const float hi_ = fmaxf(v[A + i], v[A + i + d]), lo_ = fminf(v[A + i], v[A + i + d]); v[A + i] = hi_; v[A + i + d] = lo_; }
}
template <int A, int B> DEV void merge16(float (&v)[64]) {
#pragma unroll
    for (int i = 0; i < 16; ++i) v[A + i] = fmaxf(v[A + i], v[B + 15 - i]);
    bitonic16<A>(v);
}
DEV void top16_of_64(float (&v)[64]) {
    sort16<0>(v); sort16<16>(v); sort16<32>(v); sort16<48>(v);
    merge16<0, 16>(v); merge16<32, 48>(v); merge16<0, 32>(v);
}

DEV void phase_peer_topk(const Params& p, int layer, char* smem) {
    const int tid = opaque_tid(), lane = tid & 63, w = tid >> 6, c = lane & 31, hi = lane >> 5;
    char* SK = smem;
    constexpr int CI[50] = {0,0,0,0,0,0,0,0,0,0,0,0,0,0,0,0, 1,1,1,1,1,1,1,1, 2,2,2,2,2, 3,3,3,3, 4,4,4, 5,5, 6,6, 7,7, 8,9,10,11,12,13,14,15};
    constexpr int CJ[50] = {0,1,2,3,4,5,6,7,8,9,10,11,12,13,14,15, 0,1,2,3,4,5,6,7, 0,1,2,3,4, 0,1,2,3, 0,1,2, 0,1, 0,1, 0,1, 0,0,0,0,0,0,0,0};
    int loaded_h = -1;
    for (int u = opaque_bid(); u < 512; u += gridDim.x) {
        const int h = u & 7, tg = u >> 3;
        if (h != loaded_h) {
            __syncthreads();
#pragma unroll
            for (int i = 0; i < 8; ++i) {
                const int ch = tid + NTHREADS * i, pp = ch >> 11, rem = ch & 2047, row = rem >> 4, cc = rem & 15;
                *(u32x4*)(SK + pp * 34816 + row * 272 + cc * 16) = *(const u32x4*)(p.skb() + ((((size_t)layer * 8 + h) * 2 + pp) * 128 + row) * 128 + cc * 8);
            }
            __syncthreads();
            loaded_h = h;
        }
        const int token = tg * 256 + 32 * w + c;
        float s0[16], s1[16];
#pragma unroll
        for (int pp = 0; pp < 2; ++pp) {
            bf16x8 qf[8];
            const bf16_t* qp = p.qbuf() + (size_t)token * 2048 + (h * 2 + pp) * 128 + 8 * hi;
#pragma unroll
            for (int ks = 0; ks < 8; ++ks) qf[ks] = *(const bf16x8*)(qp + 16 * ks);
            float v[64];
#pragma unroll
            for (int kt = 0; kt < 4; ++kt) {
                f32x16 acc;
#pragma unroll
                for (int rr = 0; rr < 16; ++rr) acc[rr] = 0.f;
#pragma unroll
                for (int ks = 0; ks < 8; ++ks) acc = mfma32(*(const bf16x8*)(SK + pp * 34816 + (32 * kt + c) * 272 + (16 * ks + 8 * hi) * 2), qf[ks], acc);
#pragma unroll
                for (int rr = 0; rr < 16; ++rr) {
                    const unsigned idx = (unsigned)(32 * kt + (rr & 3) + 8 * (rr >> 2) + 4 * hi);
                    v[16 * kt + rr] = __uint_as_float((__float_as_uint(acc[rr]) & ~127u) | idx);
                }
            }
            top16_of_64(v);
#pragma unroll
            for (int i = 0; i < 16; ++i) v[16 + i] = shx(v[15 - i], 32, lane);
#pragma unroll
            for (int i = 0; i < 16; ++i) v[i] = fmaxf(v[i], v[16 + i]);
            bitonic16<0>(v);
#pragma unroll
            for (int i = 0; i < 16; ++i) { if (pp == 0) s0[i] = v[i]; else s1[i] = v[i]; }
        }
        float cv[64];
#pragma unroll
        for (int k = 0; k < 50; ++k) {
            const float a = s0[CI[k]], b = s1[CJ[k]];
            const unsigned id = ((__float_as_uint(a) & 127u) << 7) | (__float_as_uint(b) & 127u);
            cv[k] = __uint_as_float((__float_as_uint(a + b) & ~0x3FFFu) | id);
        }
#pragma unroll
        for (int k = 50; k < 64; ++k) cv[k] = -__builtin_inff();
        top16_of_64(cv);
        float e[16], sum = 0.f;
#pragma unroll
        for (int i = 0; i < 16; ++i) { e[i] = expf(cv[i] - cv[0]); sum += e[i]; }
        const float inv = 1.f / sum;
        if (hi == 0) {
            int* ep = p.expert() + (size_t)token * 128 + h * 16; float* gp = p.gate() + (size_t)token * 128 + h * 16;
#pragma unroll
            for (int i4 = 0; i4 < 4; ++i4) {
                i32x4 ev; ev.x = (int)(__float_as_uint(cv[4 * i4]) & 0x3FFFu); ev.y = (int)(__float_as_uint(cv[4 * i4 + 1]) & 0x3FFFu);
                ev.z = (int)(__float_as_uint(cv[4 * i4 + 2]) & 0x3FFFu); ev.w = (int)(__float_as_uint(cv[4 * i4 + 3]) & 0x3FFFu);
                *(i32x4*)(ep + 4 * i4) = ev;
                *(f32x4*)(gp + 4 * i4) = (f32x4){e[4 * i4] * inv, e[4 * i4 + 1] * inv, e[4 * i4 + 2] * inv, e[4 * i4 + 3] * inv};
            }
        }
    }
}

typedef float f32x2 __attribute__((ext_vector_type(2)));
DEV void unpack_fp4x16(const u32x2& r, f32x2 (&f)[8]) {
#pragma unroll
    for (int q = 0; q < 2; ++q) {
        f[4 * q + 0] = __builtin_amdgcn_cvt_scalef32_pk_f32_fp4(r[q], 1.0f, 0);
        f[4 * q + 1] = __builtin_amdgcn_cvt_scalef32_pk_f32_fp4(r[q], 1.0f, 1);
        f[4 * q + 2] = __builtin_amdgcn_cvt_scalef32_pk_f32_fp4(r[q], 1.0f, 2);
        f[4 * q + 3] = __builtin_amdgcn_cvt_scalef32_pk_f32_fp4(r[q], 1.0f, 3);
    }
}

template <int NMODE>
DEV void phase_peer_gather(const Params& p, int layer, const float* __restrict__ g2, const float* __restrict__ xsrc, float* __restrict__ xdst,
                           const float* __restrict__ nw, const float* __restrict__ shv, const float* __restrict__ scv, const float* __restrict__ w8src, char* smem) {
    const int tid = opaque_tid(), lane = tid & 63, w = __builtin_amdgcn_readfirstlane(tid >> 6);
    float* W8 = (float*)smem;
    if (NMODE == 1) {
        for (int i = tid; i < 8192; i += NTHREADS) { const int k = i >> 3, c = i & 7; W8[c * 1024 + k] = w8src[(size_t)k * HY_IN + 2048 + c]; }
        __syncthreads();
    }
    f32x4 wm[4], sh[4];
#pragma unroll
    for (int i = 0; i < 4; ++i) {
        const f32x4 nv = *(const f32x4*)(nw + lane * 16 + 4 * i);
        if (NMODE == 2) { wm[i] = nv; sh[i] = (f32x4){0.f, 0.f, 0.f, 0.f}; }
        else { wm[i] = nv * (*(const f32x4*)(scv + lane * 16 + 4 * i) + 1.0f); sh[i] = *(const f32x4*)(shv + lane * 16 + 4 * i); }
    }
    const unsigned char* ub = p.ub() + (size_t)layer * 16384 * 512; const unsigned char* vb = p.vb() + (size_t)layer * 16384 * 512;
    const unsigned lo8 = (unsigned)lane * 8u;
    const int idxl = ((lane >> 5) & 1) * 8 + ((lane >> 4) & 1) * 4 + ((lane >> 3) & 1) * 2 + ((lane >> 2) & 1);
    for (int tok = opaque_bid() * 8 + w; tok < S; tok += gridDim.x * 8) {
        int hA0, hA1, hB0, hB1; float kh;
        {
            const u32x4 h0 = *(const u32x4*)(p.h() + (size_t)tok * DM + lane * 16), h1 = *(const u32x4*)(p.h() + (size_t)tok * DM + lane * 16 + 8);
            float hf[16] = {bflo(h0.x), bfhi(h0.x), bflo(h0.y), bfhi(h0.y), bflo(h0.z), bfhi(h0.z), bflo(h0.w), bfhi(h0.w),
                            bflo(h1.x), bfhi(h1.x), bflo(h1.y), bfhi(h1.y), bflo(h1.z), bfhi(h1.z), bflo(h1.w), bfhi(h1.w)};
            float mx = 0.f;
#pragma unroll
            for (int i = 0; i < 16; ++i) mx = fmaxf(mx, fabsf(hf[i]));
#pragma unroll
            for (int o = 32; o; o >>= 1) mx = fmaxf(mx, shx(mx, o, lane));
            kh = 119.f / fmaxf(mx, 1e-20f);
            unsigned a0 = 0, a1 = 0, b0 = 0, b1 = 0;
#pragma unroll
            for (int i = 0; i < 16; ++i) {
                const int h8 = (int)__builtin_rintf(hf[i] * kh);
                const int lo = ((h8 + 8) & 15) - 8, hi4 = (h8 - lo) >> 4;
                if (i < 8) { a0 |= ((unsigned)hi4 & 15u) << (4 * i); b0 |= ((unsigned)lo & 15u) << (4 * i); }
                else { a1 |= ((unsigned)hi4 & 15u) << (4 * (i - 8)); b1 |= ((unsigned)lo & 15u) << (4 * (i - 8)); }
            }
            hA0 = (int)a0; hA1 = (int)a1; hB0 = (int)b0; hB1 = (int)b1;
        }
        const int e0 = p.expert()[(size_t)tok * 128 + lane], e1 = p.expert()[(size_t)tok * 128 + 64 + lane];
        u32x2 rA[16], rB[16];
        auto req = [&](int bi, u32x2 (&rr)[16]) {
            const unsigned char* tb = bi < 8 ? ub : vb; const int b = bi & 7;
#pragma unroll
            for (int k = 0; k < 16; ++k) {
                const int e = __builtin_amdgcn_readlane(b < 4 ? e0 : e1, (b & 3) * 16 + k);
                rr[k] = *(const u32x2*)(tb + ((unsigned)e * 512u + lo8));
            }
        };
        float coef[8];
        f32x2 acc[8];
#pragma unroll
        for (int i = 0; i < 8; ++i) acc[i] = (f32x2){0.f, 0.f};
        auto use_u = [&](int b, const u32x2 (&rr)[16]) {
            float pt[16];
#pragma unroll
            for (int k = 0; k < 16; ++k) {
                int shi = __builtin_amdgcn_sdot8((int)rr[k].x, hA0, 0, false); shi = __builtin_amdgcn_sdot8((int)rr[k].y, hA1, shi, false);
                int slo = __builtin_amdgcn_sdot8((int)rr[k].x, hB0, 0, false); slo = __builtin_amdgcn_sdot8((int)rr[k].y, hB1, slo, false);
                pt[k] = (float)(16 * shi + slo);
            }
#pragma unroll
            for (int k = 0; k < 8; ++k) { const bool up = (lane & 32) != 0; const float send = up ? pt[k] : pt[k + 8], keep = up ? pt[k + 8] : pt[k]; pt[k] = keep + shx(send, 32, lane); }
#pragma unroll
            for (int k = 0; k < 4; ++k) { const bool up = (lane & 16) != 0; const float send = up ? pt[k] : pt[k + 4], keep = up ? pt[k + 4] : pt[k]; pt[k] = keep + shx(send, 16, lane); }
#pragma unroll
            for (int k = 0; k < 2; ++k) { const bool up = (lane & 8) != 0; const float send = up ? pt[k] : pt[k + 2], keep = up ? pt[k + 2] : pt[k]; pt[k] = keep + shx(send, 8, lane); }
            { const bool up = (lane & 4) != 0; const float send = up ? pt[0] : pt[1], keep = up ? pt[1] : pt[0]; pt[0] = keep + shx(send, 4, lane); }
            pt[0] += shx(pt[0], 2, lane); pt[0] += shx(pt[0], 1, lane);
            const float gv = p.gate()[(size_t)tok * 128 + b * 16 + idxl];
            const float d = pt[0] * (1.f / 96.f) / kh;
            coef[b] = gv * 0.5f * d * (1.f + erff(d * 0.70710678118654752f)) * 0.176776695f;
        };
        auto use_v = [&](int b, const u32x2 (&rr)[16]) {
#pragma unroll
            for (int k = 0; k < 16; ++k) {
                const int src = ((k >> 3) & 1) * 32 + ((k >> 2) & 1) * 16 + ((k >> 1) & 1) * 8 + (k & 1) * 4;
                const float cf = __uint_as_float((unsigned)__builtin_amdgcn_readlane((int)__float_as_uint(coef[b]), src));
                f32x2 f[8]; unpack_fp4x16(rr[k], f);
                const f32x2 cf2 = (f32x2){cf, cf};
#pragma unroll
                for (int i = 0; i < 8; ++i) acc[i] += cf2 * f[i];
            }
        };
        req(0, rA);
#pragma unroll
        for (int bi = 0; bi < 16; bi += 2) {
            req(bi + 1, rB);
            if (bi < 8) use_u(bi, rA); else use_v(bi - 8, rA);
            __builtin_amdgcn_sched_barrier(0);
            if (bi + 2 < 16) req(bi + 2, rA);
            if (bi + 1 < 8) use_u(bi + 1, rB); else use_v(bi + 1 - 8, rB);
            __builtin_amdgcn_sched_barrier(0);
        }
        const float* xp = xsrc + (size_t)tok * DM + lane * 16; float* xo = xdst + (size_t)tok * DM + lane * 16; const float* gp = g2 + lane * 16;
        f32x4 xn[4]; float ss = 0.f;
#pragma unroll
        for (int i4 = 0; i4 < 4; ++i4) {
            const f32x4 xv = *(const f32x4*)(xp + 4 * i4), gg = *(const f32x4*)(gp + 4 * i4);
            f32x4 o; o[0] = xv[0] + gg[0] * acc[2 * i4][0]; o[1] = xv[1] + gg[1] * acc[2 * i4][1]; o[2] = xv[2] + gg[2] * acc[2 * i4 + 1][0]; o[3] = xv[3] + gg[3] * acc[2 * i4 + 1][1];
            if (NMODE != 2) *(f32x4*)(xo + 4 * i4) = o;
            xn[i4] = o; ss += o[0] * o[0] + o[1] * o[1] + o[2] * o[2] + o[3] * o[3];
        }
        ss = wsum64(ss, lane);
        const float rn = rsqrtf(ss * (1.f / 1024.f) + 1e-6f);
#pragma unroll
        for (int i4 = 0; i4 < 4; ++i4) xn[i4] = xn[i4] * rn * wm[i4] + sh[i4];
        if (NMODE == 2) {
#pragma unroll
            for (int i4 = 0; i4 < 4; ++i4) *(f32x4*)(p.out + (size_t)tok * DM + lane * 16 + 4 * i4) = xn[i4];
        } else {
            u32x4 o0, o1;
            o0.x = pk2(xn[0][0], xn[0][1]); o0.y = pk2(xn[0][2], xn[0][3]); o0.z = pk2(xn[1][0], xn[1][1]); o0.w = pk2(xn[1][2], xn[1][3]);
            o1.x = pk2(xn[2][0], xn[2][1]); o1.y = pk2(xn[2][2], xn[2][3]); o1.z = pk2(xn[3][0], xn[3][1]); o1.w = pk2(xn[3][2], xn[3][3]);
            *(u32x4*)(p.h() + (size_t)tok * DM + lane * 16) = o0; *(u32x4*)(p.h() + (size_t)tok * DM + lane * 16 + 8) = o1;
        }
        if (NMODE == 1) {
            float pc[8];
#pragma unroll
            for (int c = 0; c < 8; ++c) {
                float a = 0.f;
#pragma unroll
                for (int i4 = 0; i4 < 4; ++i4) { const f32x4 ww = *(const f32x4*)(W8 + c * 1024 + lane * 16 + 4 * i4); a += xn[i4][0] * ww[0] + xn[i4][1] * ww[1] + xn[i4][2] * ww[2] + xn[i4][3] * ww[3]; }
                pc[c] = wsum64(a, lane);
            }
            if (lane == 0) { *(f32x4*)(p.ba() + (size_t)tok * 8) = (f32x4){pc[0], pc[1], pc[2], pc[3]}; *(f32x4*)(p.ba() + (size_t)tok * 8 + 4) = (f32x4){pc[4], pc[5], pc[6], pc[7]}; }
        }
    }
}

extern __shared__ __attribute__((aligned(16))) char smem_raw[];
DEV char* smem_user() { LAS char* q = (LAS char*)smem_raw + LDS_USER; asm volatile("" : "+s"(q)); return (char*)q; }
typedef const __attribute__((address_space(4))) Params* KParams;
DEV void load_params(Params& p) {
    auto kp0 = __builtin_amdgcn_kernarg_segment_ptr();
    asm volatile("" : "+s"(kp0));
    KParams kp = (KParams)kp0;
    p.x = kp->x;
    p.c = kp->c;
    p.pos = kp->pos;
    p.mod_w = kp->mod_w;
    p.mod_b = kp->mod_b;
    p.norm_mix = kp->norm_mix;
    p.norm_ffn = kp->norm_ffn;
    p.hy_w_in = kp->hy_w_in;
    p.gdn_conv = kp->gdn_conv;
    p.gdn_a_log = kp->gdn_a_log;
    p.gdn_dt_bias = kp->gdn_dt_bias;
    p.gdn_o_norm = kp->gdn_o_norm;
    p.hy_w_out = kp->hy_w_out;
    p.mla_w_in = kp->mla_w_in;
    p.mla_q_norm = kp->mla_q_norm;
    p.mla_kv_norm = kp->mla_kv_norm;
    p.mla_w_uq = kp->mla_w_uq;
    p.mla_w_ukv = kp->mla_w_ukv;
    p.mla_w_out = kp->mla_w_out;
    p.peer_w_q = kp->peer_w_q;
    p.peer_sub_keys = kp->peer_sub_keys;
    p.peer_u = kp->peer_u;
    p.peer_v = kp->peer_v;
    p.final_norm = kp->final_norm;
    p.out = kp->out;
    p.ws = kp->ws;
    p.ph_lo = kp->ph_lo;
    p.ph_hi = kp->ph_hi;
    p.use_bar = kp->use_bar;
    p.pad0 = kp->pad0;
}
#ifdef PH_NOINLINE
#define NOINL __device__ __noinline__
#else
#define NOINL __device__ __forceinline__
#endif

NOINL void f_prologue() { Params p; load_params(p);
#ifdef REP_P0
    phase_prologue(p, smem_user());
#endif
    phase_prologue(p, smem_user()); }
NOINL void f_norm_e0(int layer) {
    Params p; load_params(p); const float* mod = p.mod() + layer * 6144; const int li = layer >> 1;
    phase_norm<1>(layer == 0 ? p.x : p.xw(), p.norm_mix + layer * DM, mod, mod + 1024, p.h(), nullptr, p.hy_w_in + (size_t)li * 1024 * HY_IN, p.ba(), smem_user());
}
NOINL void f_norm_plain(int layer, int which) {
    Params p; load_params(p); const float* mod = p.mod() + layer * 6144;
    if (which == 0) phase_norm<0>(p.xw(), p.norm_mix + layer * DM, mod, mod + 1024, p.h(), nullptr, nullptr, nullptr, smem_user());
    else phase_norm<0>(p.xw(), p.norm_ffn + layer * DM, mod + 3072, mod + 4096, p.h(), nullptr, nullptr, nullptr, smem_user());
}
NOINL void f_final() { Params p; load_params(p); phase_norm<2>(
#ifdef DBG_SKIP_ALL
        p.x,
#else
        p.xw(),
#endif
 p.final_norm, nullptr, nullptr, nullptr, p.out, nullptr, nullptr, smem_user()); }
NOINL void f_gemm_hy_in(int li) {
    Params p; load_params(p);
    auto epi = [&](int m, int n, int n0, const f32x4& v) {
        if (n0 < 1536) st_bf4(p.proj_a() + (size_t)m * 1536 + n, v);
        else if (n0 < 2048) st_bf4(p.zbuf() + (size_t)m * 512 + (n - 1536), v);
        else if (n0 < 2560) { const int hd = (n - 2048) >> 7, dp = (n - 2048) & 127; const f32x4 rv = rope4(v, p.cosB() + (size_t)m * 64, p.sinB() + (size_t)m * 64, dp >> 1) * (0.08838834764831845f * 1.4426950408889634f); st_bf4(p.Qb() + ((size_t)hd * S + m) * 128 + dp, rv); }
        else if (n0 < 3072) { const int hd = (n - 2560) >> 7, dp = (n - 2560) & 127; const f32x4 rv = rope4(v, p.cosB() + (size_t)m * 64, p.sinB() + (size_t)m * 64, dp >> 1); st_bf4(p.Kb() + ((size_t)hd * S + m) * 128 + dp, rv); }
        else { const int hd = (n - 3072) >> 7, dv = (n - 3072) & 127; bf16_t* vp = p.VbT() + (((size_t)hd * 256 + (m >> 6)) * 128 + dv) * 64 + (m & 63); vp[0] = f2bf(v[0]); vp[64] = f2bf(v[1]); vp[128] = f2bf(v[2]); vp[192] = f2bf(v[3]); }
    };
#ifdef REP_GEMM
    gemm256(p.h(), p.w_hy_in() + (size_t)li * HYN * 1024, HYN, 1024, smem_user(), epi);
#endif
    gemm256(p.h(), p.w_hy_in() + (size_t)li * HYN * 1024, HYN, 1024, smem_user(), epi);
}
NOINL void f_gemm_resid(int layer) {
    Params p; load_params(p); const float* mod = p.mod() + layer * 6144; const int li = layer >> 1;
    const float* xin = layer == 0 ? p.x : p.xw(); float* xo = p.xw();
    auto epi = [&](int m, int n, int n0, const f32x4& v) {
        const f32x4 xv = *(const f32x4*)(xin + (size_t)m * DM + n), gg = *(const f32x4*)(mod + 2048 + n);
        *(f32x4*)(xo + (size_t)m * DM + n) = xv + gg * v;
    };
    const bf16_t* wt = (layer & 1) ? p.w_mla_out() + (size_t)li * 1024 * 1024 : p.w_hy_out() + (size_t)li * 1024 * 1024;
    gemm256(p.cat(), wt, 1024, 1024, smem_user(), epi);
}
NOINL void f_s0(int li) {
    Params p; load_params(p);
    for (int u = opaque_bid(); u < 512; u += gridDim.x) { if (u < 256) gdn_prep_unit(p, li, u >> 2, u & 3, smem_user()); else moba_kmean_unit(p, (u - 256) & 3, (u - 256) >> 2, smem_user()); }
}
NOINL void f_seg(int layer, int seg) {
    Params p; load_params(p);
    const int li = layer >> 1;
    float* scanst = (float*)(p.ws + SCANST_OFF);
    const int nwg = (int)gridDim.x - 16, cps = (nwg >> 2) & ~3;
    int bnd[6]; bnd[0] = 0; bnd[1] = 64;
#pragma unroll
    for (int i = 2; i < 5; ++i) { bnd[i] = bnd[i - 1] + cps; if (bnd[i] > 256) bnd[i] = 256; }
    bnd[5] = 256;
    if (opaque_bid() < 16) { gdn_scan_seg(p, opaque_bid(), bnd[seg], bnd[seg + 1], scanst, smem_user()); return; }
    if (seg == 4) return;
    const int rank = opaque_bid() - 16;
    const int pbeg = bnd[seg + 1], nprep = 4 * (bnd[seg + 2] - pbeg);
    int cidx = rank;
    for (; cidx < nprep; cidx += nwg) gdn_prep_unit(p, li, pbeg + (cidx >> 2), cidx & 3, smem_user());
    int lo = 0, hi = 0;
    if (seg == 0) hi = 128;
    else {
        const int T = moba_tile_table(p, smem_user());
        lo = seg == 1 ? 0 : (seg == 2 ? T / 4 : T / 2); hi = seg == 1 ? T / 4 : (seg == 2 ? T / 2 : T);
    }
    for (; cidx < nprep + (hi - lo); cidx += nwg) {
        if (seg == 0) moba_gate_unit(p, cidx - nprep, smem_user());
        else moba_subunit(p, lo + (cidx - nprep), smem_user());
    }
    if (layer == 0 && seg == 3) {
        convert_i4(p.peer_u, p.ub(), (size_t)4 * 16384 * 1024, 96.f, rank, nwg);
        convert_fp4(p.peer_v, p.vb(), (size_t)4 * 16384 * 1024, 5.65685425f, rank, nwg);
    }
}
NOINL void f_combine(int li) { Params p; load_params(p); phase_even_combine(p, li); }
NOINL void f_gemm_mla_in(int li) {
    Params p; load_params(p);
    auto epi = [&](int m, int n, int n0, const f32x4& v) {
        if (n0 < 768) st_bf4(p.cbuf() + (size_t)m * 768 + n, v);
        else if (n < 832) { const int dp = n - 768; const f32x4 rv = rope4(v, p.cosC() + (size_t)m * 32, p.sinC() + (size_t)m * 32, dp >> 1); st_bf4(p.Kr() + (size_t)m * 64 + dp, rv); }
    };
#ifdef REP_GEMM
    gemm256(p.h(), p.w_mla_in() + (size_t)li * 1024 * 1024, 1024, 1024, smem_user(), epi);
#endif
    gemm256(p.h(), p.w_mla_in() + (size_t)li * 1024 * 1024, 1024, 1024, smem_user(), epi);
}
NOINL void f_cnorm(int li) { Params p; load_params(p); phase_mla_cnorm(p, li); }
NOINL void f_gemm_uq(int li) {
    Params p; load_params(p);
    auto epi = [&](int m, int n, int n0, const f32x4& v0) {
        const float qs = 0.07216878364870322f * 1.4426950408889634f;
        const int hd = n / 192, d = n - hd * 192; f32x4 v = v0;
        if (d >= 128) v = rope4(v, p.cosC() + (size_t)m * 32, p.sinC() + (size_t)m * 32, (d - 128) >> 1);
        st_bf4(p.Qm() + ((size_t)hd * S + m) * 192 + d, v * qs);
    };
#ifdef REP_GEMM
    gemm256(p.cqn(), p.w_uq() + (size_t)li * 1536 * 512, 1536, 512, smem_user(), epi);
#endif
    gemm256(p.cqn(), p.w_uq() + (size_t)li * 1536 * 512, 1536, 512, smem_user(), epi);
}
NOINL void f_gemm_ukv(int li) {
    Params p; load_params(p);
    auto epi = [&](int m, int n, int n0, const f32x4& v) {
        if (n0 < 1024) { const int hd = n >> 7, d = n & 127; st_bf4(p.Kn() + ((size_t)hd * S + m) * 128 + d, v); }
        else { const int hd = (n - 1024) >> 7, dv = (n - 1024) & 127; bf16_t* vp = p.VmT() + (((size_t)hd * 256 + (m >> 6)) * 128 + dv) * 64 + (m & 63); vp[0] = f2bf(v[0]); vp[64] = f2bf(v[1]); vp[128] = f2bf(v[2]); vp[192] = f2bf(v[3]); }
    };
#ifdef REP_GEMM
    gemm256(p.ckvn(), p.w_ukv() + (size_t)li * 2048 * 256, 2048, 256, smem_user(), epi);
#endif
    gemm256(p.ckvn(), p.w_ukv() + (size_t)li * 2048 * 256, 2048, 256, smem_user(), epi);
}
NOINL void f_mla_attn() {
    Params p; load_params(p);
#ifdef REP_M4
    phase_mla_attn(p, smem_user());
#endif
    phase_mla_attn(p, smem_user());
}
NOINL void f_gemm_pq(int layer) {
    Params p; load_params(p);
    auto epi = [&](int m, int n, int n0, const f32x4& v) { st_bf4(p.qbuf() + (size_t)m * 2048 + n, v); };
#ifdef REP_GEMM
    gemm256(p.h(), p.w_pq() + (size_t)layer * 2048 * 1024, 2048, 1024, smem_user(), epi);
#endif
    gemm256(p.h(), p.w_pq() + (size_t)layer * 2048 * 1024, 2048, 1024, smem_user(), epi);
}
NOINL void f_topk(int layer) { Params p; load_params(p);
#ifdef REP_F2
    phase_peer_topk(p, layer, smem_user());
#endif
    phase_peer_topk(p, layer, smem_user()); }
NOINL void f_gather(int layer) {
    Params p; load_params(p);
    const float* g2 = p.mod() + layer * 6144 + 5120;
    if (layer == 3) phase_peer_gather<2>(p, layer, g2, p.xw(), p.xw(), p.final_norm, nullptr, nullptr, nullptr, smem_user());
    else {
        const float* modn = p.mod() + (layer + 1) * 6144;
        if (layer == 1) phase_peer_gather<1>(p, layer, g2, p.xw(), p.xw(), p.norm_mix + 2 * DM, modn, modn + 1024, p.hy_w_in + (size_t)1 * 1024 * HY_IN, smem_user());
        else phase_peer_gather<0>(p, layer, g2, p.xw(), p.xw(), p.norm_mix + (layer + 1) * DM, modn, modn + 1024, nullptr, smem_user());
    }
}

__device__ __noinline__ void grid_sync(unsigned* barw, unsigned x) {
    XcdBarrier b; b.bar = barw; b.x = x; b.st = (volatile LAS unsigned*)smem_raw;
    xcd_barrier(b);
}

__global__ void __launch_bounds__(NTHREADS) hybrid_forward(Params p) {
    if (threadIdx.x == 0) *(u32x4*)smem_raw = (u32x4){0u, 0u, 0u, 0u};
    __syncthreads();
    XcdBarrier bar; bar.bar = p.bar(); bar.x = 0; bar.st = (volatile LAS unsigned*)smem_raw;
    if (p.use_bar) bar = xcd_barrier_post(p.bar(), (volatile LAS unsigned*)smem_raw);
    int ph = 0;
#define RUN_PHASE(...) { if (ph >= p.ph_lo && ph < p.ph_hi) { __VA_ARGS__; if (p.use_bar && ph + 1 < p.ph_hi) grid_sync(bar.bar, bar.x); } ++ph; }

    RUN_PHASE(f_prologue());
    for (int layer = 0; layer < 4; ++layer) {
        const int li = layer >> 1;
        if ((layer & 1) == 0) {
            if (layer == 0) RUN_PHASE(f_norm_e0(layer));
            RUN_PHASE(f_gemm_hy_in(li));
            RUN_PHASE(f_s0(li));
            RUN_PHASE(f_seg(layer, 0));
            RUN_PHASE(f_seg(layer, 1));
            RUN_PHASE(f_seg(layer, 2));
            RUN_PHASE(f_seg(layer, 3));
            RUN_PHASE(f_seg(layer, 4));
            RUN_PHASE(f_combine(li));
            RUN_PHASE(f_gemm_resid(layer));
        } else {
            RUN_PHASE(f_gemm_mla_in(li));
            RUN_PHASE(f_cnorm(li));
            RUN_PHASE(f_gemm_uq(li); f_gemm_ukv(li));
            RUN_PHASE(f_mla_attn());
            RUN_PHASE(f_gemm_resid(layer));
        }
        RUN_PHASE(f_norm_plain(layer, 1));
        RUN_PHASE(f_gemm_pq(layer));
        RUN_PHASE(f_topk(layer));
        RUN_PHASE(f_gather(layer));
    }
}

constexpr int N_PHASES = 1 + 1 + 2 * 9 + 2 * 5 + 4 * 4;

extern "C" void kernel_launch(void* const* d_in, const int* in_sizes, int n_in, void* d_out, int out_size, void* d_ws, size_t ws_size, hipStream_t stream) {
    static int grid = 0;
    if (!grid) {
        int dev = 0, cus = 0, per_cu = 0;
        hipGetDevice(&dev);
        hipDeviceGetAttribute(&cus, hipDeviceAttributeMultiprocessorCount, dev);
        hipFuncSetAttribute((const void*)hybrid_forward, hipFuncAttributeMaxDynamicSharedMemorySize, LDS_BYTES);
        hipOccupancyMaxActiveBlocksPerMultiprocessor(&per_cu, hybrid_forward, NTHREADS, LDS_BYTES);
        if (per_cu < 1) per_cu = 1;
        grid = cus;
        if (grid > 256) grid = 256;
    }
    Params p; memset(&p, 0, sizeof(p));
    p.x = (const float*)d_in[0]; p.c = (const float*)d_in[1]; p.pos = (const int*)d_in[2]; p.mod_w = (const float*)d_in[3]; p.mod_b = (const float*)d_in[4];
    p.norm_mix = (const float*)d_in[5]; p.norm_ffn = (const float*)d_in[6]; p.hy_w_in = (const float*)d_in[7]; p.gdn_conv = (const float*)d_in[8];
    p.gdn_a_log = (const float*)d_in[9]; p.gdn_dt_bias = (const float*)d_in[10]; p.gdn_o_norm = (const float*)d_in[11]; p.hy_w_out = (const float*)d_in[12];
    p.mla_w_in = (const float*)d_in[13]; p.mla_q_norm = (const float*)d_in[14]; p.mla_kv_norm = (const float*)d_in[15]; p.mla_w_uq = (const float*)d_in[16];
    p.mla_w_ukv = (const float*)d_in[17]; p.mla_w_out = (const float*)d_in[18]; p.peer_w_q = (const float*)d_in[19]; p.peer_sub_keys = (const float*)d_in[20];
    p.peer_u = (const float*)d_in[21]; p.peer_v = (const float*)d_in[22]; p.final_norm = (const float*)d_in[23];
    p.out = (float*)d_out;
    p.ws = (char*)d_ws;
    if (WS_NEED > ws_size) { fprintf(stderr, "workspace too small: need %zu have %zu\n", (size_t)WS_NEED, ws_size); return; }
    hipMemsetAsync(p.ws, 0, 16384, stream);
#ifndef ONE_LAUNCH
    for (int ph = 0; ph < N_PHASES; ++ph) {
#ifdef DBG_SKIP_ALL
        if (ph != N_PHASES - 1) continue;
#endif
        p.ph_lo = ph; p.ph_hi = ph + 1; p.use_bar = 0;
        hipLaunchKernelGGL(hybrid_forward, dim3(grid), dim3(NTHREADS), LDS_BYTES, stream, p);
    }
#else
    p.ph_lo = 0; p.ph_hi = N_PHASES; p.use_bar = 1;
    hipLaunchKernelGGL(hybrid_forward, dim3(grid), dim3(NTHREADS), LDS_BYTES, stream, p);
#endif
}
```

```cpp
#include <hip/hip_runtime.h>
#define ONE_LAUNCH 1
#include <stdint.h>
#include <stddef.h>
#include <stdio.h>
#include <string.h>

#define DEV __device__ __forceinline__

constexpr int S = 16384;
constexpr int DM = 1024;
constexpr int HY_IN = 3592;
constexpr int HYN = 3584;
constexpr int NTHREADS = 512;
constexpr int LDS_BYTES = 163840;
constexpr int LDS_USER = 16;

typedef unsigned short bf16_t;
typedef short bf16x8 __attribute__((ext_vector_type(8)));
typedef float f32x4 __attribute__((ext_vector_type(4)));
typedef float f32x16 __attribute__((ext_vector_type(16)));
typedef __bf16 bf16v2 __attribute__((ext_vector_type(2)));
typedef unsigned u32x4 __attribute__((ext_vector_type(4)));
typedef unsigned u32x2 __attribute__((ext_vector_type(2)));
typedef int i32x4 __attribute__((ext_vector_type(4)));

#define XB_TMO      128
#define XB_XCNT(j)  (256  + 64 * (j))
#define XB_XSUB(j)  (1280 + 64 * (j))
#define XB_XGEN(j)  (2304 + 64 * (j))
#define XB_TOP      3328
#define XB_TOPGEN   3392
#define XCD_BAR_WORDS 3456
#define XB_SPIN_CAP (1u << 22)
#define LAS __attribute__((address_space(3)))

__device__ __forceinline__ unsigned xb_ld(unsigned* p)              { return __hip_atomic_load(p, __ATOMIC_RELAXED, __HIP_MEMORY_SCOPE_AGENT); }
__device__ __forceinline__ unsigned xb_add(unsigned* p, unsigned v) { return __hip_atomic_fetch_add(p, v, __ATOMIC_RELAXED, __HIP_MEMORY_SCOPE_AGENT); }
__device__ __forceinline__ unsigned xb_xcc_id() { return (unsigned)__builtin_amdgcn_s_getreg((3 << 11) | 20) & 0xFu; }
#define XB_SPIN(cond, bar) do { unsigned _sp = 0; while (cond) { __builtin_amdgcn_s_sleep(1); \
    if ((++_sp & 255u) == 0u) { if (xb_ld(&(bar)[XB_TMO])) break; if (_sp > XB_SPIN_CAP) { atomicAdd(&(bar)[XB_TMO], 1u); break; } } } } while (0)

struct XcdBarrier { unsigned* bar; unsigned x; volatile LAS unsigned* st; };

__device__ __forceinline__ XcdBarrier xcd_barrier_post(unsigned* bar, volatile LAS unsigned* st) {
    XcdBarrier b; b.bar = bar; b.x = xb_xcc_id(); b.st = st;
    if (threadIdx.x == 0) (void)xb_add(&bar[XB_XCNT(b.x)], 1u);
    return b;
}
__device__ __forceinline__ void xcd_barrier_complete(unsigned* bar, unsigned x, unsigned& nloc, unsigned& nx) {
    const unsigned G = gridDim.x * gridDim.y * gridDim.z;
    unsigned sum, cnt, mine, sp = 0u;
    for (;;) {
        sum = 0u; cnt = 0u; mine = 0u;
#pragma unroll 1
        for (unsigned j = 0; j < 16; ++j) { const unsigned c = xb_ld(&bar[XB_XCNT(j)]); sum += c; cnt += (c > 0u) ? 1u : 0u; mine = (j == x) ? c : mine; }
        if (sum == G) break;
        __builtin_amdgcn_s_sleep(1);
        if ((++sp & 255u) == 0u) { if (xb_ld(&bar[XB_TMO])) break; if (sp > XB_SPIN_CAP) { atomicAdd(&bar[XB_TMO], 1u); break; } }
    }
    nloc = mine > 0u ? mine : 1u; nx = cnt > 0u ? cnt : 1u;
}
__device__ __forceinline__ void xcd_barrier(const XcdBarrier& b) {
    asm volatile("s_waitcnt vmcnt(0)" ::: "memory");
    __syncthreads();
    if (threadIdx.x == 0) {
        unsigned* bar = b.bar;
        __builtin_amdgcn_s_waitcnt(0);
        unsigned nloc = b.st[0], nx = b.st[1];
        if (nloc == 0u) { xcd_barrier_complete(bar, b.x, nloc, nx); b.st[0] = nloc; b.st[1] = nx; }
        const unsigned old = xb_add(&bar[XB_XSUB(b.x)], 1u);
        const unsigned gen = old / nloc;
        if (old + 1u == (gen + 1u) * nloc) {
            __builtin_amdgcn_fence(__ATOMIC_RELEASE, "agent");
            asm volatile("s_waitcnt vmcnt(0)" ::: "memory");
            const unsigned og = xb_add(&bar[XB_TOP], 1u);
            const unsigned tg = og / nx;
            if (og + 1u == (tg + 1u) * nx) xb_add(&bar[XB_TOPGEN], 1u);
            else XB_SPIN(xb_ld(&bar[XB_TOPGEN]) == tg, bar);
            __builtin_amdgcn_fence(__ATOMIC_ACQUIRE, "agent");
            xb_add(&bar[XB_XGEN(b.x)], 1u);
            asm volatile("s_waitcnt vmcnt(0)" ::: "memory");
        } else {
            XB_SPIN(xb_ld(&bar[XB_XGEN(b.x)]) == gen, bar);
            __builtin_amdgcn_fence(__ATOMIC_ACQUIRE, "agent");
            asm volatile("s_waitcnt vmcnt(0)" ::: "memory");
        }
    }
    __syncthreads();
}

DEV int opaque_bid() { int b = blockIdx.x; asm volatile("" : "+s"(b)); return b; }
DEV int opaque_tid() { int t = threadIdx.x; asm volatile("" : "+v"(t)); return t & (NTHREADS - 1); }
DEV bf16_t f2bf(float f) { __bf16 v = (__bf16)f; bf16_t r; __builtin_memcpy(&r, &v, 2); return r; }
DEV unsigned pk2(float a, float b) { bf16v2 v; v[0] = (__bf16)a; v[1] = (__bf16)b; unsigned r; __builtin_memcpy(&r, &v, 4); return r; }
DEV float bflo(unsigned u) { return __uint_as_float(u << 16); }
DEV float bfhi(unsigned u) { return __uint_as_float(u & 0xffff0000u); }
DEV float shx(float v, int m, int lane) { return __int_as_float(__builtin_amdgcn_ds_bpermute((lane ^ m) << 2, __float_as_int(v))); }
DEV float wsum64(float v, int lane) {
#pragma unroll
    for (int o = 32; o; o >>= 1) v += shx(v, o, lane);
    return v;
}
DEV f32x4 mfma16(bf16x8 a, bf16x8 b, f32x4 c) { return __builtin_amdgcn_mfma_f32_16x16x32_bf16(a, b, c, 0, 0, 0); }
DEV f32x16 mfma32(bf16x8 a, bf16x8 b, f32x16 c) { return __builtin_amdgcn_mfma_f32_32x32x16_bf16(a, b, c, 0, 0, 0); }
DEV float siluf(float v) { return v / (1.f + expf(-v)); }
DEV float softplusf(float v) { return fmaxf(v, 0.f) + log1pf(expf(-fabsf(v))); }
DEV float ex2(float v) { return __builtin_amdgcn_exp2f(v); }

struct Params {
    const float* x; const float* c; const int* pos; const float* mod_w; const float* mod_b; const float* norm_mix; const float* norm_ffn;
    const float* hy_w_in; const float* gdn_conv; const float* gdn_a_log; const float* gdn_dt_bias; const float* gdn_o_norm; const float* hy_w_out;
    const float* mla_w_in; const float* mla_q_norm; const float* mla_kv_norm; const float* mla_w_uq; const float* mla_w_ukv; const float* mla_w_out;
    const float* peer_w_q; const float* peer_sub_keys; const float* peer_u; const float* peer_v; const float* final_norm;
    float* out; char* ws;
    int ph_lo, ph_hi, use_bar, pad0;
    DEV unsigned* bar() const { return (unsigned*)(ws + 0ull); }
    DEV float* mod() const { return (float*)(ws + 16384ull); }
    DEV float* cosB() const { return (float*)(ws + 114688ull); }
    DEV float* sinB() const { return (float*)(ws + 4308992ull); }
    DEV float* cosC() const { return (float*)(ws + 8503296ull); }
    DEV float* sinC() const { return (float*)(ws + 10600448ull); }
    DEV bf16_t* w_hy_in() const { return (bf16_t*)(ws + 12697600ull); }
    DEV bf16_t* w_hy_out() const { return (bf16_t*)(ws + 27377664ull); }
    DEV bf16_t* w_mla_in() const { return (bf16_t*)(ws + 863260672ull); }
    DEV bf16_t* w_uq() const { return (bf16_t*)(ws + 35241984ull); }
    DEV bf16_t* w_ukv() const { return (bf16_t*)(ws + 38387712ull); }
    DEV bf16_t* w_mla_out() const { return (bf16_t*)(ws + 40484864ull); }
    DEV bf16_t* w_pq() const { return (bf16_t*)(ws + 44679168ull); }
    DEV bf16_t* skb() const { return (bf16_t*)(ws + 61456384ull); }
    DEV unsigned char* ub() const { return (unsigned char*)(ws + 63553536ull); }
    DEV unsigned char* vb() const { return (unsigned char*)(ws + 197771264ull); }
    DEV float* xw() const { return (float*)(ws + 331988992ull); }
    DEV bf16_t* h() const { return (bf16_t*)(ws + 399097856ull); }
    DEV bf16_t* cat() const { return (bf16_t*)(ws + 432652288ull); }
    DEV bf16_t* proj_a() const { return (bf16_t*)(ws + 466206720ull); }
    DEV bf16_t* zbuf() const { return (bf16_t*)(ws + 516538368ull); }
    DEV bf16_t* Qb() const { return (bf16_t*)(ws + 533315584ull); }
    DEV bf16_t* Kb() const { return (bf16_t*)(ws + 550092800ull); }
    DEV bf16_t* VbT() const { return (bf16_t*)(ws + 566870016ull); }
    DEV float* ba() const { return (float*)(ws + 583647232ull); }
    DEV float* u32() const { return (float*)(ws + 584171520ull); }
    DEV bf16_t* wneg() const { return (bf16_t*)(ws + 617725952ull); }
    DEV bf16_t* qdec() const { return (bf16_t*)(ws + 634503168ull); }
    DEV bf16_t* kdT() const { return (bf16_t*)(ws + 651280384ull); }
    DEV bf16_t* qk() const { return (bf16_t*)(ws + 668057600ull); }
    DEV float* glast() const { return (float*)(ws + 676446208ull); }
    DEV float* oa() const { return (float*)(ws + 676450304ull); }
    DEV float* kmean() const { return (float*)(ws + 710004736ull); }
    DEV int* segcnt() const { return (int*)(ws + 710135808ull); }
    DEV int* lists() const { return (int*)(ws + 710168576ull); }
    DEV float* part() const { return (float*)(ws + 726945792ull); }
    DEV float* ml() const { return (float*)(ws + 861163520ull); }
    DEV bf16_t* cbuf() const { return (bf16_t*)(ws + 466206720ull); }
    DEV bf16_t* Kr() const { return (bf16_t*)(ws + 491372544ull); }
    DEV bf16_t* cqn() const { return (bf16_t*)(ws + 493469696ull); }
    DEV bf16_t* ckvn() const { return (bf16_t*)(ws + 510246912ull); }
    DEV bf16_t* Qm() const { return (bf16_t*)(ws + 518635520ull); }
    DEV bf16_t* Kn() const { return (bf16_t*)(ws + 568967168ull); }
    DEV bf16_t* VmT() const { return (bf16_t*)(ws + 602521600ull); }
    DEV bf16_t* qbuf() const { return (bf16_t*)(ws + 466206720ull); }
    DEV int* expert() const { return (int*)(ws + 533315584ull); }
    DEV float* gate() const { return (float*)(ws + 541704192ull); }
};
constexpr size_t SCANST_OFF = 867454976ull;
constexpr size_t WS_NEED = 867717120ull;


template <class Map>
DEV void transpose_conv(const float* __restrict__ src, int K, int ldsrc, bf16_t* __restrict__ dst, int Nd, Map map, char* smem, int& base) {
    float* T = (float*)smem;
    const int tid = opaque_tid(), nb = gridDim.x, b = opaque_bid();
    const int ntk = K / 64, ntn = Nd / 64, nun = ntk * ntn;
    int first = ((b - (base % nb)) % nb + nb) % nb;
    for (int u = first; u < nun; u += nb) {
        const int tk = u % ntk, tn = u / ntk;
        __syncthreads();
#pragma unroll
        for (int i = 0; i < 8; ++i) {
            const int kk = (tid >> 6) + 8 * i, nn = tid & 63;
            const int sc = map(tn * 64 + nn);
            float v = 0.f;
            if (sc >= 0) v = src[(size_t)(tk * 64 + kk) * ldsrc + sc];
            T[kk * 65 + nn] = v;
        }
        __syncthreads();
#pragma unroll
        for (int i = 0; i < 8; ++i) {
            const int nn = (tid >> 6) + 8 * i, kk = tid & 63;
            dst[(size_t)(tn * 64 + nn) * K + tk * 64 + kk] = f2bf(T[kk * 65 + nn]);
        }
    }
    base += nun;
}

DEV void convert_bf16(const float* __restrict__ src, bf16_t* __restrict__ dst, size_t n) {
    const size_t n8 = n / 8;
    for (size_t i = (size_t)opaque_bid() * NTHREADS + opaque_tid(); i < n8; i += (size_t)gridDim.x * NTHREADS) {
        const f32x4 a = *(const f32x4*)(src + i * 8), b = *(const f32x4*)(src + i * 8 + 4);
        u32x4 o; o.x = pk2(a[0], a[1]); o.y = pk2(a[2], a[3]); o.z = pk2(b[0], b[1]); o.w = pk2(b[2], b[3]);
        *(u32x4*)(dst + i * 8) = o;
    }
}

DEV void convert_fp4(const float* __restrict__ src, unsigned char* __restrict__ dst, size_t n, float scale, int rank, int nwg) {
    const size_t n32 = n / 32;
    for (size_t i = (size_t)rank * NTHREADS + opaque_tid(); i < n32; i += (size_t)nwg * NTHREADS) {
        u32x4 o;
#pragma unroll
        for (int q = 0; q < 4; ++q) {
            const f32x4 a = *(const f32x4*)(src + i * 32 + q * 8) * scale, b = *(const f32x4*)(src + i * 32 + q * 8 + 4) * scale;
            unsigned w = 0;
            w = __builtin_amdgcn_cvt_scalef32_pk_fp4_f32(w, a[0], a[1], 1.0f, 0);
            w = __builtin_amdgcn_cvt_scalef32_pk_fp4_f32(w, a[2], a[3], 1.0f, 1);
            w = __builtin_amdgcn_cvt_scalef32_pk_fp4_f32(w, b[0], b[1], 1.0f, 2);
            w = __builtin_amdgcn_cvt_scalef32_pk_fp4_f32(w, b[2], b[3], 1.0f, 3);
            o[q] = w;
        }
        *(u32x4*)(dst + i * 16) = o;
    }
}

DEV void convert_i4(const float* __restrict__ src, unsigned char* __restrict__ dst, size_t n, float scale, int rank, int nwg) {
    const size_t n32 = n / 32;
    for (size_t i = (size_t)rank * NTHREADS + opaque_tid(); i < n32; i += (size_t)nwg * NTHREADS) {
        u32x4 o;
#pragma unroll
        for (int q = 0; q < 4; ++q) {
            const f32x4 a = *(const f32x4*)(src + i * 32 + q * 8) * scale, b = *(const f32x4*)(src + i * 32 + q * 8 + 4) * scale;
            unsigned w = 0;
#pragma unroll
            for (int j = 0; j < 4; ++j) {
                const int qa = (int)fminf(fmaxf(__builtin_rintf(a[j]), -8.f), 7.f), qb = (int)fminf(fmaxf(__builtin_rintf(b[j]), -8.f), 7.f);
                w |= ((unsigned)qa & 15u) << (4 * j); w |= ((unsigned)qb & 15u) << (4 * (j + 4));
            }
            o[q] = w;
        }
        *(u32x4*)(dst + i * 16) = o;
    }
}

DEV void convert_fp8(const float* __restrict__ src, unsigned char* __restrict__ dst, size_t n, float scale) {
    const size_t n16 = n / 16;
    for (size_t i = (size_t)opaque_bid() * NTHREADS + opaque_tid(); i < n16; i += (size_t)gridDim.x * NTHREADS) {
        u32x4 o;
#pragma unroll
        for (int q = 0; q < 4; ++q) {
            const f32x4 a = *(const f32x4*)(src + i * 16 + q * 4) * scale;
            int w = 0;
            w = __builtin_amdgcn_cvt_pk_fp8_f32(a[0], a[1], w, false);
            w = __builtin_amdgcn_cvt_pk_fp8_f32(a[2], a[3], w, true);
            o[q] = (unsigned)w;
        }
        *(u32x4*)(dst + i * 16) = o;
    }
}

DEV void phase_prologue(const Params& p, char* smem) {
    const int tid = opaque_tid(), nb = gridDim.x, b = opaque_bid();
    {
        float* cond = (float*)smem; float* red = cond + 1024;
        for (int i = tid; i < 1024; i += NTHREADS) cond[i] = siluf(p.c[i]);
        __syncthreads();
        for (int u = b; u < 192; u += nb) {
            const int n = u * 128, layer = n / 6144, nn = n - layer * 6144;
            const int cg = tid & 31, ks = tid >> 5;
            const float* wp = p.mod_w + ((size_t)layer * 1024 + ks * 64) * 6144 + nn + cg * 4;
            f32x4 acc = {0.f, 0.f, 0.f, 0.f};
#pragma unroll 8
            for (int k = 0; k < 64; ++k) { const f32x4 w = *(const f32x4*)(wp + (size_t)k * 6144); const float cv = cond[ks * 64 + k]; acc += w * cv; }
            *(f32x4*)(red + ks * 128 + cg * 4) = acc;
            __syncthreads();
            if (tid < 128) { float s = p.mod_b[n + tid]; for (int q = 0; q < 16; ++q) s += red[q * 128 + tid]; p.mod()[n + tid] = s; }
            __syncthreads();
        }
    }
    for (size_t i = (size_t)b * NTHREADS + tid; i < (size_t)S * 64; i += (size_t)nb * NTHREADS) {
        const int s = (int)(i >> 6), f = (int)(i & 63);
        const float invf = powf(10000.f, -(float)(2 * f) / 128.f);
        const float ang = (float)p.pos[s] * invf;
        float sn, cs; sincosf(ang, &sn, &cs);
        p.cosB()[i] = cs; p.sinB()[i] = sn;
    }
    for (size_t i = (size_t)b * NTHREADS + tid; i < (size_t)S * 32; i += (size_t)nb * NTHREADS) {
        const int s = (int)(i >> 5), f = (int)(i & 31);
        const float invf = powf(10000.f, -(float)(2 * f) / 64.f);
        const float ang = (float)p.pos[s] * invf;
        float sn, cs; sincosf(ang, &sn, &cs);
        p.cosC()[i] = cs; p.sinC()[i] = sn;
    }
    int base = 0;
    for (int i = 0; i < 2; ++i) {
        transpose_conv(p.hy_w_in + (size_t)i * 1024 * HY_IN, 1024, HY_IN, p.w_hy_in() + (size_t)i * HYN * 1024, HYN,
            [](int n) -> int {
                if (n < 2048) return n;
                const int seg = (n - 2048) >> 9, r = (n - 2048) & 511, sb = 2056 + seg * 512;
                if (seg < 2) { const int hd = r >> 7, dp = r & 127; const int d = (dp & 1) ? 64 + (dp >> 1) : (dp >> 1); return sb + hd * 128 + d; }
                return sb + r;
            }, smem, base);
        transpose_conv(p.hy_w_out + (size_t)i * 1024 * 1024, 1024, 1024, p.w_hy_out() + (size_t)i * 1024 * 1024, 1024, [](int n) -> int { return n; }, smem, base);
        transpose_conv(p.mla_w_in + (size_t)i * 1024 * 832, 1024, 832, p.w_mla_in() + (size_t)i * 1024 * 1024, 1024,
            [](int n) -> int {
                if (n < 768) return n;
                if (n < 832) { const int dp = n - 768; const int d = (dp & 1) ? 32 + (dp >> 1) : (dp >> 1); return 768 + d; }
                return -1;
            }, smem, base);
        transpose_conv(p.mla_w_uq + (size_t)i * 512 * 1536, 512, 1536, p.w_uq() + (size_t)i * 1536 * 512, 1536,
            [](int n) -> int {
                const int hd = n / 192, d = n % 192;
                if (d < 128) return n;
                const int dp = d - 128; const int dd = (dp & 1) ? 32 + (dp >> 1) : (dp >> 1);
                return hd * 192 + 128 + dd;
            }, smem, base);
        transpose_conv(p.mla_w_ukv + (size_t)i * 256 * 2048, 256, 2048, p.w_ukv() + (size_t)i * 2048 * 256, 2048,
            [](int n) -> int {
                if (n < 1024) { const int hd = n >> 7, d = n & 127; return hd * 256 + d; }
                const int m = n - 1024; const int hd = m >> 7, d = m & 127; return hd * 256 + 128 + d;
            }, smem, base);
        transpose_conv(p.mla_w_out + (size_t)i * 1024 * 1024, 1024, 1024, p.w_mla_out() + (size_t)i * 1024 * 1024, 1024, [](int n) -> int { return n; }, smem, base);
    }
    for (int i = 0; i < 4; ++i)
        transpose_conv(p.peer_w_q + (size_t)i * 1024 * 2048, 1024, 2048, p.w_pq() + (size_t)i * 2048 * 1024, 2048, [](int n) -> int { return n; }, smem, base);
    convert_bf16(p.peer_sub_keys, p.skb(), (size_t)4 * 8 * 2 * 128 * 128);
}

template <int MODE>
DEV void phase_norm(const float* __restrict__ xs, const float* __restrict__ nw, const float* __restrict__ shv, const float* __restrict__ scv,
                    bf16_t* __restrict__ hout, float* __restrict__ fout, const float* __restrict__ w8src, float* __restrict__ ba, char* smem) {
    const int tid = opaque_tid(), lane = tid & 63, w = __builtin_amdgcn_readfirstlane(tid >> 6);
    float* W8 = (float*)smem;
    if (MODE == 1) {
        for (int i = tid; i < 8192; i += NTHREADS) { const int k = i >> 3, c = i & 7; W8[c * 1024 + k] = w8src[(size_t)k * HY_IN + 2048 + c]; }
        __syncthreads();
    }
    f32x4 wm[4], sh[4];
#pragma unroll
    for (int i = 0; i < 4; ++i) {
        const int e = (i * 64 + lane) * 4;
        const f32x4 nv = *(const f32x4*)(nw + e);
        if (MODE == 2) { wm[i] = nv; sh[i] = (f32x4){0.f, 0.f, 0.f, 0.f}; }
        else { const f32x4 sc = *(const f32x4*)(scv + e); wm[i] = nv * (sc + 1.0f); sh[i] = *(const f32x4*)(shv + e); }
    }
    for (int row = opaque_bid() * 8 + w; row < S; row += gridDim.x * 8) {
        f32x4 v[4]; float ss = 0.f;
#pragma unroll
        for (int i = 0; i < 4; ++i) { v[i] = *(const f32x4*)(xs + (size_t)row * DM + (i * 64 + lane) * 4); ss += v[i][0] * v[i][0] + v[i][1] * v[i][1] + v[i][2] * v[i][2] + v[i][3] * v[i][3]; }
        ss = wsum64(ss, lane);
        const float rn = rsqrtf(ss * (1.f / 1024.f) + 1e-6f);
#pragma unroll
        for (int i = 0; i < 4; ++i) v[i] = v[i] * rn * wm[i] + sh[i];
        if (MODE == 2) {
#pragma unroll
            for (int i = 0; i < 4; ++i) *(f32x4*)(fout + (size_t)row * DM + (i * 64 + lane) * 4) = v[i];
        } else {
#pragma unroll
            for (int i = 0; i < 4; ++i) { u32x2 o; o.x = pk2(v[i][0], v[i][1]); o.y = pk2(v[i][2], v[i][3]); *(u32x2*)(hout + (size_t)row * DM + (i * 64 + lane) * 4) = o; }
        }
        if (MODE == 1) {
            float pc[8];
#pragma unroll
            for (int c = 0; c < 8; ++c) {
                float a = 0.f;
#pragma unroll
                for (int i = 0; i < 4; ++i) { const f32x4 ww = *(const f32x4*)(W8 + c * 1024 + (i * 64 + lane) * 4); a += v[i][0] * ww[0] + v[i][1] * ww[1] + v[i][2] * ww[2] + v[i][3] * ww[3]; }
                pc[c] = wsum64(a, lane);
            }
            if (lane == 0) { *(f32x4*)(ba + (size_t)row * 8) = (f32x4){pc[0], pc[1], pc[2], pc[3]}; *(f32x4*)(ba + (size_t)row * 8 + 4) = (f32x4){pc[4], pc[5], pc[6], pc[7]}; }
        }
    }
}

constexpr int GA_RS = 144;
template <class Epi>
DEV void gemm_phase(const bf16_t* __restrict__ A, int lda, const bf16_t* __restrict__ Bt, int ldb, int K, int ntn, char* smem, Epi epi) {
    const int tid = opaque_tid(), lane = tid & 63, w = tid >> 6, wm = w >> 1, wn = w & 1, r = lane & 15, g = lane >> 4;
    char* As = smem; char* Bs = smem + 256 * GA_RS;
    const int nun = 64 * ntn, nk = K / 64;
    for (int u = opaque_bid(); u < nun; u += gridDim.x) {
        const int xcd = u & 7, idx = u >> 3, tn = idx % ntn, tm = xcd * 8 + idx / ntn;
        const int m0 = tm * 256, n0 = tn * 128;
        f32x4 acc[4][4];
#pragma unroll
        for (int i = 0; i < 4; ++i)
#pragma unroll
            for (int j = 0; j < 4; ++j) acc[i][j] = (f32x4){0.f, 0.f, 0.f, 0.f};
        u32x4 ra0[4], rb0[2], ra1[4], rb1[2], ra2[4], rb2[2];
        const bf16_t* Ap = A + (size_t)(m0 + (tid >> 3)) * lda + (tid & 7) * 8;
        const bf16_t* Bp = Bt + (size_t)(n0 + (tid >> 3)) * ldb + (tid & 7) * 8;
        auto gload = [&](int kt, u32x4 (&ra)[4], u32x4 (&rb)[2]) {
            const int k0 = kt * 64;
#pragma unroll
            for (int i = 0; i < 4; ++i) ra[i] = *(const u32x4*)(Ap + (size_t)(64 * i) * lda + k0);
#pragma unroll
            for (int i = 0; i < 2; ++i) rb[i] = *(const u32x4*)(Bp + (size_t)(64 * i) * ldb + k0);
        };
        auto body = [&](int kt, u32x4 (&ra)[4], u32x4 (&rb)[2]) {
            __syncthreads();
#pragma unroll
            for (int i = 0; i < 4; ++i) *(u32x4*)(As + ((tid >> 3) + 64 * i) * GA_RS + (tid & 7) * 16) = ra[i];
#pragma unroll
            for (int i = 0; i < 2; ++i) *(u32x4*)(Bs + ((tid >> 3) + 64 * i) * GA_RS + (tid & 7) * 16) = rb[i];
            __syncthreads();
            if (kt + 3 < nk) gload(kt + 3, ra, rb);
#pragma unroll
            for (int ks = 0; ks < 2; ++ks) {
                bf16x8 af[4], bfr[4];
#pragma unroll
                for (int mt = 0; mt < 4; ++mt) af[mt] = *(const bf16x8*)(As + (64 * wm + 16 * mt + r) * GA_RS + (32 * ks + 8 * g) * 2);
#pragma unroll
                for (int nt = 0; nt < 4; ++nt) bfr[nt] = *(const bf16x8*)(Bs + (64 * wn + 16 * nt + r) * GA_RS + (32 * ks + 8 * g) * 2);
#pragma unroll
                for (int mt = 0; mt < 4; ++mt)
#pragma unroll
                    for (int nt = 0; nt < 4; ++nt) acc[mt][nt] = mfma16(bfr[nt], af[mt], acc[mt][nt]);
            }
        };
        gload(0, ra0, rb0); gload(1, ra1, rb1); gload(2, ra2, rb2);
        for (int kt = 0; kt < nk; kt += 3) {
            body(kt, ra0, rb0);
            if (kt + 1 < nk) body(kt + 1, ra1, rb1);
            if (kt + 2 < nk) body(kt + 2, ra2, rb2);
        }
        epi(acc, m0 + 64 * wm + r, n0 + 64 * wn + 4 * g, n0);
    }
}

DEV void st_bf4(bf16_t* p, f32x4 v) { u32x2 o; o.x = pk2(v[0], v[1]); o.y = pk2(v[2], v[3]); *(u32x2*)p = o; }
DEV f32x4 rope4(f32x4 v, const float* cs, const float* sn, int fi) {
    const float c0 = cs[fi], s0 = sn[fi], c1 = cs[fi + 1], s1 = sn[fi + 1];
    f32x4 o; o[0] = v[0] * c0 - v[1] * s0; o[1] = v[1] * c0 + v[0] * s0; o[2] = v[2] * c1 - v[3] * s1; o[3] = v[3] * c1 + v[2] * s1; return o;
}

namespace pg8 {
#define PG8_LAS __attribute__((address_space(3)))
typedef unsigned short bf16_t;
typedef short bf16x8 __attribute__((ext_vector_type(8)));
typedef float f32x4 __attribute__((ext_vector_type(4)));
constexpr int BM = 256, BK = 64, HALF = 128, HTB = HALF * BK * 2  , STAGE_BYTES = 8 * HTB, NXCD = 8, WGM = 8;

__host__ __device__ __forceinline__ int lds_byte(int r, int c) { const int st = (r >> 4) * 2 + (c >> 5), rr = r & 15, cc = c & 31, ob = rr * 64 + cc * 2; return st * 1024 + (ob ^ (((ob >> 9) & 1) << 5)); }
__host__ __device__ __forceinline__ void stage_rc(int b, int& R, int& C) { const int st = b / 1024, sb = b % 1024, swz = sb ^ (((sb >> 9) & 1) << 5); R = (st >> 1) * 16 + swz / 64; C = (st & 1) * 32 + (swz % 64) / 2; }
__host__ __device__ __forceinline__ int perm32(int rho) { const int n = rho >> 4, i = rho & 15; return 8 * (i >> 2) + 4 * n + (i & 3); }

struct Unit { int pm, pn; };
struct Gemm { const bf16_t* A; const bf16_t* Bt; int M, N, K; };

struct StaticOrder {
    int nM, nN, nwg, G, c;
    __host__ __device__ void init(int M, int N, int G_, int c_) { nM = M / BM; nN = N / BM; nwg = nM * nN; G = G_; c = c_; }
    __host__ __device__ bool next(int i, Unit& u) const {
        const long L = (long)i * G + c; if (L >= nwg) return false;
        int wgid = (int)L; { const int q = nwg / NXCD, r = nwg % NXCD, xcd = wgid % NXCD, off = wgid / NXCD; wgid = (xcd < r ? xcd * (q + 1) : r * (q + 1) + (xcd - r) * q) + off; }
        const int nig = WGM * nN, gid = wgid / nig, fm = gid * WGM, gsz = (nM - fm) < WGM ? (nM - fm) : WGM;
        u.pm = fm + ((wgid % nig) % gsz); u.pn = (wgid % nig) / gsz; return true;
    }
    __device__ __forceinline__ void a_ready(const Unit&) const {}
    __device__ __forceinline__ void done(const Unit&) const {}
};
template <class Epi, class Sched, bool STAMP = false>
__device__ __forceinline__ void gemm_phase(PG8_LAS unsigned char* lds, const Gemm g, const Sched& S, const Epi& E, unsigned long long* stamps) {
    const int tid = opaque_tid(), wid = __builtin_amdgcn_readfirstlane(tid >> 6), lane = tid & 63, wr = wid >> 2, wc = wid & 3, fr = lane & 15, fq = lane >> 4;
    const int K = g.K, nt = K / BK;
    int ts_lo = 0, ts_hi = 0, nts = 0; const unsigned long long rt_entry = STAMP ? (unsigned long long)wall_clock64() : 0ull;
#define PG8_STAMP() do { if (STAMP && wid == 0 && nts < 64) { const unsigned long long _c = (unsigned long long)clock64(); \
        ts_lo = (lane == nts) ? (int)(unsigned)_c : ts_lo; ts_hi = (lane == nts) ? (int)(unsigned)(_c >> 32) : ts_hi; ++nts; } } while (0)
    PG8_STAMP();
    unsigned voffA[2], voffB[2];
#pragma unroll
    for (int i = 0; i < 2; ++i) { int R, C; stage_rc(tid * 16 + i * 8192, R, C); const int Rb = Epi::PERM ? ((R & ~31) + perm32(R & 31)) : R;
        voffA[i] = (unsigned)(R * K + C) * 2u; voffB[i] = (unsigned)(Rb * K + C) * 2u; }
    const size_t kstep = (size_t)(BK * 2);
    const size_t hstep = (size_t)HALF * K * 2;
    const size_t tstep = 2 * hstep;
    const unsigned ldsw = (unsigned)wid * 1024u;
    const int aoff = lds_byte(wr * 64 + fr, fq * 8), boff = lds_byte(wc * 32 + fr, fq * 8);
#define PG8_SA(b, h) (((b) * 2 + (h)) * HTB)
#define PG8_SB(b, h) ((4 + (b) * 2 + (h)) * HTB)
#define PG8_STAGE(bufoff, gbase, voff) do { _Pragma("unroll") for (int _i = 0; _i < 2; ++_i) \
        __builtin_amdgcn_global_load_lds((const unsigned*)((const char*)(gbase) + (voff)[_i]), (PG8_LAS unsigned*)(lds + (bufoff) + ldsw + _i * 8192), 16, 0, 0); } while (0)
#define PG8_LDA(dst, b, h) do { _Pragma("unroll") for (int m = 0; m < 4; ++m) _Pragma("unroll") for (int k = 0; k < 2; ++k) dst[m][k] = *(const PG8_LAS bf16x8*)(lds + PG8_SA(b, h) + aoff + m * 2048 + k * 1024); } while (0)
#define PG8_LDB(dst, b, h) do { _Pragma("unroll") for (int n = 0; n < 2; ++n) _Pragma("unroll") for (int k = 0; k < 2; ++k) dst[n][k] = *(const PG8_LAS bf16x8*)(lds + PG8_SB(b, h) + boff + n * 2048 + k * 1024); } while (0)
#define PG8_MMA(ai, bj, At, Bt) do { __builtin_amdgcn_s_setprio(1); _Pragma("unroll") for (int m = 0; m < 4; ++m) _Pragma("unroll") for (int n = 0; n < 2; ++n) _Pragma("unroll") for (int k = 0; k < 2; ++k) \
        acc[ai][bj][m][n] = __builtin_amdgcn_mfma_f32_16x16x32_bf16(Bt[n][k], At[m][k], acc[ai][bj][m][n], 0, 0, 0); __builtin_amdgcn_s_setprio(0); } while (0)
#define PG8_WAIT_V(n) asm volatile("s_waitcnt vmcnt(" #n ")" ::: "memory")
#define PG8_WAIT_L(n) asm volatile("s_waitcnt lgkmcnt(" #n ")" ::: "memory")
#define PG8_BAR __builtin_amdgcn_s_barrier()
#define PG8_SCHED __builtin_amdgcn_sched_barrier(0)
    Unit cur, nxt; int ui = 0;
    if (!S.next(0, cur)) return;
    f32x4 acc[2][2][4][2];
#pragma unroll
    for (int a = 0; a < 2; ++a)
#pragma unroll
        for (int b = 0; b < 2; ++b)
#pragma unroll
            for (int m = 0; m < 4; ++m)
#pragma unroll
                for (int n = 0; n < 2; ++n) acc[a][b][m][n] = (f32x4){0.f, 0.f, 0.f, 0.f};
    bf16x8 At[4][2], B0[2][2], B1[2][2];
    const char* cA = (const char*)g.A + (size_t)cur.pm * tstep; const char* cB = (const char*)g.Bt + (size_t)cur.pn * tstep;
    S.a_ready(cur);
    PG8_STAGE(PG8_SB(0, 0), cB, voffB); PG8_STAGE(PG8_SA(0, 0), cA, voffA); PG8_STAGE(PG8_SB(0, 1), cB + hstep, voffB); PG8_STAGE(PG8_SA(0, 1), cA + hstep, voffA);
    if (wr == 1) PG8_BAR;
    PG8_WAIT_V(4); PG8_BAR;
    PG8_STAGE(PG8_SB(1, 0), cB + kstep, voffB); PG8_STAGE(PG8_SA(1, 0), cA + kstep, voffA); PG8_STAGE(PG8_SB(1, 1), cB + hstep + kstep, voffB);
    PG8_WAIT_V(6); PG8_BAR;
    PG8_STAMP();
    for (;;) {
        const bool has_next = S.next(ui + 1, nxt);
        const char* nA = has_next ? (const char*)g.A + (size_t)nxt.pm * tstep : cA; const char* nB = has_next ? (const char*)g.Bt + (size_t)nxt.pn * tstep : cB;
        for (int t = 0; t < nt; t += 2) {
            const bool last = (t == nt - 2);
            const char* a1 = cA + (size_t)(t + 1) * kstep;
            const char* a2 = last ? nA : cA + (size_t)(t + 2) * kstep; const char* b2 = last ? nB : cB + (size_t)(t + 2) * kstep;
            const char* a3 = a2 + kstep; const char* b3 = b2 + kstep;
            if (last && has_next) S.a_ready(nxt);
            PG8_LDB(B0, 0, 0); PG8_SCHED; PG8_LDA(At, 0, 0); PG8_STAGE(PG8_SA(1, 1), a1 + hstep, voffA);
            PG8_WAIT_L(8); PG8_BAR; PG8_WAIT_L(0); PG8_MMA(0, 0, At, B0); PG8_BAR; PG8_SCHED;
            PG8_LDB(B1, 0, 1); PG8_STAGE(PG8_SB(0, 0), b2, voffB);
            PG8_BAR; PG8_WAIT_L(0); PG8_MMA(0, 1, At, B1); PG8_BAR;
            PG8_LDA(At, 0, 1); PG8_STAGE(PG8_SA(0, 0), a2, voffA);
            PG8_BAR; PG8_WAIT_L(0); PG8_MMA(1, 0, At, B0); PG8_BAR; PG8_SCHED;
            PG8_STAGE(PG8_SB(0, 1), b2 + hstep, voffB);
            PG8_WAIT_V(6); PG8_BAR; PG8_MMA(1, 1, At, B1); PG8_BAR;
            PG8_LDB(B0, 1, 0); PG8_SCHED; PG8_LDA(At, 1, 0); PG8_STAGE(PG8_SA(0, 1), a2 + hstep, voffA);
            PG8_WAIT_L(8); PG8_BAR; PG8_WAIT_L(0); PG8_MMA(0, 0, At, B0); PG8_BAR; PG8_SCHED;
            PG8_LDB(B1, 1, 1); PG8_STAGE(PG8_SB(1, 0), b3, voffB);
            PG8_BAR; PG8_WAIT_L(0); PG8_MMA(0, 1, At, B1); PG8_BAR;
            PG8_LDA(At, 1, 1); PG8_STAGE(PG8_SA(1, 0), a3, voffA);
            PG8_BAR; PG8_WAIT_L(0); PG8_MMA(1, 0, At, B0); PG8_BAR; PG8_SCHED;
            PG8_STAGE(PG8_SB(1, 1), b3 + hstep, voffB);
            PG8_WAIT_V(6); PG8_BAR; PG8_MMA(1, 1, At, B1); PG8_BAR;
        }
        PG8_STAMP();
        if constexpr (!Epi::AFTER_DRAIN) { E(acc, cur, wr, wc, fr, fq); S.done(cur); }
        PG8_STAMP();
        if (!has_next) break;
#pragma unroll
        for (int a = 0; a < 2; ++a)
#pragma unroll
            for (int b = 0; b < 2; ++b)
#pragma unroll
                for (int m = 0; m < 4; ++m)
#pragma unroll
                    for (int n = 0; n < 2; ++n) acc[a][b][m][n] = (f32x4){0.f, 0.f, 0.f, 0.f};
        cur = nxt; cA = nA; cB = nB; ++ui;
    }
    PG8_WAIT_V(0);
    if (wr == 0) PG8_BAR;
    PG8_BAR;
    if constexpr (Epi::AFTER_DRAIN) { E.fused(acc, cur, wr, wc, fr, fq, lds, wid, lane); S.done(cur); }
    PG8_STAMP();
    if (STAMP && wid == 0) { stamps[lane] = lane < nts ? (((unsigned long long)(unsigned)ts_hi << 32) | (unsigned)ts_lo) : 0ull;
        if (lane == 62) stamps[62] = rt_entry; if (lane == 63) stamps[63] = (unsigned long long)wall_clock64(); }
#undef PG8_STAMP
#undef PG8_SA
#undef PG8_SB
#undef PG8_STAGE
#undef PG8_LDA
#undef PG8_LDB
#undef PG8_MMA
#undef PG8_WAIT_V
#undef PG8_WAIT_L
#undef PG8_BAR
#undef PG8_SCHED
}
}

template <class F> struct EpiCall {
    static constexpr bool PERM = false, AFTER_DRAIN = false;
    F f;
    __device__ __forceinline__ void operator()(const f32x4 (&acc)[2][2][4][2], const pg8::Unit& u, int wr, int wc, int fr, int fq) const {
        { const int t_ = opaque_tid(); fr = t_ & 15; fq = (t_ >> 4) & 3; const int wid_ = __builtin_amdgcn_readfirstlane(t_ >> 6); wr = wid_ >> 2; wc = wid_ & 3; }
#pragma unroll
        for (int ai = 0; ai < 2; ++ai)
#pragma unroll
            for (int bj = 0; bj < 2; ++bj) {
                const int n0 = u.pn * 256 + 128 * bj;
#pragma unroll
                for (int m = 0; m < 4; ++m) {
#pragma unroll
                    for (int n = 0; n < 2; ++n) f(u.pm * 256 + 128 * ai + 64 * wr + 16 * m + fr, n0 + 32 * wc + 16 * n + 4 * fq, n0, acc[ai][bj][m][n]);
                    __builtin_amdgcn_sched_barrier(0);
                }
            }
    }
};
template <class F>
DEV void gemm256(const bf16_t* A, const bf16_t* Bt, int N, int K, char* smem, F f) {
    pg8::Gemm g; g.A = A; g.Bt = Bt; g.M = S; g.N = N; g.K = K;
    pg8::StaticOrder so; so.init(S, N, (int)gridDim.x, opaque_bid());
    EpiCall<F> e{f};
    pg8::gemm_phase<EpiCall<F>, pg8::StaticOrder, false>((PG8_LAS unsigned char*)smem, g, so, e, nullptr);
}

template <int DQK>
DEV void attn_run(const bf16_t* __restrict__ qrow, bool wactive, const bf16_t* __restrict__ Kn, const bf16_t* __restrict__ Kr,
                  const bf16_t* __restrict__ VT, int t_lo, int t_hi, int t_plain, int qpos, int wqmin, int wqmax, char* smem,
                  f32x16 (&o)[4], float& mrun, float& lrun) {
    constexpr int KRS = (DQK + 8) * 2;
    constexpr int VRS = 144;
    constexpr int NKS = DQK / 16;
    constexpr int QREG = 4;
    constexpr bool ROPE = (DQK == 192);
    char* Vb0 = smem + 2 * 64 * KRS; char* Qs = Vb0 + 2 * 128 * VRS;
    const int tid = opaque_tid(), lane = tid & 63, c = lane & 31, hi = lane >> 5;
    bf16x8 qf[QREG];
#pragma unroll
    for (int ks = 0; ks < QREG; ++ks) qf[ks] = *(const bf16x8*)(qrow + 16 * ks + 8 * hi);
    char* Qw = Qs + (tid >> 6) * ((NKS - QREG) * 1024) + lane * 16;
#pragma unroll
    for (int ks = QREG; ks < NKS; ++ks) *(bf16x8*)(Qw + (ks - QREG) * 1024) = *(const bf16x8*)(qrow + 16 * ks + 8 * hi);
#pragma unroll
    for (int i = 0; i < 4; ++i)
#pragma unroll
        for (int rr = 0; rr < 16; ++rr) o[i][rr] = 0.f;
    mrun = -1e30f; lrun = 0.f;
    u32x4 kreg[2], rreg, vreg[2];
    auto gloadK = [&](int t) {
        int t2 = tid; asm volatile("" : "+v"(t2));
        const char* kn_t = (const char*)Kn + (size_t)t * (64 * 256);
#pragma unroll
        for (int i = 0; i < 2; ++i) { const int ch = t2 + NTHREADS * i; kreg[i] = *(const u32x4*)(kn_t + (unsigned)((ch >> 4) * 256 + (ch & 15) * 16)); }
        if (ROPE) { const char* kr_t = (const char*)Kr + (size_t)t * (64 * 128); rreg = *(const u32x4*)(kr_t + (unsigned)((t2 >> 3) * 128 + (t2 & 7) * 16)); }
    };
    auto gloadV = [&](int t) {
        int t2 = tid; asm volatile("" : "+v"(t2));
        const char* vt_t = (const char*)VT + (size_t)t * (128 * 128);
#pragma unroll
        for (int i = 0; i < 2; ++i) { const int ch = t2 + NTHREADS * i; vreg[i] = *(const u32x4*)(vt_t + (unsigned)(ch * 16)); }
    };
    auto lstoreK = [&](int t) {
        int t2 = tid; asm volatile("" : "+v"(t2));
        char* Ks = smem + (t & 1) * (64 * KRS);
#pragma unroll
        for (int i = 0; i < 2; ++i) { const int ch = t2 + NTHREADS * i; *(u32x4*)(Ks + (ch >> 4) * KRS + (ch & 15) * 16) = kreg[i]; }
        if (ROPE) *(u32x4*)(Ks + (t2 >> 3) * KRS + 256 + (t2 & 7) * 16) = rreg;
    };
    auto lstoreV = [&](int t) {
        int t2 = tid; asm volatile("" : "+v"(t2));
        char* Vs = Vb0 + (t & 1) * (128 * VRS);
#pragma unroll
        for (int i = 0; i < 2; ++i) {
            const int ch = t2 + NTHREADS * i;
            char* d = Vs + (ch >> 3) * VRS + ((ch & 7) >> 1) * 32 + (ch & 1) * 8;
            *(u32x2*)d = (u32x2){vreg[i].x, vreg[i].y}; *(u32x2*)(d + 16) = (u32x2){vreg[i].z, vreg[i].w};
        }
    };
    auto qk = [&](int t, f32x16 (&sv)[2]) {
        const char* Ks = smem + (t & 1) * (64 * KRS) + c * KRS + 16 * hi;
#pragma unroll
        for (int kt = 0; kt < 2; ++kt)
#pragma unroll
            for (int rr = 0; rr < 16; ++rr) sv[kt][rr] = 0.f;
        bf16x8 k0[3], k1[3], qv[3];
#pragma unroll
        for (int ks = 0; ks < 2; ++ks) {
            k0[ks] = *(const bf16x8*)(Ks + 32 * ks); k1[ks] = *(const bf16x8*)(Ks + 32 * KRS + 32 * ks);
            if (ks < QREG) qv[ks] = qf[ks < QREG ? ks : 0]; else qv[ks] = *(const bf16x8*)(Qw + (ks - QREG) * 1024);
        }
#pragma unroll
        for (int ks = 0; ks < NKS; ++ks) {
            if (ks + 2 < NKS) {
                k0[(ks + 2) % 3] = *(const bf16x8*)(Ks + 32 * (ks + 2)); k1[(ks + 2) % 3] = *(const bf16x8*)(Ks + 32 * KRS + 32 * (ks + 2));
                if (ks + 2 < QREG) qv[(ks + 2) % 3] = qf[ks + 2 < QREG ? ks + 2 : 0]; else qv[(ks + 2) % 3] = *(const bf16x8*)(Qw + (ks + 2 - QREG) * 1024);
            }
            sv[0] = mfma32(k0[ks % 3], qv[ks % 3], sv[0]);
            sv[1] = mfma32(k1[ks % 3], qv[ks % 3], sv[1]);
        }
    };
    float mnew_ = 0.f;
    auto softmax_a = [&](int t, f32x16 (&sv)[2]) {
        const int kb = t * 64;
        if (kb + 63 > wqmin) {
#pragma unroll
            for (int kt = 0; kt < 2; ++kt)
#pragma unroll
                for (int rr = 0; rr < 16; ++rr) { const int key = kb + 32 * kt + (rr & 3) + 8 * (rr >> 2) + 4 * hi; if (key > qpos) sv[kt][rr] = -__builtin_inff(); }
        }
        float tmax = sv[0][0];
#pragma unroll
        for (int rr = 1; rr < 16; ++rr) tmax = fmaxf(tmax, sv[0][rr]);
#pragma unroll
        for (int rr = 0; rr < 16; ++rr) tmax = fmaxf(tmax, sv[1][rr]);
        tmax = fmaxf(tmax, shx(tmax, 32, lane));
        const float mnew = fmaxf(mrun, tmax);
        const float alpha = ex2(mrun - mnew);
        mrun = mnew; mnew_ = mnew;
        lrun *= alpha;
        if (!__all(alpha == 1.f)) {
#pragma unroll
            for (int i = 0; i < 4; ++i)
#pragma unroll
                for (int rr = 0; rr < 16; ++rr) o[i][rr] *= alpha;
        }
    };
    auto softmax_b = [&](f32x16 (&sv)[2], bf16x8 (&pf)[2][2]) {
        const float mnew = mnew_;
        float ps = 0.f;
#pragma unroll
        for (int kt = 0; kt < 2; ++kt)
#pragma unroll
            for (int rr = 0; rr < 16; ++rr) { const float pv = ex2(sv[kt][rr] - mnew); sv[kt][rr] = pv; ps += pv; }
        lrun += ps;
#pragma unroll
        for (int kt = 0; kt < 2; ++kt)
#pragma unroll
            for (int s2 = 0; s2 < 2; ++s2) {
                u32x4 pw; pw.x = pk2(sv[kt][8 * s2 + 0], sv[kt][8 * s2 + 1]); pw.y = pk2(sv[kt][8 * s2 + 2], sv[kt][8 * s2 + 3]);
                pw.z = pk2(sv[kt][8 * s2 + 4], sv[kt][8 * s2 + 5]); pw.w = pk2(sv[kt][8 * s2 + 6], sv[kt][8 * s2 + 7]);
                pf[kt][s2] = *(const bf16x8*)&pw;
            }
    };
    auto pv = [&](int t, const bf16x8 (&pf)[2][2]) {
        const char* Vs = Vb0 + (t & 1) * (128 * VRS) + c * VRS + 16 * hi;
#pragma unroll
        for (int g = 0; g < 4; ++g)
#pragma unroll
            for (int dvt = 0; dvt < 4; ++dvt) o[dvt] = mfma32(*(const bf16x8*)(Vs + 32 * dvt * VRS + 32 * g), pf[g >> 1][g & 1], o[dvt]);
    };
    auto active = [&](int t) -> bool { return wactive && (t * 64 <= wqmax); };
    auto step = [&](int t, f32x16 (&sc)[2], f32x16 (&sn)[2]) {
        const bool more = t + 1 < t_hi;
        const int tk = t + 2 < t_hi ? t + 2 : t_hi - 1, tv = more ? t + 1 : t_hi - 1;
        const bool a0 = active(t), a1 = more && active(t + 1);
        if (a0) {
            bf16x8 pf[2][2];
            if (a1) { qk(t + 1, sn); gloadK(tk); gloadV(tv); softmax_b(sc, pf); pv(t, pf); asm volatile("; arm qk+exp+pv" ::: "memory"); }
            else { gloadK(tk); gloadV(tv); softmax_b(sc, pf); pv(t, pf); asm volatile("; arm exp+pv" ::: "memory"); }
        } else { gloadK(tk); gloadV(tv); }
        lstoreK(t + 2); lstoreV(t + 1);
        if (a1) softmax_a(t + 1, sn);
        __syncthreads();
    };
    auto fstep = [&](int t, f32x16 (&sc)[2], f32x16 (&sn)[2]) {
        const char* Ks = smem + ((t + 1) & 1) * (64 * KRS) + c * KRS + 16 * hi;
        const char* Vs = Vb0 + (t & 1) * (128 * VRS) + c * VRS + 16 * hi;
        const float mref = mnew_;
        const f32x16 zero16 = {0.f, 0.f, 0.f, 0.f, 0.f, 0.f, 0.f, 0.f, 0.f, 0.f, 0.f, 0.f, 0.f, 0.f, 0.f, 0.f};
        bf16x8 kf[3], ql[2];
        u32x4 pf4[4];
        float ps = 0.f;
        kf[0] = *(const bf16x8*)(Ks); kf[1] = *(const bf16x8*)(Ks + 32 * KRS);
        __builtin_amdgcn_sched_barrier(0);
#pragma unroll
        for (int g = 0; g < 2 * NKS; ++g) {
            const int ks = g >> 1, kt = g & 1;
            if (g + 2 < 2 * NKS) kf[(g + 2) % 3] = *(const bf16x8*)(Ks + ((g + 2) & 1) * (32 * KRS) + 32 * ((g + 2) >> 1));
            if (kt == 0 && ks + 1 >= QREG && ks + 1 < NKS) ql[(ks + 1) & 1] = *(const bf16x8*)(Qw + (ks + 1 - QREG) * 1024);
            const bf16x8 qop = ks < QREG ? qf[ks < QREG ? ks : 0] : ql[ks & 1];
            if (ks == 0) sn[kt] = mfma32(kf[g % 3], qop, zero16); else sn[kt] = mfma32(kf[g % 3], qop, sn[kt]);
            if (g < 16) {
                const int e = 2 * g;
                const float p0 = ex2(sc[e >> 4][e & 15] - mref), p1 = ex2(sc[e >> 4][(e & 15) + 1] - mref);
                ps += p0; ps += p1;
                unsigned wd = pk2(p0, p1);
                asm volatile("" : "+v"(wd), "+v"(ps));
                pf4[g >> 2][g & 3] = wd;
            }
            if (g == 17) gloadK(t + 2);
            if (g == 19) gloadV(t + 1);
            __builtin_amdgcn_sched_barrier(0);
        }
        lrun += ps;
        bf16x8 vf[3];
        vf[0] = *(const bf16x8*)(Vs); vf[1] = *(const bf16x8*)(Vs + 32 * VRS);
        float tmax = sn[0][0], tsw = 0.f, alpha = 1.f;
        __builtin_amdgcn_sched_barrier(0);
#pragma unroll
        for (int g = 0; g < 16; ++g) {
            const int gg = g >> 2, dvt = g & 3;
            if (g + 2 < 16) vf[(g + 2) % 3] = *(const bf16x8*)(Vs + 32 * ((g + 2) & 3) * VRS + 32 * ((g + 2) >> 2));
            o[dvt] = mfma32(vf[g % 3], *(const bf16x8*)&pf4[gg], o[dvt]);
            if (g < 8) {
                const int kt = g >> 2, r0 = 4 * (g & 3);
                tmax = fmaxf(fmaxf(tmax, sn[kt][r0]), sn[kt][r0 + 1]); tmax = fmaxf(fmaxf(tmax, sn[kt][r0 + 2]), sn[kt][r0 + 3]);
                asm volatile("" : "+v"(tmax));
            }
            if (g == 8) { tsw = shx(tmax, 32, lane); }
            if (g == 12) {
                tmax = fmaxf(tmax, tsw);
                const float mnew = fmaxf(mrun, tmax);
                alpha = ex2(mrun - mnew);
                mrun = mnew; mnew_ = mnew;
                lrun *= alpha;
                asm volatile("" : "+v"(alpha), "+v"(lrun));
            }
            __builtin_amdgcn_sched_barrier(0);
        }
        if (!__all(alpha == 1.f)) {
#pragma unroll
            for (int i = 0; i < 4; ++i)
#pragma unroll
                for (int rr = 0; rr < 16; ++rr) o[i][rr] *= alpha;
        }
        lstoreK(t + 2); lstoreV(t + 1);
        __syncthreads();
    };
    __syncthreads();
    gloadK(t_lo); gloadV(t_lo); lstoreK(t_lo); lstoreV(t_lo);
    if (t_lo + 1 < t_hi) { gloadK(t_lo + 1); lstoreK(t_lo + 1); }
    __syncthreads();
    f32x16 sA[2], sB[2];
    if (active(t_lo)) { qk(t_lo, sA); softmax_a(t_lo, sA); }
    __syncthreads();
    int t = t_lo;
    for (; t + 2 < t_plain; t += 2) { fstep(t, sA, sB); fstep(t + 1, sB, sA); }
    for (; t < t_hi; t += 2) {
        step(t, sA, sB);
        if (t + 1 < t_hi) step(t + 1, sB, sA);
    }
    lrun += shx(lrun, 32, lane);
}

DEV void phase_mla_attn(const Params& p, char* smem) {
    const int tid = opaque_tid(), lane = tid & 63, w = tid >> 6, c = lane & 31, hi = lane >> 5;
    for (int u = opaque_bid(); u < 256; u += gridDim.x) {
        const int head = u & 7, pi = u >> 3;
        for (int half = 0; half < 2; ++half) {
            const int qb = half == 0 ? (63 - pi) : pi;
            const int q = qb * 256 + 32 * w + c;
            f32x16 o[4]; float m, l;
            attn_run<192>(p.Qm() + ((size_t)head * S + q) * 192, true, p.Kn() + (size_t)head * S * 128, p.Kr(), p.VmT() + (size_t)head * 128 * S,
                          0, 4 * qb + 4, 4 * qb, q, qb * 256 + 32 * w, qb * 256 + 32 * w + 31, smem, o, m, l);
            const float inv = 1.f / l;
#pragma unroll
            for (int dvt = 0; dvt < 4; ++dvt)
#pragma unroll
                for (int rg = 0; rg < 4; ++rg) {
                    const int dv = 32 * dvt + 8 * rg + 4 * hi;
                    f32x4 v = {o[dvt][4 * rg] * inv, o[dvt][4 * rg + 1] * inv, o[dvt][4 * rg + 2] * inv, o[dvt][4 * rg + 3] * inv};
                    st_bf4(p.cat() + (size_t)q * DM + head * 128 + dv, v);
                }
        }
    }
}

DEV void moba_kmean_unit(const Params& p, int h, int j, char* smem) {
    float* red = (float*)smem;
    const int tid = opaque_tid(), d = tid & 127, qq = tid >> 7;
    const bf16_t* kp = p.Kb() + ((size_t)h * S + 256 * j + qq * 64) * 128 + d;
    float s = 0.f;
    for (int t = 0; t < 64; ++t) s += __uint_as_float(((unsigned)kp[(size_t)t * 128]) << 16);
    __syncthreads();
    red[qq * 128 + d] = s;
    __syncthreads();
    if (tid < 128) p.kmean()[((size_t)h * 64 + j) * 128 + tid] = (red[tid] + red[128 + tid] + red[256 + tid] + red[384 + tid]) * (1.f / 256.f);
}

DEV void moba_gate_unit(const Params& p, int u, char* smem) {
    float* km = (float*)smem;
    int* cnt = (int*)(smem + 32768);
    const int tid = opaque_tid();
    {
        const int h = u & 3, t = u >> 2;
        __syncthreads();
        for (int i = tid; i < 8192; i += NTHREADS) km[i] = p.kmean()[(size_t)h * 8192 + i];
        if (tid < 64) cnt[tid] = 0;
        __syncthreads();
        const int q = t * 512 + tid, own = q >> 8;
        float qv[128];
        const u32x4* qp = (const u32x4*)(p.Qb() + ((size_t)h * S + q) * 128);
#pragma unroll
        for (int i = 0; i < 16; ++i) { const u32x4 v = qp[i]; qv[8 * i] = bflo(v.x); qv[8 * i + 1] = bfhi(v.x); qv[8 * i + 2] = bflo(v.y); qv[8 * i + 3] = bfhi(v.y); qv[8 * i + 4] = bflo(v.z); qv[8 * i + 5] = bfhi(v.z); qv[8 * i + 6] = bflo(v.w); qv[8 * i + 7] = bfhi(v.w); }
        float b0 = -__builtin_inff(), b1 = b0, b2 = b0; int i0 = 0, i1 = 0, i2 = 0;
        const int ownw = __builtin_amdgcn_readfirstlane(own);
        for (int j = 0; j < ownw; ++j) {
            float s = 0.f; const f32x4* kp = (const f32x4*)(km + j * 128);
#pragma unroll
            for (int d4 = 0; d4 < 32; ++d4) { const f32x4 kk = kp[d4]; s += qv[4 * d4] * kk[0] + qv[4 * d4 + 1] * kk[1] + qv[4 * d4 + 2] * kk[2] + qv[4 * d4 + 3] * kk[3]; }
            if (s > b0) { b2 = b1; i2 = i1; b1 = b0; i1 = i0; b0 = s; i0 = j; }
            else if (s > b1) { b2 = b1; i2 = i1; b1 = s; i1 = j; }
            else if (s > b2) { b2 = s; i2 = j; }
        }
        const int nsel = own < 3 ? own : 3;
        if (0 < nsel) { const int pos = atomicAdd(&cnt[i0], 1); p.lists()[(((size_t)h * 64 + i0) * 32 + t) * 512 + pos] = (q << 2) | 0; }
        if (1 < nsel) { const int pos = atomicAdd(&cnt[i1], 1); p.lists()[(((size_t)h * 64 + i1) * 32 + t) * 512 + pos] = (q << 2) | 1; }
        if (2 < nsel) { const int pos = atomicAdd(&cnt[i2], 1); p.lists()[(((size_t)h * 64 + i2) * 32 + t) * 512 + pos] = (q << 2) | 2; }
        __syncthreads();
        if (tid < 64) p.segcnt()[((size_t)h * 64 + tid) * 32 + t] = cnt[tid];
    }
}

DEV void moba_write_partial(const Params& p, int q, int h, int slot, const f32x16 (&o)[4], float m, float l, int hi) {
    bf16_t* pp = (bf16_t*)p.part() + (((size_t)q * 4 + h) * 4 + slot) * 128;
    const float il = 1.f / l;
#pragma unroll
    for (int dvt = 0; dvt < 4; ++dvt)
#pragma unroll
        for (int rg = 0; rg < 4; ++rg) {
            const int dv = 32 * dvt + 8 * rg + 4 * hi;
            st_bf4(pp + dv, (f32x4){o[dvt][4 * rg] * il, o[dvt][4 * rg + 1] * il, o[dvt][4 * rg + 2] * il, o[dvt][4 * rg + 3] * il});
        }
    if (hi == 0) { float* mp = p.ml() + (((size_t)q * 4 + h) * 4 + slot) * 2; mp[0] = m; mp[1] = l; }
}

constexpr int MB_KRS = 272, MB_VRS = 136, MB_KB = 64 * MB_KRS, MB_VB = 128 * MB_VRS, MB_TAB = 8 * 17408;
DEV int moba_tile_table(const Params& p, char* smem) {
    int* P = (int*)(smem + MB_TAB + 256);
    const int tid = opaque_tid();
    __syncthreads();
    if (tid < 256) {
        const int j = tid >> 2, h = tid & 3; int s = 0;
        const int* sc = p.segcnt() + ((size_t)h * 64 + j) * 32;
        for (int t = 0; t < 32; ++t) s += sc[t];
        const int ntiles = 1 + ((s + 255) >> 8);
        P[tid + 1] = (ntiles + 3) >> 2;
    }
    if (tid == 0) P[0] = 0;
    __syncthreads();
    if (tid == 0) { int s = 0; for (int i = 1; i <= 256; ++i) { s += P[i]; P[i] = s; } }
    __syncthreads();
    return P[256];
}
DEV void moba_attn_resident(const bf16_t* __restrict__ qrow, bool wactive, int qpos, int wqmin, int wqmax, int kb0, char* smem, f32x16 (&o)[4], float& mrun, float& lrun) {
    const int tid = opaque_tid(), lane = tid & 63, c = lane & 31, hi = lane >> 5;
    bf16x8 qf[8];
#pragma unroll
    for (int ks = 0; ks < 8; ++ks) qf[ks] = *(const bf16x8*)(qrow + 16 * ks + 8 * hi);
#pragma unroll
    for (int i = 0; i < 4; ++i)
#pragma unroll
        for (int rr = 0; rr < 16; ++rr) o[i][rr] = 0.f;
    mrun = -1e30f; lrun = 0.f;
    if (!wactive) return;
    float mnew_ = 0.f;
    auto qk = [&](int t, f32x16 (&sv)[2]) {
        const char* Ks = smem + t * MB_KB + c * MB_KRS + 16 * hi;
#pragma unroll
        for (int kt = 0; kt < 2; ++kt)
#pragma unroll
            for (int rr = 0; rr < 16; ++rr) sv[kt][rr] = 0.f;
#pragma unroll
        for (int ks = 0; ks < 8; ++ks) {
            sv[0] = mfma32(*(const bf16x8*)(Ks + 32 * ks), qf[ks], sv[0]);
            sv[1] = mfma32(*(const bf16x8*)(Ks + 32 * MB_KRS + 32 * ks), qf[ks], sv[1]);
        }
    };
    auto softmax_a = [&](int t, f32x16 (&sv)[2]) {
        const int kb = kb0 + t * 64;
        if (kb + 63 > wqmin) {
#pragma unroll
            for (int kt = 0; kt < 2; ++kt)
#pragma unroll
                for (int rr = 0; rr < 16; ++rr) { const int key = kb + 32 * kt + (rr & 3) + 8 * (rr >> 2) + 4 * hi; if (key > qpos) sv[kt][rr] = -__builtin_inff(); }
        }
        float tmax = sv[0][0];
#pragma unroll
        for (int rr = 1; rr < 16; ++rr) tmax = fmaxf(tmax, sv[0][rr]);
#pragma unroll
        for (int rr = 0; rr < 16; ++rr) tmax = fmaxf(tmax, sv[1][rr]);
        tmax = fmaxf(tmax, shx(tmax, 32, lane));
        const float mnew = fmaxf(mrun, tmax);
        const float alpha = ex2(mrun - mnew);
        mrun = mnew; mnew_ = mnew;
        lrun *= alpha;
        if (!__all(alpha == 1.f)) {
#pragma unroll
            for (int i = 0; i < 4; ++i)
#pragma unroll
                for (int rr = 0; rr < 16; ++rr) o[i][rr] *= alpha;
        }
    };
    auto softmax_b = [&](f32x16 (&sv)[2], bf16x8 (&pf)[2][2]) {
        const float mnew = mnew_;
        float ps = 0.f;
#pragma unroll
        for (int kt = 0; kt < 2; ++kt)
#pragma unroll
            for (int rr = 0; rr < 16; ++rr) { const float pv = ex2(sv[kt][rr] - mnew); sv[kt][rr] = pv; ps += pv; }
        lrun += ps;
#pragma unroll
        for (int kt = 0; kt < 2; ++kt)
#pragma unroll
            for (int s2 = 0; s2 < 2; ++s2) {
                u32x4 pw; pw.x = pk2(sv[kt][8 * s2 + 0], sv[kt][8 * s2 + 1]); pw.y = pk2(sv[kt][8 * s2 + 2], sv[kt][8 * s2 + 3]);
                pw.z = pk2(sv[kt][8 * s2 + 4], sv[kt][8 * s2 + 5]); pw.w = pk2(sv[kt][8 * s2 + 6], sv[kt][8 * s2 + 7]);
                pf[kt][s2] = *(const bf16x8*)&pw;
            }
    };
    auto pv = [&](int t, const bf16x8 (&pf)[2][2]) {
        const char* Vs = smem + 4 * MB_KB + t * MB_VB + c * MB_VRS + 8 * hi;
#pragma unroll
        for (int g = 0; g < 4; ++g) {
#pragma unroll
            for (int dvt = 0; dvt < 4; ++dvt) {
                const u32x2 v0 = *(const u32x2*)(Vs + 32 * dvt * MB_VRS + 32 * g), v1 = *(const u32x2*)(Vs + 32 * dvt * MB_VRS + 32 * g + 16);
                u32x4 vw; vw.x = v0.x; vw.y = v0.y; vw.z = v1.x; vw.w = v1.y;
                o[dvt] = mfma32(*(const bf16x8*)&vw, pf[g >> 1][g & 1], o[dvt]);
            }
        }
    };
    int nt_act = 4;
    if (wqmax != 0x7fffffff) { nt_act = ((wqmax - kb0) >> 6) + 1; if (nt_act > 4) nt_act = 4; }
    f32x16 sA[2], sB[2];
    qk(0, sA);
    for (int t = 0; t < nt_act; t += 2) {
        {
            bf16x8 pf[2][2];
            softmax_a(t, sA);
            if (t + 1 < nt_act) { qk(t + 1, sB); softmax_b(sA, pf); pv(t, pf); asm volatile("; arm A1" ::: "memory"); }
            else { softmax_b(sA, pf); pv(t, pf); asm volatile("; arm A2" ::: "memory"); }
        }
        if (t + 1 < nt_act) {
            bf16x8 pf[2][2];
            softmax_a(t + 1, sB);
            if (t + 2 < nt_act) { qk(t + 2, sA); softmax_b(sB, pf); pv(t + 1, pf); asm volatile("; arm B1" ::: "memory"); }
            else { softmax_b(sB, pf); pv(t + 1, pf); asm volatile("; arm B2" ::: "memory"); }
        }
    }
    lrun += shx(lrun, 32, lane);
}
DEV void moba_subunit(const Params& p, int su, char* smem) {
    const int tid = opaque_tid(), lane = tid & 63, w = tid >> 6, c = lane & 31, hi = lane >> 5;
    int* pre = (int*)(smem + MB_TAB);
    const int* P = (const int*)(smem + MB_TAB + 256);
    int u = 0;
#pragma unroll
    for (int s = 128; s >= 1; s >>= 1) if (P[u + s] <= su) u += s;
    const int sidx = su - P[u], j = u >> 2, h = u & 3;
    const bf16_t* Kh = p.Kb() + ((size_t)h * S + 256 * j) * 128;
    const bf16_t* Vh = p.VbT() + ((size_t)h * 256 + 4 * j) * (128 * 64);
    __syncthreads();
    if (tid == 0) { int s = 0; for (int t = 0; t < 32; ++t) { pre[t] = s; s += p.segcnt()[((size_t)h * 64 + j) * 32 + t]; } pre[32] = s; }
#pragma unroll
    for (int i = 0; i < 8; ++i) {
        const int ch = tid + NTHREADS * i, row = ch >> 4, cc = ch & 15;
        *(u32x4*)(smem + (row >> 6) * MB_KB + (row & 63) * MB_KRS + cc * 16) = *(const u32x4*)((const char*)Kh + (size_t)ch * 16);
    }
#pragma unroll
    for (int i = 0; i < 8; ++i) {
        const int ch = tid + NTHREADS * i, t = ch >> 10, row = (ch >> 3) & 127, cc = ch & 7;
        const u32x4 v = *(const u32x4*)((const char*)Vh + (size_t)ch * 16);
        u32x2* d = (u32x2*)(smem + 4 * MB_KB + t * MB_VB + row * MB_VRS + cc * 16);
        d[0] = (u32x2){v.x, v.y}; d[1] = (u32x2){v.z, v.w};
    }
    __syncthreads();
    const int total = pre[32], ntiles = 1 + ((total + 255) >> 8);
    const int k_hi = (4 * sidx + 4) < ntiles ? (4 * sidx + 4) : ntiles;
    for (int k = 4 * sidx; k < k_hi; ++k) {
        const int k0 = (k - 1) * 256;
        int q, slot, qpos, wqmin, wqmax; bool valid, wact;
        if (k0 < 0) {
            q = 256 * j + 32 * w + c; slot = 3; qpos = q; wqmin = 256 * j + 32 * w; wqmax = wqmin + 31; valid = true; wact = true;
        } else {
            const int e = k0 + 32 * w + c; valid = e < total; q = 0; slot = 0;
            if (valid) {
                int seg = 0;
                for (int t = 1; t < 32; ++t) if (pre[t] <= e) seg = t;
                const int ent = p.lists()[(((size_t)h * 64 + j) * 32 + seg) * 512 + (e - pre[seg])];
                q = ent >> 2; slot = ent & 3;
            }
            qpos = 0x7fffffff; wqmin = 0x7fffffff; wqmax = 0x7fffffff; wact = (k0 + 32 * w) < total;
        }
        f32x16 o[4]; float m, l;
        moba_attn_resident(p.Qb() + ((size_t)h * S + q) * 128, wact, qpos, wqmin, wqmax, 256 * j, smem, o, m, l);
        if (valid) moba_write_partial(p, q, h, slot, o, m, l, hi);
    }
}

constexpr int GP_KN = 0, GP_KB = 17408, GP_QS = 34816, GP_RF = 52224, GP_LM = 117760, GP_KDT = 135168, GP_GC = 153600, GP_BT = 153856;
DEV void gdn_prep_unit(const Params& p, int li, int n, int h, char* smem) {
    const int tid = opaque_tid(), lane = tid & 63, w = tid >> 6, r = lane & 15, g = lane >> 4;
    char* Kn16 = smem + GP_KN; char* Kb16 = smem + GP_KB; char* Qs16 = smem + GP_QS;
    float* Rf = (float*)(smem + GP_RF); float* Lm = (float*)(smem + GP_LM); char* KdT = smem + GP_KDT;
    float* gc = (float*)(smem + GP_GC); float* bt = (float*)(smem + GP_BT);
    const size_t cb = (size_t)n * 4 + h;
    __syncthreads();
    if (w == 0) {
        const int tok = 64 * n + lane;
        const float a = p.ba()[(size_t)tok * 8 + 4 + h], bb = p.ba()[(size_t)tok * 8 + h];
        float gv = -expf(p.gdn_a_log[li * 4 + h]) * softplusf(a + p.gdn_dt_bias[li * 4 + h]);
#pragma unroll
        for (int o = 1; o < 64; o <<= 1) { const float t = __int_as_float(__builtin_amdgcn_ds_bpermute((lane - o) << 2, __float_as_int(gv))); if (lane >= o) gv += t; }
        gc[lane] = gv; bt[lane] = 1.f / (1.f + expf(-bb));
    }
    __syncthreads();
    const float glast = gc[63];
    {
        const int tok = tid >> 3, grp = tid & 7, gt = 64 * n + tok;
        const float gct = gc[tok], btt = bt[tok];
        const float egc = expf(gct), egl = expf(glast - gct);
        const float* cw = p.gdn_conv + (size_t)li * 4 * 1536;
#pragma unroll
        for (int part = 0; part < 3; ++part) {
            const int ch0 = part * 512 + h * 128 + grp * 16;
            float val[16];
#pragma unroll
            for (int i = 0; i < 16; ++i) val[i] = 0.f;
#pragma unroll
            for (int j = 0; j < 4; ++j) {
                const int ts = gt - 3 + j;
                if (ts >= 0) {
                    const u32x4* xp = (const u32x4*)(p.proj_a() + (size_t)ts * 1536 + ch0);
                    const u32x4 x0 = xp[0], x1 = xp[1];
                    const f32x4* wp = (const f32x4*)(cw + (size_t)j * 1536 + ch0);
                    const f32x4 w0 = wp[0], w1 = wp[1], w2 = wp[2], w3 = wp[3];
                    val[0] += bflo(x0.x) * w0[0]; val[1] += bfhi(x0.x) * w0[1]; val[2] += bflo(x0.y) * w0[2]; val[3] += bfhi(x0.y) * w0[3];
                    val[4] += bflo(x0.z) * w1[0]; val[5] += bfhi(x0.z) * w1[1]; val[6] += bflo(x0.w) * w1[2]; val[7] += bfhi(x0.w) * w1[3];
                    val[8] += bflo(x1.x) * w2[0]; val[9] += bfhi(x1.x) * w2[1]; val[10] += bflo(x1.y) * w2[2]; val[11] += bfhi(x1.y) * w2[3];
                    val[12] += bflo(x1.z) * w3[0]; val[13] += bfhi(x1.z) * w3[1]; val[14] += bflo(x1.w) * w3[2]; val[15] += bfhi(x1.w) * w3[3];
                }
            }
#pragma unroll
            for (int i = 0; i < 16; ++i) val[i] = siluf(val[i]);
            if (part < 2) {
                float ss = 0.f;
#pragma unroll
                for (int i = 0; i < 16; ++i) ss += val[i] * val[i];
                ss += shx(ss, 1, lane); ss += shx(ss, 2, lane); ss += shx(ss, 4, lane);
                const float rn = rsqrtf(ss + 1e-6f);
#pragma unroll
                for (int i = 0; i < 16; ++i) val[i] *= rn;
            }
            if (part == 0) {
                const float qs = 0.08838834764831845f;
                u32x4 a0, a1, d0, d1;
                a0.x = pk2(val[0] * qs, val[1] * qs); a0.y = pk2(val[2] * qs, val[3] * qs); a0.z = pk2(val[4] * qs, val[5] * qs); a0.w = pk2(val[6] * qs, val[7] * qs);
                a1.x = pk2(val[8] * qs, val[9] * qs); a1.y = pk2(val[10] * qs, val[11] * qs); a1.z = pk2(val[12] * qs, val[13] * qs); a1.w = pk2(val[14] * qs, val[15] * qs);
                *(u32x4*)(Qs16 + tok * 272 + grp * 32) = a0; *(u32x4*)(Qs16 + tok * 272 + grp * 32 + 16) = a1;
                const float qd = qs * egc;
                d0.x = pk2(val[0] * qd, val[1] * qd); d0.y = pk2(val[2] * qd, val[3] * qd); d0.z = pk2(val[4] * qd, val[5] * qd); d0.w = pk2(val[6] * qd, val[7] * qd);
                d1.x = pk2(val[8] * qd, val[9] * qd); d1.y = pk2(val[10] * qd, val[11] * qd); d1.z = pk2(val[12] * qd, val[13] * qd); d1.w = pk2(val[14] * qd, val[15] * qd);
                bf16_t* qo = p.qdec() + (((cb * 4 + (tok >> 4)) * 4 + (grp >> 1)) * 64 + (2 * (grp & 1)) * 16 + (tok & 15)) * 8;
                *(u32x4*)qo = d0; *(u32x4*)(qo + 16 * 8) = d1;
            } else if (part == 1) {
                u32x4 a0, a1, d0, d1;
                a0.x = pk2(val[0], val[1]); a0.y = pk2(val[2], val[3]); a0.z = pk2(val[4], val[5]); a0.w = pk2(val[6], val[7]);
                a1.x = pk2(val[8], val[9]); a1.y = pk2(val[10], val[11]); a1.z = pk2(val[12], val[13]); a1.w = pk2(val[14], val[15]);
                *(u32x4*)(Kn16 + tok * 272 + grp * 32) = a0; *(u32x4*)(Kn16 + tok * 272 + grp * 32 + 16) = a1;
                d0.x = pk2(val[0] * btt, val[1] * btt); d0.y = pk2(val[2] * btt, val[3] * btt); d0.z = pk2(val[4] * btt, val[5] * btt); d0.w = pk2(val[6] * btt, val[7] * btt);
                d1.x = pk2(val[8] * btt, val[9] * btt); d1.y = pk2(val[10] * btt, val[11] * btt); d1.z = pk2(val[12] * btt, val[13] * btt); d1.w = pk2(val[14] * btt, val[15] * btt);
                *(u32x4*)(Kb16 + tok * 272 + grp * 32) = d0; *(u32x4*)(Kb16 + tok * 272 + grp * 32 + 16) = d1;
                const float kb = btt * egc;
#pragma unroll
                for (int i = 0; i < 16; ++i) {
                    Rf[tok * 256 + 128 + grp * 16 + i] = val[i] * kb;
                    *(bf16_t*)(KdT + (grp * 16 + i) * 144 + tok * 2) = f2bf(val[i] * egl);
                }
            } else {
#pragma unroll
                for (int i = 0; i < 16; ++i) Rf[tok * 256 + grp * 16 + i] = val[i] * btt;
            }
        }
    }
    __syncthreads();
#pragma unroll
    for (int tt = 0; tt < 2; ++tt) {
        const int tile = 2 * w + tt, ct = tile >> 2, mt = tile & 3;
        f32x4 accL = {0.f, 0.f, 0.f, 0.f}, accQ = {0.f, 0.f, 0.f, 0.f};
#pragma unroll
        for (int ks = 0; ks < 4; ++ks) {
            const bf16x8 akb = *(const bf16x8*)(Kb16 + (16 * ct + r) * 272 + (32 * ks + 8 * g) * 2);
            const bf16x8 knm = *(const bf16x8*)(Kn16 + (16 * mt + r) * 272 + (32 * ks + 8 * g) * 2);
            const bf16x8 qsc = *(const bf16x8*)(Qs16 + (16 * ct + r) * 272 + (32 * ks + 8 * g) * 2);
            accL = mfma16(akb, knm, accL);
            accQ = mfma16(knm, qsc, accQ);
        }
#pragma unroll
        for (int jj = 0; jj < 4; ++jj) {
            const int ci = 16 * ct + 4 * g + jj, mi = 16 * mt + r;
            Lm[ci * 68 + mi] = (mi < ci) ? accL[jj] * expf(gc[ci] - gc[mi]) : 0.f;
        }
        {
            const int ci = 16 * ct + r;
            f32x4 v;
#pragma unroll
            for (int jj = 0; jj < 4; ++jj) { const int mi = 16 * mt + 4 * g + jj; v[jj] = (mi <= ci) ? accQ[jj] * expf(gc[ci] - gc[mi]) : 0.f; }
            { const int m0_ = 16 * mt + 4 * g;
              st_bf4(p.qk() + (((cb * 4 + ct) * 2 + (m0_ >> 5)) * 64 + ((m0_ >> 3) & 3) * 16 + r) * 8 + (m0_ & 7), v); }
        }
    }
#pragma unroll
    for (int i = 0; i < 2; ++i) {
        const int ch = tid + NTHREADS * i, row = ch >> 3, cc = ch & 7;
        *(u32x4*)(p.kdT() + (((cb * 8 + (row >> 4)) * 2 + (cc >> 2)) * 64 + (cc & 3) * 16 + (row & 15)) * 8) = *(const u32x4*)(KdT + row * 144 + cc * 16);
    }
    __syncthreads();
    if (w < 4) {
        const int col = tid;
        float x[64];
#pragma unroll
        for (int i = 0; i < 64; ++i) {
            float a = Rf[i * 256 + col];
#pragma unroll
            for (int j4 = 0; j4 < (i + 3) / 4; ++j4) {
                const f32x4 l4 = *(const f32x4*)(Lm + i * 68 + 4 * j4);
#pragma unroll
                for (int jj = 0; jj < 4; ++jj) if (4 * j4 + jj < i) a -= l4[jj] * x[4 * j4 + jj];
            }
            x[i] = a;
        }
        if (col < 128) {
#pragma unroll
            for (int i4 = 0; i4 < 16; ++i4) {
                float* up_ = p.u32() + ((((cb * 4 + (i4 >> 2)) * 8 + (col >> 4)) * 64 + (i4 & 3) * 16 + (col & 15)) * 4);
                *(f32x4*)up_ = (f32x4){x[4 * i4], x[4 * i4 + 1], x[4 * i4 + 2], x[4 * i4 + 3]};
            }
        } else {
#pragma unroll
            for (int i = 0; i < 64; ++i) { const int cc_ = col - 128; p.wneg()[(((cb * 4 + (i >> 4)) * 4 + (cc_ >> 5)) * 64 + ((cc_ >> 3) & 3) * 16 + (i & 15)) * 8 + (cc_ & 7)] = f2bf(-x[i]); }
        }
    }
    if (tid == 0) p.glast()[cb] = expf(glast);
}

struct ScanFr { bf16x8 af[4]; bf16x8 qkf[2]; bf16x8 kdf[2]; f32x4 u[2]; float eg; };
DEV void gdn_scan_seg(const Params& p, int sw, int seg, float* __restrict__ scanst, char* smem) {
    const int tid = opaque_tid(), lane = tid & 63, w = tid >> 6, r = lane & 15, g = lane >> 4;
    const int h = sw >> 2, dvb = (sw & 3) * 32;
    const bool lead = w < 4; const int mt = w & 3;
    char* S16 = smem; char* Vn16 = smem + 8704;
    const int nbeg = seg * 64, nend = nbeg + 64;
    float* stp = scanst + ((size_t)sw * NTHREADS + tid) * 8;
    __syncthreads();
    f32x4 sacc[2] = {{0.f, 0.f, 0.f, 0.f}, {0.f, 0.f, 0.f, 0.f}};
    if (seg > 0) { sacc[0] = *(const f32x4*)stp; sacc[1] = *(const f32x4*)(stp + 4); }
#pragma unroll
    for (int n2 = 0; n2 < 2; ++n2)
        *(u32x2*)(S16 + (16 * n2 + r) * 272 + (16 * w + 4 * g) * 2) = (u32x2){pk2(sacc[n2][0], sacc[n2][1]), pk2(sacc[n2][2], sacc[n2][3])};
    auto load = [&](int n, ScanFr& f) {
        const size_t cb = (size_t)n * 4 + h;
        const bf16_t* ap = (lead ? p.wneg() : p.qdec()) + ((cb * 4 + mt) * 4) * 512 + lane * 8;
#pragma unroll
        for (int ks = 0; ks < 4; ++ks) f.af[ks] = *(const bf16x8*)(ap + ks * 512);
        const bf16_t* kp = p.kdT() + ((cb * 8 + w) * 2) * 512 + lane * 8;
#pragma unroll
        for (int ks = 0; ks < 2; ++ks) f.kdf[ks] = *(const bf16x8*)(kp + ks * 512);
        if (lead) {
            const float* up = p.u32() + (((cb * 4 + mt) * 8 + (dvb >> 4)) * 64 + lane) * 4;
            f.u[0] = *(const f32x4*)up; f.u[1] = *(const f32x4*)(up + 256);
        } else {
            const bf16_t* qkp = p.qk() + ((cb * 4 + mt) * 2) * 512 + lane * 8;
#pragma unroll
            for (int ks = 0; ks < 2; ++ks) f.qkf[ks] = *(const bf16x8*)(qkp + ks * 512);
        }
        f.eg = p.glast()[cb];
    };
    ScanFr fA, fB, fC, fD; load(nbeg, fA); load(nbeg + 1, fB); load(nbeg + 2, fC);
    __syncthreads();
    auto step = [&](int n, ScanFr& cu, ScanFr& nx3) {
        if (n + 3 < nend) load(n + 3, nx3);
        f32x4 a[2];
        if (lead) { a[0] = cu.u[0]; a[1] = cu.u[1]; } else { a[0] = (f32x4){0.f, 0.f, 0.f, 0.f}; a[1] = a[0]; }
#pragma unroll
        for (int ks = 0; ks < 4; ++ks) {
#pragma unroll
            for (int nt = 0; nt < 2; ++nt) {
                const bf16x8 sf = *(const bf16x8*)(S16 + (16 * nt + r) * 272 + (32 * ks + 8 * g) * 2);
                a[nt] = mfma16(cu.af[ks], sf, a[nt]);
            }
        }
        if (lead) {
#pragma unroll
            for (int nt = 0; nt < 2; ++nt)
                *(u32x2*)(Vn16 + (16 * nt + r) * 144 + (16 * mt + 4 * g) * 2) = (u32x2){pk2(a[nt][0], a[nt][1]), pk2(a[nt][2], a[nt][3])};
        }
        asm volatile("s_waitcnt lgkmcnt(0)" ::: "memory"); __builtin_amdgcn_s_barrier(); asm volatile("" ::: "memory");
        bf16x8 vf[2][2];
#pragma unroll
        for (int nt = 0; nt < 2; ++nt)
#pragma unroll
            for (int ks = 0; ks < 2; ++ks) vf[nt][ks] = *(const bf16x8*)(Vn16 + (16 * nt + r) * 144 + (32 * ks + 8 * g) * 2);
        if (!lead) {
#pragma unroll
            for (int nt = 0; nt < 2; ++nt) {
#pragma unroll
                for (int ks = 0; ks < 2; ++ks) a[nt] = mfma16(cu.qkf[ks], vf[nt][ks], a[nt]);
                *(f32x4*)(p.oa() + ((((size_t)n * 4 + mt) * 32 + (h * 8 + (dvb >> 4) + nt)) * 64 + lane) * 4) = a[nt];
            }
        }
#pragma unroll
        for (int n2 = 0; n2 < 2; ++n2) {
            sacc[n2] = sacc[n2] * cu.eg;
#pragma unroll
            for (int ks = 0; ks < 2; ++ks) sacc[n2] = mfma16(cu.kdf[ks], vf[n2][ks], sacc[n2]);
            *(u32x2*)(S16 + (16 * n2 + r) * 272 + (16 * w + 4 * g) * 2) = (u32x2){pk2(sacc[n2][0], sacc[n2][1]), pk2(sacc[n2][2], sacc[n2][3])};
        }
        asm volatile("s_waitcnt lgkmcnt(0)" ::: "memory"); __builtin_amdgcn_s_barrier(); asm volatile("" ::: "memory");
    };
    for (int n = nbeg; n < nend; n += 4) { step(n, fA, fD); step(n + 1, fB, fA); step(n + 2, fC, fB); step(n + 3, fD, fC); }
    *(f32x4*)stp = sacc[0]; *(f32x4*)(stp + 4) = sacc[1];
}

DEV void phase_even_combine(const Params& p, int li) {
    const int tid = opaque_tid(), lane = tid & 63, w = __builtin_amdgcn_readfirstlane(tid >> 6), hh = lane >> 4, d0 = (lane & 15) * 8;
    for (int tok = opaque_bid() * 8 + w; tok < S; tok += gridDim.x * 8) {
        {
            const int col0 = hh * 128 + d0;
            const float* op = p.oa() + (((((size_t)(tok >> 6)) * 4 + ((tok & 63) >> 4)) * 32 + (col0 >> 4)) * 64 + ((tok & 15) >> 2) * 16 + (col0 & 15)) * 4 + (tok & 3);
            const f32x4 a = {op[0], op[4], op[8], op[12]}, b = {op[16], op[20], op[24], op[28]};
            float ss = a[0] * a[0] + a[1] * a[1] + a[2] * a[2] + a[3] * a[3] + b[0] * b[0] + b[1] * b[1] + b[2] * b[2] + b[3] * b[3];
            ss += shx(ss, 1, lane); ss += shx(ss, 2, lane); ss += shx(ss, 4, lane); ss += shx(ss, 8, lane);
            const float rn = rsqrtf(ss * (1.f / 128.f) + 1e-6f);
            const u32x4 z = *(const u32x4*)(p.zbuf() + (size_t)tok * 512 + hh * 128 + d0);
            const f32x4 n0 = *(const f32x4*)(p.gdn_o_norm + li * 128 + d0), n1 = *(const f32x4*)(p.gdn_o_norm + li * 128 + d0 + 4);
            u32x4 o;
            o.x = pk2(a[0] * rn * n0[0] * siluf(bflo(z.x)), a[1] * rn * n0[1] * siluf(bfhi(z.x)));
            o.y = pk2(a[2] * rn * n0[2] * siluf(bflo(z.y)), a[3] * rn * n0[3] * siluf(bfhi(z.y)));
            o.z = pk2(b[0] * rn * n1[0] * siluf(bflo(z.z)), b[1] * rn * n1[1] * siluf(bfhi(z.z)));
            o.w = pk2(b[2] * rn * n1[2] * siluf(bflo(z.w)), b[3] * rn * n1[3] * siluf(bfhi(z.w)));
            *(u32x4*)(p.cat() + (size_t)tok * DM + hh * 128 + d0) = o;
        }
        {
            const int own = tok >> 8, nsel = own < 3 ? own : 3;
            const float* mlp = p.ml() + ((size_t)tok * 4 + hh) * 8;
            const bf16_t* pp = (const bf16_t*)p.part() + ((size_t)tok * 4 + hh) * 4 * 128 + d0;
            const float m3 = mlp[6], l3 = mlp[7];
            float ms[3], ls[3]; float mm = m3;
#pragma unroll
            for (int s = 0; s < 3; ++s) { ms[s] = -1e30f; ls[s] = 0.f; if (s < nsel) { ms[s] = mlp[2 * s]; ls[s] = mlp[2 * s + 1]; mm = fmaxf(mm, ms[s]); } }
            float wt = ex2(m3 - mm) * l3, den = wt;
            f32x4 a, b;
            { const u32x4 v = *(const u32x4*)(pp + 3 * 128); a = (f32x4){bflo(v.x), bfhi(v.x), bflo(v.y), bfhi(v.y)} * wt; b = (f32x4){bflo(v.z), bfhi(v.z), bflo(v.w), bfhi(v.w)} * wt; }
#pragma unroll
            for (int s = 0; s < 3; ++s) if (s < nsel) {
                wt = ex2(ms[s] - mm) * ls[s]; den += wt;
                const u32x4 v = *(const u32x4*)(pp + s * 128);
                a += (f32x4){bflo(v.x), bfhi(v.x), bflo(v.y), bfhi(v.y)} * wt; b += (f32x4){bflo(v.z), bfhi(v.z), bflo(v.w), bfhi(v.w)} * wt;
            }
            const float inv = 1.f / den;
            u32x4 o; o.x = pk2(a[0] * inv, a[1] * inv); o.y = pk2(a[2] * inv, a[3] * inv); o.z = pk2(b[0] * inv, b[1] * inv); o.w = pk2(b[2] * inv, b[3] * inv);
            *(u32x4*)(p.cat() + (size_t)tok * DM + 512 + hh * 128 + d0) = o;
        }
    }
}

DEV void phase_mla_cnorm(const Params& p, int li) {
    const int tid = opaque_tid(), lane = tid & 63, w = __builtin_amdgcn_readfirstlane(tid >> 6);
    for (int row = opaque_bid() * 8 + w; row < S; row += gridDim.x * 8) {
        const bf16_t* cp = p.cbuf() + (size_t)row * 768;
        const u32x4 qv = *(const u32x4*)(cp + lane * 8);
        const u32x2 kv = *(const u32x2*)(cp + 512 + lane * 4);
        float q[8] = {bflo(qv.x), bfhi(qv.x), bflo(qv.y), bfhi(qv.y), bflo(qv.z), bfhi(qv.z), bflo(qv.w), bfhi(qv.w)};
        float k[4] = {bflo(kv.x), bfhi(kv.x), bflo(kv.y), bfhi(kv.y)};
        float sq = 0.f, sk = 0.f;
#pragma unroll
        for (int i = 0; i < 8; ++i) sq += q[i] * q[i];
#pragma unroll
        for (int i = 0; i < 4; ++i) sk += k[i] * k[i];
        sq = wsum64(sq, lane); sk = wsum64(sk, lane);
        const float rq = rsqrtf(sq * (1.f / 512.f) + 1e-6f), rk = rsqrtf(sk * (1.f / 256.f) + 1e-6f);
        const float* qn = p.mla_q_norm + li * 512 + lane * 8; const float* kn = p.mla_kv_norm + li * 256 + lane * 4;
        u32x4 oq; oq.x = pk2(q[0] * rq * qn[0], q[1] * rq * qn[1]); oq.y = pk2(q[2] * rq * qn[2], q[3] * rq * qn[3]);
        oq.z = pk2(q[4] * rq * qn[4], q[5] * rq * qn[5]); oq.w = pk2(q[6] * rq * qn[6], q[7] * rq * qn[7]);
        *(u32x4*)(p.cqn() + (size_t)row * 512 + lane * 8) = oq;
        u32x2 ok; ok.x = pk2(k[0] * rk * kn[0], k[1] * rk * kn[1]); ok.y = pk2(k[2] * rk * kn[2], k[3] * rk * kn[3]);
        *(u32x2*)(p.ckvn() + (size_t)row * 256 + lane * 4) = ok;
    }
}

#define SORT16_NET(CE) CE(0,1) CE(2,3) CE(0,2) CE(1,3) CE(1,2) CE(4,5) CE(6,7) CE(4,6) CE(5,7) CE(5,6) CE(0,4) CE(2,6) CE(2,4) CE(1,5) CE(3,7) CE(3,5) CE(1,2) CE(3,4) CE(5,6) CE(8,9) CE(10,11) CE(8,10) CE(9,11) CE(9,10) CE(12,13) CE(14,15) CE(12,14) CE(13,15) CE(13,14) CE(8,12) CE(10,14) CE(10,12) CE(9,13) CE(11,15) CE(11,13) CE(9,10) CE(11,12) CE(13,14) CE(0,8) CE(4,12) CE(4,8) CE(2,10) CE(6,14) CE(6,10) CE(2,4) CE(6,8) CE(10,12) CE(1,9) CE(5,13) CE(5,9) CE(3,11) CE(7,15) CE(7,11) CE(3,5) CE(7,9) CE(11,13) CE(1,2) CE(3,4) CE(5,6) CE(7,8) CE(9,10) CE(11,12) CE(13,14)

template <int OFF> DEV void sort16(float (&v)[64]) {
#define CE_(a, b) { const float hi_ = fmaxf(v[OFF + a], v[OFF + b]), lo_ = fminf(v[OFF + a], v[OFF + b]); v[OFF + a] = hi_; v[OFF + b] = lo_; }
    SORT16_NET(CE_)
#undef CE_
}
template <int A> DEV void bitonic16(float (&v)[64]) {
#pragma unroll
    for (int d = 8; d >= 1; d >>= 1)
#pragma unroll
        for (int i = 0; i < 16; ++i) if ((i & d) == 0) { const float hi_ = fmaxf(v[A + i], v[A + i + d]), lo_ = fminf(v[A + i], v[A + i + d]); v[A + i] = hi_; v[A + i + d] = lo_; }
}
template <int A, int B> DEV void merge16(float (&v)[64]) {
#pragma unroll
    for (int i = 0; i < 16; ++i) v[A + i] = fmaxf(v[A + i], v[B + 15 - i]);
    bitonic16<A>(v);
}
DEV void top16_of_64(float (&v)[64]) {
    sort16<0>(v); sort16<16>(v); sort16<32>(v); sort16<48>(v);
    merge16<0, 16>(v); merge16<32, 48>(v); merge16<0, 32>(v);
}

DEV void phase_peer_topk(const Params& p, int layer, char* smem) {
    const int tid = opaque_tid(), lane = tid & 63, w = tid >> 6, c = lane & 31, hi = lane >> 5;
    char* SK = smem;
    constexpr int CI[50] = {0,0,0,0,0,0,0,0,0,0,0,0,0,0,0,0, 1,1,1,1,1,1,1,1, 2,2,2,2,2, 3,3,3,3, 4,4,4, 5,5, 6,6, 7,7, 8,9,10,11,12,13,14,15};
    constexpr int CJ[50] = {0,1,2,3,4,5,6,7,8,9,10,11,12,13,14,15, 0,1,2,3,4,5,6,7, 0,1,2,3,4, 0,1,2,3, 0,1,2, 0,1, 0,1, 0,1, 0,0,0,0,0,0,0,0};
    int loaded_h = -1;
    for (int u = opaque_bid(); u < 512; u += gridDim.x) {
        const int h = u & 7, tg = u >> 3;
        if (h != loaded_h) {
            __syncthreads();
#pragma unroll
            for (int i = 0; i < 8; ++i) {
                const int ch = tid + NTHREADS * i, pp = ch >> 11, rem = ch & 2047, row = rem >> 4, cc = rem & 15;
                *(u32x4*)(SK + pp * 34816 + row * 272 + cc * 16) = *(const u32x4*)(p.skb() + ((((size_t)layer * 8 + h) * 2 + pp) * 128 + row) * 128 + cc * 8);
            }
            __syncthreads();
            loaded_h = h;
        }
        const int token = tg * 256 + 32 * w + c;
        float s0[16], s1[16];
#pragma unroll
        for (int pp = 0; pp < 2; ++pp) {
            bf16x8 qf[8];
            const bf16_t* qp = p.qbuf() + (size_t)token * 2048 + (h * 2 + pp) * 128 + 8 * hi;
#pragma unroll
            for (int ks = 0; ks < 8; ++ks) qf[ks] = *(const bf16x8*)(qp + 16 * ks);
            float v[64];
#pragma unroll
            for (int kt = 0; kt < 4; ++kt) {
                f32x16 acc;
#pragma unroll
                for (int rr = 0; rr < 16; ++rr) acc[rr] = 0.f;
#pragma unroll
                for (int ks = 0; ks < 8; ++ks) acc = mfma32(*(const bf16x8*)(SK + pp * 34816 + (32 * kt + c) * 272 + (16 * ks + 8 * hi) * 2), qf[ks], acc);
#pragma unroll
                for (int rr = 0; rr < 16; ++rr) {
                    const unsigned idx = (unsigned)(32 * kt + (rr & 3) + 8 * (rr >> 2) + 4 * hi);
                    v[16 * kt + rr] = __uint_as_float((__float_as_uint(acc[rr]) & ~127u) | idx);
                }
            }
            top16_of_64(v);
#pragma unroll
            for (int i = 0; i < 16; ++i) v[16 + i] = shx(v[15 - i], 32, lane);
#pragma unroll
            for (int i = 0; i < 16; ++i) v[i] = fmaxf(v[i], v[16 + i]);
            bitonic16<0>(v);
#pragma unroll
            for (int i = 0; i < 16; ++i) { if (pp == 0) s0[i] = v[i]; else s1[i] = v[i]; }
        }
        float cv[64];
#pragma unroll
        for (int k = 0; k < 50; ++k) {
            const float a = s0[CI[k]], b = s1[CJ[k]];
            const unsigned id = ((__float_as_uint(a) & 127u) << 7) | (__float_as_uint(b) & 127u);
            cv[k] = __uint_as_float((__float_as_uint(a + b) & ~0x3FFFu) | id);
        }
#pragma unroll
        for (int k = 50; k < 64; ++k) cv[k] = -__builtin_inff();
        top16_of_64(cv);
        float e[16], sum = 0.f;
#pragma unroll
        for (int i = 0; i < 16; ++i) { e[i] = expf(cv[i] - cv[0]); sum += e[i]; }
        const float inv = 1.f / sum;
        if (hi == 0) {
            int* ep = p.expert() + (size_t)token * 128 + h * 16; float* gp = p.gate() + (size_t)token * 128 + h * 16;
#pragma unroll
            for (int i4 = 0; i4 < 4; ++i4) {
                i32x4 ev; ev.x = (int)(__float_as_uint(cv[4 * i4]) & 0x3FFFu); ev.y = (int)(__float_as_uint(cv[4 * i4 + 1]) & 0x3FFFu);
                ev.z = (int)(__float_as_uint(cv[4 * i4 + 2]) & 0x3FFFu); ev.w = (int)(__float_as_uint(cv[4 * i4 + 3]) & 0x3FFFu);
                *(i32x4*)(ep + 4 * i4) = ev;
                *(f32x4*)(gp + 4 * i4) = (f32x4){e[4 * i4] * inv, e[4 * i4 + 1] * inv, e[4 * i4 + 2] * inv, e[4 * i4 + 3] * inv};
            }
        }
    }
}

typedef float f32x2 __attribute__((ext_vector_type(2)));
DEV void unpack_fp4x16(const u32x2& r, f32x2 (&f)[8]) {
#pragma unroll
    for (int q = 0; q < 2; ++q) {
        f[4 * q + 0] = __builtin_amdgcn_cvt_scalef32_pk_f32_fp4(r[q], 1.0f, 0);
        f[4 * q + 1] = __builtin_amdgcn_cvt_scalef32_pk_f32_fp4(r[q], 1.0f, 1);
        f[4 * q + 2] = __builtin_amdgcn_cvt_scalef32_pk_f32_fp4(r[q], 1.0f, 2);
        f[4 * q + 3] = __builtin_amdgcn_cvt_scalef32_pk_f32_fp4(r[q], 1.0f, 3);
    }
}

template <int NMODE>
DEV void phase_peer_gather(const Params& p, int layer, const float* __restrict__ g2, const float* __restrict__ xsrc, float* __restrict__ xdst,
                           const float* __restrict__ nw, const float* __restrict__ shv, const float* __restrict__ scv, const float* __restrict__ w8src, char* smem) {
    const int tid = opaque_tid(), lane = tid & 63, w = __builtin_amdgcn_readfirstlane(tid >> 6);
    float* W8 = (float*)smem;
    if (NMODE == 1) {
        for (int i = tid; i < 8192; i += NTHREADS) { const int k = i >> 3, c = i & 7; W8[c * 1024 + k] = w8src[(size_t)k * HY_IN + 2048 + c]; }
        __syncthreads();
    }
    f32x4 wm[4], sh[4];
#pragma unroll
    for (int i = 0; i < 4; ++i) {
        const f32x4 nv = *(const f32x4*)(nw + lane * 16 + 4 * i);
        if (NMODE == 2) { wm[i] = nv; sh[i] = (f32x4){0.f, 0.f, 0.f, 0.f}; }
        else { wm[i] = nv * (*(const f32x4*)(scv + lane * 16 + 4 * i) + 1.0f); sh[i] = *(const f32x4*)(shv + lane * 16 + 4 * i); }
    }
    const unsigned char* ub = p.ub() + (size_t)layer * 16384 * 512; const unsigned char* vb = p.vb() + (size_t)layer * 16384 * 512;
    const unsigned lo8 = (unsigned)lane * 8u;
    const int idxl = ((lane >> 5) & 1) * 8 + ((lane >> 4) & 1) * 4 + ((lane >> 3) & 1) * 2 + ((lane >> 2) & 1);
    for (int tok = opaque_bid() * 8 + w; tok < S; tok += gridDim.x * 8) {
        int hA0, hA1, hB0, hB1; float kh;
        {
            const u32x4 h0 = *(const u32x4*)(p.h() + (size_t)tok * DM + lane * 16), h1 = *(const u32x4*)(p.h() + (size_t)tok * DM + lane * 16 + 8);
            float hf[16] = {bflo(h0.x), bfhi(h0.x), bflo(h0.y), bfhi(h0.y), bflo(h0.z), bfhi(h0.z), bflo(h0.w), bfhi(h0.w),
                            bflo(h1.x), bfhi(h1.x), bflo(h1.y), bfhi(h1.y), bflo(h1.z), bfhi(h1.z), bflo(h1.w), bfhi(h1.w)};
            float mx = 0.f;
#pragma unroll
            for (int i = 0; i < 16; ++i) mx = fmaxf(mx, fabsf(hf[i]));
#pragma unroll
            for (int o = 32; o; o >>= 1) mx = fmaxf(mx, shx(mx, o, lane));
            kh = 119.f / fmaxf(mx, 1e-20f);
            unsigned a0 = 0, a1 = 0, b0 = 0, b1 = 0;
#pragma unroll
            for (int i = 0; i < 16; ++i) {
                const int h8 = (int)__builtin_rintf(hf[i] * kh);
                const int lo = ((h8 + 8) & 15) - 8, hi4 = (h8 - lo) >> 4;
                if (i < 8) { a0 |= ((unsigned)hi4 & 15u) << (4 * i); b0 |= ((unsigned)lo & 15u) << (4 * i); }
                else { a1 |= ((unsigned)hi4 & 15u) << (4 * (i - 8)); b1 |= ((unsigned)lo & 15u) << (4 * (i - 8)); }
            }
            hA0 = (int)a0; hA1 = (int)a1; hB0 = (int)b0; hB1 = (int)b1;
        }
        const int e0 = p.expert()[(size_t)tok * 128 + lane], e1 = p.expert()[(size_t)tok * 128 + 64 + lane];
        u32x2 rA[16], rB[16];
        auto req = [&](int bi, u32x2 (&rr)[16]) {
            const unsigned char* tb = bi < 8 ? ub : vb; const int b = bi & 7;
#pragma unroll
            for (int k = 0; k < 16; ++k) {
                const int e = __builtin_amdgcn_readlane(b < 4 ? e0 : e1, (b & 3) * 16 + k);
                rr[k] = *(const u32x2*)(tb + ((unsigned)e * 512u + lo8));
            }
        };
        float coef[8];
        f32x2 acc[8];
#pragma unroll
        for (int i = 0; i < 8; ++i) acc[i] = (f32x2){0.f, 0.f};
        auto use_u = [&](int b, const u32x2 (&rr)[16]) {
            float pt[16];
#pragma unroll
            for (int k = 0; k < 16; ++k) {
                int shi = __builtin_amdgcn_sdot8((int)rr[k].x, hA0, 0, false); shi = __builtin_amdgcn_sdot8((int)rr[k].y, hA1, shi, false);
                int slo = __builtin_amdgcn_sdot8((int)rr[k].x, hB0, 0, false); slo = __builtin_amdgcn_sdot8((int)rr[k].y, hB1, slo, false);
                pt[k] = (float)(16 * shi + slo);
            }
#pragma unroll
            for (int k = 0; k < 8; ++k) { const bool up = (lane & 32) != 0; const float send = up ? pt[k] : pt[k + 8], keep = up ? pt[k + 8] : pt[k]; pt[k] = keep + shx(send, 32, lane); }
#pragma unroll
            for (int k = 0; k < 4; ++k) { const bool up = (lane & 16) != 0; const float send = up ? pt[k] : pt[k + 4], keep = up ? pt[k + 4] : pt[k]; pt[k] = keep + shx(send, 16, lane); }
#pragma unroll
            for (int k = 0; k < 2; ++k) { const bool up = (lane & 8) != 0; const float send = up ? pt[k] : pt[k + 2], keep = up ? pt[k + 2] : pt[k]; pt[k] = keep + shx(send, 8, lane); }
            { const bool up = (lane & 4) != 0; const float send = up ? pt[0] : pt[1], keep = up ? pt[1] : pt[0]; pt[0] = keep + shx(send, 4, lane); }
            pt[0] += shx(pt[0], 2, lane); pt[0] += shx(pt[0], 1, lane);
            const float gv = p.gate()[(size_t)tok * 128 + b * 16 + idxl];
            const float d = pt[0] * (1.f / 96.f) / kh;
            coef[b] = gv * 0.5f * d * (1.f + erff(d * 0.70710678118654752f)) * 0.176776695f;
        };
        auto use_v = [&](int b, const u32x2 (&rr)[16]) {
#pragma unroll
            for (int k = 0; k < 16; ++k) {
                const int src = ((k >> 3) & 1) * 32 + ((k >> 2) & 1) * 16 + ((k >> 1) & 1) * 8 + (k & 1) * 4;
                const float cf = __uint_as_float((unsigned)__builtin_amdgcn_readlane((int)__float_as_uint(coef[b]), src));
                f32x2 f[8]; unpack_fp4x16(rr[k], f);
                const f32x2 cf2 = (f32x2){cf, cf};
#pragma unroll
                for (int i = 0; i < 8; ++i) acc[i] += cf2 * f[i];
            }
        };
        req(0, rA);
#pragma unroll
        for (int bi = 0; bi < 16; bi += 2) {
            req(bi + 1, rB);
            if (bi < 8) use_u(bi, rA); else use_v(bi - 8, rA);
            __builtin_amdgcn_sched_barrier(0);
            if (bi + 2 < 16) req(bi + 2, rA);
            if (bi + 1 < 8) use_u(bi + 1, rB); else use_v(bi + 1 - 8, rB);
            __builtin_amdgcn_sched_barrier(0);
        }
        const float* xp = xsrc + (size_t)tok * DM + lane * 16; float* xo = xdst + (size_t)tok * DM + lane * 16; const float* gp = g2 + lane * 16;
        f32x4 xn[4]; float ss = 0.f;
#pragma unroll
        for (int i4 = 0; i4 < 4; ++i4) {
            const f32x4 xv = *(const f32x4*)(xp + 4 * i4), gg = *(const f32x4*)(gp + 4 * i4);
            f32x4 o; o[0] = xv[0] + gg[0] * acc[2 * i4][0]; o[1] = xv[1] + gg[1] * acc[2 * i4][1]; o[2] = xv[2] + gg[2] * acc[2 * i4 + 1][0]; o[3] = xv[3] + gg[3] * acc[2 * i4 + 1][1];
            if (NMODE != 2) *(f32x4*)(xo + 4 * i4) = o;
            xn[i4] = o; ss += o[0] * o[0] + o[1] * o[1] + o[2] * o[2] + o[3] * o[3];
        }
        ss = wsum64(ss, lane);
        const float rn = rsqrtf(ss * (1.f / 1024.f) + 1e-6f);
#pragma unroll
        for (int i4 = 0; i4 < 4; ++i4) xn[i4] = xn[i4] * rn * wm[i4] + sh[i4];
        if (NMODE == 2) {
#pragma unroll
            for (int i4 = 0; i4 < 4; ++i4) *(f32x4*)(p.out + (size_t)tok * DM + lane * 16 + 4 * i4) = xn[i4];
        } else {
            u32x4 o0, o1;
            o0.x = pk2(xn[0][0], xn[0][1]); o0.y = pk2(xn[0][2], xn[0][3]); o0.z = pk2(xn[1][0], xn[1][1]); o0.w = pk2(xn[1][2], xn[1][3]);
            o1.x = pk2(xn[2][0], xn[2][1]); o1.y = pk2(xn[2][2], xn[2][3]); o1.z = pk2(xn[3][0], xn[3][1]); o1.w = pk2(xn[3][2], xn[3][3]);
            *(u32x4*)(p.h() + (size_t)tok * DM + lane * 16) = o0; *(u32x4*)(p.h() + (size_t)tok * DM + lane * 16 + 8) = o1;
        }
        if (NMODE == 1) {
            float pc[8];
#pragma unroll
            for (int c = 0; c < 8; ++c) {
                float a = 0.f;
#pragma unroll
                for (int i4 = 0; i4 < 4; ++i4) { const f32x4 ww = *(const f32x4*)(W8 + c * 1024 + lane * 16 + 4 * i4); a += xn[i4][0] * ww[0] + xn[i4][1] * ww[1] + xn[i4][2] * ww[2] + xn[i4][3] * ww[3]; }
                pc[c] = wsum64(a, lane);
            }
            if (lane == 0) { *(f32x4*)(p.ba() + (size_t)tok * 8) = (f32x4){pc[0], pc[1], pc[2], pc[3]}; *(f32x4*)(p.ba() + (size_t)tok * 8 + 4) = (f32x4){pc[4], pc[5], pc[6], pc[7]}; }
        }
    }
}

extern __shared__ __attribute__((aligned(16))) char smem_raw[];
DEV char* smem_user() { LAS char* q = (LAS char*)smem_raw + LDS_USER; asm volatile("" : "+s"(q)); return (char*)q; }
typedef const __attribute__((address_space(4))) Params* KParams;
DEV void load_params(Params& p) {
    auto kp0 = __builtin_amdgcn_kernarg_segment_ptr();
    asm volatile("" : "+s"(kp0));
    KParams kp = (KParams)kp0;
    p.x = kp->x;
    p.c = kp->c;
    p.pos = kp->pos;
    p.mod_w = kp->mod_w;
    p.mod_b = kp->mod_b;
    p.norm_mix = kp->norm_mix;
    p.norm_ffn = kp->norm_ffn;
    p.hy_w_in = kp->hy_w_in;
    p.gdn_conv = kp->gdn_conv;
    p.gdn_a_log = kp->gdn_a_log;
    p.gdn_dt_bias = kp->gdn_dt_bias;
    p.gdn_o_norm = kp->gdn_o_norm;
    p.hy_w_out = kp->hy_w_out;
    p.mla_w_in = kp->mla_w_in;
    p.mla_q_norm = kp->mla_q_norm;
    p.mla_kv_norm = kp->mla_kv_norm;
    p.mla_w_uq = kp->mla_w_uq;
    p.mla_w_ukv = kp->mla_w_ukv;
    p.mla_w_out = kp->mla_w_out;
    p.peer_w_q = kp->peer_w_q;
    p.peer_sub_keys = kp->peer_sub_keys;
    p.peer_u = kp->peer_u;
    p.peer_v = kp->peer_v;
    p.final_norm = kp->final_norm;
    p.out = kp->out;
    p.ws = kp->ws;
    p.ph_lo = kp->ph_lo;
    p.ph_hi = kp->ph_hi;
    p.use_bar = kp->use_bar;
    p.pad0 = kp->pad0;
}
#ifdef PH_NOINLINE
#define NOINL __device__ __noinline__
#else
#define NOINL __device__ __forceinline__
#endif

NOINL void f_prologue() { Params p; load_params(p);
#ifdef REP_P0
    phase_prologue(p, smem_user());
#endif
    phase_prologue(p, smem_user()); }
NOINL void f_norm_e0(int layer) {
    Params p; load_params(p); const float* mod = p.mod() + layer * 6144; const int li = layer >> 1;
    phase_norm<1>(layer == 0 ? p.x : p.xw(), p.norm_mix + layer * DM, mod, mod + 1024, p.h(), nullptr, p.hy_w_in + (size_t)li * 1024 * HY_IN, p.ba(), smem_user());
}
NOINL void f_norm_plain(int layer, int which) {
    Params p; load_params(p); const float* mod = p.mod() + layer * 6144;
    if (which == 0) phase_norm<0>(p.xw(), p.norm_mix + layer * DM, mod, mod + 1024, p.h(), nullptr, nullptr, nullptr, smem_user());
    else phase_norm<0>(p.xw(), p.norm_ffn + layer * DM, mod + 3072, mod + 4096, p.h(), nullptr, nullptr, nullptr, smem_user());
}
NOINL void f_final() { Params p; load_params(p); phase_norm<2>(
#ifdef DBG_SKIP_ALL
        p.x,
#else
        p.xw(),
#endif
 p.final_norm, nullptr, nullptr, nullptr, p.out, nullptr, nullptr, smem_user()); }
NOINL void f_gemm_hy_in(int li) {
    Params p; load_params(p);
    auto epi = [&](int m, int n, int n0, const f32x4& v) {
        if (n0 < 1536) st_bf4(p.proj_a() + (size_t)m * 1536 + n, v);
        else if (n0 < 2048) st_bf4(p.zbuf() + (size_t)m * 512 + (n - 1536), v);
        else if (n0 < 2560) { const int hd = (n - 2048) >> 7, dp = (n - 2048) & 127; const f32x4 rv = rope4(v, p.cosB() + (size_t)m * 64, p.sinB() + (size_t)m * 64, dp >> 1) * (0.08838834764831845f * 1.4426950408889634f); st_bf4(p.Qb() + ((size_t)hd * S + m) * 128 + dp, rv); }
        else if (n0 < 3072) { const int hd = (n - 2560) >> 7, dp = (n - 2560) & 127; const f32x4 rv = rope4(v, p.cosB() + (size_t)m * 64, p.sinB() + (size_t)m * 64, dp >> 1); st_bf4(p.Kb() + ((size_t)hd * S + m) * 128 + dp, rv); }
        else { const int hd = (n - 3072) >> 7, dv = (n - 3072) & 127; bf16_t* vp = p.VbT() + (((size_t)hd * 256 + (m >> 6)) * 128 + dv) * 64 + (m & 63); vp[0] = f2bf(v[0]); vp[64] = f2bf(v[1]); vp[128] = f2bf(v[2]); vp[192] = f2bf(v[3]); }
    };
#ifdef REP_GEMM
    gemm256(p.h(), p.w_hy_in() + (size_t)li * HYN * 1024, HYN, 1024, smem_user(), epi);
#endif
    gemm256(p.h(), p.w_hy_in() + (size_t)li * HYN * 1024, HYN, 1024, smem_user(), epi);
}
NOINL void f_gemm_resid(int layer) {
    Params p; load_params(p); const float* mod = p.mod() + layer * 6144; const int li = layer >> 1;
    const float* xin = layer == 0 ? p.x : p.xw(); float* xo = p.xw();
    auto epi = [&](int m, int n, int n0, const f32x4& v) {
        const f32x4 xv = *(const f32x4*)(xin + (size_t)m * DM + n), gg = *(const f32x4*)(mod + 2048 + n);
        *(f32x4*)(xo + (size_t)m * DM + n) = xv + gg * v;
    };
    const bf16_t* wt = (layer & 1) ? p.w_mla_out() + (size_t)li * 1024 * 1024 : p.w_hy_out() + (size_t)li * 1024 * 1024;
    gemm256(p.cat(), wt, 1024, 1024, smem_user(), epi);
}
NOINL void f_s0(int li) {
    Params p; load_params(p);
    for (int u = opaque_bid(); u < 512; u += gridDim.x) { if (u < 256) gdn_prep_unit(p, li, u >> 2, u & 3, smem_user()); else moba_kmean_unit(p, (u - 256) & 3, (u - 256) >> 2, smem_user()); }
}
NOINL void f_seg(int layer, int seg) {
    Params p; load_params(p);
    const int li = layer >> 1;
    float* scanst = (float*)(p.ws + SCANST_OFF);
    if (opaque_bid() < 16) { gdn_scan_seg(p, opaque_bid(), seg, scanst, smem_user()); return; }
    const int rank = opaque_bid() - 16, nwg = (int)gridDim.x - 16;
    const int nprep = seg < 3 ? 256 : 0;
    int cidx = rank;
    for (; cidx < nprep; cidx += nwg) gdn_prep_unit(p, li, 64 * (seg + 1) + (cidx >> 2), cidx & 3, smem_user());
    int lo = 0, hi = 0;
    if (seg == 0) hi = 128;
    else {
        const int T = moba_tile_table(p, smem_user());
        lo = seg == 1 ? 0 : (seg == 2 ? (T * 28) / 100 : (T * 56) / 100); hi = seg == 1 ? (T * 28) / 100 : (seg == 2 ? (T * 56) / 100 : T);
    }
    for (; cidx < nprep + (hi - lo); cidx += nwg) {
        if (seg == 0) moba_gate_unit(p, cidx - nprep, smem_user());
        else moba_subunit(p, lo + (cidx - nprep), smem_user());
    }
    if (layer == 0 && seg == 3) {
        convert_i4(p.peer_u, p.ub(), (size_t)4 * 16384 * 1024, 96.f, rank, nwg);
        convert_fp4(p.peer_v, p.vb(), (size_t)4 * 16384 * 1024, 5.65685425f, rank, nwg);
    }
}
NOINL void f_combine(int li) { Params p; load_params(p); phase_even_combine(p, li); }
NOINL void f_gemm_mla_in(int li) {
    Params p; load_params(p);
    auto epi = [&](int m, int n, int n0, const f32x4& v) {
        if (n0 < 768) st_bf4(p.cbuf() + (size_t)m * 768 + n, v);
        else if (n < 832) { const int dp = n - 768; const f32x4 rv = rope4(v, p.cosC() + (size_t)m * 32, p.sinC() + (size_t)m * 32, dp >> 1); st_bf4(p.Kr() + (size_t)m * 64 + dp, rv); }
    };
#ifdef REP_GEMM
    gemm256(p.h(), p.w_mla_in() + (size_t)li * 1024 * 1024, 1024, 1024, smem_user(), epi);
#endif
    gemm256(p.h(), p.w_mla_in() + (size_t)li * 1024 * 1024, 1024, 1024, smem_user(), epi);
}
NOINL void f_cnorm(int li) { Params p; load_params(p); phase_mla_cnorm(p, li); }
NOINL void f_gemm_uq(int li) {
    Params p; load_params(p);
    auto epi = [&](int m, int n, int n0, const f32x4& v0) {
        const float qs = 0.07216878364870322f * 1.4426950408889634f;
        const int hd = n / 192, d = n - hd * 192; f32x4 v = v0;
        if (d >= 128) v = rope4(v, p.cosC() + (size_t)m * 32, p.sinC() + (size_t)m * 32, (d - 128) >> 1);
        st_bf4(p.Qm() + ((size_t)hd * S + m) * 192 + d, v * qs);
    };
#ifdef REP_GEMM
    gemm256(p.cqn(), p.w_uq() + (size_t)li * 1536 * 512, 1536, 512, smem_user(), epi);
#endif
    gemm256(p.cqn(), p.w_uq() + (size_t)li * 1536 * 512, 1536, 512, smem_user(), epi);
}
NOINL void f_gemm_ukv(int li) {
    Params p; load_params(p);
    auto epi = [&](int m, int n, int n0, const f32x4& v) {
        if (n0 < 1024) { const int hd = n >> 7, d = n & 127; st_bf4(p.Kn() + ((size_t)hd * S + m) * 128 + d, v); }
        else { const int hd = (n - 1024) >> 7, dv = (n - 1024) & 127; bf16_t* vp = p.VmT() + (((size_t)hd * 256 + (m >> 6)) * 128 + dv) * 64 + (m & 63); vp[0] = f2bf(v[0]); vp[64] = f2bf(v[1]); vp[128] = f2bf(v[2]); vp[192] = f2bf(v[3]); }
    };
#ifdef REP_GEMM
    gemm256(p.ckvn(), p.w_ukv() + (size_t)li * 2048 * 256, 2048, 256, smem_user(), epi);
#endif
    gemm256(p.ckvn(), p.w_ukv() + (size_t)li * 2048 * 256, 2048, 256, smem_user(), epi);
}
NOINL void f_mla_attn() {
    Params p; load_params(p);
#ifdef REP_M4
    phase_mla_attn(p, smem_user());
#endif
    phase_mla_attn(p, smem_user());
}
NOINL void f_gemm_pq(int layer) {
    Params p; load_params(p);
    auto epi = [&](int m, int n, int n0, const f32x4& v) { st_bf4(p.qbuf() + (size_t)m * 2048 + n, v); };
#ifdef REP_GEMM
    gemm256(p.h(), p.w_pq() + (size_t)layer * 2048 * 1024, 2048, 1024, smem_user(), epi);
#endif
    gemm256(p.h(), p.w_pq() + (size_t)layer * 2048 * 1024, 2048, 1024, smem_user(), epi);
}
NOINL void f_topk(int layer) { Params p; load_params(p);
#ifdef REP_F2
    phase_peer_topk(p, layer, smem_user());
#endif
    phase_peer_topk(p, layer, smem_user()); }
NOINL void f_gather(int layer) {
    Params p; load_params(p);
    const float* g2 = p.mod() + layer * 6144 + 5120;
    if (layer == 3) phase_peer_gather<2>(p, layer, g2, p.xw(), p.xw(), p.final_norm, nullptr, nullptr, nullptr, smem_user());
    else {
        const float* modn = p.mod() + (layer + 1) * 6144;
        if (layer == 1) phase_peer_gather<1>(p, layer, g2, p.xw(), p.xw(), p.norm_mix + 2 * DM, modn, modn + 1024, p.hy_w_in + (size_t)1 * 1024 * HY_IN, smem_user());
        else phase_peer_gather<0>(p, layer, g2, p.xw(), p.xw(), p.norm_mix + (layer + 1) * DM, modn, modn + 1024, nullptr, smem_user());
    }
}

__device__ __noinline__ void grid_sync(unsigned* barw, unsigned x) {
    XcdBarrier b; b.bar = barw; b.x = x; b.st = (volatile LAS unsigned*)smem_raw;
    xcd_barrier(b);
}

__global__ void __launch_bounds__(NTHREADS) hybrid_forward(Params p) {
    if (threadIdx.x == 0) *(u32x4*)smem_raw = (u32x4){0u, 0u, 0u, 0u};
    __syncthreads();
    XcdBarrier bar; bar.bar = p.bar(); bar.x = 0; bar.st = (volatile LAS unsigned*)smem_raw;
    if (p.use_bar) bar = xcd_barrier_post(p.bar(), (volatile LAS unsigned*)smem_raw);
    int ph = 0;
#define RUN_PHASE(...) { if (ph >= p.ph_lo && ph < p.ph_hi) { __VA_ARGS__; if (p.use_bar && ph + 1 < p.ph_hi) grid_sync(bar.bar, bar.x); } ++ph; }

    RUN_PHASE(f_prologue());
    for (int layer = 0; layer < 4; ++layer) {
        const int li = layer >> 1;
        if ((layer & 1) == 0) {
            if (layer == 0) RUN_PHASE(f_norm_e0(layer));
            RUN_PHASE(f_gemm_hy_in(li));
            RUN_PHASE(f_s0(li));
            RUN_PHASE(f_seg(layer, 0));
            RUN_PHASE(f_seg(layer, 1));
            RUN_PHASE(f_seg(layer, 2));
            RUN_PHASE(f_seg(layer, 3));
            RUN_PHASE(f_combine(li));
            RUN_PHASE(f_gemm_resid(layer));
        } else {
            RUN_PHASE(f_gemm_mla_in(li));
            RUN_PHASE(f_cnorm(li));
            RUN_PHASE(f_gemm_uq(li); f_gemm_ukv(li));
            RUN_PHASE(f_mla_attn());
            RUN_PHASE(f_gemm_resid(layer));
        }
        RUN_PHASE(f_norm_plain(layer, 1));
        RUN_PHASE(f_gemm_pq(layer));
        RUN_PHASE(f_topk(layer));
        RUN_PHASE(f_gather(layer));
    }
}

constexpr int N_PHASES = 1 + 1 + 2 * 8 + 2 * 5 + 4 * 4;

extern "C" void kernel_launch(void* const* d_in, const int* in_sizes, int n_in, void* d_out, int out_size, void* d_ws, size_t ws_size, hipStream_t stream) {
    static int grid = 0;
    if (!grid) {
        int dev = 0, cus = 0, per_cu = 0;
        hipGetDevice(&dev);
        hipDeviceGetAttribute(&cus, hipDeviceAttributeMultiprocessorCount, dev);
        hipFuncSetAttribute((const void*)hybrid_forward, hipFuncAttributeMaxDynamicSharedMemorySize, LDS_BYTES);
        hipOccupancyMaxActiveBlocksPerMultiprocessor(&per_cu, hybrid_forward, NTHREADS, LDS_BYTES);
        if (per_cu < 1) per_cu = 1;
        grid = cus;
        if (grid > 256) grid = 256;
    }
    Params p; memset(&p, 0, sizeof(p));
    p.x = (const float*)d_in[0]; p.c = (const float*)d_in[1]; p.pos = (const int*)d_in[2]; p.mod_w = (const float*)d_in[3]; p.mod_b = (const float*)d_in[4];
    p.norm_mix = (const float*)d_in[5]; p.norm_ffn = (const float*)d_in[6]; p.hy_w_in = (const float*)d_in[7]; p.gdn_conv = (const float*)d_in[8];
    p.gdn_a_log = (const float*)d_in[9]; p.gdn_dt_bias = (const float*)d_in[10]; p.gdn_o_norm = (const float*)d_in[11]; p.hy_w_out = (const float*)d_in[12];
    p.mla_w_in = (const float*)d_in[13]; p.mla_q_norm = (const float*)d_in[14]; p.mla_kv_norm = (const float*)d_in[15]; p.mla_w_uq = (const float*)d_in[16];
    p.mla_w_ukv = (const float*)d_in[17]; p.mla_w_out = (const float*)d_in[18]; p.peer_w_q = (const float*)d_in[19]; p.peer_sub_keys = (const float*)d_in[20];
    p.peer_u = (const float*)d_in[21]; p.peer_v = (const float*)d_in[22]; p.final_norm = (const float*)d_in[23];
    p.out = (float*)d_out;
    p.ws = (char*)d_ws;
    if (WS_NEED > ws_size) { fprintf(stderr, "workspace too small: need %zu have %zu\n", (size_t)WS_NEED, ws_size); return; }
    hipMemsetAsync(p.ws, 0, 16384, stream);
#ifndef ONE_LAUNCH
    for (int ph = 0; ph < N_PHASES; ++ph) {
#ifdef DBG_SKIP_ALL
        if (ph != N_PHASES - 1) continue;
#endif
        p.ph_lo = ph; p.ph_hi = ph + 1; p.use_bar = 0;
        hipLaunchKernelGGL(hybrid_forward, dim3(grid), dim3(NTHREADS), LDS_BYTES, stream, p);
    }
#else
    p.ph_lo = 0; p.ph_hi = N_PHASES; p.use_bar = 1;
    hipLaunchKernelGGL(hybrid_forward, dim3(grid), dim3(NTHREADS), LDS_BYTES, stream, p);
#endif
}
```

```cpp
#include <hip/hip_runtime.h>
#define ONE_LAUNCH 1
#include <stdint.h>
#include <stddef.h>
#include <stdio.h>
#include <string.h>

#define DEV __device__ __forceinline__

constexpr int S = 16384;
constexpr int DM = 1024;
constexpr int HY_IN = 3592;
constexpr int HYN = 3584;
constexpr int NTHREADS = 512;
constexpr int LDS_BYTES = 163840;
constexpr int LDS_USER = 16;

typedef unsigned short bf16_t;
typedef short bf16x8 __attribute__((ext_vector_type(8)));
typedef float f32x4 __attribute__((ext_vector_type(4)));
typedef float f32x2 __attribute__((ext_vector_type(2)));
typedef float f32x16 __attribute__((ext_vector_type(16)));
typedef __bf16 bf16v2 __attribute__((ext_vector_type(2)));
typedef unsigned u32x4 __attribute__((ext_vector_type(4)));
typedef unsigned u32x2 __attribute__((ext_vector_type(2)));
typedef int i32x4 __attribute__((ext_vector_type(4)));

#define XB_TMO      128
#define XB_XCNT(j)  (256  + 64 * (j))
#define XB_XSUB(j)  (1280 + 64 * (j))
#define XB_XGEN(j)  (2304 + 64 * (j))
#define XB_TOP      3328
#define XB_TOPGEN   3392
#define XCD_BAR_WORDS 3456
#define XB_SPIN_CAP (1u << 22)
#define LAS __attribute__((address_space(3)))

__device__ __forceinline__ unsigned xb_ld(unsigned* p)              { return __hip_atomic_load(p, __ATOMIC_RELAXED, __HIP_MEMORY_SCOPE_AGENT); }
__device__ __forceinline__ unsigned xb_add(unsigned* p, unsigned v) { return __hip_atomic_fetch_add(p, v, __ATOMIC_RELAXED, __HIP_MEMORY_SCOPE_AGENT); }
__device__ __forceinline__ unsigned xb_xcc_id() { return (unsigned)__builtin_amdgcn_s_getreg((3 << 11) | 20) & 0xFu; }
#define XB_SPIN(cond, bar) do { unsigned _sp = 0; while (cond) { __builtin_amdgcn_s_sleep(1); \
    if ((++_sp & 255u) == 0u) { if (xb_ld(&(bar)[XB_TMO])) break; if (_sp > XB_SPIN_CAP) { atomicAdd(&(bar)[XB_TMO], 1u); break; } } } } while (0)

struct XcdBarrier { unsigned* bar; unsigned x; volatile LAS unsigned* st; };

__device__ __forceinline__ XcdBarrier xcd_barrier_post(unsigned* bar, volatile LAS unsigned* st) {
    XcdBarrier b; b.bar = bar; b.x = xb_xcc_id(); b.st = st;
    if (threadIdx.x == 0) (void)xb_add(&bar[XB_XCNT(b.x)], 1u);
    return b;
}
__device__ __forceinline__ void xcd_barrier_complete(unsigned* bar, unsigned x, unsigned& nloc, unsigned& nx) {
    const unsigned G = gridDim.x * gridDim.y * gridDim.z;
    unsigned sum, cnt, mine, sp = 0u;
    for (;;) {
        sum = 0u; cnt = 0u; mine = 0u;
#pragma unroll 1
        for (unsigned j = 0; j < 16; ++j) { const unsigned c = xb_ld(&bar[XB_XCNT(j)]); sum += c; cnt += (c > 0u) ? 1u : 0u; mine = (j == x) ? c : mine; }
        if (sum == G) break;
        __builtin_amdgcn_s_sleep(1);
        if ((++sp & 255u) == 0u) { if (xb_ld(&bar[XB_TMO])) break; if (sp > XB_SPIN_CAP) { atomicAdd(&bar[XB_TMO], 1u); break; } }
    }
    nloc = mine > 0u ? mine : 1u; nx = cnt > 0u ? cnt : 1u;
}
__device__ __forceinline__ void xcd_barrier(const XcdBarrier& b) {
    asm volatile("s_waitcnt vmcnt(0)" ::: "memory");
    __syncthreads();
    if (threadIdx.x == 0) {
        unsigned* bar = b.bar;
        __builtin_amdgcn_s_waitcnt(0);
        unsigned nloc = b.st[0], nx = b.st[1];
        if (nloc == 0u) { xcd_barrier_complete(bar, b.x, nloc, nx); b.st[0] = nloc; b.st[1] = nx; }
        const unsigned old = xb_add(&bar[XB_XSUB(b.x)], 1u);
        const unsigned gen = old / nloc;
        if (old + 1u == (gen + 1u) * nloc) {
            __builtin_amdgcn_fence(__ATOMIC_RELEASE, "agent");
            asm volatile("s_waitcnt vmcnt(0)" ::: "memory");
            const unsigned og = xb_add(&bar[XB_TOP], 1u);
            const unsigned tg = og / nx;
            if (og + 1u == (tg + 1u) * nx) xb_add(&bar[XB_TOPGEN], 1u);
            else XB_SPIN(xb_ld(&bar[XB_TOPGEN]) == tg, bar);
            __builtin_amdgcn_fence(__ATOMIC_ACQUIRE, "agent");
            xb_add(&bar[XB_XGEN(b.x)], 1u);
            asm volatile("s_waitcnt vmcnt(0)" ::: "memory");
        } else {
            XB_SPIN(xb_ld(&bar[XB_XGEN(b.x)]) == gen, bar);
            __builtin_amdgcn_fence(__ATOMIC_ACQUIRE, "agent");
            asm volatile("s_waitcnt vmcnt(0)" ::: "memory");
        }
    }
    __syncthreads();
}

DEV int opaque_bid() { int b = blockIdx.x; asm volatile("" : "+s"(b)); return b; }
DEV int opaque_tid() { int t = threadIdx.x; asm volatile("" : "+v"(t)); return t & (NTHREADS - 1); }
DEV bf16_t f2bf(float f) { __bf16 v = (__bf16)f; bf16_t r; __builtin_memcpy(&r, &v, 2); return r; }
DEV unsigned pk2(float a, float b) { bf16v2 v; v[0] = (__bf16)a; v[1] = (__bf16)b; unsigned r; __builtin_memcpy(&r, &v, 4); return r; }
DEV float bflo(unsigned u) { return __uint_as_float(u << 16); }
DEV float bfhi(unsigned u) { return __uint_as_float(u & 0xffff0000u); }
DEV float shx(float v, int m, int lane) { return __int_as_float(__builtin_amdgcn_ds_bpermute((lane ^ m) << 2, __float_as_int(v))); }
DEV float wsum64(float v, int lane) {
#pragma unroll
    for (int o = 32; o; o >>= 1) v += shx(v, o, lane);
    return v;
}
DEV f32x4 mfma16(bf16x8 a, bf16x8 b, f32x4 c) { return __builtin_amdgcn_mfma_f32_16x16x32_bf16(a, b, c, 0, 0, 0); }
DEV f32x16 mfma32(bf16x8 a, bf16x8 b, f32x16 c) { return __builtin_amdgcn_mfma_f32_32x32x16_bf16(a, b, c, 0, 0, 0); }
DEV float siluf(float v) { return v / (1.f + expf(-v)); }
DEV float softplusf(float v) { return fmaxf(v, 0.f) + log1pf(expf(-fabsf(v))); }
DEV float ex2(float v) { return __builtin_amdgcn_exp2f(v); }

struct Params {
    const float* x; const float* c; const int* pos; const float* mod_w; const float* mod_b; const float* norm_mix; const float* norm_ffn;
    const float* hy_w_in; const float* gdn_conv; const float* gdn_a_log; const float* gdn_dt_bias; const float* gdn_o_norm; const float* hy_w_out;
    const float* mla_w_in; const float* mla_q_norm; const float* mla_kv_norm; const float* mla_w_uq; const float* mla_w_ukv; const float* mla_w_out;
    const float* peer_w_q; const float* peer_sub_keys; const float* peer_u; const float* peer_v; const float* final_norm;
    float* out; char* ws;
    int ph_lo, ph_hi, use_bar, pad0;
    DEV unsigned* bar() const { return (unsigned*)(ws + 0ull); }
    DEV float* mod() const { return (float*)(ws + 16384ull); }
    DEV float* cosB() const { return (float*)(ws + 114688ull); }
    DEV float* sinB() const { return (float*)(ws + 4308992ull); }
    DEV float* cosC() const { return (float*)(ws + 8503296ull); }
    DEV float* sinC() const { return (float*)(ws + 10600448ull); }
    DEV bf16_t* w_hy_in() const { return (bf16_t*)(ws + 12697600ull); }
    DEV bf16_t* w_hy_out() const { return (bf16_t*)(ws + 27377664ull); }
    DEV bf16_t* w_mla_in() const { return (bf16_t*)(ws + 863260672ull); }
    DEV bf16_t* w_uq() const { return (bf16_t*)(ws + 35241984ull); }
    DEV bf16_t* w_ukv() const { return (bf16_t*)(ws + 38387712ull); }
    DEV bf16_t* w_mla_out() const { return (bf16_t*)(ws + 40484864ull); }
    DEV bf16_t* w_pq() const { return (bf16_t*)(ws + 44679168ull); }
    DEV bf16_t* skb() const { return (bf16_t*)(ws + 61456384ull); }
    DEV unsigned char* ub() const { return (unsigned char*)(ws + 63553536ull); }
    DEV unsigned char* vb() const { return (unsigned char*)(ws + 197771264ull); }
    DEV float* xw() const { return (float*)(ws + 331988992ull); }
    DEV bf16_t* h() const { return (bf16_t*)(ws + 399097856ull); }
    DEV bf16_t* cat() const { return (bf16_t*)(ws + 432652288ull); }
    DEV bf16_t* proj_a() const { return (bf16_t*)(ws + 466206720ull); }
    DEV bf16_t* zbuf() const { return (bf16_t*)(ws + 516538368ull); }
    DEV bf16_t* Qb() const { return (bf16_t*)(ws + 533315584ull); }
    DEV bf16_t* Kb() const { return (bf16_t*)(ws + 550092800ull); }
    DEV bf16_t* VbT() const { return (bf16_t*)(ws + 566870016ull); }
    DEV float* ba() const { return (float*)(ws + 583647232ull); }
    DEV float* u32() const { return (float*)(ws + 584171520ull); }
    DEV bf16_t* wneg() const { return (bf16_t*)(ws + 617725952ull); }
    DEV bf16_t* qdec() const { return (bf16_t*)(ws + 634503168ull); }
    DEV bf16_t* kdT() const { return (bf16_t*)(ws + 651280384ull); }
    DEV bf16_t* qk() const { return (bf16_t*)(ws + 668057600ull); }
    DEV float* glast() const { return (float*)(ws + 676446208ull); }
    DEV float* oa() const { return (float*)(ws + 676450304ull); }
    DEV float* kmean() const { return (float*)(ws + 710004736ull); }
    DEV int* segcnt() const { return (int*)(ws + 710135808ull); }
    DEV int* lists() const { return (int*)(ws + 710168576ull); }
    DEV float* part() const { return (float*)(ws + 726945792ull); }
    DEV float* ml() const { return (float*)(ws + 861163520ull); }
    DEV bf16_t* cbuf() const { return (bf16_t*)(ws + 466206720ull); }
    DEV bf16_t* Kr() const { return (bf16_t*)(ws + 491372544ull); }
    DEV bf16_t* cqn() const { return (bf16_t*)(ws + 493469696ull); }
    DEV bf16_t* ckvn() const { return (bf16_t*)(ws + 510246912ull); }
    DEV bf16_t* Qm() const { return (bf16_t*)(ws + 518635520ull); }
    DEV bf16_t* Kn() const { return (bf16_t*)(ws + 568967168ull); }
    DEV bf16_t* VmT() const { return (bf16_t*)(ws + 602521600ull); }
    DEV bf16_t* qbuf() const { return (bf16_t*)(ws + 466206720ull); }
    DEV int* expert() const { return (int*)(ws + 533315584ull); }
    DEV float* gate() const { return (float*)(ws + 541704192ull); }
};
constexpr size_t SCANST_OFF = 867454976ull;
constexpr size_t WS_NEED = 867717120ull;


template <class Map>
DEV void transpose_conv(const float* __restrict__ src, int K, int ldsrc, bf16_t* __restrict__ dst, int Nd, Map map, char* smem, int& base) {
    float* T = (float*)smem;
    const int tid = opaque_tid(), nb = gridDim.x, b = opaque_bid();
    const int ntk = K / 64, ntn = Nd / 64, nun = ntk * ntn;
    int first = ((b - (base % nb)) % nb + nb) % nb;
    for (int u = first; u < nun; u += nb) {
        const int tk = u % ntk, tn = u / ntk;
        __syncthreads();
#pragma unroll
        for (int i = 0; i < 8; ++i) {
            const int kk = (tid >> 6) + 8 * i, nn = tid & 63;
            const int sc = map(tn * 64 + nn);
            float v = 0.f;
            if (sc >= 0) v = src[(size_t)(tk * 64 + kk) * ldsrc + sc];
            T[kk * 65 + nn] = v;
        }
        __syncthreads();
#pragma unroll
        for (int i = 0; i < 8; ++i) {
            const int nn = (tid >> 6) + 8 * i, kk = tid & 63;
            dst[(size_t)(tn * 64 + nn) * K + tk * 64 + kk] = f2bf(T[kk * 65 + nn]);
        }
    }
    base += nun;
}

DEV void convert_bf16(const float* __restrict__ src, bf16_t* __restrict__ dst, size_t n) {
    const size_t n8 = n / 8;
    for (size_t i = (size_t)opaque_bid() * NTHREADS + opaque_tid(); i < n8; i += (size_t)gridDim.x * NTHREADS) {
        const f32x4 a = *(const f32x4*)(src + i * 8), b = *(const f32x4*)(src + i * 8 + 4);
        u32x4 o; o.x = pk2(a[0], a[1]); o.y = pk2(a[2], a[3]); o.z = pk2(b[0], b[1]); o.w = pk2(b[2], b[3]);
        *(u32x4*)(dst + i * 8) = o;
    }
}

DEV void convert_fp4(const float* __restrict__ src, unsigned char* __restrict__ dst, size_t n, float scale, int rank, int nwg) {
    const size_t n32 = n / 32;
    for (size_t i = (size_t)rank * NTHREADS + opaque_tid(); i < n32; i += (size_t)nwg * NTHREADS) {
        u32x4 o;
#pragma unroll
        for (int q = 0; q < 4; ++q) {
            const f32x4 a = *(const f32x4*)(src + i * 32 + q * 8) * scale, b = *(const f32x4*)(src + i * 32 + q * 8 + 4) * scale;
            unsigned w = 0;
            w = __builtin_amdgcn_cvt_scalef32_pk_fp4_f32(w, a[0], a[1], 1.0f, 0);
            w = __builtin_amdgcn_cvt_scalef32_pk_fp4_f32(w, a[2], a[3], 1.0f, 1);
            w = __builtin_amdgcn_cvt_scalef32_pk_fp4_f32(w, b[0], b[1], 1.0f, 2);
            w = __builtin_amdgcn_cvt_scalef32_pk_fp4_f32(w, b[2], b[3], 1.0f, 3);
            o[q] = w;
        }
        *(u32x4*)(dst + i * 16) = o;
    }
}

DEV void convert_i4(const float* __restrict__ src, unsigned char* __restrict__ dst, size_t n, float scale, int rank, int nwg) {
    const size_t n32 = n / 32;
    for (size_t i = (size_t)rank * NTHREADS + opaque_tid(); i < n32; i += (size_t)nwg * NTHREADS) {
        u32x4 o;
#pragma unroll
        for (int q = 0; q < 4; ++q) {
            const f32x4 a = *(const f32x4*)(src + i * 32 + q * 8) * scale, b = *(const f32x4*)(src + i * 32 + q * 8 + 4) * scale;
            unsigned w = 0;
#pragma unroll
            for (int j = 0; j < 4; ++j) {
                const int qa = (int)fminf(fmaxf(__builtin_rintf(a[j]), -8.f), 7.f), qb = (int)fminf(fmaxf(__builtin_rintf(b[j]), -8.f), 7.f);
                w |= ((unsigned)qa & 15u) << (4 * j); w |= ((unsigned)qb & 15u) << (4 * (j + 4));
            }
            o[q] = w;
        }
        *(u32x4*)(dst + i * 16) = o;
    }
}

DEV void convert_fp8(const float* __restrict__ src, unsigned char* __restrict__ dst, size_t n, float scale) {
    const size_t n16 = n / 16;
    for (size_t i = (size_t)opaque_bid() * NTHREADS + opaque_tid(); i < n16; i += (size_t)gridDim.x * NTHREADS) {
        u32x4 o;
#pragma unroll
        for (int q = 0; q < 4; ++q) {
            const f32x4 a = *(const f32x4*)(src + i * 16 + q * 4) * scale;
            int w = 0;
            w = __builtin_amdgcn_cvt_pk_fp8_f32(a[0], a[1], w, false);
            w = __builtin_amdgcn_cvt_pk_fp8_f32(a[2], a[3], w, true);
            o[q] = (unsigned)w;
        }
        *(u32x4*)(dst + i * 16) = o;
    }
}

DEV void phase_prologue(const Params& p, char* smem) {
    const int tid = opaque_tid(), nb = gridDim.x, b = opaque_bid();
    {
        float* cond = (float*)smem; float* red = cond + 1024;
        for (int i = tid; i < 1024; i += NTHREADS) cond[i] = siluf(p.c[i]);
        __syncthreads();
        for (int u = b; u < 192; u += nb) {
            const int n = u * 128, layer = n / 6144, nn = n - layer * 6144;
            const int cg = tid & 31, ks = tid >> 5;
            const float* wp = p.mod_w + ((size_t)layer * 1024 + ks * 64) * 6144 + nn + cg * 4;
            f32x4 acc = {0.f, 0.f, 0.f, 0.f};
#pragma unroll 8
            for (int k = 0; k < 64; ++k) { const f32x4 w = *(const f32x4*)(wp + (size_t)k * 6144); const float cv = cond[ks * 64 + k]; acc += w * cv; }
            *(f32x4*)(red + ks * 128 + cg * 4) = acc;
            __syncthreads();
            if (tid < 128) { float s = p.mod_b[n + tid]; for (int q = 0; q < 16; ++q) s += red[q * 128 + tid]; p.mod()[n + tid] = s; }
            __syncthreads();
        }
    }
    for (size_t i = (size_t)b * NTHREADS + tid; i < (size_t)S * 64; i += (size_t)nb * NTHREADS) {
        const int s = (int)(i >> 6), f = (int)(i & 63);
        const float invf = powf(10000.f, -(float)(2 * f) / 128.f);
        const float ang = (float)p.pos[s] * invf;
        float sn, cs; sincosf(ang, &sn, &cs);
        p.cosB()[i] = cs; p.sinB()[i] = sn;
    }
    for (size_t i = (size_t)b * NTHREADS + tid; i < (size_t)S * 32; i += (size_t)nb * NTHREADS) {
        const int s = (int)(i >> 5), f = (int)(i & 31);
        const float invf = powf(10000.f, -(float)(2 * f) / 64.f);
        const float ang = (float)p.pos[s] * invf;
        float sn, cs; sincosf(ang, &sn, &cs);
        p.cosC()[i] = cs; p.sinC()[i] = sn;
    }
    int base = 0;
    for (int i = 0; i < 2; ++i) {
        transpose_conv(p.hy_w_in + (size_t)i * 1024 * HY_IN, 1024, HY_IN, p.w_hy_in() + (size_t)i * HYN * 1024, HYN,
            [](int n) -> int {
                if (n < 2048) return n;
                const int seg = (n - 2048) >> 9, r = (n - 2048) & 511, sb = 2056 + seg * 512;
                if (seg < 2) { const int hd = r >> 7, dp = r & 127; const int d = (dp & 1) ? 64 + (dp >> 1) : (dp >> 1); return sb + hd * 128 + d; }
                return sb + r;
            }, smem, base);
        transpose_conv(p.hy_w_out + (size_t)i * 1024 * 1024, 1024, 1024, p.w_hy_out() + (size_t)i * 1024 * 1024, 1024, [](int n) -> int { return n; }, smem, base);
        transpose_conv(p.mla_w_in + (size_t)i * 1024 * 832, 1024, 832, p.w_mla_in() + (size_t)i * 1024 * 1024, 1024,
            [](int n) -> int {
                if (n < 768) return n;
                if (n < 832) { const int dp = n - 768; const int d = (dp & 1) ? 32 + (dp >> 1) : (dp >> 1); return 768 + d; }
                return -1;
            }, smem, base);
        transpose_conv(p.mla_w_uq + (size_t)i * 512 * 1536, 512, 1536, p.w_uq() + (size_t)i * 1536 * 512, 1536,
            [](int n) -> int {
                const int hd = n / 192, d = n % 192;
                if (d < 128) return n;
                const int dp = d - 128; const int dd = (dp & 1) ? 32 + (dp >> 1) : (dp >> 1);
                return hd * 192 + 128 + dd;
            }, smem, base);
        transpose_conv(p.mla_w_ukv + (size_t)i * 256 * 2048, 256, 2048, p.w_ukv() + (size_t)i * 2048 * 256, 2048,
            [](int n) -> int {
                if (n < 1024) { const int hd = n >> 7, d = n & 127; return hd * 256 + d; }
                const int m = n - 1024; const int hd = m >> 7, d = m & 127; return hd * 256 + 128 + d;
            }, smem, base);
        transpose_conv(p.mla_w_out + (size_t)i * 1024 * 1024, 1024, 1024, p.w_mla_out() + (size_t)i * 1024 * 1024, 1024, [](int n) -> int { return n; }, smem, base);
    }
    for (int i = 0; i < 4; ++i)
        transpose_conv(p.peer_w_q + (size_t)i * 1024 * 2048, 1024, 2048, p.w_pq() + (size_t)i * 2048 * 1024, 2048, [](int n) -> int { return n; }, smem, base);
    convert_bf16(p.peer_sub_keys, p.skb(), (size_t)4 * 8 * 2 * 128 * 128);
}

template <int MODE>
DEV void phase_norm(const float* __restrict__ xs, const float* __restrict__ nw, const float* __restrict__ shv, const float* __restrict__ scv,
                    bf16_t* __restrict__ hout, float* __restrict__ fout, const float* __restrict__ w8src, float* __restrict__ ba, char* smem) {
    const int tid = opaque_tid(), lane = tid & 63, w = __builtin_amdgcn_readfirstlane(tid >> 6);
    float* W8 = (float*)smem;
    if (MODE == 1) {
        for (int i = tid; i < 8192; i += NTHREADS) { const int k = i >> 3, c = i & 7; W8[c * 1024 + k] = w8src[(size_t)k * HY_IN + 2048 + c]; }
        __syncthreads();
    }
    f32x4 wm[4], sh[4];
#pragma unroll
    for (int i = 0; i < 4; ++i) {
        const int e = (i * 64 + lane) * 4;
        const f32x4 nv = *(const f32x4*)(nw + e);
        if (MODE == 2) { wm[i] = nv; sh[i] = (f32x4){0.f, 0.f, 0.f, 0.f}; }
        else { const f32x4 sc = *(const f32x4*)(scv + e); wm[i] = nv * (sc + 1.0f); sh[i] = *(const f32x4*)(shv + e); }
    }
    for (int row = opaque_bid() * 8 + w; row < S; row += gridDim.x * 8) {
        f32x4 v[4]; float ss = 0.f;
#pragma unroll
        for (int i = 0; i < 4; ++i) { v[i] = *(const f32x4*)(xs + (size_t)row * DM + (i * 64 + lane) * 4); ss += v[i][0] * v[i][0] + v[i][1] * v[i][1] + v[i][2] * v[i][2] + v[i][3] * v[i][3]; }
        ss = wsum64(ss, lane);
        const float rn = rsqrtf(ss * (1.f / 1024.f) + 1e-6f);
#pragma unroll
        for (int i = 0; i < 4; ++i) v[i] = v[i] * rn * wm[i] + sh[i];
        if (MODE == 2) {
#pragma unroll
            for (int i = 0; i < 4; ++i) *(f32x4*)(fout + (size_t)row * DM + (i * 64 + lane) * 4) = v[i];
        } else {
#pragma unroll
            for (int i = 0; i < 4; ++i) { u32x2 o; o.x = pk2(v[i][0], v[i][1]); o.y = pk2(v[i][2], v[i][3]); *(u32x2*)(hout + (size_t)row * DM + (i * 64 + lane) * 4) = o; }
        }
        if (MODE == 1) {
            float pc[8];
#pragma unroll
            for (int c = 0; c < 8; ++c) {
                float a = 0.f;
#pragma unroll
                for (int i = 0; i < 4; ++i) { const f32x4 ww = *(const f32x4*)(W8 + c * 1024 + (i * 64 + lane) * 4); a += v[i][0] * ww[0] + v[i][1] * ww[1] + v[i][2] * ww[2] + v[i][3] * ww[3]; }
                pc[c] = wsum64(a, lane);
            }
            if (lane == 0) { *(f32x4*)(ba + (size_t)row * 8) = (f32x4){pc[0], pc[1], pc[2], pc[3]}; *(f32x4*)(ba + (size_t)row * 8 + 4) = (f32x4){pc[4], pc[5], pc[6], pc[7]}; }
        }
    }
}

constexpr int GA_RS = 144;
template <class Epi>
DEV void gemm_phase(const bf16_t* __restrict__ A, int lda, const bf16_t* __restrict__ Bt, int ldb, int K, int ntn, char* smem, Epi epi) {
    const int tid = opaque_tid(), lane = tid & 63, w = tid >> 6, wm = w >> 1, wn = w & 1, r = lane & 15, g = lane >> 4;
    char* As = smem; char* Bs = smem + 256 * GA_RS;
    const int nun = 64 * ntn, nk = K / 64;
    for (int u = opaque_bid(); u < nun; u += gridDim.x) {
        const int xcd = u & 7, idx = u >> 3, tn = idx % ntn, tm = xcd * 8 + idx / ntn;
        const int m0 = tm * 256, n0 = tn * 128;
        f32x4 acc[4][4];
#pragma unroll
        for (int i = 0; i < 4; ++i)
#pragma unroll
            for (int j = 0; j < 4; ++j) acc[i][j] = (f32x4){0.f, 0.f, 0.f, 0.f};
        u32x4 ra0[4], rb0[2], ra1[4], rb1[2], ra2[4], rb2[2];
        const bf16_t* Ap = A + (size_t)(m0 + (tid >> 3)) * lda + (tid & 7) * 8;
        const bf16_t* Bp = Bt + (size_t)(n0 + (tid >> 3)) * ldb + (tid & 7) * 8;
        auto gload = [&](int kt, u32x4 (&ra)[4], u32x4 (&rb)[2]) {
            const int k0 = kt * 64;
#pragma unroll
            for (int i = 0; i < 4; ++i) ra[i] = *(const u32x4*)(Ap + (size_t)(64 * i) * lda + k0);
#pragma unroll
            for (int i = 0; i < 2; ++i) rb[i] = *(const u32x4*)(Bp + (size_t)(64 * i) * ldb + k0);
        };
        auto body = [&](int kt, u32x4 (&ra)[4], u32x4 (&rb)[2]) {
            __syncthreads();
#pragma unroll
            for (int i = 0; i < 4; ++i) *(u32x4*)(As + ((tid >> 3) + 64 * i) * GA_RS + (tid & 7) * 16) = ra[i];
#pragma unroll
            for (int i = 0; i < 2; ++i) *(u32x4*)(Bs + ((tid >> 3) + 64 * i) * GA_RS + (tid & 7) * 16) = rb[i];
            __syncthreads();
            if (kt + 3 < nk) gload(kt + 3, ra, rb);
#pragma unroll
            for (int ks = 0; ks < 2; ++ks) {
                bf16x8 af[4], bfr[4];
#pragma unroll
                for (int mt = 0; mt < 4; ++mt) af[mt] = *(const bf16x8*)(As + (64 * wm + 16 * mt + r) * GA_RS + (32 * ks + 8 * g) * 2);
#pragma unroll
                for (int nt = 0; nt < 4; ++nt) bfr[nt] = *(const bf16x8*)(Bs + (64 * wn + 16 * nt + r) * GA_RS + (32 * ks + 8 * g) * 2);
#pragma unroll
                for (int mt = 0; mt < 4; ++mt)
#pragma unroll
                    for (int nt = 0; nt < 4; ++nt) acc[mt][nt] = mfma16(bfr[nt], af[mt], acc[mt][nt]);
            }
        };
        gload(0, ra0, rb0); gload(1, ra1, rb1); gload(2, ra2, rb2);
        for (int kt = 0; kt < nk; kt += 3) {
            body(kt, ra0, rb0);
            if (kt + 1 < nk) body(kt + 1, ra1, rb1);
            if (kt + 2 < nk) body(kt + 2, ra2, rb2);
        }
        epi(acc, m0 + 64 * wm + r, n0 + 64 * wn + 4 * g, n0);
    }
}

DEV void st_bf4(bf16_t* p, f32x4 v) { u32x2 o; o.x = pk2(v[0], v[1]); o.y = pk2(v[2], v[3]); *(u32x2*)p = o; }
DEV f32x4 rope4(f32x4 v, const float* cs, const float* sn, int fi) {
    const float c0 = cs[fi], s0 = sn[fi], c1 = cs[fi + 1], s1 = sn[fi + 1];
    f32x4 o; o[0] = v[0] * c0 - v[1] * s0; o[1] = v[1] * c0 + v[0] * s0; o[2] = v[2] * c1 - v[3] * s1; o[3] = v[3] * c1 + v[2] * s1; return o;
}

namespace pg8 {
#define PG8_LAS __attribute__((address_space(3)))
typedef unsigned short bf16_t;
typedef short bf16x8 __attribute__((ext_vector_type(8)));
typedef float f32x4 __attribute__((ext_vector_type(4)));
constexpr int BM = 256, BK = 64, HALF = 128, HTB = HALF * BK * 2  , STAGE_BYTES = 8 * HTB, NXCD = 8, WGM = 8;

__host__ __device__ __forceinline__ int lds_byte(int r, int c) { const int st = (r >> 4) * 2 + (c >> 5), rr = r & 15, cc = c & 31, ob = rr * 64 + cc * 2; return st * 1024 + (ob ^ (((ob >> 9) & 1) << 5)); }
__host__ __device__ __forceinline__ void stage_rc(int b, int& R, int& C) { const int st = b / 1024, sb = b % 1024, swz = sb ^ (((sb >> 9) & 1) << 5); R = (st >> 1) * 16 + swz / 64; C = (st & 1) * 32 + (swz % 64) / 2; }
__host__ __device__ __forceinline__ int perm32(int rho) { const int n = rho >> 4, i = rho & 15; return 8 * (i >> 2) + 4 * n + (i & 3); }

struct Unit { int pm, pn; };
struct Gemm { const bf16_t* A; const bf16_t* Bt; int M, N, K; };

struct StaticOrder {
    int nM, nN, nwg, G, c;
    __host__ __device__ void init(int M, int N, int G_, int c_) { nM = M / BM; nN = N / BM; nwg = nM * nN; G = G_; c = c_; }
    __host__ __device__ bool next(int i, Unit& u) const {
        const long L = (long)i * G + c; if (L >= nwg) return false;
        int wgid = (int)L; { const int q = nwg / NXCD, r = nwg % NXCD, xcd = wgid % NXCD, off = wgid / NXCD; wgid = (xcd < r ? xcd * (q + 1) : r * (q + 1) + (xcd - r) * q) + off; }
        const int nig = WGM * nN, gid = wgid / nig, fm = gid * WGM, gsz = (nM - fm) < WGM ? (nM - fm) : WGM;
        u.pm = fm + ((wgid % nig) % gsz); u.pn = (wgid % nig) / gsz; return true;
    }
    __device__ __forceinline__ void a_ready(const Unit&) const {}
    __device__ __forceinline__ void done(const Unit&) const {}
};
template <class Epi, class Sched, bool STAMP = false>
__device__ __forceinline__ void gemm_phase(PG8_LAS unsigned char* lds, const Gemm g, const Sched& S, const Epi& E, unsigned long long* stamps) {
    const int tid = opaque_tid(), wid = __builtin_amdgcn_readfirstlane(tid >> 6), lane = tid & 63, wr = wid >> 2, wc = wid & 3, fr = lane & 15, fq = lane >> 4;
    const int K = g.K, nt = K / BK;
    int ts_lo = 0, ts_hi = 0, nts = 0; const unsigned long long rt_entry = STAMP ? (unsigned long long)wall_clock64() : 0ull;
#define PG8_STAMP() do { if (STAMP && wid == 0 && nts < 64) { const unsigned long long _c = (unsigned long long)clock64(); \
        ts_lo = (lane == nts) ? (int)(unsigned)_c : ts_lo; ts_hi = (lane == nts) ? (int)(unsigned)(_c >> 32) : ts_hi; ++nts; } } while (0)
    PG8_STAMP();
    unsigned voffA[2], voffB[2];
#pragma unroll
    for (int i = 0; i < 2; ++i) { int R, C; stage_rc(tid * 16 + i * 8192, R, C); const int Rb = Epi::PERM ? ((R & ~31) + perm32(R & 31)) : R;
        voffA[i] = (unsigned)(R * K + C) * 2u; voffB[i] = (unsigned)(Rb * K + C) * 2u; }
    const size_t kstep = (size_t)(BK * 2);
    const size_t hstep = (size_t)HALF * K * 2;
    const size_t tstep = 2 * hstep;
    const unsigned ldsw = (unsigned)wid * 1024u;
    const int aoff = lds_byte(wr * 64 + fr, fq * 8), boff = lds_byte(wc * 32 + fr, fq * 8);
#define PG8_SA(b, h) (((b) * 2 + (h)) * HTB)
#define PG8_SB(b, h) ((4 + (b) * 2 + (h)) * HTB)
#define PG8_STAGE(bufoff, gbase, voff) do { _Pragma("unroll") for (int _i = 0; _i < 2; ++_i) \
        __builtin_amdgcn_global_load_lds((const unsigned*)((const char*)(gbase) + (voff)[_i]), (PG8_LAS unsigned*)(lds + (bufoff) + ldsw + _i * 8192), 16, 0, 0); } while (0)
#define PG8_LDA(dst, b, h) do { _Pragma("unroll") for (int m = 0; m < 4; ++m) _Pragma("unroll") for (int k = 0; k < 2; ++k) dst[m][k] = *(const PG8_LAS bf16x8*)(lds + PG8_SA(b, h) + aoff + m * 2048 + k * 1024); } while (0)
#define PG8_LDB(dst, b, h) do { _Pragma("unroll") for (int n = 0; n < 2; ++n) _Pragma("unroll") for (int k = 0; k < 2; ++k) dst[n][k] = *(const PG8_LAS bf16x8*)(lds + PG8_SB(b, h) + boff + n * 2048 + k * 1024); } while (0)
#define PG8_MMA(ai, bj, At, Bt) do { __builtin_amdgcn_s_setprio(1); _Pragma("unroll") for (int m = 0; m < 4; ++m) _Pragma("unroll") for (int n = 0; n < 2; ++n) _Pragma("unroll") for (int k = 0; k < 2; ++k) \
        acc[ai][bj][m][n] = __builtin_amdgcn_mfma_f32_16x16x32_bf16(Bt[n][k], At[m][k], acc[ai][bj][m][n], 0, 0, 0); __builtin_amdgcn_s_setprio(0); } while (0)
#define PG8_WAIT_V(n) asm volatile("s_waitcnt vmcnt(" #n ")" ::: "memory")
#define PG8_WAIT_L(n) asm volatile("s_waitcnt lgkmcnt(" #n ")" ::: "memory")
#define PG8_BAR __builtin_amdgcn_s_barrier()
#define PG8_SCHED __builtin_amdgcn_sched_barrier(0)
    Unit cur, nxt; int ui = 0;
    if (!S.next(0, cur)) return;
    f32x4 acc[2][2][4][2];
#pragma unroll
    for (int a = 0; a < 2; ++a)
#pragma unroll
        for (int b = 0; b < 2; ++b)
#pragma unroll
            for (int m = 0; m < 4; ++m)
#pragma unroll
                for (int n = 0; n < 2; ++n) acc[a][b][m][n] = (f32x4){0.f, 0.f, 0.f, 0.f};
    bf16x8 At[4][2], B0[2][2], B1[2][2];
    const char* cA = (const char*)g.A + (size_t)cur.pm * tstep; const char* cB = (const char*)g.Bt + (size_t)cur.pn * tstep;
    S.a_ready(cur);
    PG8_STAGE(PG8_SB(0, 0), cB, voffB); PG8_STAGE(PG8_SA(0, 0), cA, voffA); PG8_STAGE(PG8_SB(0, 1), cB + hstep, voffB); PG8_STAGE(PG8_SA(0, 1), cA + hstep, voffA);
    if (wr == 1) PG8_BAR;
    PG8_WAIT_V(4); PG8_BAR;
    PG8_STAGE(PG8_SB(1, 0), cB + kstep, voffB); PG8_STAGE(PG8_SA(1, 0), cA + kstep, voffA); PG8_STAGE(PG8_SB(1, 1), cB + hstep + kstep, voffB);
    PG8_WAIT_V(6); PG8_BAR;
    PG8_STAMP();
    for (;;) {
        const bool has_next = S.next(ui + 1, nxt);
        const char* nA = has_next ? (const char*)g.A + (size_t)nxt.pm * tstep : cA; const char* nB = has_next ? (const char*)g.Bt + (size_t)nxt.pn * tstep : cB;
        for (int t = 0; t < nt; t += 2) {
            const bool last = (t == nt - 2);
            const char* a1 = cA + (size_t)(t + 1) * kstep;
            const char* a2 = last ? nA : cA + (size_t)(t + 2) * kstep; const char* b2 = last ? nB : cB + (size_t)(t + 2) * kstep;
            const char* a3 = a2 + kstep; const char* b3 = b2 + kstep;
            if (last && has_next) S.a_ready(nxt);
            PG8_LDB(B0, 0, 0); PG8_SCHED; PG8_LDA(At, 0, 0); PG8_STAGE(PG8_SA(1, 1), a1 + hstep, voffA);
            PG8_WAIT_L(8); PG8_BAR; PG8_WAIT_L(0); PG8_MMA(0, 0, At, B0); PG8_BAR; PG8_SCHED;
            PG8_LDB(B1, 0, 1); PG8_STAGE(PG8_SB(0, 0), b2, voffB);
            PG8_BAR; PG8_WAIT_L(0); PG8_MMA(0, 1, At, B1); PG8_BAR;
            PG8_LDA(At, 0, 1); PG8_STAGE(PG8_SA(0, 0), a2, voffA);
            PG8_BAR; PG8_WAIT_L(0); PG8_MMA(1, 0, At, B0); PG8_BAR; PG8_SCHED;
            PG8_STAGE(PG8_SB(0, 1), b2 + hstep, voffB);
            PG8_WAIT_V(6); PG8_BAR; PG8_MMA(1, 1, At, B1); PG8_BAR;
            PG8_LDB(B0, 1, 0); PG8_SCHED; PG8_LDA(At, 1, 0); PG8_STAGE(PG8_SA(0, 1), a2 + hstep, voffA);
            PG8_WAIT_L(8); PG8_BAR; PG8_WAIT_L(0); PG8_MMA(0, 0, At, B0); PG8_BAR; PG8_SCHED;
            PG8_LDB(B1, 1, 1); PG8_STAGE(PG8_SB(1, 0), b3, voffB);
            PG8_BAR; PG8_WAIT_L(0); PG8_MMA(0, 1, At, B1); PG8_BAR;
            PG8_LDA(At, 1, 1); PG8_STAGE(PG8_SA(1, 0), a3, voffA);
            PG8_BAR; PG8_WAIT_L(0); PG8_MMA(1, 0, At, B0); PG8_BAR; PG8_SCHED;
            PG8_STAGE(PG8_SB(1, 1), b3 + hstep, voffB);
            PG8_WAIT_V(6); PG8_BAR; PG8_MMA(1, 1, At, B1); PG8_BAR;
        }
        PG8_STAMP();
        if constexpr (!Epi::AFTER_DRAIN) { E(acc, cur, wr, wc, fr, fq); S.done(cur); }
        PG8_STAMP();
        if (!has_next) break;
#pragma unroll
        for (int a = 0; a < 2; ++a)
#pragma unroll
            for (int b = 0; b < 2; ++b)
#pragma unroll
                for (int m = 0; m < 4; ++m)
#pragma unroll
                    for (int n = 0; n < 2; ++n) acc[a][b][m][n] = (f32x4){0.f, 0.f, 0.f, 0.f};
        cur = nxt; cA = nA; cB = nB; ++ui;
    }
    PG8_WAIT_V(0);
    if (wr == 0) PG8_BAR;
    PG8_BAR;
    if constexpr (Epi::AFTER_DRAIN) { E.fused(acc, cur, wr, wc, fr, fq, lds, wid, lane); S.done(cur); }
    PG8_STAMP();
    if (STAMP && wid == 0) { stamps[lane] = lane < nts ? (((unsigned long long)(unsigned)ts_hi << 32) | (unsigned)ts_lo) : 0ull;
        if (lane == 62) stamps[62] = rt_entry; if (lane == 63) stamps[63] = (unsigned long long)wall_clock64(); }
#undef PG8_STAMP
#undef PG8_SA
#undef PG8_SB
#undef PG8_STAGE
#undef PG8_LDA
#undef PG8_LDB
#undef PG8_MMA
#undef PG8_WAIT_V
#undef PG8_WAIT_L
#undef PG8_BAR
#undef PG8_SCHED
}
}

template <class F> struct EpiCall {
    static constexpr bool PERM = false, AFTER_DRAIN = false;
    F f;
    __device__ __forceinline__ void operator()(const f32x4 (&acc)[2][2][4][2], const pg8::Unit& u, int wr, int wc, int fr, int fq) const {
        { const int t_ = opaque_tid(); fr = t_ & 15; fq = (t_ >> 4) & 3; const int wid_ = __builtin_amdgcn_readfirstlane(t_ >> 6); wr = wid_ >> 2; wc = wid_ & 3; }
#pragma unroll
        for (int ai = 0; ai < 2; ++ai)
#pragma unroll
            for (int bj = 0; bj < 2; ++bj) {
                const int n0 = u.pn * 256 + 128 * bj;
#pragma unroll
                for (int m = 0; m < 4; ++m) {
#pragma unroll
                    for (int n = 0; n < 2; ++n) f(u.pm * 256 + 128 * ai + 64 * wr + 16 * m + fr, n0 + 32 * wc + 16 * n + 4 * fq, n0, acc[ai][bj][m][n]);
                    __builtin_amdgcn_sched_barrier(0);
                }
            }
    }
};
template <class F>
DEV void gemm256(const bf16_t* A, const bf16_t* Bt, int N, int K, char* smem, F f) {
    pg8::Gemm g; g.A = A; g.Bt = Bt; g.M = S; g.N = N; g.K = K;
    pg8::StaticOrder so; so.init(S, N, (int)gridDim.x, opaque_bid());
    EpiCall<F> e{f};
    pg8::gemm_phase<EpiCall<F>, pg8::StaticOrder, false>((PG8_LAS unsigned char*)smem, g, so, e, nullptr);
}

template <int DQK>
DEV void attn_run(const bf16_t* __restrict__ qrow, bool wactive, const bf16_t* __restrict__ Kn, const bf16_t* __restrict__ Kr,
                  const bf16_t* __restrict__ VT, int t_lo, int t_hi, int t_plain, int qpos, int wqmin, int wqmax, char* smem,
                  f32x16 (&o)[4], float& mrun, float& lrun) {
    constexpr int KRS = (DQK + 8) * 2;
    constexpr int VRS = 144;
    constexpr int NKS = DQK / 16;
    constexpr int QREG = 4;
    constexpr bool ROPE = (DQK == 192);
    char* Vb0 = smem + 2 * 64 * KRS; char* Qs = Vb0 + 2 * 128 * VRS;
    const int tid = opaque_tid(), lane = tid & 63, c = lane & 31, hi = lane >> 5;
    bf16x8 qf[QREG];
#pragma unroll
    for (int ks = 0; ks < QREG; ++ks) qf[ks] = *(const bf16x8*)(qrow + 16 * ks + 8 * hi);
    char* Qw = Qs + (tid >> 6) * ((NKS - QREG) * 1024) + lane * 16;
#pragma unroll
    for (int ks = QREG; ks < NKS; ++ks) *(bf16x8*)(Qw + (ks - QREG) * 1024) = *(const bf16x8*)(qrow + 16 * ks + 8 * hi);
#pragma unroll
    for (int i = 0; i < 4; ++i)
#pragma unroll
        for (int rr = 0; rr < 16; ++rr) o[i][rr] = 0.f;
    mrun = -1e30f; lrun = 0.f;
    u32x4 kreg[2], rreg, vreg[2];
    auto gloadK = [&](int t) {
        int t2 = tid; asm volatile("" : "+v"(t2));
        const char* kn_t = (const char*)Kn + (size_t)t * (64 * 256);
#pragma unroll
        for (int i = 0; i < 2; ++i) { const int ch = t2 + NTHREADS * i; kreg[i] = *(const u32x4*)(kn_t + (unsigned)((ch >> 4) * 256 + (ch & 15) * 16)); }
        if (ROPE) { const char* kr_t = (const char*)Kr + (size_t)t * (64 * 128); rreg = *(const u32x4*)(kr_t + (unsigned)((t2 >> 3) * 128 + (t2 & 7) * 16)); }
    };
    auto gloadV = [&](int t) {
        int t2 = tid; asm volatile("" : "+v"(t2));
        const char* vt_t = (const char*)VT + (size_t)t * (128 * 128);
#pragma unroll
        for (int i = 0; i < 2; ++i) { const int ch = t2 + NTHREADS * i; vreg[i] = *(const u32x4*)(vt_t + (unsigned)(ch * 16)); }
    };
    auto lstoreK = [&](int t) {
        int t2 = tid; asm volatile("" : "+v"(t2));
        char* Ks = smem + (t & 1) * (64 * KRS);
#pragma unroll
        for (int i = 0; i < 2; ++i) { const int ch = t2 + NTHREADS * i; *(u32x4*)(Ks + (ch >> 4) * KRS + (ch & 15) * 16) = kreg[i]; }
        if (ROPE) *(u32x4*)(Ks + (t2 >> 3) * KRS + 256 + (t2 & 7) * 16) = rreg;
    };
    auto lstoreV = [&](int t) {
        int t2 = tid; asm volatile("" : "+v"(t2));
        char* Vs = Vb0 + (t & 1) * (128 * VRS);
#pragma unroll
        for (int i = 0; i < 2; ++i) {
            const int ch = t2 + NTHREADS * i;
            char* d = Vs + (ch >> 3) * VRS + ((ch & 7) >> 1) * 32 + (ch & 1) * 8;
            *(u32x2*)d = (u32x2){vreg[i].x, vreg[i].y}; *(u32x2*)(d + 16) = (u32x2){vreg[i].z, vreg[i].w};
        }
    };
    auto qk = [&](int t, f32x16 (&sv)[2]) {
        const char* Ks = smem + (t & 1) * (64 * KRS) + c * KRS + 16 * hi;
#pragma unroll
        for (int kt = 0; kt < 2; ++kt)
#pragma unroll
            for (int rr = 0; rr < 16; ++rr) sv[kt][rr] = 0.f;
        bf16x8 k0[3], k1[3], qv[3];
#pragma unroll
        for (int ks = 0; ks < 2; ++ks) {
            k0[ks] = *(const bf16x8*)(Ks + 32 * ks); k1[ks] = *(const bf16x8*)(Ks + 32 * KRS + 32 * ks);
            if (ks < QREG) qv[ks] = qf[ks < QREG ? ks : 0]; else qv[ks] = *(const bf16x8*)(Qw + (ks - QREG) * 1024);
        }
#pragma unroll
        for (int ks = 0; ks < NKS; ++ks) {
            if (ks + 2 < NKS) {
                k0[(ks + 2) % 3] = *(const bf16x8*)(Ks + 32 * (ks + 2)); k1[(ks + 2) % 3] = *(const bf16x8*)(Ks + 32 * KRS + 32 * (ks + 2));
                if (ks + 2 < QREG) qv[(ks + 2) % 3] = qf[ks + 2 < QREG ? ks + 2 : 0]; else qv[(ks + 2) % 3] = *(const bf16x8*)(Qw + (ks + 2 - QREG) * 1024);
            }
            sv[0] = mfma32(k0[ks % 3], qv[ks % 3], sv[0]);
            sv[1] = mfma32(k1[ks % 3], qv[ks % 3], sv[1]);
        }
    };
    float mnew_ = 0.f;
    auto softmax_a = [&](int t, f32x16 (&sv)[2]) {
        const int kb = t * 64;
        if (kb + 63 > wqmin) {
#pragma unroll
            for (int kt = 0; kt < 2; ++kt)
#pragma unroll
                for (int rr = 0; rr < 16; ++rr) { const int key = kb + 32 * kt + (rr & 3) + 8 * (rr >> 2) + 4 * hi; if (key > qpos) sv[kt][rr] = -__builtin_inff(); }
        }
        float tmax = sv[0][0];
#pragma unroll
        for (int rr = 1; rr < 16; ++rr) tmax = fmaxf(tmax, sv[0][rr]);
#pragma unroll
        for (int rr = 0; rr < 16; ++rr) tmax = fmaxf(tmax, sv[1][rr]);
        tmax = fmaxf(tmax, shx(tmax, 32, lane));
        const float mnew = fmaxf(mrun, tmax);
        const float alpha = ex2(mrun - mnew);
        mrun = mnew; mnew_ = mnew;
        lrun *= alpha;
        if (!__all(alpha == 1.f)) {
#pragma unroll
            for (int i = 0; i < 4; ++i)
#pragma unroll
                for (int rr = 0; rr < 16; ++rr) o[i][rr] *= alpha;
        }
    };
    auto softmax_b = [&](f32x16 (&sv)[2], bf16x8 (&pf)[2][2]) {
        const float mnew = mnew_;
        float ps = 0.f;
#pragma unroll
        for (int kt = 0; kt < 2; ++kt)
#pragma unroll
            for (int rr = 0; rr < 16; ++rr) { const float pv = ex2(sv[kt][rr] - mnew); sv[kt][rr] = pv; ps += pv; }
        lrun += ps;
#pragma unroll
        for (int kt = 0; kt < 2; ++kt)
#pragma unroll
            for (int s2 = 0; s2 < 2; ++s2) {
                u32x4 pw; pw.x = pk2(sv[kt][8 * s2 + 0], sv[kt][8 * s2 + 1]); pw.y = pk2(sv[kt][8 * s2 + 2], sv[kt][8 * s2 + 3]);
                pw.z = pk2(sv[kt][8 * s2 + 4], sv[kt][8 * s2 + 5]); pw.w = pk2(sv[kt][8 * s2 + 6], sv[kt][8 * s2 + 7]);
                pf[kt][s2] = *(const bf16x8*)&pw;
            }
    };
    auto pv = [&](int t, const bf16x8 (&pf)[2][2]) {
        const char* Vs = Vb0 + (t & 1) * (128 * VRS) + c * VRS + 16 * hi;
#pragma unroll
        for (int g = 0; g < 4; ++g)
#pragma unroll
            for (int dvt = 0; dvt < 4; ++dvt) o[dvt] = mfma32(*(const bf16x8*)(Vs + 32 * dvt * VRS + 32 * g), pf[g >> 1][g & 1], o[dvt]);
    };
    auto active = [&](int t) -> bool { return wactive && (t * 64 <= wqmax); };
    auto step = [&](int t, f32x16 (&sc)[2], f32x16 (&sn)[2]) {
        const bool more = t + 1 < t_hi;
        const int tk = t + 2 < t_hi ? t + 2 : t_hi - 1, tv = more ? t + 1 : t_hi - 1;
        const bool a0 = active(t), a1 = more && active(t + 1);
        if (a0) {
            bf16x8 pf[2][2];
            if (a1) { qk(t + 1, sn); gloadK(tk); gloadV(tv); softmax_b(sc, pf); pv(t, pf); asm volatile("; arm qk+exp+pv" ::: "memory"); }
            else { gloadK(tk); gloadV(tv); softmax_b(sc, pf); pv(t, pf); asm volatile("; arm exp+pv" ::: "memory"); }
        } else { gloadK(tk); gloadV(tv); }
        lstoreK(t + 2); lstoreV(t + 1);
        if (a1) softmax_a(t + 1, sn);
        __syncthreads();
    };
    int kso[2], rso, vso[2];
#pragma unroll
    for (int i = 0; i < 2; ++i) { const int ch = tid + NTHREADS * i; kso[i] = (ch >> 4) * KRS + (ch & 15) * 16; vso[i] = (ch >> 3) * VRS + ((ch & 7) >> 1) * 32 + (ch & 1) * 8; }
    rso = (tid >> 3) * KRS + 256 + (tid & 7) * 16;
    auto fstep = [&](int t, f32x16 (&sc)[2], f32x16 (&sn)[2]) {
        const char* Ks = smem + ((t + 1) & 1) * (64 * KRS) + c * KRS + 16 * hi;
        const char* Vs = Vb0 + (t & 1) * (128 * VRS) + c * VRS + 16 * hi;
        char* Kst = smem + (t & 1) * (64 * KRS); char* Vst = Vb0 + ((t + 1) & 1) * (128 * VRS);
        f32x2 nm2 = {-mnew_, -mnew_}; asm volatile("" : "+v"(nm2));
        const f32x16 zero16 = {0.f, 0.f, 0.f, 0.f, 0.f, 0.f, 0.f, 0.f, 0.f, 0.f, 0.f, 0.f, 0.f, 0.f, 0.f, 0.f};
        bf16x8 kf[3], ql[2], vf[3];
        u32x4 pf4[4];
        f32x2 ps2 = {0.f, 0.f}, d2 = {0.f, 0.f};
        float plo = 0.f, tmax = 0.f, alpha = 1.f;
        auto filler = [&](int G) {
            if (G < 32) {
                if ((G & 1) == 0) {
                    d2 = (f32x2){sc[G >> 4][G & 15], sc[G >> 4][(G & 15) + 1]} + nm2;
                    plo = ex2(d2[0]);
                    asm volatile("" : "+v"(plo), "+v"(d2));
                } else {
                    f32x2 pp; pp[0] = plo; pp[1] = ex2(d2[1]);
                    ps2 += pp;
                    unsigned wd = pk2(pp[0], pp[1]);
                    asm volatile("" : "+v"(wd), "+v"(ps2));
                    pf4[G >> 3][(G >> 1) & 3] = wd;
                }
            }
            if (G == 0) gloadK(t + 2);
            if (G == 1) gloadV(t + 1);
            {
                const int i0 = G - 2 * NKS;
                if (i0 >= 0 && i0 < 12) {
                    const int first = i0 < 4 ? 2 * i0 : 4 + i0, cnt = i0 < 4 ? 2 : 1;
#pragma unroll
                    for (int i = first; i < first + cnt; ++i) {
                        const int kt = i >> 3, r0 = 2 * (i & 7);
                        if (i == 0) tmax = fmaxf(sn[0][0], sn[0][1]); else tmax = fmaxf(fmaxf(tmax, sn[kt][r0]), sn[kt][r0 + 1]);
                    }
                    asm volatile("" : "+v"(tmax));
                }
                if (i0 == 12) {
                    const unsigned tb = __float_as_uint(tmax);
                    const auto sw = __builtin_amdgcn_permlane32_swap(tb, tb, false, false);
                    tmax = fmaxf(__uint_as_float(sw[0]), __uint_as_float(sw[1]));
                    asm volatile("" : "+v"(tmax));
                }
                if (i0 == 13) {
                    const float mnew = fmaxf(mrun, tmax);
                    alpha = ex2(mrun - mnew);
                    mrun = mnew; mnew_ = mnew;
                    lrun = (lrun + (ps2[0] + ps2[1])) * alpha;
                    asm volatile("" : "+v"(alpha), "+v"(lrun));
                }
            }
            if (G >= 32 && G < 39) {
                const int i = G - 32;
                if (i < 2) *(u32x4*)(Kst + kso[i]) = kreg[i];
                else if (i == 2) { if (ROPE) *(u32x4*)(Kst + rso) = rreg; }
                else {
                    const int j = (i - 3) >> 1;
                    if (((i - 3) & 1) == 0) *(u32x2*)(Vst + vso[j]) = (u32x2){vreg[j].x, vreg[j].y}; else *(u32x2*)(Vst + vso[j] + 16) = (u32x2){vreg[j].z, vreg[j].w};
                }
            }
        };
        static_assert(2 * NKS + 16 >= 39 && 2 * NKS <= 32 && 2 * NKS + 13 < 2 * NKS + 16 && 2 * NKS + 13 >= 32, "filler slots");
        kf[0] = *(const bf16x8*)(Ks); kf[1] = *(const bf16x8*)(Ks + 32 * KRS);
        __builtin_amdgcn_sched_barrier(0);
#pragma unroll
        for (int g = 0; g < 2 * NKS; ++g) {
            const int ks = g >> 1, kt = g & 1;
            if (g + 2 < 2 * NKS) kf[(g + 2) % 3] = *(const bf16x8*)(Ks + ((g + 2) & 1) * (32 * KRS) + 32 * ((g + 2) >> 1));
            if (g + 2 == 2 * NKS) vf[0] = *(const bf16x8*)(Vs);
            if (g + 1 == 2 * NKS) vf[1] = *(const bf16x8*)(Vs + 32 * VRS);
            if (kt == 0 && ks + 1 >= QREG && ks + 1 < NKS) ql[(ks + 1) & 1] = *(const bf16x8*)(Qw + (ks + 1 - QREG) * 1024);
            const bf16x8 qop = ks < QREG ? qf[ks < QREG ? ks : 0] : ql[ks & 1];
            if (ks == 0) sn[kt] = mfma32(kf[g % 3], qop, zero16); else sn[kt] = mfma32(kf[g % 3], qop, sn[kt]);
            filler(g);
            __builtin_amdgcn_sched_barrier(0);
        }
#pragma unroll
        for (int g = 0; g < 16; ++g) {
            const int gg = g >> 2, dvt = g & 3;
            if (g + 2 < 16) vf[(g + 2) % 3] = *(const bf16x8*)(Vs + 32 * ((g + 2) & 3) * VRS + 32 * ((g + 2) >> 2));
            o[dvt] = mfma32(vf[g % 3], *(const bf16x8*)&pf4[gg], o[dvt]);
            filler(2 * NKS + g);
            __builtin_amdgcn_sched_barrier(0);
        }
        if (!__all(alpha == 1.f)) {
#pragma unroll
            for (int i = 0; i < 4; ++i)
#pragma unroll
                for (int rr = 0; rr < 16; ++rr) o[i][rr] *= alpha;
        }
        __syncthreads();
    };
    __syncthreads();
    gloadK(t_lo); gloadV(t_lo); lstoreK(t_lo); lstoreV(t_lo);
    if (t_lo + 1 < t_hi) { gloadK(t_lo + 1); lstoreK(t_lo + 1); }
    __syncthreads();
    f32x16 sA[2], sB[2];
    if (active(t_lo)) { qk(t_lo, sA); softmax_a(t_lo, sA); }
    __syncthreads();
    int t = t_lo;
    for (; t + 2 < t_plain; t += 2) { fstep(t, sA, sB); fstep(t + 1, sB, sA); }
    for (; t < t_hi; t += 2) {
        step(t, sA, sB);
        if (t + 1 < t_hi) step(t + 1, sB, sA);
    }
    lrun += shx(lrun, 32, lane);
}

DEV void phase_mla_attn(const Params& p, char* smem) {
    const int tid = opaque_tid(), lane = tid & 63, w = tid >> 6, c = lane & 31, hi = lane >> 5;
    for (int u = opaque_bid(); u < 256; u += gridDim.x) {
        const int head = u & 7, pi = u >> 3;
        for (int half = 0; half < 2; ++half) {
            const int qb = half == 0 ? (63 - pi) : pi;
            const int q = qb * 256 + 32 * w + c;
            f32x16 o[4]; float m, l;
            attn_run<192>(p.Qm() + ((size_t)head * S + q) * 192, true, p.Kn() + (size_t)head * S * 128, p.Kr(), p.VmT() + (size_t)head * 128 * S,
                          0, 4 * qb + 4, 4 * qb, q, qb * 256 + 32 * w, qb * 256 + 32 * w + 31, smem, o, m, l);
            const float inv = 1.f / l;
#pragma unroll
            for (int dvt = 0; dvt < 4; ++dvt)
#pragma unroll
                for (int rg = 0; rg < 4; ++rg) {
                    const int dv = 32 * dvt + 8 * rg + 4 * hi;
                    f32x4 v = {o[dvt][4 * rg] * inv, o[dvt][4 * rg + 1] * inv, o[dvt][4 * rg + 2] * inv, o[dvt][4 * rg + 3] * inv};
                    st_bf4(p.cat() + (size_t)q * DM + head * 128 + dv, v);
                }
        }
    }
}

DEV void moba_kmean_unit(const Params& p, int h, int j, char* smem) {
    float* red = (float*)smem;
    const int tid = opaque_tid(), d = tid & 127, qq = tid >> 7;
    const bf16_t* kp = p.Kb() + ((size_t)h * S + 256 * j + qq * 64) * 128 + d;
    float s = 0.f;
    for (int t = 0; t < 64; ++t) s += __uint_as_float(((unsigned)kp[(size_t)t * 128]) << 16);
    __syncthreads();
    red[qq * 128 + d] = s;
    __syncthreads();
    if (tid < 128) p.kmean()[((size_t)h * 64 + j) * 128 + tid] = (red[tid] + red[128 + tid] + red[256 + tid] + red[384 + tid]) * (1.f / 256.f);
}

DEV void moba_gate_unit(const Params& p, int u, char* smem) {
    float* km = (float*)smem;
    int* cnt = (int*)(smem + 32768);
    const int tid = opaque_tid();
    {
        const int h = u & 3, t = u >> 2;
        __syncthreads();
        for (int i = tid; i < 8192; i += NTHREADS) km[i] = p.kmean()[(size_t)h * 8192 + i];
        if (tid < 64) cnt[tid] = 0;
        __syncthreads();
        const int q = t * 512 + tid, own = q >> 8;
        float qv[128];
        const u32x4* qp = (const u32x4*)(p.Qb() + ((size_t)h * S + q) * 128);
#pragma unroll
        for (int i = 0; i < 16; ++i) { const u32x4 v = qp[i]; qv[8 * i] = bflo(v.x); qv[8 * i + 1] = bfhi(v.x); qv[8 * i + 2] = bflo(v.y); qv[8 * i + 3] = bfhi(v.y); qv[8 * i + 4] = bflo(v.z); qv[8 * i + 5] = bfhi(v.z); qv[8 * i + 6] = bflo(v.w); qv[8 * i + 7] = bfhi(v.w); }
        float b0 = -__builtin_inff(), b1 = b0, b2 = b0; int i0 = 0, i1 = 0, i2 = 0;
        const int ownw = __builtin_amdgcn_readfirstlane(own);
        for (int j = 0; j < ownw; ++j) {
            float s = 0.f; const f32x4* kp = (const f32x4*)(km + j * 128);
#pragma unroll
            for (int d4 = 0; d4 < 32; ++d4) { const f32x4 kk = kp[d4]; s += qv[4 * d4] * kk[0] + qv[4 * d4 + 1] * kk[1] + qv[4 * d4 + 2] * kk[2] + qv[4 * d4 + 3] * kk[3]; }
            if (s > b0) { b2 = b1; i2 = i1; b1 = b0; i1 = i0; b0 = s; i0 = j; }
            else if (s > b1) { b2 = b1; i2 = i1; b1 = s; i1 = j; }
            else if (s > b2) { b2 = s; i2 = j; }
        }
        const int nsel = own < 3 ? own : 3;
        if (0 < nsel) { const int pos = atomicAdd(&cnt[i0], 1); p.lists()[(((size_t)h * 64 + i0) * 32 + t) * 512 + pos] = (q << 2) | 0; }
        if (1 < nsel) { const int pos = atomicAdd(&cnt[i1], 1); p.lists()[(((size_t)h * 64 + i1) * 32 + t) * 512 + pos] = (q << 2) | 1; }
        if (2 < nsel) { const int pos = atomicAdd(&cnt[i2], 1); p.lists()[(((size_t)h * 64 + i2) * 32 + t) * 512 + pos] = (q << 2) | 2; }
        __syncthreads();
        if (tid < 64) p.segcnt()[((size_t)h * 64 + tid) * 32 + t] = cnt[tid];
    }
}

DEV void moba_write_partial(const Params& p, int q, int h, int slot, const f32x16 (&o)[4], float m, float l, int hi) {
    bf16_t* pp = (bf16_t*)p.part() + (((size_t)q * 4 + h) * 4 + slot) * 128;
    const float il = 1.f / l;
#pragma unroll
    for (int dvt = 0; dvt < 4; ++dvt)
#pragma unroll
        for (int rg = 0; rg < 4; ++rg) {
            const int dv = 32 * dvt + 8 * rg + 4 * hi;
            st_bf4(pp + dv, (f32x4){o[dvt][4 * rg] * il, o[dvt][4 * rg + 1] * il, o[dvt][4 * rg + 2] * il, o[dvt][4 * rg + 3] * il});
        }
    if (hi == 0) { float* mp = p.ml() + (((size_t)q * 4 + h) * 4 + slot) * 2; mp[0] = m; mp[1] = l; }
}

constexpr int MB_KRS = 272, MB_VRS = 136, MB_KB = 64 * MB_KRS, MB_VB = 128 * MB_VRS, MB_TAB = 8 * 17408;
DEV int moba_tile_table(const Params& p, char* smem) {
    int* P = (int*)(smem + MB_TAB + 256);
    const int tid = opaque_tid();
    __syncthreads();
    if (tid < 256) {
        const int j = tid >> 2, h = tid & 3; int s = 0;
        const int* sc = p.segcnt() + ((size_t)h * 64 + j) * 32;
        for (int t = 0; t < 32; ++t) s += sc[t];
        const int ntiles = 1 + ((s + 255) >> 8);
        P[tid + 1] = (ntiles + 3) >> 2;
    }
    if (tid == 0) P[0] = 0;
    __syncthreads();
    if (tid == 0) { int s = 0; for (int i = 1; i <= 256; ++i) { s += P[i]; P[i] = s; } }
    __syncthreads();
    return P[256];
}
DEV void moba_attn_resident(const bf16_t* __restrict__ qrow, bool wactive, int qpos, int wqmin, int wqmax, int kb0, char* smem, f32x16 (&o)[4], float& mrun, float& lrun) {
    const int tid = opaque_tid(), lane = tid & 63, c = lane & 31, hi = lane >> 5;
    bf16x8 qf[8];
#pragma unroll
    for (int ks = 0; ks < 8; ++ks) qf[ks] = *(const bf16x8*)(qrow + 16 * ks + 8 * hi);
#pragma unroll
    for (int i = 0; i < 4; ++i)
#pragma unroll
        for (int rr = 0; rr < 16; ++rr) o[i][rr] = 0.f;
    mrun = -1e30f; lrun = 0.f;
    if (!wactive) return;
    float mnew_ = 0.f;
    auto qk = [&](int t, f32x16 (&sv)[2]) {
        const char* Ks = smem + t * MB_KB + c * MB_KRS + 16 * hi;
#pragma unroll
        for (int kt = 0; kt < 2; ++kt)
#pragma unroll
            for (int rr = 0; rr < 16; ++rr) sv[kt][rr] = 0.f;
#pragma unroll
        for (int ks = 0; ks < 8; ++ks) {
            sv[0] = mfma32(*(const bf16x8*)(Ks + 32 * ks), qf[ks], sv[0]);
            sv[1] = mfma32(*(const bf16x8*)(Ks + 32 * MB_KRS + 32 * ks), qf[ks], sv[1]);
        }
    };
    auto softmax_a = [&](int t, f32x16 (&sv)[2]) {
        const int kb = kb0 + t * 64;
        if (kb + 63 > wqmin) {
#pragma unroll
            for (int kt = 0; kt < 2; ++kt)
#pragma unroll
                for (int rr = 0; rr < 16; ++rr) { const int key = kb + 32 * kt + (rr & 3) + 8 * (rr >> 2) + 4 * hi; if (key > qpos) sv[kt][rr] = -__builtin_inff(); }
        }
        float tmax = sv[0][0];
#pragma unroll
        for (int rr = 1; rr < 16; ++rr) tmax = fmaxf(tmax, sv[0][rr]);
#pragma unroll
        for (int rr = 0; rr < 16; ++rr) tmax = fmaxf(tmax, sv[1][rr]);
        tmax = fmaxf(tmax, shx(tmax, 32, lane));
        const float mnew = fmaxf(mrun, tmax);
        const float alpha = ex2(mrun - mnew);
        mrun = mnew; mnew_ = mnew;
        lrun *= alpha;
        if (!__all(alpha == 1.f)) {
#pragma unroll
            for (int i = 0; i < 4; ++i)
#pragma unroll
                for (int rr = 0; rr < 16; ++rr) o[i][rr] *= alpha;
        }
    };
    auto softmax_b = [&](f32x16 (&sv)[2], bf16x8 (&pf)[2][2]) {
        const float mnew = mnew_;
        float ps = 0.f;
#pragma unroll
        for (int kt = 0; kt < 2; ++kt)
#pragma unroll
            for (int rr = 0; rr < 16; ++rr) { const float pv = ex2(sv[kt][rr] - mnew); sv[kt][rr] = pv; ps += pv; }
        lrun += ps;
#pragma unroll
        for (int kt = 0; kt < 2; ++kt)
#pragma unroll
            for (int s2 = 0; s2 < 2; ++s2) {
                u32x4 pw; pw.x = pk2(sv[kt][8 * s2 + 0], sv[kt][8 * s2 + 1]); pw.y = pk2(sv[kt][8 * s2 + 2], sv[kt][8 * s2 + 3]);
                pw.z = pk2(sv[kt][8 * s2 + 4], sv[kt][8 * s2 + 5]); pw.w = pk2(sv[kt][8 * s2 + 6], sv[kt][8 * s2 + 7]);
                pf[kt][s2] = *(const bf16x8*)&pw;
            }
    };
    auto pv = [&](int t, const bf16x8 (&pf)[2][2]) {
        const char* Vs = smem + 4 * MB_KB + t * MB_VB + c * MB_VRS + 8 * hi;
#pragma unroll
        for (int g = 0; g < 4; ++g) {
#pragma unroll
            for (int dvt = 0; dvt < 4; ++dvt) {
                const u32x2 v0 = *(const u32x2*)(Vs + 32 * dvt * MB_VRS + 32 * g), v1 = *(const u32x2*)(Vs + 32 * dvt * MB_VRS + 32 * g + 16);
                u32x4 vw; vw.x = v0.x; vw.y = v0.y; vw.z = v1.x; vw.w = v1.y;
                o[dvt] = mfma32(*(const bf16x8*)&vw, pf[g >> 1][g & 1], o[dvt]);
            }
        }
    };
    int nt_act = 4;
    if (wqmax != 0x7fffffff) { nt_act = ((wqmax - kb0) >> 6) + 1; if (nt_act > 4) nt_act = 4; }
    f32x16 sA[2], sB[2];
    qk(0, sA);
    for (int t = 0; t < nt_act; t += 2) {
        {
            bf16x8 pf[2][2];
            softmax_a(t, sA);
            if (t + 1 < nt_act) { qk(t + 1, sB); softmax_b(sA, pf); pv(t, pf); asm volatile("; arm A1" ::: "memory"); }
            else { softmax_b(sA, pf); pv(t, pf); asm volatile("; arm A2" ::: "memory"); }
        }
        if (t + 1 < nt_act) {
            bf16x8 pf[2][2];
            softmax_a(t + 1, sB);
            if (t + 2 < nt_act) { qk(t + 2, sA); softmax_b(sB, pf); pv(t + 1, pf); asm volatile("; arm B1" ::: "memory"); }
            else { softmax_b(sB, pf); pv(t + 1, pf); asm volatile("; arm B2" ::: "memory"); }
        }
    }
    lrun += shx(lrun, 32, lane);
}
DEV void moba_subunit(const Params& p, int su, char* smem) {
    const int tid = opaque_tid(), lane = tid & 63, w = tid >> 6, c = lane & 31, hi = lane >> 5;
    int* pre = (int*)(smem + MB_TAB);
    const int* P = (const int*)(smem + MB_TAB + 256);
    int u = 0;
#pragma unroll
    for (int s = 128; s >= 1; s >>= 1) if (P[u + s] <= su) u += s;
    const int sidx = su - P[u], j = u >> 2, h = u & 3;
    const bf16_t* Kh = p.Kb() + ((size_t)h * S + 256 * j) * 128;
    const bf16_t* Vh = p.VbT() + ((size_t)h * 256 + 4 * j) * (128 * 64);
    __syncthreads();
    if (tid == 0) { int s = 0; for (int t = 0; t < 32; ++t) { pre[t] = s; s += p.segcnt()[((size_t)h * 64 + j) * 32 + t]; } pre[32] = s; }
#pragma unroll
    for (int i = 0; i < 8; ++i) {
        const int ch = tid + NTHREADS * i, row = ch >> 4, cc = ch & 15;
        *(u32x4*)(smem + (row >> 6) * MB_KB + (row & 63) * MB_KRS + cc * 16) = *(const u32x4*)((const char*)Kh + (size_t)ch * 16);
    }
#pragma unroll
    for (int i = 0; i < 8; ++i) {
        const int ch = tid + NTHREADS * i, t = ch >> 10, row = (ch >> 3) & 127, cc = ch & 7;
        const u32x4 v = *(const u32x4*)((const char*)Vh + (size_t)ch * 16);
        u32x2* d = (u32x2*)(smem + 4 * MB_KB + t * MB_VB + row * MB_VRS + cc * 16);
        d[0] = (u32x2){v.x, v.y}; d[1] = (u32x2){v.z, v.w};
    }
    __syncthreads();
    const int total = pre[32], ntiles = 1 + ((total + 255) >> 8);
    const int k_hi = (4 * sidx + 4) < ntiles ? (4 * sidx + 4) : ntiles;
    for (int k = 4 * sidx; k < k_hi; ++k) {
        const int k0 = (k - 1) * 256;
        int q, slot, qpos, wqmin, wqmax; bool valid, wact;
        if (k0 < 0) {
            q = 256 * j + 32 * w + c; slot = 3; qpos = q; wqmin = 256 * j + 32 * w; wqmax = wqmin + 31; valid = true; wact = true;
        } else {
            const int e = k0 + 32 * w + c; valid = e < total; q = 0; slot = 0;
            if (valid) {
                int seg = 0;
                for (int t = 1; t < 32; ++t) if (pre[t] <= e) seg = t;
                const int ent = p.lists()[(((size_t)h * 64 + j) * 32 + seg) * 512 + (e - pre[seg])];
                q = ent >> 2; slot = ent & 3;
            }
            qpos = 0x7fffffff; wqmin = 0x7fffffff; wqmax = 0x7fffffff; wact = (k0 + 32 * w) < total;
        }
        f32x16 o[4]; float m, l;
        moba_attn_resident(p.Qb() + ((size_t)h * S + q) * 128, wact, qpos, wqmin, wqmax, 256 * j, smem, o, m, l);
        if (valid) moba_write_partial(p, q, h, slot, o, m, l, hi);
    }
}

constexpr int GP_KN = 0, GP_KB = 17408, GP_QS = 34816, GP_RF = 52224, GP_LM = 117760, GP_KDT = 135168, GP_GC = 153600, GP_BT = 153856;
DEV void gdn_prep_unit(const Params& p, int li, int n, int h, char* smem) {
    const int tid = opaque_tid(), lane = tid & 63, w = tid >> 6, r = lane & 15, g = lane >> 4;
    char* Kn16 = smem + GP_KN; char* Kb16 = smem + GP_KB; char* Qs16 = smem + GP_QS;
    float* Rf = (float*)(smem + GP_RF); float* Lm = (float*)(smem + GP_LM); char* KdT = smem + GP_KDT;
    float* gc = (float*)(smem + GP_GC); float* bt = (float*)(smem + GP_BT);
    const size_t cb = (size_t)n * 4 + h;
    __syncthreads();
    if (w == 0) {
        const int tok = 64 * n + lane;
        const float a = p.ba()[(size_t)tok * 8 + 4 + h], bb = p.ba()[(size_t)tok * 8 + h];
        float gv = -expf(p.gdn_a_log[li * 4 + h]) * softplusf(a + p.gdn_dt_bias[li * 4 + h]);
#pragma unroll
        for (int o = 1; o < 64; o <<= 1) { const float t = __int_as_float(__builtin_amdgcn_ds_bpermute((lane - o) << 2, __float_as_int(gv))); if (lane >= o) gv += t; }
        gc[lane] = gv; bt[lane] = 1.f / (1.f + expf(-bb));
    }
    __syncthreads();
    const float glast = gc[63];
    {
        const int tok = tid >> 3, grp = tid & 7, gt = 64 * n + tok;
        const float gct = gc[tok], btt = bt[tok];
        const float egc = expf(gct), egl = expf(glast - gct);
        const float* cw = p.gdn_conv + (size_t)li * 4 * 1536;
#pragma unroll
        for (int part = 0; part < 3; ++part) {
            const int ch0 = part * 512 + h * 128 + grp * 16;
            float val[16];
#pragma unroll
            for (int i = 0; i < 16; ++i) val[i] = 0.f;
#pragma unroll
            for (int j = 0; j < 4; ++j) {
                const int ts = gt - 3 + j;
                if (ts >= 0) {
                    const u32x4* xp = (const u32x4*)(p.proj_a() + (size_t)ts * 1536 + ch0);
                    const u32x4 x0 = xp[0], x1 = xp[1];
                    const f32x4* wp = (const f32x4*)(cw + (size_t)j * 1536 + ch0);
                    const f32x4 w0 = wp[0], w1 = wp[1], w2 = wp[2], w3 = wp[3];
                    val[0] += bflo(x0.x) * w0[0]; val[1] += bfhi(x0.x) * w0[1]; val[2] += bflo(x0.y) * w0[2]; val[3] += bfhi(x0.y) * w0[3];
                    val[4] += bflo(x0.z) * w1[0]; val[5] += bfhi(x0.z) * w1[1]; val[6] += bflo(x0.w) * w1[2]; val[7] += bfhi(x0.w) * w1[3];
                    val[8] += bflo(x1.x) * w2[0]; val[9] += bfhi(x1.x) * w2[1]; val[10] += bflo(x1.y) * w2[2]; val[11] += bfhi(x1.y) * w2[3];
                    val[12] += bflo(x1.z) * w3[0]; val[13] += bfhi(x1.z) * w3[1]; val[14] += bflo(x1.w) * w3[2]; val[15] += bfhi(x1.w) * w3[3];
                }
            }
#pragma unroll
            for (int i = 0; i < 16; ++i) val[i] = siluf(val[i]);
            if (part < 2) {
                float ss = 0.f;
#pragma unroll
                for (int i = 0; i < 16; ++i) ss += val[i] * val[i];
                ss += shx(ss, 1, lane); ss += shx(ss, 2, lane); ss += shx(ss, 4, lane);
                const float rn = rsqrtf(ss + 1e-6f);
#pragma unroll
                for (int i = 0; i < 16; ++i) val[i] *= rn;
            }
            if (part == 0) {
                const float qs = 0.08838834764831845f;
                u32x4 a0, a1, d0, d1;
                a0.x = pk2(val[0] * qs, val[1] * qs); a0.y = pk2(val[2] * qs, val[3] * qs); a0.z = pk2(val[4] * qs, val[5] * qs); a0.w = pk2(val[6] * qs, val[7] * qs);
                a1.x = pk2(val[8] * qs, val[9] * qs); a1.y = pk2(val[10] * qs, val[11] * qs); a1.z = pk2(val[12] * qs, val[13] * qs); a1.w = pk2(val[14] * qs, val[15] * qs);
                *(u32x4*)(Qs16 + tok * 272 + grp * 32) = a0; *(u32x4*)(Qs16 + tok * 272 + grp * 32 + 16) = a1;
                const float qd = qs * egc;
                d0.x = pk2(val[0] * qd, val[1] * qd); d0.y = pk2(val[2] * qd, val[3] * qd); d0.z = pk2(val[4] * qd, val[5] * qd); d0.w = pk2(val[6] * qd, val[7] * qd);
                d1.x = pk2(val[8] * qd, val[9] * qd); d1.y = pk2(val[10] * qd, val[11] * qd); d1.z = pk2(val[12] * qd, val[13] * qd); d1.w = pk2(val[14] * qd, val[15] * qd);
                bf16_t* qo = p.qdec() + (((cb * 4 + (tok >> 4)) * 4 + (grp >> 1)) * 64 + (2 * (grp & 1)) * 16 + (tok & 15)) * 8;
                *(u32x4*)qo = d0; *(u32x4*)(qo + 16 * 8) = d1;
            } else if (part == 1) {
                u32x4 a0, a1, d0, d1;
                a0.x = pk2(val[0], val[1]); a0.y = pk2(val[2], val[3]); a0.z = pk2(val[4], val[5]); a0.w = pk2(val[6], val[7]);
                a1.x = pk2(val[8], val[9]); a1.y = pk2(val[10], val[11]); a1.z = pk2(val[12], val[13]); a1.w = pk2(val[14], val[15]);
                *(u32x4*)(Kn16 + tok * 272 + grp * 32) = a0; *(u32x4*)(Kn16 + tok * 272 + grp * 32 + 16) = a1;
                d0.x = pk2(val[0] * btt, val[1] * btt); d0.y = pk2(val[2] * btt, val[3] * btt); d0.z = pk2(val[4] * btt, val[5] * btt); d0.w = pk2(val[6] * btt, val[7] * btt);
                d1.x = pk2(val[8] * btt, val[9] * btt); d1.y = pk2(val[10] * btt, val[11] * btt); d1.z = pk2(val[12] * btt, val[13] * btt); d1.w = pk2(val[14] * btt, val[15] * btt);
                *(u32x4*)(Kb16 + tok * 272 + grp * 32) = d0; *(u32x4*)(Kb16 + tok * 272 + grp * 32 + 16) = d1;
                const float kb = btt * egc;
#pragma unroll
                for (int i = 0; i < 16; ++i) {
                    Rf[tok * 256 + 128 + grp * 16 + i] = val[i] * kb;
                    *(bf16_t*)(KdT + (grp * 16 + i) * 144 + tok * 2) = f2bf(val[i] * egl);
                }
            } else {
#pragma unroll
                for (int i = 0; i < 16; ++i) Rf[tok * 256 + grp * 16 + i] = val[i] * btt;
            }
        }
    }
    __syncthreads();
#pragma unroll
    for (int tt = 0; tt < 2; ++tt) {
        const int tile = 2 * w + tt, ct = tile >> 2, mt = tile & 3;
        f32x4 accL = {0.f, 0.f, 0.f, 0.f}, accQ = {0.f, 0.f, 0.f, 0.f};
#pragma unroll
        for (int ks = 0; ks < 4; ++ks) {
            const bf16x8 akb = *(const bf16x8*)(Kb16 + (16 * ct + r) * 272 + (32 * ks + 8 * g) * 2);
            const bf16x8 knm = *(const bf16x8*)(Kn16 + (16 * mt + r) * 272 + (32 * ks + 8 * g) * 2);
            const bf16x8 qsc = *(const bf16x8*)(Qs16 + (16 * ct + r) * 272 + (32 * ks + 8 * g) * 2);
            accL = mfma16(akb, knm, accL);
            accQ = mfma16(knm, qsc, accQ);
        }
#pragma unroll
        for (int jj = 0; jj < 4; ++jj) {
            const int ci = 16 * ct + 4 * g + jj, mi = 16 * mt + r;
            Lm[ci * 68 + mi] = (mi < ci) ? accL[jj] * expf(gc[ci] - gc[mi]) : 0.f;
        }
        {
            const int ci = 16 * ct + r;
            f32x4 v;
#pragma unroll
            for (int jj = 0; jj < 4; ++jj) { const int mi = 16 * mt + 4 * g + jj; v[jj] = (mi <= ci) ? accQ[jj] * expf(gc[ci] - gc[mi]) : 0.f; }
            { const int m0_ = 16 * mt + 4 * g;
              st_bf4(p.qk() + (((cb * 4 + ct) * 2 + (m0_ >> 5)) * 64 + ((m0_ >> 3) & 3) * 16 + r) * 8 + (m0_ & 7), v); }
        }
    }
#pragma unroll
    for (int i = 0; i < 2; ++i) {
        const int ch = tid + NTHREADS * i, row = ch >> 3, cc = ch & 7;
        *(u32x4*)(p.kdT() + (((cb * 8 + (row >> 4)) * 2 + (cc >> 2)) * 64 + (cc & 3) * 16 + (row & 15)) * 8) = *(const u32x4*)(KdT + row * 144 + cc * 16);
    }
    __syncthreads();
    if (w < 4) {
        const int col = tid;
        float x[64];
#pragma unroll
        for (int i = 0; i < 64; ++i) {
            float a = Rf[i * 256 + col];
#pragma unroll
            for (int j4 = 0; j4 < (i + 3) / 4; ++j4) {
                const f32x4 l4 = *(const f32x4*)(Lm + i * 68 + 4 * j4);
#pragma unroll
                for (int jj = 0; jj < 4; ++jj) if (4 * j4 + jj < i) a -= l4[jj] * x[4 * j4 + jj];
            }
            x[i] = a;
        }
        if (col < 128) {
#pragma unroll
            for (int i4 = 0; i4 < 16; ++i4) {
                float* up_ = p.u32() + ((((cb * 4 + (i4 >> 2)) * 8 + (col >> 4)) * 64 + (i4 & 3) * 16 + (col & 15)) * 4);
                *(f32x4*)up_ = (f32x4){x[4 * i4], x[4 * i4 + 1], x[4 * i4 + 2], x[4 * i4 + 3]};
            }
        } else {
#pragma unroll
            for (int i = 0; i < 64; ++i) { const int cc_ = col - 128; p.wneg()[(((cb * 4 + (i >> 4)) * 4 + (cc_ >> 5)) * 64 + ((cc_ >> 3) & 3) * 16 + (i & 15)) * 8 + (cc_ & 7)] = f2bf(-x[i]); }
        }
    }
    if (tid == 0) p.glast()[cb] = expf(glast);
}

struct ScanFr { bf16x8 af[4]; bf16x8 qkf[2]; bf16x8 kdf[2]; f32x4 u[2]; float eg; };
DEV void gdn_scan_seg(const Params& p, int sw, int seg, float* __restrict__ scanst, char* smem) {
    const int tid = opaque_tid(), lane = tid & 63, w = tid >> 6, r = lane & 15, g = lane >> 4;
    const int h = sw >> 2, dvb = (sw & 3) * 32;
    const bool lead = w < 4; const int mt = w & 3;
    char* S16 = smem; char* Vn16 = smem + 8704;
    const int nbeg = seg * 64, nend = nbeg + 64;
    float* stp = scanst + ((size_t)sw * NTHREADS + tid) * 8;
    __syncthreads();
    f32x4 sacc[2] = {{0.f, 0.f, 0.f, 0.f}, {0.f, 0.f, 0.f, 0.f}};
    if (seg > 0) { sacc[0] = *(const f32x4*)stp; sacc[1] = *(const f32x4*)(stp + 4); }
#pragma unroll
    for (int n2 = 0; n2 < 2; ++n2)
        *(u32x2*)(S16 + (16 * n2 + r) * 272 + (16 * w + 4 * g) * 2) = (u32x2){pk2(sacc[n2][0], sacc[n2][1]), pk2(sacc[n2][2], sacc[n2][3])};
    auto load = [&](int n, ScanFr& f) {
        const size_t cb = (size_t)n * 4 + h;
        const bf16_t* ap = (lead ? p.wneg() : p.qdec()) + ((cb * 4 + mt) * 4) * 512 + lane * 8;
#pragma unroll
        for (int ks = 0; ks < 4; ++ks) f.af[ks] = *(const bf16x8*)(ap + ks * 512);
        const bf16_t* kp = p.kdT() + ((cb * 8 + w) * 2) * 512 + lane * 8;
#pragma unroll
        for (int ks = 0; ks < 2; ++ks) f.kdf[ks] = *(const bf16x8*)(kp + ks * 512);
        if (lead) {
            const float* up = p.u32() + (((cb * 4 + mt) * 8 + (dvb >> 4)) * 64 + lane) * 4;
            f.u[0] = *(const f32x4*)up; f.u[1] = *(const f32x4*)(up + 256);
        } else {
            const bf16_t* qkp = p.qk() + ((cb * 4 + mt) * 2) * 512 + lane * 8;
#pragma unroll
            for (int ks = 0; ks < 2; ++ks) f.qkf[ks] = *(const bf16x8*)(qkp + ks * 512);
        }
        f.eg = p.glast()[cb];
    };
    ScanFr fA, fB, fC, fD; load(nbeg, fA); load(nbeg + 1, fB); load(nbeg + 2, fC);
    __syncthreads();
    auto step = [&](int n, ScanFr& cu, ScanFr& nx3) {
        if (n + 3 < nend) load(n + 3, nx3);
        f32x4 a[2];
        if (lead) { a[0] = cu.u[0]; a[1] = cu.u[1]; } else { a[0] = (f32x4){0.f, 0.f, 0.f, 0.f}; a[1] = a[0]; }
#pragma unroll
        for (int ks = 0; ks < 4; ++ks) {
#pragma unroll
            for (int nt = 0; nt < 2; ++nt) {
                const bf16x8 sf = *(const bf16x8*)(S16 + (16 * nt + r) * 272 + (32 * ks + 8 * g) * 2);
                a[nt] = mfma16(cu.af[ks], sf, a[nt]);
            }
        }
        if (lead) {
#pragma unroll
            for (int nt = 0; nt < 2; ++nt)
                *(u32x2*)(Vn16 + (16 * nt + r) * 144 + (16 * mt + 4 * g) * 2) = (u32x2){pk2(a[nt][0], a[nt][1]), pk2(a[nt][2], a[nt][3])};
        }
        asm volatile("s_waitcnt lgkmcnt(0)" ::: "memory"); __builtin_amdgcn_s_barrier(); asm volatile("" ::: "memory");
        bf16x8 vf[2][2];
#pragma unroll
        for (int nt = 0; nt < 2; ++nt)
#pragma unroll
            for (int ks = 0; ks < 2; ++ks) vf[nt][ks] = *(const bf16x8*)(Vn16 + (16 * nt + r) * 144 + (32 * ks + 8 * g) * 2);
        if (!lead) {
#pragma unroll
            for (int nt = 0; nt < 2; ++nt) {
#pragma unroll
                for (int ks = 0; ks < 2; ++ks) a[nt] = mfma16(cu.qkf[ks], vf[nt][ks], a[nt]);
                *(f32x4*)(p.oa() + ((((size_t)n * 4 + mt) * 32 + (h * 8 + (dvb >> 4) + nt)) * 64 + lane) * 4) = a[nt];
            }
        }
#pragma unroll
        for (int n2 = 0; n2 < 2; ++n2) {
            sacc[n2] = sacc[n2] * cu.eg;
#pragma unroll
            for (int ks = 0; ks < 2; ++ks) sacc[n2] = mfma16(cu.kdf[ks], vf[n2][ks], sacc[n2]);
            *(u32x2*)(S16 + (16 * n2 + r) * 272 + (16 * w + 4 * g) * 2) = (u32x2){pk2(sacc[n2][0], sacc[n2][1]), pk2(sacc[n2][2], sacc[n2][3])};
        }
        asm volatile("s_waitcnt lgkmcnt(0)" ::: "memory"); __builtin_amdgcn_s_barrier(); asm volatile("" ::: "memory");
    };
    for (int n = nbeg; n < nend; n += 4) { step(n, fA, fD); step(n + 1, fB, fA); step(n + 2, fC, fB); step(n + 3, fD, fC); }
    *(f32x4*)stp = sacc[0]; *(f32x4*)(stp + 4) = sacc[1];
}

DEV void phase_even_combine(const Params& p, int li) {
    const int tid = opaque_tid(), lane = tid & 63, w = __builtin_amdgcn_readfirstlane(tid >> 6), hh = lane >> 4, d0 = (lane & 15) * 8;
    for (int tok = opaque_bid() * 8 + w; tok < S; tok += gridDim.x * 8) {
        {
            const int col0 = hh * 128 + d0;
            const float* op = p.oa() + (((((size_t)(tok >> 6)) * 4 + ((tok & 63) >> 4)) * 32 + (col0 >> 4)) * 64 + ((tok & 15) >> 2) * 16 + (col0 & 15)) * 4 + (tok & 3);
            const f32x4 a = {op[0], op[4], op[8], op[12]}, b = {op[16], op[20], op[24], op[28]};
            float ss = a[0] * a[0] + a[1] * a[1] + a[2] * a[2] + a[3] * a[3] + b[0] * b[0] + b[1] * b[1] + b[2] * b[2] + b[3] * b[3];
            ss += shx(ss, 1, lane); ss += shx(ss, 2, lane); ss += shx(ss, 4, lane); ss += shx(ss, 8, lane);
            const float rn = rsqrtf(ss * (1.f / 128.f) + 1e-6f);
            const u32x4 z = *(const u32x4*)(p.zbuf() + (size_t)tok * 512 + hh * 128 + d0);
            const f32x4 n0 = *(const f32x4*)(p.gdn_o_norm + li * 128 + d0), n1 = *(const f32x4*)(p.gdn_o_norm + li * 128 + d0 + 4);
            u32x4 o;
            o.x = pk2(a[0] * rn * n0[0] * siluf(bflo(z.x)), a[1] * rn * n0[1] * siluf(bfhi(z.x)));
            o.y = pk2(a[2] * rn * n0[2] * siluf(bflo(z.y)), a[3] * rn * n0[3] * siluf(bfhi(z.y)));
            o.z = pk2(b[0] * rn * n1[0] * siluf(bflo(z.z)), b[1] * rn * n1[1] * siluf(bfhi(z.z)));
            o.w = pk2(b[2] * rn * n1[2] * siluf(bflo(z.w)), b[3] * rn * n1[3] * siluf(bfhi(z.w)));
            *(u32x4*)(p.cat() + (size_t)tok * DM + hh * 128 + d0) = o;
        }
        {
            const int own = tok >> 8, nsel = own < 3 ? own : 3;
            const float* mlp = p.ml() + ((size_t)tok * 4 + hh) * 8;
            const bf16_t* pp = (const bf16_t*)p.part() + ((size_t)tok * 4 + hh) * 4 * 128 + d0;
            const float m3 = mlp[6], l3 = mlp[7];
            float ms[3], ls[3]; float mm = m3;
#pragma unroll
            for (int s = 0; s < 3; ++s) { ms[s] = -1e30f; ls[s] = 0.f; if (s < nsel) { ms[s] = mlp[2 * s]; ls[s] = mlp[2 * s + 1]; mm = fmaxf(mm, ms[s]); } }
            float wt = ex2(m3 - mm) * l3, den = wt;
            f32x4 a, b;
            { const u32x4 v = *(const u32x4*)(pp + 3 * 128); a = (f32x4){bflo(v.x), bfhi(v.x), bflo(v.y), bfhi(v.y)} * wt; b = (f32x4){bflo(v.z), bfhi(v.z), bflo(v.w), bfhi(v.w)} * wt; }
#pragma unroll
            for (int s = 0; s < 3; ++s) if (s < nsel) {
                wt = ex2(ms[s] - mm) * ls[s]; den += wt;
                const u32x4 v = *(const u32x4*)(pp + s * 128);
                a += (f32x4){bflo(v.x), bfhi(v.x), bflo(v.y), bfhi(v.y)} * wt; b += (f32x4){bflo(v.z), bfhi(v.z), bflo(v.w), bfhi(v.w)} * wt;
            }
            const float inv = 1.f / den;
            u32x4 o; o.x = pk2(a[0] * inv, a[1] * inv); o.y = pk2(a[2] * inv, a[3] * inv); o.z = pk2(b[0] * inv, b[1] * inv); o.w = pk2(b[2] * inv, b[3] * inv);
            *(u32x4*)(p.cat() + (size_t)tok * DM + 512 + hh * 128 + d0) = o;
        }
    }
}

DEV void phase_mla_cnorm(const Params& p, int li) {
    const int tid = opaque_tid(), lane = tid & 63, w = __builtin_amdgcn_readfirstlane(tid >> 6);
    for (int row = opaque_bid() * 8 + w; row < S; row += gridDim.x * 8) {
        const bf16_t* cp = p.cbuf() + (size_t)row * 768;
        const u32x4 qv = *(const u32x4*)(cp + lane * 8);
        const u32x2 kv = *(const u32x2*)(cp + 512 + lane * 4);
        float q[8] = {bflo(qv.x), bfhi(qv.x), bflo(qv.y), bfhi(qv.y), bflo(qv.z), bfhi(qv.z), bflo(qv.w), bfhi(qv.w)};
        float k[4] = {bflo(kv.x), bfhi(kv.x), bflo(kv.y), bfhi(kv.y)};
        float sq = 0.f, sk = 0.f;
#pragma unroll
        for (int i = 0; i < 8; ++i) sq += q[i] * q[i];
#pragma unroll
        for (int i = 0; i < 4; ++i) sk += k[i] * k[i];
        sq = wsum64(sq, lane); sk = wsum64(sk, lane);
        const float rq = rsqrtf(sq * (1.f / 512.f) + 1e-6f), rk = rsqrtf(sk * (1.f / 256.f) + 1e-6f);
        const float* qn = p.mla_q_norm + li * 512 + lane * 8; const float* kn = p.mla_kv_norm + li * 256 + lane * 4;
        u32x4 oq; oq.x = pk2(q[0] * rq * qn[0], q[1] * rq * qn[1]); oq.y = pk2(q[2] * rq * qn[2], q[3] * rq * qn[3]);
        oq.z = pk2(q[4] * rq * qn[4], q[5] * rq * qn[5]); oq.w = pk2(q[6] * rq * qn[6], q[7] * rq * qn[7]);
        *(u32x4*)(p.cqn() + (size_t)row * 512 + lane * 8) = oq;
        u32x2 ok; ok.x = pk2(k[0] * rk * kn[0], k[1] * rk * kn[1]); ok.y = pk2(k[2] * rk * kn[2], k[3] * rk * kn[3]);
        *(u32x2*)(p.ckvn() + (size_t)row * 256 + lane * 4) = ok;
    }
}

#define SORT16_NET(CE) CE(0,1) CE(2,3) CE(0,2) CE(1,3) CE(1,2) CE(4,5) CE(6,7) CE(4,6) CE(5,7) CE(5,6) CE(0,4) CE(2,6) CE(2,4) CE(1,5) CE(3,7) CE(3,5) CE(1,2) CE(3,4) CE(5,6) CE(8,9) CE(10,11) CE(8,10) CE(9,11) CE(9,10) CE(12,13) CE(14,15) CE(12,14) CE(13,15) CE(13,14) CE(8,12) CE(10,14) CE(10,12) CE(9,13) CE(11,15) CE(11,13) CE(9,10) CE(11,12) CE(13,14) CE(0,8) CE(4,12) CE(4,8) CE(2,10) CE(6,14) CE(6,10) CE(2,4) CE(6,8) CE(10,12) CE(1,9) CE(5,13) CE(5,9) CE(3,11) CE(7,15) CE(7,11) CE(3,5) CE(7,9) CE(11,13) CE(1,2) CE(3,4) CE(5,6) CE(7,8) CE(9,10) CE(11,12) CE(13,14)

template <int OFF> DEV void sort16(float (&v)[64]) {
#define CE_(a, b) { const float hi_ = fmaxf(v[OFF + a], v[OFF + b]), lo_ = fminf(v[OFF + a], v[OFF + b]); v[OFF + a] = hi_; v[OFF + b] = lo_; }
    SORT16_NET(CE_)
#undef CE_
}
template <int A> DEV void bitonic16(float (&v)[64]) {
#pragma unroll
    for (int d = 8; d >= 1; d >>= 1)
#pragma unroll
        for (int i = 0; i < 16; ++i) if ((i & d) == 0) { const float hi_ = fmaxf(v[A + i], v[A + i + d]), lo_ = fminf(v[A + i], v[A + i + d]); v[A + i] = hi_; v[A + i + d] = lo_; }
}
template <int A, int B> DEV void merge16(float (&v)[64]) {
#pragma unroll
    for (int i = 0; i < 16; ++i) v[A + i] = fmaxf(v[A + i], v[B + 15 - i]);
    bitonic16<A>(v);
}
DEV void top16_of_64(float (&v)[64]) {
    sort16<0>(v); sort16<16>(v); sort16<32>(v); sort16<48>(v);
    merge16<0, 16>(v); merge16<32, 48>(v); merge16<0, 32>(v);
}

DEV void phase_peer_topk(const Params& p, int layer, char* smem) {
    const int tid = opaque_tid(), lane = tid & 63, w = tid >> 6, c = lane & 31, hi = lane >> 5;
    char* SK = smem;
    constexpr int CI[50] = {0,0,0,0,0,0,0,0,0,0,0,0,0,0,0,0, 1,1,1,1,1,1,1,1, 2,2,2,2,2, 3,3,3,3, 4,4,4, 5,5, 6,6, 7,7, 8,9,10,11,12,13,14,15};
    constexpr int CJ[50] = {0,1,2,3,4,5,6,7,8,9,10,11,12,13,14,15, 0,1,2,3,4,5,6,7, 0,1,2,3,4, 0,1,2,3, 0,1,2, 0,1, 0,1, 0,1, 0,0,0,0,0,0,0,0};
    int loaded_h = -1;
    for (int u = opaque_bid(); u < 512; u += gridDim.x) {
        const int h = u & 7, tg = u >> 3;
        if (h != loaded_h) {
            __syncthreads();
#pragma unroll
            for (int i = 0; i < 8; ++i) {
                const int ch = tid + NTHREADS * i, pp = ch >> 11, rem = ch & 2047, row = rem >> 4, cc = rem & 15;
                *(u32x4*)(SK + pp * 34816 + row * 272 + cc * 16) = *(const u32x4*)(p.skb() + ((((size_t)layer * 8 + h) * 2 + pp) * 128 + row) * 128 + cc * 8);
            }
            __syncthreads();
            loaded_h = h;
        }
        const int token = tg * 256 + 32 * w + c;
        float s0[16], s1[16];
#pragma unroll
        for (int pp = 0; pp < 2; ++pp) {
            bf16x8 qf[8];
            const bf16_t* qp = p.qbuf() + (size_t)token * 2048 + (h * 2 + pp) * 128 + 8 * hi;
#pragma unroll
            for (int ks = 0; ks < 8; ++ks) qf[ks] = *(const bf16x8*)(qp + 16 * ks);
            float v[64];
#pragma unroll
            for (int kt = 0; kt < 4; ++kt) {
                f32x16 acc;
#pragma unroll
                for (int rr = 0; rr < 16; ++rr) acc[rr] = 0.f;
#pragma unroll
                for (int ks = 0; ks < 8; ++ks) acc = mfma32(*(const bf16x8*)(SK + pp * 34816 + (32 * kt + c) * 272 + (16 * ks + 8 * hi) * 2), qf[ks], acc);
#pragma unroll
                for (int rr = 0; rr < 16; ++rr) {
                    const unsigned idx = (unsigned)(32 * kt + (rr & 3) + 8 * (rr >> 2) + 4 * hi);
                    v[16 * kt + rr] = __uint_as_float((__float_as_uint(acc[rr]) & ~127u) | idx);
                }
            }
            top16_of_64(v);
#pragma unroll
            for (int i = 0; i < 16; ++i) v[16 + i] = shx(v[15 - i], 32, lane);
#pragma unroll
            for (int i = 0; i < 16; ++i) v[i] = fmaxf(v[i], v[16 + i]);
            bitonic16<0>(v);
#pragma unroll
            for (int i = 0; i < 16; ++i) { if (pp == 0) s0[i] = v[i]; else s1[i] = v[i]; }
        }
        float cv[64];
#pragma unroll
        for (int k = 0; k < 50; ++k) {
            const float a = s0[CI[k]], b = s1[CJ[k]];
            const unsigned id = ((__float_as_uint(a) & 127u) << 7) | (__float_as_uint(b) & 127u);
            cv[k] = __uint_as_float((__float_as_uint(a + b) & ~0x3FFFu) | id);
        }
#pragma unroll
        for (int k = 50; k < 64; ++k) cv[k] = -__builtin_inff();
        top16_of_64(cv);
        float e[16], sum = 0.f;
#pragma unroll
        for (int i = 0; i < 16; ++i) { e[i] = expf(cv[i] - cv[0]); sum += e[i]; }
        const float inv = 1.f / sum;
        if (hi == 0) {
            int* ep = p.expert() + (size_t)token * 128 + h * 16; float* gp = p.gate() + (size_t)token * 128 + h * 16;
#pragma unroll
            for (int i4 = 0; i4 < 4; ++i4) {
                i32x4 ev; ev.x = (int)(__float_as_uint(cv[4 * i4]) & 0x3FFFu); ev.y = (int)(__float_as_uint(cv[4 * i4 + 1]) & 0x3FFFu);
                ev.z = (int)(__float_as_uint(cv[4 * i4 + 2]) & 0x3FFFu); ev.w = (int)(__float_as_uint(cv[4 * i4 + 3]) & 0x3FFFu);
                *(i32x4*)(ep + 4 * i4) = ev;
                *(f32x4*)(gp + 4 * i4) = (f32x4){e[4 * i4] * inv, e[4 * i4 + 1] * inv, e[4 * i4 + 2] * inv, e[4 * i4 + 3] * inv};
            }
        }
    }
}

DEV void unpack_fp4x16(const u32x2& r, f32x2 (&f)[8]) {
#pragma unroll
    for (int q = 0; q < 2; ++q) {
        f[4 * q + 0] = __builtin_amdgcn_cvt_scalef32_pk_f32_fp4(r[q], 1.0f, 0);
        f[4 * q + 1] = __builtin_amdgcn_cvt_scalef32_pk_f32_fp4(r[q], 1.0f, 1);
        f[4 * q + 2] = __builtin_amdgcn_cvt_scalef32_pk_f32_fp4(r[q], 1.0f, 2);
        f[4 * q + 3] = __builtin_amdgcn_cvt_scalef32_pk_f32_fp4(r[q], 1.0f, 3);
    }
}

template <int NMODE>
DEV void phase_peer_gather(const Params& p, int layer, const float* __restrict__ g2, const float* __restrict__ xsrc, float* __restrict__ xdst,
                           const float* __restrict__ nw, const float* __restrict__ shv, const float* __restrict__ scv, const float* __restrict__ w8src, char* smem) {
    const int tid = opaque_tid(), lane = tid & 63, w = __builtin_amdgcn_readfirstlane(tid >> 6);
    float* W8 = (float*)smem;
    if (NMODE == 1) {
        for (int i = tid; i < 8192; i += NTHREADS) { const int k = i >> 3, c = i & 7; W8[c * 1024 + k] = w8src[(size_t)k * HY_IN + 2048 + c]; }
        __syncthreads();
    }
    f32x4 wm[4], sh[4];
#pragma unroll
    for (int i = 0; i < 4; ++i) {
        const f32x4 nv = *(const f32x4*)(nw + lane * 16 + 4 * i);
        if (NMODE == 2) { wm[i] = nv; sh[i] = (f32x4){0.f, 0.f, 0.f, 0.f}; }
        else { wm[i] = nv * (*(const f32x4*)(scv + lane * 16 + 4 * i) + 1.0f); sh[i] = *(const f32x4*)(shv + lane * 16 + 4 * i); }
    }
    const unsigned char* ub = p.ub() + (size_t)layer * 16384 * 512; const unsigned char* vb = p.vb() + (size_t)layer * 16384 * 512;
    const unsigned lo8 = (unsigned)lane * 8u;
    const int idxl = ((lane >> 5) & 1) * 8 + ((lane >> 4) & 1) * 4 + ((lane >> 3) & 1) * 2 + ((lane >> 2) & 1);
    for (int tok = opaque_bid() * 8 + w; tok < S; tok += gridDim.x * 8) {
        int hA0, hA1, hB0, hB1; float kh;
        {
            const u32x4 h0 = *(const u32x4*)(p.h() + (size_t)tok * DM + lane * 16), h1 = *(const u32x4*)(p.h() + (size_t)tok * DM + lane * 16 + 8);
            float hf[16] = {bflo(h0.x), bfhi(h0.x), bflo(h0.y), bfhi(h0.y), bflo(h0.z), bfhi(h0.z), bflo(h0.w), bfhi(h0.w),
                            bflo(h1.x), bfhi(h1.x), bflo(h1.y), bfhi(h1.y), bflo(h1.z), bfhi(h1.z), bflo(h1.w), bfhi(h1.w)};
            float mx = 0.f;
#pragma unroll
            for (int i = 0; i < 16; ++i) mx = fmaxf(mx, fabsf(hf[i]));
#pragma unroll
            for (int o = 32; o; o >>= 1) mx = fmaxf(mx, shx(mx, o, lane));
            kh = 119.f / fmaxf(mx, 1e-20f);
            unsigned a0 = 0, a1 = 0, b0 = 0, b1 = 0;
#pragma unroll
            for (int i = 0; i < 16; ++i) {
                const int h8 = (int)__builtin_rintf(hf[i] * kh);
                const int lo = ((h8 + 8) & 15) - 8, hi4 = (h8 - lo) >> 4;
                if (i < 8) { a0 |= ((unsigned)hi4 & 15u) << (4 * i); b0 |= ((unsigned)lo & 15u) << (4 * i); }
                else { a1 |= ((unsigned)hi4 & 15u) << (4 * (i - 8)); b1 |= ((unsigned)lo & 15u) << (4 * (i - 8)); }
            }
            hA0 = (int)a0; hA1 = (int)a1; hB0 = (int)b0; hB1 = (int)b1;
        }
        const int e0 = p.expert()[(size_t)tok * 128 + lane], e1 = p.expert()[(size_t)tok * 128 + 64 + lane];
        u32x2 rA[16], rB[16];
        auto req = [&](int bi, u32x2 (&rr)[16]) {
            const unsigned char* tb = bi < 8 ? ub : vb; const int b = bi & 7;
#pragma unroll
            for (int k = 0; k < 16; ++k) {
                const int e = __builtin_amdgcn_readlane(b < 4 ? e0 : e1, (b & 3) * 16 + k);
                rr[k] = *(const u32x2*)(tb + ((unsigned)e * 512u + lo8));
            }
        };
        float coef[8];
        f32x2 acc[8];
#pragma unroll
        for (int i = 0; i < 8; ++i) acc[i] = (f32x2){0.f, 0.f};
        auto use_u = [&](int b, const u32x2 (&rr)[16]) {
            float pt[16];
#pragma unroll
            for (int k = 0; k < 16; ++k) {
                int shi = __builtin_amdgcn_sdot8((int)rr[k].x, hA0, 0, false); shi = __builtin_amdgcn_sdot8((int)rr[k].y, hA1, shi, false);
                int slo = __builtin_amdgcn_sdot8((int)rr[k].x, hB0, 0, false); slo = __builtin_amdgcn_sdot8((int)rr[k].y, hB1, slo, false);
                pt[k] = (float)(16 * shi + slo);
            }
#pragma unroll
            for (int k = 0; k < 8; ++k) { const bool up = (lane & 32) != 0; const float send = up ? pt[k] : pt[k + 8], keep = up ? pt[k + 8] : pt[k]; pt[k] = keep + shx(send, 32, lane); }
#pragma unroll
            for (int k = 0; k < 4; ++k) { const bool up = (lane & 16) != 0; const float send = up ? pt[k] : pt[k + 4], keep = up ? pt[k + 4] : pt[k]; pt[k] = keep + shx(send, 16, lane); }
#pragma unroll
            for (int k = 0; k < 2; ++k) { const bool up = (lane & 8) != 0; const float send = up ? pt[k] : pt[k + 2], keep = up ? pt[k + 2] : pt[k]; pt[k] = keep + shx(send, 8, lane); }
            { const bool up = (lane & 4) != 0; const float send = up ? pt[0] : pt[1], keep = up ? pt[1] : pt[0]; pt[0] = keep + shx(send, 4, lane); }
            pt[0] += shx(pt[0], 2, lane); pt[0] += shx(pt[0], 1, lane);
            const float gv = p.gate()[(size_t)tok * 128 + b * 16 + idxl];
            const float d = pt[0] * (1.f / 96.f) / kh;
            coef[b] = gv * 0.5f * d * (1.f + erff(d * 0.70710678118654752f)) * 0.176776695f;
        };
        auto use_v = [&](int b, const u32x2 (&rr)[16]) {
#pragma unroll
            for (int k = 0; k < 16; ++k) {
                const int src = ((k >> 3) & 1) * 32 + ((k >> 2) & 1) * 16 + ((k >> 1) & 1) * 8 + (k & 1) * 4;
                const float cf = __uint_as_float((unsigned)__builtin_amdgcn_readlane((int)__float_as_uint(coef[b]), src));
                f32x2 f[8]; unpack_fp4x16(rr[k], f);
                const f32x2 cf2 = (f32x2){cf, cf};
#pragma unroll
                for (int i = 0; i < 8; ++i) acc[i] += cf2 * f[i];
            }
        };
        req(0, rA);
#pragma unroll
        for (int bi = 0; bi < 16; bi += 2) {
            req(bi + 1, rB);
            if (bi < 8) use_u(bi, rA); else use_v(bi - 8, rA);
            __builtin_amdgcn_sched_barrier(0);
            if (bi + 2 < 16) req(bi + 2, rA);
            if (bi + 1 < 8) use_u(bi + 1, rB); else use_v(bi + 1 - 8, rB);
            __builtin_amdgcn_sched_barrier(0);
        }
        const float* xp = xsrc + (size_t)tok * DM + lane * 16; float* xo = xdst + (size_t)tok * DM + lane * 16; const float* gp = g2 + lane * 16;
        f32x4 xn[4]; float ss = 0.f;
#pragma unroll
        for (int i4 = 0; i4 < 4; ++i4) {
            const f32x4 xv = *(const f32x4*)(xp + 4 * i4), gg = *(const f32x4*)(gp + 4 * i4);
            f32x4 o; o[0] = xv[0] + gg[0] * acc[2 * i4][0]; o[1] = xv[1] + gg[1] * acc[2 * i4][1]; o[2] = xv[2] + gg[2] * acc[2 * i4 + 1][0]; o[3] = xv[3] + gg[3] * acc[2 * i4 + 1][1];
            if (NMODE != 2) *(f32x4*)(xo + 4 * i4) = o;
            xn[i4] = o; ss += o[0] * o[0] + o[1] * o[1] + o[2] * o[2] + o[3] * o[3];
        }
        ss = wsum64(ss, lane);
        const float rn = rsqrtf(ss * (1.f / 1024.f) + 1e-6f);
#pragma unroll
        for (int i4 = 0; i4 < 4; ++i4) xn[i4] = xn[i4] * rn * wm[i4] + sh[i4];
        if (NMODE == 2) {
#pragma unroll
            for (int i4 = 0; i4 < 4; ++i4) *(f32x4*)(p.out + (size_t)tok * DM + lane * 16 + 4 * i4) = xn[i4];
        } else {
            u32x4 o0, o1;
            o0.x = pk2(xn[0][0], xn[0][1]); o0.y = pk2(xn[0][2], xn[0][3]); o0.z = pk2(xn[1][0], xn[1][1]); o0.w = pk2(xn[1][2], xn[1][3]);
            o1.x = pk2(xn[2][0], xn[2][1]); o1.y = pk2(xn[2][2], xn[2][3]); o1.z = pk2(xn[3][0], xn[3][1]); o1.w = pk2(xn[3][2], xn[3][3]);
            *(u32x4*)(p.h() + (size_t)tok * DM + lane * 16) = o0; *(u32x4*)(p.h() + (size_t)tok * DM + lane * 16 + 8) = o1;
        }
        if (NMODE == 1) {
            float pc[8];
#pragma unroll
            for (int c = 0; c < 8; ++c) {
                float a = 0.f;
#pragma unroll
                for (int i4 = 0; i4 < 4; ++i4) { const f32x4 ww = *(const f32x4*)(W8 + c * 1024 + lane * 16 + 4 * i4); a += xn[i4][0] * ww[0] + xn[i4][1] * ww[1] + xn[i4][2] * ww[2] + xn[i4][3] * ww[3]; }
                pc[c] = wsum64(a, lane);
            }
            if (lane == 0) { *(f32x4*)(p.ba() + (size_t)tok * 8) = (f32x4){pc[0], pc[1], pc[2], pc[3]}; *(f32x4*)(p.ba() + (size_t)tok * 8 + 4) = (f32x4){pc[4], pc[5], pc[6], pc[7]}; }
        }
    }
}

extern __shared__ __attribute__((aligned(16))) char smem_raw[];
DEV char* smem_user() { LAS char* q = (LAS char*)smem_raw + LDS_USER; asm volatile("" : "+s"(q)); return (char*)q; }
typedef const __attribute__((address_space(4))) Params* KParams;
DEV void load_params(Params& p) {
    auto kp0 = __builtin_amdgcn_kernarg_segment_ptr();
    asm volatile("" : "+s"(kp0));
    KParams kp = (KParams)kp0;
    p.x = kp->x;
    p.c = kp->c;
    p.pos = kp->pos;
    p.mod_w = kp->mod_w;
    p.mod_b = kp->mod_b;
    p.norm_mix = kp->norm_mix;
    p.norm_ffn = kp->norm_ffn;
    p.hy_w_in = kp->hy_w_in;
    p.gdn_conv = kp->gdn_conv;
    p.gdn_a_log = kp->gdn_a_log;
    p.gdn_dt_bias = kp->gdn_dt_bias;
    p.gdn_o_norm = kp->gdn_o_norm;
    p.hy_w_out = kp->hy_w_out;
    p.mla_w_in = kp->mla_w_in;
    p.mla_q_norm = kp->mla_q_norm;
    p.mla_kv_norm = kp->mla_kv_norm;
    p.mla_w_uq = kp->mla_w_uq;
    p.mla_w_ukv = kp->mla_w_ukv;
    p.mla_w_out = kp->mla_w_out;
    p.peer_w_q = kp->peer_w_q;
    p.peer_sub_keys = kp->peer_sub_keys;
    p.peer_u = kp->peer_u;
    p.peer_v = kp->peer_v;
    p.final_norm = kp->final_norm;
    p.out = kp->out;
    p.ws = kp->ws;
    p.ph_lo = kp->ph_lo;
    p.ph_hi = kp->ph_hi;
    p.use_bar = kp->use_bar;
    p.pad0 = kp->pad0;
}
#ifdef PH_NOINLINE
#define NOINL __device__ __noinline__
#else
#define NOINL __device__ __forceinline__
#endif

NOINL void f_prologue() { Params p; load_params(p);
#ifdef REP_P0
    phase_prologue(p, smem_user());
#endif
    phase_prologue(p, smem_user()); }
NOINL void f_norm_e0(int layer) {
    Params p; load_params(p); const float* mod = p.mod() + layer * 6144; const int li = layer >> 1;
    phase_norm<1>(layer == 0 ? p.x : p.xw(), p.norm_mix + layer * DM, mod, mod + 1024, p.h(), nullptr, p.hy_w_in + (size_t)li * 1024 * HY_IN, p.ba(), smem_user());
}
NOINL void f_norm_plain(int layer, int which) {
    Params p; load_params(p); const float* mod = p.mod() + layer * 6144;
    if (which == 0) phase_norm<0>(p.xw(), p.norm_mix + layer * DM, mod, mod + 1024, p.h(), nullptr, nullptr, nullptr, smem_user());
    else phase_norm<0>(p.xw(), p.norm_ffn + layer * DM, mod + 3072, mod + 4096, p.h(), nullptr, nullptr, nullptr, smem_user());
}
NOINL void f_final() { Params p; load_params(p); phase_norm<2>(
#ifdef DBG_SKIP_ALL
        p.x,
#else
        p.xw(),
#endif
 p.final_norm, nullptr, nullptr, nullptr, p.out, nullptr, nullptr, smem_user()); }
NOINL void f_gemm_hy_in(int li) {
    Params p; load_params(p);
    auto epi = [&](int m, int n, int n0, const f32x4& v) {
        if (n0 < 1536) st_bf4(p.proj_a() + (size_t)m * 1536 + n, v);
        else if (n0 < 2048) st_bf4(p.zbuf() + (size_t)m * 512 + (n - 1536), v);
        else if (n0 < 2560) { const int hd = (n - 2048) >> 7, dp = (n - 2048) & 127; const f32x4 rv = rope4(v, p.cosB() + (size_t)m * 64, p.sinB() + (size_t)m * 64, dp >> 1) * (0.08838834764831845f * 1.4426950408889634f); st_bf4(p.Qb() + ((size_t)hd * S + m) * 128 + dp, rv); }
        else if (n0 < 3072) { const int hd = (n - 2560) >> 7, dp = (n - 2560) & 127; const f32x4 rv = rope4(v, p.cosB() + (size_t)m * 64, p.sinB() + (size_t)m * 64, dp >> 1); st_bf4(p.Kb() + ((size_t)hd * S + m) * 128 + dp, rv); }
        else { const int hd = (n - 3072) >> 7, dv = (n - 3072) & 127; bf16_t* vp = p.VbT() + (((size_t)hd * 256 + (m >> 6)) * 128 + dv) * 64 + (m & 63); vp[0] = f2bf(v[0]); vp[64] = f2bf(v[1]); vp[128] = f2bf(v[2]); vp[192] = f2bf(v[3]); }
    };
#ifdef REP_GEMM
    gemm256(p.h(), p.w_hy_in() + (size_t)li * HYN * 1024, HYN, 1024, smem_user(), epi);
#endif
    gemm256(p.h(), p.w_hy_in() + (size_t)li * HYN * 1024, HYN, 1024, smem_user(), epi);
}
NOINL void f_gemm_resid(int layer) {
    Params p; load_params(p); const float* mod = p.mod() + layer * 6144; const int li = layer >> 1;
    const float* xin = layer == 0 ? p.x : p.xw(); float* xo = p.xw();
    auto epi = [&](int m, int n, int n0, const f32x4& v) {
        const f32x4 xv = *(const f32x4*)(xin + (size_t)m * DM + n), gg = *(const f32x4*)(mod + 2048 + n);
        *(f32x4*)(xo + (size_t)m * DM + n) = xv + gg * v;
    };
    const bf16_t* wt = (layer & 1) ? p.w_mla_out() + (size_t)li * 1024 * 1024 : p.w_hy_out() + (size_t)li * 1024 * 1024;
    gemm256(p.cat(), wt, 1024, 1024, smem_user(), epi);
}
NOINL void f_s0(int li) {
    Params p; load_params(p);
    for (int u = opaque_bid(); u < 512; u += gridDim.x) { if (u < 256) gdn_prep_unit(p, li, u >> 2, u & 3, smem_user()); else moba_kmean_unit(p, (u - 256) & 3, (u - 256) >> 2, smem_user()); }
}
NOINL void f_seg(int layer, int seg) {
    Params p; load_params(p);
    const int li = layer >> 1;
    float* scanst = (float*)(p.ws + SCANST_OFF);
    if (opaque_bid() < 16) { gdn_scan_seg(p, opaque_bid(), seg, scanst, smem_user()); return; }
    const int rank = opaque_bid() - 16, nwg = (int)gridDim.x - 16;
    const int nprep = seg < 3 ? 256 : 0;
    int cidx = rank;
    for (; cidx < nprep; cidx += nwg) gdn_prep_unit(p, li, 64 * (seg + 1) + (cidx >> 2), cidx & 3, smem_user());
    int lo = 0, hi = 0;
    if (seg == 0) hi = 128;
    else {
        const int T = moba_tile_table(p, smem_user());
        lo = seg == 1 ? 0 : (seg == 2 ? (T * 28) / 100 : (T * 56) / 100); hi = seg == 1 ? (T * 28) / 100 : (seg == 2 ? (T * 56) / 100 : T);
    }
    for (; cidx < nprep + (hi - lo); cidx += nwg) {
        if (seg == 0) moba_gate_unit(p, cidx - nprep, smem_user());
        else moba_subunit(p, lo + (cidx - nprep), smem_user());
    }
    if (layer == 0 && seg == 3) {
        convert_i4(p.peer_u, p.ub(), (size_t)4 * 16384 * 1024, 96.f, rank, nwg);
        convert_fp4(p.peer_v, p.vb(), (size_t)4 * 16384 * 1024, 5.65685425f, rank, nwg);
    }
}
NOINL void f_combine(int li) { Params p; load_params(p); phase_even_combine(p, li); }
NOINL void f_gemm_mla_in(int li) {
    Params p; load_params(p);
    auto epi = [&](int m, int n, int n0, const f32x4& v) {
        if (n0 < 768) st_bf4(p.cbuf() + (size_t)m * 768 + n, v);
        else if (n < 832) { const int dp = n - 768; const f32x4 rv = rope4(v, p.cosC() + (size_t)m * 32, p.sinC() + (size_t)m * 32, dp >> 1); st_bf4(p.Kr() + (size_t)m * 64 + dp, rv); }
    };
#ifdef REP_GEMM
    gemm256(p.h(), p.w_mla_in() + (size_t)li * 1024 * 1024, 1024, 1024, smem_user(), epi);
#endif
    gemm256(p.h(), p.w_mla_in() + (size_t)li * 1024 * 1024, 1024, 1024, smem_user(), epi);
}
NOINL void f_cnorm(int li) { Params p; load_params(p); phase_mla_cnorm(p, li); }
NOINL void f_gemm_uq(int li) {
    Params p; load_params(p);
    auto epi = [&](int m, int n, int n0, const f32x4& v0) {
        const float qs = 0.07216878364870322f * 1.4426950408889634f;
        const int hd = n / 192, d = n - hd * 192; f32x4 v = v0;
        if (d >= 128) v = rope4(v, p.cosC() + (size_t)m * 32, p.sinC() + (size_t)m * 32, (d - 128) >> 1);
        st_bf4(p.Qm() + ((size_t)hd * S + m) * 192 + d, v * qs);
    };
#ifdef REP_GEMM
    gemm256(p.cqn(), p.w_uq() + (size_t)li * 1536 * 512, 1536, 512, smem_user(), epi);
#endif
    gemm256(p.cqn(), p.w_uq() + (size_t)li * 1536 * 512, 1536, 512, smem_user(), epi);
}
NOINL void f_gemm_ukv(int li) {
    Params p; load_params(p);
    auto epi = [&](int m, int n, int n0, const f32x4& v) {
        if (n0 < 1024) { const int hd = n >> 7, d = n & 127; st_bf4(p.Kn() + ((size_t)hd * S + m) * 128 + d, v); }
        else { const int hd = (n - 1024) >> 7, dv = (n - 1024) & 127; bf16_t* vp = p.VmT() + (((size_t)hd * 256 + (m >> 6)) * 128 + dv) * 64 + (m & 63); vp[0] = f2bf(v[0]); vp[64] = f2bf(v[1]); vp[128] = f2bf(v[2]); vp[192] = f2bf(v[3]); }
    };
#ifdef REP_GEMM
    gemm256(p.ckvn(), p.w_ukv() + (size_t)li * 2048 * 256, 2048, 256, smem_user(), epi);
#endif
    gemm256(p.ckvn(), p.w_ukv() + (size_t)li * 2048 * 256, 2048, 256, smem_user(), epi);
}
NOINL void f_mla_attn() {
    Params p; load_params(p);
#ifdef REP_M4
    phase_mla_attn(p, smem_user());
#endif
    phase_mla_attn(p, smem_user());
}
NOINL void f_gemm_pq(int layer) {
    Params p; load_params(p);
    auto epi = [&](int m, int n, int n0, const f32x4& v) { st_bf4(p.qbuf() + (size_t)m * 2048 + n, v); };
#ifdef REP_GEMM
    gemm256(p.h(), p.w_pq() + (size_t)layer * 2048 * 1024, 2048, 1024, smem_user(), epi);
#endif
    gemm256(p.h(), p.w_pq() + (size_t)layer * 2048 * 1024, 2048, 1024, smem_user(), epi);
}
NOINL void f_topk(int layer) { Params p; load_params(p);
#ifdef REP_F2
    phase_peer_topk(p, layer, smem_user());
#endif
    phase_peer_topk(p, layer, smem_user()); }
NOINL void f_gather(int layer) {
    Params p; load_params(p);
    const float* g2 = p.mod() + layer * 6144 + 5120;
    if (layer == 3) phase_peer_gather<2>(p, layer, g2, p.xw(), p.xw(), p.final_norm, nullptr, nullptr, nullptr, smem_user());
    else {
        const float* modn = p.mod() + (layer + 1) * 6144;
        if (layer == 1) phase_peer_gather<1>(p, layer, g2, p.xw(), p.xw(), p.norm_mix + 2 * DM, modn, modn + 1024, p.hy_w_in + (size_t)1 * 1024 * HY_IN, smem_user());
        else phase_peer_gather<0>(p, layer, g2, p.xw(), p.xw(), p.norm_mix + (layer + 1) * DM, modn, modn + 1024, nullptr, smem_user());
    }
}

__device__ __noinline__ void grid_sync(unsigned* barw, unsigned x) {
    XcdBarrier b; b.bar = barw; b.x = x; b.st = (volatile LAS unsigned*)smem_raw;
    xcd_barrier(b);
}

__global__ void __launch_bounds__(NTHREADS) hybrid_forward(Params p) {
    if (threadIdx.x == 0) *(u32x4*)smem_raw = (u32x4){0u, 0u, 0u, 0u};
    __syncthreads();
    XcdBarrier bar; bar.bar = p.bar(); bar.x = 0; bar.st = (volatile LAS unsigned*)smem_raw;
    if (p.use_bar) bar = xcd_barrier_post(p.bar(), (volatile LAS unsigned*)smem_raw);
    int ph = 0;
#define RUN_PHASE(...) { if (ph >= p.ph_lo && ph < p.ph_hi) { __VA_ARGS__; if (p.use_bar && ph + 1 < p.ph_hi) grid_sync(bar.bar, bar.x); } ++ph; }

    RUN_PHASE(f_prologue());
    for (int layer = 0; layer < 4; ++layer) {
        const int li = layer >> 1;
        if ((layer & 1) == 0) {
            if (layer == 0) RUN_PHASE(f_norm_e0(layer));
            RUN_PHASE(f_gemm_hy_in(li));
            RUN_PHASE(f_s0(li));
            RUN_PHASE(f_seg(layer, 0));
            RUN_PHASE(f_seg(layer, 1));
            RUN_PHASE(f_seg(layer, 2));
            RUN_PHASE(f_seg(layer, 3));
            RUN_PHASE(f_combine(li));
            RUN_PHASE(f_gemm_resid(layer));
        } else {
            RUN_PHASE(f_gemm_mla_in(li));
            RUN_PHASE(f_cnorm(li));
            RUN_PHASE(f_gemm_uq(li); f_gemm_ukv(li));
            RUN_PHASE(f_mla_attn());
            RUN_PHASE(f_gemm_resid(layer));
        }
        RUN_PHASE(f_norm_plain(layer, 1));
        RUN_PHASE(f_gemm_pq(layer));
        RUN_PHASE(f_topk(layer));
        RUN_PHASE(f_gather(layer));
    }
}

constexpr int N_PHASES = 1 + 1 + 2 * 8 + 2 * 5 + 4 * 4;

extern "C" void kernel_launch(void* const* d_in, const int* in_sizes, int n_in, void* d_out, int out_size, void* d_ws, size_t ws_size, hipStream_t stream) {
    static int grid = 0;
    if (!grid) {
        int dev = 0, cus = 0, per_cu = 0;
        hipGetDevice(&dev);
        hipDeviceGetAttribute(&cus, hipDeviceAttributeMultiprocessorCount, dev);
        hipFuncSetAttribute((const void*)hybrid_forward, hipFuncAttributeMaxDynamicSharedMemorySize, LDS_BYTES);
        hipOccupancyMaxActiveBlocksPerMultiprocessor(&per_cu, hybrid_forward, NTHREADS, LDS_BYTES);
        if (per_cu < 1) per_cu = 1;
        grid = cus;
        if (grid > 256) grid = 256;
    }
    Params p; memset(&p, 0, sizeof(p));
    p.x = (const float*)d_in[0]; p.c = (const float*)d_in[1]; p.pos = (const int*)d_in[2]; p.mod_w = (const float*)d_in[3]; p.mod_b = (const float*)d_in[4];
    p.norm_mix = (const float*)d_in[5]; p.norm_ffn = (const float*)d_in[6]; p.hy_w_in = (const float*)d_in[7]; p.gdn_conv = (const float*)d_in[8];
    p.gdn_a_log = (const float*)d_in[9]; p.gdn_dt_bias = (const float*)d_in[10]; p.gdn_o_norm = (const float*)d_in[11]; p.hy_w_out = (const float*)d_in[12];
    p.mla_w_in = (const float*)d_in[13]; p.mla_q_norm = (const float*)d_in[14]; p.mla_kv_norm = (const float*)d_in[15]; p.mla_w_uq = (const float*)d_in[16];
    p.mla_w_ukv = (const float*)d_in[17]; p.mla_w_out = (const float*)d_in[18]; p.peer_w_q = (const float*)d_in[19]; p.peer_sub_keys = (const float*)d_in[20];
    p.peer_u = (const float*)d_in[21]; p.peer_v = (const float*)d_in[22]; p.final_norm = (const float*)d_in[23];
    p.out = (float*)d_out;
    p.ws = (char*)d_ws;
    if (WS_NEED > ws_size) { fprintf(stderr, "workspace too small: need %zu have %zu\n", (size_t)WS_NEED, ws_size); return; }
    hipMemsetAsync(p.ws, 0, 16384, stream);
#ifndef ONE_LAUNCH
    for (int ph = 0; ph < N_PHASES; ++ph) {
#ifdef DBG_SKIP_ALL
        if (ph != N_PHASES - 1) continue;
#endif
        p.ph_lo = ph; p.ph_hi = ph + 1; p.use_bar = 0;
        hipLaunchKernelGGL(hybrid_forward, dim3(grid), dim3(NTHREADS), LDS_BYTES, stream, p);
    }
#else
    p.ph_lo = 0; p.ph_hi = N_PHASES; p.use_bar = 1;
    hipLaunchKernelGGL(hybrid_forward, dim3(grid), dim3(NTHREADS), LDS_BYTES, stream, p);
#endif
}
```

```cpp
#include <hip/hip_runtime.h>
#define ONE_LAUNCH 1
#include <stdint.h>
#include <stddef.h>
#include <stdio.h>
#include <string.h>

#define DEV __device__ __forceinline__

constexpr int S = 16384;
constexpr int DM = 1024;
constexpr int HY_IN = 3592;
constexpr int HYN = 3584;
constexpr int NTHREADS = 512;
constexpr int LDS_BYTES = 163840;
constexpr int LDS_USER = 16;

typedef unsigned short bf16_t;
typedef short bf16x8 __attribute__((ext_vector_type(8)));
typedef float f32x4 __attribute__((ext_vector_type(4)));
typedef float f32x2 __attribute__((ext_vector_type(2)));
typedef float f32x16 __attribute__((ext_vector_type(16)));
typedef __bf16 bf16v2 __attribute__((ext_vector_type(2)));
typedef unsigned u32x4 __attribute__((ext_vector_type(4)));
typedef unsigned u32x2 __attribute__((ext_vector_type(2)));
typedef int i32x4 __attribute__((ext_vector_type(4)));

#define XB_TMO      128
#define XB_XCNT(j)  (256  + 64 * (j))
#define XB_XSUB(j)  (1280 + 64 * (j))
#define XB_XGEN(j)  (2304 + 64 * (j))
#define XB_TOP      3328
#define XB_TOPGEN   3392
#define XCD_BAR_WORDS 3456
#define XB_SPIN_CAP (1u << 22)
#define LAS __attribute__((address_space(3)))

__device__ __forceinline__ unsigned xb_ld(unsigned* p)              { return __hip_atomic_load(p, __ATOMIC_RELAXED, __HIP_MEMORY_SCOPE_AGENT); }
__device__ __forceinline__ unsigned xb_add(unsigned* p, unsigned v) { return __hip_atomic_fetch_add(p, v, __ATOMIC_RELAXED, __HIP_MEMORY_SCOPE_AGENT); }
__device__ __forceinline__ unsigned xb_xcc_id() { return (unsigned)__builtin_amdgcn_s_getreg((3 << 11) | 20) & 0xFu; }
#define XB_SPIN(cond, bar) do { unsigned _sp = 0; while (cond) { __builtin_amdgcn_s_sleep(1); \
    if ((++_sp & 255u) == 0u) { if (xb_ld(&(bar)[XB_TMO])) break; if (_sp > XB_SPIN_CAP) { atomicAdd(&(bar)[XB_TMO], 1u); break; } } } } while (0)

struct XcdBarrier { unsigned* bar; unsigned x; volatile LAS unsigned* st; };

__device__ __forceinline__ XcdBarrier xcd_barrier_post(unsigned* bar, volatile LAS unsigned* st) {
    XcdBarrier b; b.bar = bar; b.x = xb_xcc_id(); b.st = st;
    if (threadIdx.x == 0) (void)xb_add(&bar[XB_XCNT(b.x)], 1u);
    return b;
}
__device__ __forceinline__ void xcd_barrier_complete(unsigned* bar, unsigned x, unsigned& nloc, unsigned& nx) {
    const unsigned G = gridDim.x * gridDim.y * gridDim.z;
    unsigned sum, cnt, mine, sp = 0u;
    for (;;) {
        sum = 0u; cnt = 0u; mine = 0u;
#pragma unroll 1
        for (unsigned j = 0; j < 16; ++j) { const unsigned c = xb_ld(&bar[XB_XCNT(j)]); sum += c; cnt += (c > 0u) ? 1u : 0u; mine = (j == x) ? c : mine; }
        if (sum == G) break;
        __builtin_amdgcn_s_sleep(1);
        if ((++sp & 255u) == 0u) { if (xb_ld(&bar[XB_TMO])) break; if (sp > XB_SPIN_CAP) { atomicAdd(&bar[XB_TMO], 1u); break; } }
    }
    nloc = mine > 0u ? mine : 1u; nx = cnt > 0u ? cnt : 1u;
}
__device__ __forceinline__ void xcd_barrier(const XcdBarrier& b) {
    asm volatile("s_waitcnt vmcnt(0)" ::: "memory");
    __syncthreads();
    if (threadIdx.x == 0) {
        unsigned* bar = b.bar;
        __builtin_amdgcn_s_waitcnt(0);
        unsigned nloc = b.st[0], nx = b.st[1];
        if (nloc == 0u) { xcd_barrier_complete(bar, b.x, nloc, nx); b.st[0] = nloc; b.st[1] = nx; }
        const unsigned old = xb_add(&bar[XB_XSUB(b.x)], 1u);
        const unsigned gen = old / nloc;
        if (old + 1u == (gen + 1u) * nloc) {
            __builtin_amdgcn_fence(__ATOMIC_RELEASE, "agent");
            asm volatile("s_waitcnt vmcnt(0)" ::: "memory");
            const unsigned og = xb_add(&bar[XB_TOP], 1u);
            const unsigned tg = og / nx;
            if (og + 1u == (tg + 1u) * nx) xb_add(&bar[XB_TOPGEN], 1u);
            else XB_SPIN(xb_ld(&bar[XB_TOPGEN]) == tg, bar);
            __builtin_amdgcn_fence(__ATOMIC_ACQUIRE, "agent");
            xb_add(&bar[XB_XGEN(b.x)], 1u);
            asm volatile("s_waitcnt vmcnt(0)" ::: "memory");
        } else {
            XB_SPIN(xb_ld(&bar[XB_XGEN(b.x)]) == gen, bar);
            __builtin_amdgcn_fence(__ATOMIC_ACQUIRE, "agent");
            asm volatile("s_waitcnt vmcnt(0)" ::: "memory");
        }
    }
    __syncthreads();
}

DEV int opaque_bid() { int b = blockIdx.x; asm volatile("" : "+s"(b)); return b; }
DEV int opaque_tid() { int t = threadIdx.x; asm volatile("" : "+v"(t)); return t & (NTHREADS - 1); }
DEV bf16_t f2bf(float f) { __bf16 v = (__bf16)f; bf16_t r; __builtin_memcpy(&r, &v, 2); return r; }
DEV unsigned pk2(float a, float b) { bf16v2 v; v[0] = (__bf16)a; v[1] = (__bf16)b; unsigned r; __builtin_memcpy(&r, &v, 4); return r; }
DEV float bflo(unsigned u) { return __uint_as_float(u << 16); }
DEV float bfhi(unsigned u) { return __uint_as_float(u & 0xffff0000u); }
DEV float shx(float v, int m, int lane) { return __int_as_float(__builtin_amdgcn_ds_bpermute((lane ^ m) << 2, __float_as_int(v))); }
DEV float wsum64(float v, int lane) {
#pragma unroll
    for (int o = 32; o; o >>= 1) v += shx(v, o, lane);
    return v;
}
DEV f32x4 mfma16(bf16x8 a, bf16x8 b, f32x4 c) { return __builtin_amdgcn_mfma_f32_16x16x32_bf16(a, b, c, 0, 0, 0); }
DEV f32x16 mfma32(bf16x8 a, bf16x8 b, f32x16 c) { return __builtin_amdgcn_mfma_f32_32x32x16_bf16(a, b, c, 0, 0, 0); }
DEV float siluf(float v) { return v / (1.f + expf(-v)); }
DEV float softplusf(float v) { return fmaxf(v, 0.f) + log1pf(expf(-fabsf(v))); }
DEV float ex2(float v) { return __builtin_amdgcn_exp2f(v); }

struct Params {
    const float* x; const float* c; const int* pos; const float* mod_w; const float* mod_b; const float* norm_mix; const float* norm_ffn;
    const float* hy_w_in; const float* gdn_conv; const float* gdn_a_log; const float* gdn_dt_bias; const float* gdn_o_norm; const float* hy_w_out;
    const float* mla_w_in; const float* mla_q_norm; const float* mla_kv_norm; const float* mla_w_uq; const float* mla_w_ukv; const float* mla_w_out;
    const float* peer_w_q; const float* peer_sub_keys; const float* peer_u; const float* peer_v; const float* final_norm;
    float* out; char* ws;
    int ph_lo, ph_hi, use_bar, pad0;
    DEV unsigned* bar() const { return (unsigned*)(ws + 0ull); }
    DEV float* mod() const { return (float*)(ws + 16384ull); }
    DEV float* cosB() const { return (float*)(ws + 114688ull); }
    DEV float* sinB() const { return (float*)(ws + 4308992ull); }
    DEV float* cosC() const { return (float*)(ws + 8503296ull); }
    DEV float* sinC() const { return (float*)(ws + 10600448ull); }
    DEV bf16_t* w_hy_in() const { return (bf16_t*)(ws + 12697600ull); }
    DEV bf16_t* w_hy_out() const { return (bf16_t*)(ws + 27377664ull); }
    DEV bf16_t* w_mla_in() const { return (bf16_t*)(ws + 863260672ull); }
    DEV bf16_t* w_uq() const { return (bf16_t*)(ws + 35241984ull); }
    DEV bf16_t* w_ukv() const { return (bf16_t*)(ws + 38387712ull); }
    DEV bf16_t* w_mla_out() const { return (bf16_t*)(ws + 40484864ull); }
    DEV bf16_t* w_pq() const { return (bf16_t*)(ws + 44679168ull); }
    DEV bf16_t* skb() const { return (bf16_t*)(ws + 61456384ull); }
    DEV unsigned char* ub() const { return (unsigned char*)(ws + 63553536ull); }
    DEV unsigned char* vb() const { return (unsigned char*)(ws + 197771264ull); }
    DEV float* xw() const { return (float*)(ws + 331988992ull); }
    DEV bf16_t* h() const { return (bf16_t*)(ws + 399097856ull); }
    DEV bf16_t* cat() const { return (bf16_t*)(ws + 432652288ull); }
    DEV bf16_t* proj_a() const { return (bf16_t*)(ws + 466206720ull); }
    DEV bf16_t* zbuf() const { return (bf16_t*)(ws + 516538368ull); }
    DEV bf16_t* Qb() const { return (bf16_t*)(ws + 533315584ull); }
    DEV bf16_t* Kb() const { return (bf16_t*)(ws + 550092800ull); }
    DEV bf16_t* VbT() const { return (bf16_t*)(ws + 566870016ull); }
    DEV float* ba() const { return (float*)(ws + 583647232ull); }
    DEV float* u32() const { return (float*)(ws + 584171520ull); }
    DEV bf16_t* wneg() const { return (bf16_t*)(ws + 617725952ull); }
    DEV bf16_t* qdec() const { return (bf16_t*)(ws + 634503168ull); }
    DEV bf16_t* kdT() const { return (bf16_t*)(ws + 651280384ull); }
    DEV bf16_t* qk() const { return (bf16_t*)(ws + 668057600ull); }
    DEV float* glast() const { return (float*)(ws + 676446208ull); }
    DEV float* oa() const { return (float*)(ws + 676450304ull); }
    DEV float* kmean() const { return (float*)(ws + 710004736ull); }
    DEV int* segcnt() const { return (int*)(ws + 710135808ull); }
    DEV int* lists() const { return (int*)(ws + 710168576ull); }
    DEV float* part() const { return (float*)(ws + 726945792ull); }
    DEV float* ml() const { return (float*)(ws + 861163520ull); }
    DEV bf16_t* cbuf() const { return (bf16_t*)(ws + 466206720ull); }
    DEV bf16_t* Kr() const { return (bf16_t*)(ws + 491372544ull); }
    DEV bf16_t* cqn() const { return (bf16_t*)(ws + 493469696ull); }
    DEV bf16_t* ckvn() const { return (bf16_t*)(ws + 510246912ull); }
    DEV bf16_t* Qm() const { return (bf16_t*)(ws + 518635520ull); }
    DEV bf16_t* Kn() const { return (bf16_t*)(ws + 568967168ull); }
    DEV bf16_t* VmT() const { return (bf16_t*)(ws + 602521600ull); }
    DEV bf16_t* qbuf() const { return (bf16_t*)(ws + 466206720ull); }
    DEV int* expert() const { return (int*)(ws + 533315584ull); }
    DEV float* gate() const { return (float*)(ws + 541704192ull); }
};
constexpr size_t SCANST_OFF = 867454976ull;
constexpr size_t WS_NEED = 867717120ull;


template <class Map>
DEV void transpose_conv(const float* __restrict__ src, int K, int ldsrc, bf16_t* __restrict__ dst, int Nd, Map map, char* smem, int& base) {
    float* T = (float*)smem;
    const int tid = opaque_tid(), nb = gridDim.x, b = opaque_bid();
    const int ntk = K / 64, ntn = Nd / 64, nun = ntk * ntn;
    int first = ((b - (base % nb)) % nb + nb) % nb;
    for (int u = first; u < nun; u += nb) {
        const int tk = u % ntk, tn = u / ntk;
        __syncthreads();
#pragma unroll
        for (int i = 0; i < 8; ++i) {
            const int kk = (tid >> 6) + 8 * i, nn = tid & 63;
            const int sc = map(tn * 64 + nn);
            float v = 0.f;
            if (sc >= 0) v = src[(size_t)(tk * 64 + kk) * ldsrc + sc];
            T[kk * 65 + nn] = v;
        }
        __syncthreads();
#pragma unroll
        for (int i = 0; i < 8; ++i) {
            const int nn = (tid >> 6) + 8 * i, kk = tid & 63;
            dst[(size_t)(tn * 64 + nn) * K + tk * 64 + kk] = f2bf(T[kk * 65 + nn]);
        }
    }
    base += nun;
}

DEV void convert_bf16(const float* __restrict__ src, bf16_t* __restrict__ dst, size_t n) {
    const size_t n8 = n / 8;
    for (size_t i = (size_t)opaque_bid() * NTHREADS + opaque_tid(); i < n8; i += (size_t)gridDim.x * NTHREADS) {
        const f32x4 a = *(const f32x4*)(src + i * 8), b = *(const f32x4*)(src + i * 8 + 4);
        u32x4 o; o.x = pk2(a[0], a[1]); o.y = pk2(a[2], a[3]); o.z = pk2(b[0], b[1]); o.w = pk2(b[2], b[3]);
        *(u32x4*)(dst + i * 8) = o;
    }
}

DEV void convert_fp4(const float* __restrict__ src, unsigned char* __restrict__ dst, size_t n, float scale, int rank, int nwg) {
    const size_t n32 = n / 32;
    for (size_t i = (size_t)rank * NTHREADS + opaque_tid(); i < n32; i += (size_t)nwg * NTHREADS) {
        u32x4 o;
#pragma unroll
        for (int q = 0; q < 4; ++q) {
            const f32x4 a = *(const f32x4*)(src + i * 32 + q * 8) * scale, b = *(const f32x4*)(src + i * 32 + q * 8 + 4) * scale;
            unsigned w = 0;
            w = __builtin_amdgcn_cvt_scalef32_pk_fp4_f32(w, a[0], a[1], 1.0f, 0);
            w = __builtin_amdgcn_cvt_scalef32_pk_fp4_f32(w, a[2], a[3], 1.0f, 1);
            w = __builtin_amdgcn_cvt_scalef32_pk_fp4_f32(w, b[0], b[1], 1.0f, 2);
            w = __builtin_amdgcn_cvt_scalef32_pk_fp4_f32(w, b[2], b[3], 1.0f, 3);
            o[q] = w;
        }
        *(u32x4*)(dst + i * 16) = o;
    }
}

DEV void convert_i4(const float* __restrict__ src, unsigned char* __restrict__ dst, size_t n, float scale, int rank, int nwg) {
    const size_t n32 = n / 32;
    for (size_t i = (size_t)rank * NTHREADS + opaque_tid(); i < n32; i += (size_t)nwg * NTHREADS) {
        u32x4 o;
#pragma unroll
        for (int q = 0; q < 4; ++q) {
            const f32x4 a = *(const f32x4*)(src + i * 32 + q * 8) * scale, b = *(const f32x4*)(src + i * 32 + q * 8 + 4) * scale;
            unsigned w = 0;
#pragma unroll
            for (int j = 0; j < 4; ++j) {
                const int qa = (int)fminf(fmaxf(__builtin_rintf(a[j]), -8.f), 7.f), qb = (int)fminf(fmaxf(__builtin_rintf(b[j]), -8.f), 7.f);
                w |= ((unsigned)qa & 15u) << (4 * j); w |= ((unsigned)qb & 15u) << (4 * (j + 4));
            }
            o[q] = w;
        }
        *(u32x4*)(dst + i * 16) = o;
    }
}

DEV void convert_fp8(const float* __restrict__ src, unsigned char* __restrict__ dst, size_t n, float scale) {
    const size_t n16 = n / 16;
    for (size_t i = (size_t)opaque_bid() * NTHREADS + opaque_tid(); i < n16; i += (size_t)gridDim.x * NTHREADS) {
        u32x4 o;
#pragma unroll
        for (int q = 0; q < 4; ++q) {
            const f32x4 a = *(const f32x4*)(src + i * 16 + q * 4) * scale;
            int w = 0;
            w = __builtin_amdgcn_cvt_pk_fp8_f32(a[0], a[1], w, false);
            w = __builtin_amdgcn_cvt_pk_fp8_f32(a[2], a[3], w, true);
            o[q] = (unsigned)w;
        }
        *(u32x4*)(dst + i * 16) = o;
    }
}

DEV void phase_prologue(const Params& p, char* smem) {
    const int tid = opaque_tid(), nb = gridDim.x, b = opaque_bid();
    {
        float* cond = (float*)smem; float* red = cond + 1024;
        for (int i = tid; i < 1024; i += NTHREADS) cond[i] = siluf(p.c[i]);
        __syncthreads();
        for (int u = b; u < 192; u += nb) {
            const int n = u * 128, layer = n / 6144, nn = n - layer * 6144;
            const int cg = tid & 31, ks = tid >> 5;
            const float* wp = p.mod_w + ((size_t)layer * 1024 + ks * 64) * 6144 + nn + cg * 4;
            f32x4 acc = {0.f, 0.f, 0.f, 0.f};
#pragma unroll 8
            for (int k = 0; k < 64; ++k) { const f32x4 w = *(const f32x4*)(wp + (size_t)k * 6144); const float cv = cond[ks * 64 + k]; acc += w * cv; }
            *(f32x4*)(red + ks * 128 + cg * 4) = acc;
            __syncthreads();
            if (tid < 128) { float s = p.mod_b[n + tid]; for (int q = 0; q < 16; ++q) s += red[q * 128 + tid]; p.mod()[n + tid] = s; }
            __syncthreads();
        }
    }
    for (size_t i = (size_t)b * NTHREADS + tid; i < (size_t)S * 64; i += (size_t)nb * NTHREADS) {
        const int s = (int)(i >> 6), f = (int)(i & 63);
        const float invf = powf(10000.f, -(float)(2 * f) / 128.f);
        const float ang = (float)p.pos[s] * invf;
        float sn, cs; sincosf(ang, &sn, &cs);
        p.cosB()[i] = cs; p.sinB()[i] = sn;
    }
    for (size_t i = (size_t)b * NTHREADS + tid; i < (size_t)S * 32; i += (size_t)nb * NTHREADS) {
        const int s = (int)(i >> 5), f = (int)(i & 31);
        const float invf = powf(10000.f, -(float)(2 * f) / 64.f);
        const float ang = (float)p.pos[s] * invf;
        float sn, cs; sincosf(ang, &sn, &cs);
        p.cosC()[i] = cs; p.sinC()[i] = sn;
    }
    int base = 0;
    for (int i = 0; i < 2; ++i) {
        transpose_conv(p.hy_w_in + (size_t)i * 1024 * HY_IN, 1024, HY_IN, p.w_hy_in() + (size_t)i * HYN * 1024, HYN,
            [](int n) -> int {
                if (n < 2048) return n;
                const int seg = (n - 2048) >> 9, r = (n - 2048) & 511, sb = 2056 + seg * 512;
                if (seg < 2) { const int hd = r >> 7, dp = r & 127; const int d = (dp & 1) ? 64 + (dp >> 1) : (dp >> 1); return sb + hd * 128 + d; }
                return sb + r;
            }, smem, base);
        transpose_conv(p.hy_w_out + (size_t)i * 1024 * 1024, 1024, 1024, p.w_hy_out() + (size_t)i * 1024 * 1024, 1024, [](int n) -> int { return n; }, smem, base);
        transpose_conv(p.mla_w_in + (size_t)i * 1024 * 832, 1024, 832, p.w_mla_in() + (size_t)i * 1024 * 1024, 1024,
            [](int n) -> int {
                if (n < 768) return n;
                if (n < 832) { const int dp = n - 768; const int d = (dp & 1) ? 32 + (dp >> 1) : (dp >> 1); return 768 + d; }
                return -1;
            }, smem, base);
        transpose_conv(p.mla_w_uq + (size_t)i * 512 * 1536, 512, 1536, p.w_uq() + (size_t)i * 1536 * 512, 1536,
            [](int n) -> int {
                const int hd = n / 192, d = n % 192;
                if (d < 128) return n;
                const int dp = d - 128; const int dd = (dp & 1) ? 32 + (dp >> 1) : (dp >> 1);
                return hd * 192 + 128 + dd;
            }, smem, base);
        transpose_conv(p.mla_w_ukv + (size_t)i * 256 * 2048, 256, 2048, p.w_ukv() + (size_t)i * 2048 * 256, 2048,
            [](int n) -> int {
                if (n < 1024) { const int hd = n >> 7, d = n & 127; return hd * 256 + d; }
                const int m = n - 1024; const int hd = m >> 7, d = m & 127; return hd * 256 + 128 + d;
            }, smem, base);
        transpose_conv(p.mla_w_out + (size_t)i * 1024 * 1024, 1024, 1024, p.w_mla_out() + (size_t)i * 1024 * 1024, 1024, [](int n) -> int { return n; }, smem, base);
    }
    for (int i = 0; i < 4; ++i)
        transpose_conv(p.peer_w_q + (size_t)i * 1024 * 2048, 1024, 2048, p.w_pq() + (size_t)i * 2048 * 1024, 2048, [](int n) -> int { return n; }, smem, base);
    convert_bf16(p.peer_sub_keys, p.skb(), (size_t)4 * 8 * 2 * 128 * 128);
}

template <int MODE>
DEV void phase_norm(const float* __restrict__ xs, const float* __restrict__ nw, const float* __restrict__ shv, const float* __restrict__ scv,
                    bf16_t* __restrict__ hout, float* __restrict__ fout, const float* __restrict__ w8src, float* __restrict__ ba, char* smem) {
    const int tid = opaque_tid(), lane = tid & 63, w = __builtin_amdgcn_readfirstlane(tid >> 6);
    float* W8 = (float*)smem;
    if (MODE == 1) {
        for (int i = tid; i < 8192; i += NTHREADS) { const int k = i >> 3, c = i & 7; W8[c * 1024 + k] = w8src[(size_t)k * HY_IN + 2048 + c]; }
        __syncthreads();
    }
    f32x4 wm[4], sh[4];
#pragma unroll
    for (int i = 0; i < 4; ++i) {
        const int e = (i * 64 + lane) * 4;
        const f32x4 nv = *(const f32x4*)(nw + e);
        if (MODE == 2) { wm[i] = nv; sh[i] = (f32x4){0.f, 0.f, 0.f, 0.f}; }
        else { const f32x4 sc = *(const f32x4*)(scv + e); wm[i] = nv * (sc + 1.0f); sh[i] = *(const f32x4*)(shv + e); }
    }
    for (int row = opaque_bid() * 8 + w; row < S; row += gridDim.x * 8) {
        f32x4 v[4]; float ss = 0.f;
#pragma unroll
        for (int i = 0; i < 4; ++i) { v[i] = *(const f32x4*)(xs + (size_t)row * DM + (i * 64 + lane) * 4); ss += v[i][0] * v[i][0] + v[i][1] * v[i][1] + v[i][2] * v[i][2] + v[i][3] * v[i][3]; }
        ss = wsum64(ss, lane);
        const float rn = rsqrtf(ss * (1.f / 1024.f) + 1e-6f);
#pragma unroll
        for (int i = 0; i < 4; ++i) v[i] = v[i] * rn * wm[i] + sh[i];
        if (MODE == 2) {
#pragma unroll
            for (int i = 0; i < 4; ++i) *(f32x4*)(fout + (size_t)row * DM + (i * 64 + lane) * 4) = v[i];
        } else {
#pragma unroll
            for (int i = 0; i < 4; ++i) { u32x2 o; o.x = pk2(v[i][0], v[i][1]); o.y = pk2(v[i][2], v[i][3]); *(u32x2*)(hout + (size_t)row * DM + (i * 64 + lane) * 4) = o; }
        }
        if (MODE == 1) {
            float pc[8];
#pragma unroll
            for (int c = 0; c < 8; ++c) {
                float a = 0.f;
#pragma unroll
                for (int i = 0; i < 4; ++i) { const f32x4 ww = *(const f32x4*)(W8 + c * 1024 + (i * 64 + lane) * 4); a += v[i][0] * ww[0] + v[i][1] * ww[1] + v[i][2] * ww[2] + v[i][3] * ww[3]; }
                pc[c] = wsum64(a, lane);
            }
            if (lane == 0) { *(f32x4*)(ba + (size_t)row * 8) = (f32x4){pc[0], pc[1], pc[2], pc[3]}; *(f32x4*)(ba + (size_t)row * 8 + 4) = (f32x4){pc[4], pc[5], pc[6], pc[7]}; }
        }
    }
}

constexpr int GA_RS = 144;
template <class Epi>
DEV void gemm_phase(const bf16_t* __restrict__ A, int lda, const bf16_t* __restrict__ Bt, int ldb, int K, int ntn, char* smem, Epi epi) {
    const int tid = opaque_tid(), lane = tid & 63, w = tid >> 6, wm = w >> 1, wn = w & 1, r = lane & 15, g = lane >> 4;
    char* As = smem; char* Bs = smem + 256 * GA_RS;
    const int nun = 64 * ntn, nk = K / 64;
    for (int u = opaque_bid(); u < nun; u += gridDim.x) {
        const int xcd = u & 7, idx = u >> 3, tn = idx % ntn, tm = xcd * 8 + idx / ntn;
        const int m0 = tm * 256, n0 = tn * 128;
        f32x4 acc[4][4];
#pragma unroll
        for (int i = 0; i < 4; ++i)
#pragma unroll
            for (int j = 0; j < 4; ++j) acc[i][j] = (f32x4){0.f, 0.f, 0.f, 0.f};
        u32x4 ra0[4], rb0[2], ra1[4], rb1[2], ra2[4], rb2[2];
        const bf16_t* Ap = A + (size_t)(m0 + (tid >> 3)) * lda + (tid & 7) * 8;
        const bf16_t* Bp = Bt + (size_t)(n0 + (tid >> 3)) * ldb + (tid & 7) * 8;
        auto gload = [&](int kt, u32x4 (&ra)[4], u32x4 (&rb)[2]) {
            const int k0 = kt * 64;
#pragma unroll
            for (int i = 0; i < 4; ++i) ra[i] = *(const u32x4*)(Ap + (size_t)(64 * i) * lda + k0);
#pragma unroll
            for (int i = 0; i < 2; ++i) rb[i] = *(const u32x4*)(Bp + (size_t)(64 * i) * ldb + k0);
        };
        auto body = [&](int kt, u32x4 (&ra)[4], u32x4 (&rb)[2]) {
            __syncthreads();
#pragma unroll
            for (int i = 0; i < 4; ++i) *(u32x4*)(As + ((tid >> 3) + 64 * i) * GA_RS + (tid & 7) * 16) = ra[i];
#pragma unroll
            for (int i = 0; i < 2; ++i) *(u32x4*)(Bs + ((tid >> 3) + 64 * i) * GA_RS + (tid & 7) * 16) = rb[i];
            __syncthreads();
            if (kt + 3 < nk) gload(kt + 3, ra, rb);
#pragma unroll
            for (int ks = 0; ks < 2; ++ks) {
                bf16x8 af[4], bfr[4];
#pragma unroll
                for (int mt = 0; mt < 4; ++mt) af[mt] = *(const bf16x8*)(As + (64 * wm + 16 * mt + r) * GA_RS + (32 * ks + 8 * g) * 2);
#pragma unroll
                for (int nt = 0; nt < 4; ++nt) bfr[nt] = *(const bf16x8*)(Bs + (64 * wn + 16 * nt + r) * GA_RS + (32 * ks + 8 * g) * 2);
#pragma unroll
                for (int mt = 0; mt < 4; ++mt)
#pragma unroll
                    for (int nt = 0; nt < 4; ++nt) acc[mt][nt] = mfma16(bfr[nt], af[mt], acc[mt][nt]);
            }
        };
        gload(0, ra0, rb0); gload(1, ra1, rb1); gload(2, ra2, rb2);
        for (int kt = 0; kt < nk; kt += 3) {
            body(kt, ra0, rb0);
            if (kt + 1 < nk) body(kt + 1, ra1, rb1);
            if (kt + 2 < nk) body(kt + 2, ra2, rb2);
        }
        epi(acc, m0 + 64 * wm + r, n0 + 64 * wn + 4 * g, n0);
    }
}

DEV void st_bf4(bf16_t* p, f32x4 v) { u32x2 o; o.x = pk2(v[0], v[1]); o.y = pk2(v[2], v[3]); *(u32x2*)p = o; }
DEV f32x4 rope4(f32x4 v, const float* cs, const float* sn, int fi) {
    const float c0 = cs[fi], s0 = sn[fi], c1 = cs[fi + 1], s1 = sn[fi + 1];
    f32x4 o; o[0] = v[0] * c0 - v[1] * s0; o[1] = v[1] * c0 + v[0] * s0; o[2] = v[2] * c1 - v[3] * s1; o[3] = v[3] * c1 + v[2] * s1; return o;
}

namespace pg8 {
#define PG8_LAS __attribute__((address_space(3)))
typedef unsigned short bf16_t;
typedef short bf16x8 __attribute__((ext_vector_type(8)));
typedef float f32x4 __attribute__((ext_vector_type(4)));
constexpr int BM = 256, BK = 64, HALF = 128, HTB = HALF * BK * 2  , STAGE_BYTES = 8 * HTB, NXCD = 8, WGM = 8;

__host__ __device__ __forceinline__ int lds_byte(int r, int c) { const int st = (r >> 4) * 2 + (c >> 5), rr = r & 15, cc = c & 31, ob = rr * 64 + cc * 2; return st * 1024 + (ob ^ (((ob >> 9) & 1) << 5)); }
__host__ __device__ __forceinline__ void stage_rc(int b, int& R, int& C) { const int st = b / 1024, sb = b % 1024, swz = sb ^ (((sb >> 9) & 1) << 5); R = (st >> 1) * 16 + swz / 64; C = (st & 1) * 32 + (swz % 64) / 2; }
__host__ __device__ __forceinline__ int perm32(int rho) { const int n = rho >> 4, i = rho & 15; return 8 * (i >> 2) + 4 * n + (i & 3); }

struct Unit { int pm, pn; };
struct Gemm { const bf16_t* A; const bf16_t* Bt; int M, N, K; };

struct StaticOrder {
    int nM, nN, nwg, G, c;
    __host__ __device__ void init(int M, int N, int G_, int c_) { nM = M / BM; nN = N / BM; nwg = nM * nN; G = G_; c = c_; }
    __host__ __device__ bool next(int i, Unit& u) const {
        const long L = (long)i * G + c; if (L >= nwg) return false;
        int wgid = (int)L; { const int q = nwg / NXCD, r = nwg % NXCD, xcd = wgid % NXCD, off = wgid / NXCD; wgid = (xcd < r ? xcd * (q + 1) : r * (q + 1) + (xcd - r) * q) + off; }
        const int nig = WGM * nN, gid = wgid / nig, fm = gid * WGM, gsz = (nM - fm) < WGM ? (nM - fm) : WGM;
        u.pm = fm + ((wgid % nig) % gsz); u.pn = (wgid % nig) / gsz; return true;
    }
    __device__ __forceinline__ void a_ready(const Unit&) const {}
    __device__ __forceinline__ void done(const Unit&) const {}
};
template <class Epi, class Sched, bool STAMP = false>
__device__ __forceinline__ void gemm_phase(PG8_LAS unsigned char* lds, const Gemm g, const Sched& S, const Epi& E, unsigned long long* stamps) {
    const int tid = opaque_tid(), wid = __builtin_amdgcn_readfirstlane(tid >> 6), lane = tid & 63, wr = wid >> 2, wc = wid & 3, fr = lane & 15, fq = lane >> 4;
    const int K = g.K, nt = K / BK;
    int ts_lo = 0, ts_hi = 0, nts = 0; const unsigned long long rt_entry = STAMP ? (unsigned long long)wall_clock64() : 0ull;
#define PG8_STAMP() do { if (STAMP && wid == 0 && nts < 64) { const unsigned long long _c = (unsigned long long)clock64(); \
        ts_lo = (lane == nts) ? (int)(unsigned)_c : ts_lo; ts_hi = (lane == nts) ? (int)(unsigned)(_c >> 32) : ts_hi; ++nts; } } while (0)
    PG8_STAMP();
    unsigned voffA[2], voffB[2];
#pragma unroll
    for (int i = 0; i < 2; ++i) { int R, C; stage_rc(tid * 16 + i * 8192, R, C); const int Rb = Epi::PERM ? ((R & ~31) + perm32(R & 31)) : R;
        voffA[i] = (unsigned)(R * K + C) * 2u; voffB[i] = (unsigned)(Rb * K + C) * 2u; }
    const size_t kstep = (size_t)(BK * 2);
    const size_t hstep = (size_t)HALF * K * 2;
    const size_t tstep = 2 * hstep;
    const unsigned ldsw = (unsigned)wid * 1024u;
    const int aoff = lds_byte(wr * 64 + fr, fq * 8), boff = lds_byte(wc * 32 + fr, fq * 8);
#define PG8_SA(b, h) (((b) * 2 + (h)) * HTB)
#define PG8_SB(b, h) ((4 + (b) * 2 + (h)) * HTB)
#define PG8_STAGE(bufoff, gbase, voff) do { _Pragma("unroll") for (int _i = 0; _i < 2; ++_i) \
        __builtin_amdgcn_global_load_lds((const unsigned*)((const char*)(gbase) + (voff)[_i]), (PG8_LAS unsigned*)(lds + (bufoff) + ldsw + _i * 8192), 16, 0, 0); } while (0)
#define PG8_LDA(dst, b, h) do { _Pragma("unroll") for (int m = 0; m < 4; ++m) _Pragma("unroll") for (int k = 0; k < 2; ++k) dst[m][k] = *(const PG8_LAS bf16x8*)(lds + PG8_SA(b, h) + aoff + m * 2048 + k * 1024); } while (0)
#define PG8_LDB(dst, b, h) do { _Pragma("unroll") for (int n = 0; n < 2; ++n) _Pragma("unroll") for (int k = 0; k < 2; ++k) dst[n][k] = *(const PG8_LAS bf16x8*)(lds + PG8_SB(b, h) + boff + n * 2048 + k * 1024); } while (0)
#define PG8_MMA(ai, bj, At, Bt) do { __builtin_amdgcn_s_setprio(1); _Pragma("unroll") for (int m = 0; m < 4; ++m) _Pragma("unroll") for (int n = 0; n < 2; ++n) _Pragma("unroll") for (int k = 0; k < 2; ++k) \
        acc[ai][bj][m][n] = __builtin_amdgcn_mfma_f32_16x16x32_bf16(Bt[n][k], At[m][k], acc[ai][bj][m][n], 0, 0, 0); __builtin_amdgcn_s_setprio(0); } while (0)
#define PG8_WAIT_V(n) asm volatile("s_waitcnt vmcnt(" #n ")" ::: "memory")
#define PG8_WAIT_L(n) asm volatile("s_waitcnt lgkmcnt(" #n ")" ::: "memory")
#define PG8_BAR __builtin_amdgcn_s_barrier()
#define PG8_SCHED __builtin_amdgcn_sched_barrier(0)
    Unit cur, nxt; int ui = 0;
    if (!S.next(0, cur)) return;
    f32x4 acc[2][2][4][2];
#pragma unroll
    for (int a = 0; a < 2; ++a)
#pragma unroll
        for (int b = 0; b < 2; ++b)
#pragma unroll
            for (int m = 0; m < 4; ++m)
#pragma unroll
                for (int n = 0; n < 2; ++n) acc[a][b][m][n] = (f32x4){0.f, 0.f, 0.f, 0.f};
    bf16x8 At[4][2], B0[2][2], B1[2][2];
    const char* cA = (const char*)g.A + (size_t)cur.pm * tstep; const char* cB = (const char*)g.Bt + (size_t)cur.pn * tstep;
    S.a_ready(cur);
    PG8_STAGE(PG8_SB(0, 0), cB, voffB); PG8_STAGE(PG8_SA(0, 0), cA, voffA); PG8_STAGE(PG8_SB(0, 1), cB + hstep, voffB); PG8_STAGE(PG8_SA(0, 1), cA + hstep, voffA);
    if (wr == 1) PG8_BAR;
    PG8_WAIT_V(4); PG8_BAR;
    PG8_STAGE(PG8_SB(1, 0), cB + kstep, voffB); PG8_STAGE(PG8_SA(1, 0), cA + kstep, voffA); PG8_STAGE(PG8_SB(1, 1), cB + hstep + kstep, voffB);
    PG8_WAIT_V(6); PG8_BAR;
    PG8_STAMP();
    for (;;) {
        const bool has_next = S.next(ui + 1, nxt);
        const char* nA = has_next ? (const char*)g.A + (size_t)nxt.pm * tstep : cA; const char* nB = has_next ? (const char*)g.Bt + (size_t)nxt.pn * tstep : cB;
        for (int t = 0; t < nt; t += 2) {
            const bool last = (t == nt - 2);
            const char* a1 = cA + (size_t)(t + 1) * kstep;
            const char* a2 = last ? nA : cA + (size_t)(t + 2) * kstep; const char* b2 = last ? nB : cB + (size_t)(t + 2) * kstep;
            const char* a3 = a2 + kstep; const char* b3 = b2 + kstep;
            if (last && has_next) S.a_ready(nxt);
            PG8_LDB(B0, 0, 0); PG8_SCHED; PG8_LDA(At, 0, 0); PG8_STAGE(PG8_SA(1, 1), a1 + hstep, voffA);
            PG8_WAIT_L(8); PG8_BAR; PG8_WAIT_L(0); PG8_MMA(0, 0, At, B0); PG8_BAR; PG8_SCHED;
            PG8_LDB(B1, 0, 1); PG8_STAGE(PG8_SB(0, 0), b2, voffB);
            PG8_BAR; PG8_WAIT_L(0); PG8_MMA(0, 1, At, B1); PG8_BAR;
            PG8_LDA(At, 0, 1); PG8_STAGE(PG8_SA(0, 0), a2, voffA);
            PG8_BAR; PG8_WAIT_L(0); PG8_MMA(1, 0, At, B0); PG8_BAR; PG8_SCHED;
            PG8_STAGE(PG8_SB(0, 1), b2 + hstep, voffB);
            PG8_WAIT_V(6); PG8_BAR; PG8_MMA(1, 1, At, B1); PG8_BAR;
            PG8_LDB(B0, 1, 0); PG8_SCHED; PG8_LDA(At, 1, 0); PG8_STAGE(PG8_SA(0, 1), a2 + hstep, voffA);
            PG8_WAIT_L(8); PG8_BAR; PG8_WAIT_L(0); PG8_MMA(0, 0, At, B0); PG8_BAR; PG8_SCHED;
            PG8_LDB(B1, 1, 1); PG8_STAGE(PG8_SB(1, 0), b3, voffB);
            PG8_BAR; PG8_WAIT_L(0); PG8_MMA(0, 1, At, B1); PG8_BAR;
            PG8_LDA(At, 1, 1); PG8_STAGE(PG8_SA(1, 0), a3, voffA);
            PG8_BAR; PG8_WAIT_L(0); PG8_MMA(1, 0, At, B0); PG8_BAR; PG8_SCHED;
            PG8_STAGE(PG8_SB(1, 1), b3 + hstep, voffB);
            PG8_WAIT_V(6); PG8_BAR; PG8_MMA(1, 1, At, B1); PG8_BAR;
        }
        PG8_STAMP();
        if constexpr (!Epi::AFTER_DRAIN) { E(acc, cur, wr, wc, fr, fq); S.done(cur); }
        PG8_STAMP();
        if (!has_next) break;
#pragma unroll
        for (int a = 0; a < 2; ++a)
#pragma unroll
            for (int b = 0; b < 2; ++b)
#pragma unroll
                for (int m = 0; m < 4; ++m)
#pragma unroll
                    for (int n = 0; n < 2; ++n) acc[a][b][m][n] = (f32x4){0.f, 0.f, 0.f, 0.f};
        cur = nxt; cA = nA; cB = nB; ++ui;
    }
    PG8_WAIT_V(0);
    if (wr == 0) PG8_BAR;
    PG8_BAR;
    if constexpr (Epi::AFTER_DRAIN) { E.fused(acc, cur, wr, wc, fr, fq, lds, wid, lane); S.done(cur); }
    PG8_STAMP();
    if (STAMP && wid == 0) { stamps[lane] = lane < nts ? (((unsigned long long)(unsigned)ts_hi << 32) | (unsigned)ts_lo) : 0ull;
        if (lane == 62) stamps[62] = rt_entry; if (lane == 63) stamps[63] = (unsigned long long)wall_clock64(); }
#undef PG8_STAMP
#undef PG8_SA
#undef PG8_SB
#undef PG8_STAGE
#undef PG8_LDA
#undef PG8_LDB
#undef PG8_MMA
#undef PG8_WAIT_V
#undef PG8_WAIT_L
#undef PG8_BAR
#undef PG8_SCHED
}
}

template <class F> struct EpiCall {
    static constexpr bool PERM = false, AFTER_DRAIN = false;
    F f;
    __device__ __forceinline__ void operator()(const f32x4 (&acc)[2][2][4][2], const pg8::Unit& u, int wr, int wc, int fr, int fq) const {
        { const int t_ = opaque_tid(); fr = t_ & 15; fq = (t_ >> 4) & 3; const int wid_ = __builtin_amdgcn_readfirstlane(t_ >> 6); wr = wid_ >> 2; wc = wid_ & 3; }
#pragma unroll
        for (int ai = 0; ai < 2; ++ai)
#pragma unroll
            for (int bj = 0; bj < 2; ++bj) {
                const int n0 = u.pn * 256 + 128 * bj;
#pragma unroll
                for (int m = 0; m < 4; ++m) {
#pragma unroll
                    for (int n = 0; n < 2; ++n) f(u.pm * 256 + 128 * ai + 64 * wr + 16 * m + fr, n0 + 32 * wc + 16 * n + 4 * fq, n0, acc[ai][bj][m][n]);
                    __builtin_amdgcn_sched_barrier(0);
                }
            }
    }
};
template <class F>
DEV void gemm256(const bf16_t* A, const bf16_t* Bt, int N, int K, char* smem, F f) {
    pg8::Gemm g; g.A = A; g.Bt = Bt; g.M = S; g.N = N; g.K = K;
    pg8::StaticOrder so; so.init(S, N, (int)gridDim.x, opaque_bid());
    EpiCall<F> e{f};
    pg8::gemm_phase<EpiCall<F>, pg8::StaticOrder, false>((PG8_LAS unsigned char*)smem, g, so, e, nullptr);
}

template <int DQK>
DEV void attn_run(const bf16_t* __restrict__ qrow, bool wactive, const bf16_t* __restrict__ Kn, const bf16_t* __restrict__ Kr,
                  const bf16_t* __restrict__ VT, int t_lo, int t_hi, int t_plain, int qpos, int wqmin, int wqmax, char* smem,
                  f32x16 (&o)[4], float& mrun, float& lrun) {
    constexpr int KRS = (DQK + 8) * 2;
    constexpr int VRS = 144;
    constexpr int NKS = DQK / 16;
    constexpr int QREG = 4;
    constexpr bool ROPE = (DQK == 192);
    char* Vb0 = smem + 2 * 64 * KRS; char* Qs = Vb0 + 2 * 128 * VRS;
    const int tid = opaque_tid(), lane = tid & 63, c = lane & 31, hi = lane >> 5;
    bf16x8 qf[QREG];
#pragma unroll
    for (int ks = 0; ks < QREG; ++ks) qf[ks] = *(const bf16x8*)(qrow + 16 * ks + 8 * hi);
    char* Qw = Qs + (tid >> 6) * ((NKS - QREG) * 1024) + lane * 16;
#pragma unroll
    for (int ks = QREG; ks < NKS; ++ks) *(bf16x8*)(Qw + (ks - QREG) * 1024) = *(const bf16x8*)(qrow + 16 * ks + 8 * hi);
#pragma unroll
    for (int i = 0; i < 4; ++i)
#pragma unroll
        for (int rr = 0; rr < 16; ++rr) o[i][rr] = 0.f;
    mrun = -1e30f; lrun = 0.f;
    u32x4 kreg[2], rreg, vreg[2];
    typedef const __attribute__((address_space(1))) char* gptr_t;
    typedef const __attribute__((address_space(1))) u32x4* gvec_t;
    auto sbase = [&](const void* ptr) -> gptr_t {
        const unsigned long long v = (unsigned long long)ptr;
        unsigned lo = __builtin_amdgcn_readfirstlane((unsigned)v), hi = __builtin_amdgcn_readfirstlane((unsigned)(v >> 32));
        asm volatile("" : "+s"(lo), "+s"(hi));
        return (gptr_t)(((unsigned long long)hi << 32) | lo);
    };
    const unsigned voff16 = (unsigned)tid * 16u;
    auto gloadK = [&](int t) {
        const gptr_t kn0 = sbase((const char*)Kn + (size_t)t * (64 * 256));
        const gptr_t kn1 = sbase((const char*)Kn + (size_t)t * (64 * 256) + 8192);
        kreg[0] = *(gvec_t)(kn0 + voff16); kreg[1] = *(gvec_t)(kn1 + voff16);
        if (ROPE) { const gptr_t kr_t = sbase((const char*)Kr + (size_t)t * (64 * 128)); rreg = *(gvec_t)(kr_t + voff16); }
    };
    auto gloadV = [&](int t) {
        const gptr_t vt0 = sbase((const char*)VT + (size_t)t * (128 * 128));
        const gptr_t vt1 = sbase((const char*)VT + (size_t)t * (128 * 128) + 8192);
        vreg[0] = *(gvec_t)(vt0 + voff16); vreg[1] = *(gvec_t)(vt1 + voff16);
    };
    auto lstoreK = [&](int t) {
        int t2 = tid; asm volatile("" : "+v"(t2));
        char* Ks = smem + (t & 1) * (64 * KRS);
#pragma unroll
        for (int i = 0; i < 2; ++i) { const int ch = t2 + NTHREADS * i; *(u32x4*)(Ks + (ch >> 4) * KRS + (ch & 15) * 16) = kreg[i]; }
        if (ROPE) *(u32x4*)(Ks + (t2 >> 3) * KRS + 256 + (t2 & 7) * 16) = rreg;
    };
    auto lstoreV = [&](int t) {
        int t2 = tid; asm volatile("" : "+v"(t2));
        char* Vs = Vb0 + (t & 1) * (128 * VRS);
#pragma unroll
        for (int i = 0; i < 2; ++i) {
            const int ch = t2 + NTHREADS * i;
            char* d = Vs + (ch >> 3) * VRS + ((ch & 7) >> 1) * 32 + (ch & 1) * 8;
            *(u32x2*)d = (u32x2){vreg[i].x, vreg[i].y}; *(u32x2*)(d + 16) = (u32x2){vreg[i].z, vreg[i].w};
        }
    };
    auto qk = [&](int t, f32x16 (&sv)[2]) {
        const char* Ks = smem + (t & 1) * (64 * KRS) + c * KRS + 16 * hi;
#pragma unroll
        for (int kt = 0; kt < 2; ++kt)
#pragma unroll
            for (int rr = 0; rr < 16; ++rr) sv[kt][rr] = 0.f;
        bf16x8 k0[3], k1[3], qv[3];
#pragma unroll
        for (int ks = 0; ks < 2; ++ks) {
            k0[ks] = *(const bf16x8*)(Ks + 32 * ks); k1[ks] = *(const bf16x8*)(Ks + 32 * KRS + 32 * ks);
            if (ks < QREG) qv[ks] = qf[ks < QREG ? ks : 0]; else qv[ks] = *(const bf16x8*)(Qw + (ks - QREG) * 1024);
        }
#pragma unroll
        for (int ks = 0; ks < NKS; ++ks) {
            if (ks + 2 < NKS) {
                k0[(ks + 2) % 3] = *(const bf16x8*)(Ks + 32 * (ks + 2)); k1[(ks + 2) % 3] = *(const bf16x8*)(Ks + 32 * KRS + 32 * (ks + 2));
                if (ks + 2 < QREG) qv[(ks + 2) % 3] = qf[ks + 2 < QREG ? ks + 2 : 0]; else qv[(ks + 2) % 3] = *(const bf16x8*)(Qw + (ks + 2 - QREG) * 1024);
            }
            sv[0] = mfma32(k0[ks % 3], qv[ks % 3], sv[0]);
            sv[1] = mfma32(k1[ks % 3], qv[ks % 3], sv[1]);
        }
    };
    float mnew_ = 0.f;
    auto softmax_a = [&](int t, f32x16 (&sv)[2]) {
        const int kb = t * 64;
        if (kb + 63 > wqmin) {
#pragma unroll
            for (int kt = 0; kt < 2; ++kt)
#pragma unroll
                for (int rr = 0; rr < 16; ++rr) { const int key = kb + 32 * kt + (rr & 3) + 8 * (rr >> 2) + 4 * hi; if (key > qpos) sv[kt][rr] = -__builtin_inff(); }
        }
        float tmax = sv[0][0];
#pragma unroll
        for (int rr = 1; rr < 16; ++rr) tmax = fmaxf(tmax, sv[0][rr]);
#pragma unroll
        for (int rr = 0; rr < 16; ++rr) tmax = fmaxf(tmax, sv[1][rr]);
        tmax = fmaxf(tmax, shx(tmax, 32, lane));
        const float mnew = fmaxf(mrun, tmax);
        const float alpha = ex2(mrun - mnew);
        mrun = mnew; mnew_ = mnew;
        lrun *= alpha;
        if (!__all(alpha == 1.f)) {
#pragma unroll
            for (int i = 0; i < 4; ++i)
#pragma unroll
                for (int rr = 0; rr < 16; ++rr) o[i][rr] *= alpha;
        }
    };
    auto softmax_b = [&](f32x16 (&sv)[2], bf16x8 (&pf)[2][2]) {
        const float mnew = mnew_;
        float ps = 0.f;
#pragma unroll
        for (int kt = 0; kt < 2; ++kt)
#pragma unroll
            for (int rr = 0; rr < 16; ++rr) { const float pv = ex2(sv[kt][rr] - mnew); sv[kt][rr] = pv; ps += pv; }
        lrun += ps;
#pragma unroll
        for (int kt = 0; kt < 2; ++kt)
#pragma unroll
            for (int s2 = 0; s2 < 2; ++s2) {
                u32x4 pw; pw.x = pk2(sv[kt][8 * s2 + 0], sv[kt][8 * s2 + 1]); pw.y = pk2(sv[kt][8 * s2 + 2], sv[kt][8 * s2 + 3]);
                pw.z = pk2(sv[kt][8 * s2 + 4], sv[kt][8 * s2 + 5]); pw.w = pk2(sv[kt][8 * s2 + 6], sv[kt][8 * s2 + 7]);
                pf[kt][s2] = *(const bf16x8*)&pw;
            }
    };
    auto pv = [&](int t, const bf16x8 (&pf)[2][2]) {
        const char* Vs = Vb0 + (t & 1) * (128 * VRS) + c * VRS + 16 * hi;
#pragma unroll
        for (int g = 0; g < 4; ++g)
#pragma unroll
            for (int dvt = 0; dvt < 4; ++dvt) o[dvt] = mfma32(*(const bf16x8*)(Vs + 32 * dvt * VRS + 32 * g), pf[g >> 1][g & 1], o[dvt]);
    };
    auto active = [&](int t) -> bool { return wactive && (t * 64 <= wqmax); };
    auto step = [&](int t, f32x16 (&sc)[2], f32x16 (&sn)[2]) {
        const bool more = t + 1 < t_hi;
        const int tk = t + 2 < t_hi ? t + 2 : t_hi - 1, tv = more ? t + 1 : t_hi - 1;
        const bool a0 = active(t), a1 = more && active(t + 1);
        if (a0) {
            bf16x8 pf[2][2];
            if (a1) { qk(t + 1, sn); gloadK(tk); gloadV(tv); softmax_b(sc, pf); pv(t, pf); asm volatile("; arm qk+exp+pv" ::: "memory"); }
            else { gloadK(tk); gloadV(tv); softmax_b(sc, pf); pv(t, pf); asm volatile("; arm exp+pv" ::: "memory"); }
        } else { gloadK(tk); gloadV(tv); }
        lstoreK(t + 2); lstoreV(t + 1);
        if (a1) softmax_a(t + 1, sn);
        __syncthreads();
    };
    int kso[2], rso, vso[2];
#pragma unroll
    for (int i = 0; i < 2; ++i) { const int ch = tid + NTHREADS * i; kso[i] = (ch >> 4) * KRS + (ch & 15) * 16; vso[i] = (ch >> 3) * VRS + ((ch & 7) >> 1) * 32 + (ch & 1) * 8; }
    rso = (tid >> 3) * KRS + 256 + (tid & 7) * 16;
    auto fstep = [&](int t, f32x16 (&sc)[2], f32x16 (&sn)[2]) {
        constexpr int NA = 2 * NKS, NG = NA + 16;
        static_assert(NG >= 39 && NA + 14 <= NG && NA + 8 >= 28, "filler slots");
        const char* Ks = smem + ((t + 1) & 1) * (64 * KRS) + c * KRS + 16 * hi;
        const char* Vs = Vb0 + (t & 1) * (128 * VRS) + c * VRS + 16 * hi;
        char* Kst = smem + (t & 1) * (64 * KRS); char* Vst = Vb0 + ((t + 1) & 1) * (128 * VRS);
        const float mref = mnew_;
        const f32x16 zero16 = {0.f, 0.f, 0.f, 0.f, 0.f, 0.f, 0.f, 0.f, 0.f, 0.f, 0.f, 0.f, 0.f, 0.f, 0.f, 0.f};
        bf16x8 fr[5], ql[3];
        u32x4 pf4[4];
        float ps0 = 0.f, ps1 = 0.f, plo = 0.f, d1 = 0.f, tmax = 0.f, alpha = 1.f;
        auto fread = [&](int G) -> bf16x8 {
            if (G < NA) return *(const bf16x8*)(Ks + (G & 1) * (32 * KRS) + 32 * (G >> 1));
            return *(const bf16x8*)(Vs + 32 * ((G - NA) & 3) * VRS + 32 * ((G - NA) >> 2));
        };
        auto expfill = [&](int E) {
            if ((E & 1) == 0) {
                const float d0 = sc[E >> 4][E & 15] - mref; d1 = sc[E >> 4][(E & 15) + 1] - mref;
                plo = ex2(d0);
                asm volatile("" : "+v"(plo), "+v"(d1));
            } else {
                const float phi = ex2(d1);
                ps0 += plo; ps1 += phi;
                unsigned wd = pk2(plo, phi);
                asm volatile("" : "+v"(wd), "+v"(ps0), "+v"(ps1));
                pf4[E >> 3][(E >> 1) & 3] = wd;
            }
        };
        auto filler = [&](int G) {
            if (G + 4 < 32) expfill(G + 4);
            const int i0 = G - NA;
            if (i0 >= 0 && i0 < 12) {
                const int first = i0 < 4 ? 2 * i0 : 4 + i0, cnt = i0 < 4 ? 2 : 1;
#pragma unroll
                for (int i = first; i < first + cnt; ++i) {
                    const int kt = i >> 3, r0 = 2 * (i & 7);
                    if (i == 0) tmax = fmaxf(sn[0][0], sn[0][1]); else tmax = fmaxf(fmaxf(tmax, sn[kt][r0]), sn[kt][r0 + 1]);
                }
                asm volatile("" : "+v"(tmax));
            }
            if (i0 == 12) {
                const unsigned tb = __float_as_uint(tmax);
                const auto sw = __builtin_amdgcn_permlane32_swap(tb, tb, false, false);
                tmax = fmaxf(__uint_as_float(sw[0]), __uint_as_float(sw[1]));
                asm volatile("" : "+v"(tmax));
            }
            if (i0 == 13) {
                const float mnew = fmaxf(mrun, tmax);
                alpha = ex2(mrun - mnew);
                mrun = mnew; mnew_ = mnew;
                lrun = (lrun + (ps0 + ps1)) * alpha;
                asm volatile("" : "+v"(alpha), "+v"(lrun));
            }
            if (G >= 32 && G < 39) {
                const int i = G - 32;
                if (i < 2) *(u32x4*)(Kst + kso[i]) = kreg[i];
                else if (i == 2) { if (ROPE) *(u32x4*)(Kst + rso) = rreg; }
                else {
                    const int j = (i - 3) >> 1;
                    if (((i - 3) & 1) == 0) *(u32x2*)(Vst + vso[j]) = (u32x2){vreg[j].x, vreg[j].y}; else *(u32x2*)(Vst + vso[j] + 16) = (u32x2){vreg[j].z, vreg[j].w};
                }
            }
        };
#pragma unroll
        for (int G = 0; G < 4; ++G) fr[G] = fread(G);
#pragma unroll
        for (int ks = QREG; ks < QREG + 2 && ks < NKS; ++ks) ql[ks % 3] = *(const bf16x8*)(Qw + (ks - QREG) * 1024);
        gloadK(t + 2); gloadV(t + 1);
#pragma unroll
        for (int E = 0; E < 4; ++E) expfill(E);
        __builtin_amdgcn_sched_barrier(0);
#pragma unroll
        for (int G = 0; G < NG; ++G) {
            if (G + 4 < NG) fr[(G + 4) % 5] = fread(G + 4);
            if (G < NA) {
                const int ks = G >> 1, kt = G & 1;
                if (kt == 0 && ks + 2 >= QREG + 2 && ks + 2 < NKS) ql[(ks + 2) % 3] = *(const bf16x8*)(Qw + (ks + 2 - QREG) * 1024);
                const bf16x8 qop = ks < QREG ? qf[ks < QREG ? ks : 0] : ql[ks % 3];
                if (ks == 0) sn[kt] = mfma32(fr[G % 5], qop, zero16); else sn[kt] = mfma32(fr[G % 5], qop, sn[kt]);
            } else {
                const int g = G - NA, gg = g >> 2, dvt = g & 3;
                o[dvt] = mfma32(fr[G % 5], *(const bf16x8*)&pf4[gg], o[dvt]);
            }
            filler(G);
            __builtin_amdgcn_sched_barrier(0);
        }
        if (!__all(alpha == 1.f)) {
#pragma unroll
            for (int i = 0; i < 4; ++i)
#pragma unroll
                for (int rr = 0; rr < 16; ++rr) o[i][rr] *= alpha;
        }
        __syncthreads();
    };
    __syncthreads();
    gloadK(t_lo); gloadV(t_lo); lstoreK(t_lo); lstoreV(t_lo);
    if (t_lo + 1 < t_hi) { gloadK(t_lo + 1); lstoreK(t_lo + 1); }
    __syncthreads();
    f32x16 sA[2], sB[2];
    if (active(t_lo)) { qk(t_lo, sA); softmax_a(t_lo, sA); }
    __syncthreads();
    int t = t_lo;
    for (; t + 2 < t_plain; t += 2) { fstep(t, sA, sB); fstep(t + 1, sB, sA); }
    for (; t < t_hi; t += 2) {
        step(t, sA, sB);
        if (t + 1 < t_hi) step(t + 1, sB, sA);
    }
    lrun += shx(lrun, 32, lane);
}

DEV void phase_mla_attn(const Params& p, char* smem) {
    const int tid = opaque_tid(), lane = tid & 63, w = tid >> 6, c = lane & 31, hi = lane >> 5;
    for (int u = __builtin_amdgcn_readfirstlane(opaque_bid()); u < 256; u += gridDim.x) {
        const int head = u & 7, pi = u >> 3;
        for (int half = 0; half < 2; ++half) {
            const int qb = half == 0 ? (63 - pi) : pi;
            const int q = qb * 256 + 32 * w + c;
            f32x16 o[4]; float m, l;
            attn_run<192>(p.Qm() + ((size_t)head * S + q) * 192, true, p.Kn() + (size_t)head * S * 128, p.Kr(), p.VmT() + (size_t)head * 128 * S,
                          0, 4 * qb + 4, 4 * qb, q, qb * 256 + 32 * w, qb * 256 + 32 * w + 31, smem, o, m, l);
            const float inv = 1.f / l;
#pragma unroll
            for (int dvt = 0; dvt < 4; ++dvt)
#pragma unroll
                for (int rg = 0; rg < 4; ++rg) {
                    const int dv = 32 * dvt + 8 * rg + 4 * hi;
                    f32x4 v = {o[dvt][4 * rg] * inv, o[dvt][4 * rg + 1] * inv, o[dvt][4 * rg + 2] * inv, o[dvt][4 * rg + 3] * inv};
                    st_bf4(p.cat() + (size_t)q * DM + head * 128 + dv, v);
                }
        }
    }
}

DEV void moba_kmean_unit(const Params& p, int h, int j, char* smem) {
    float* red = (float*)smem;
    const int tid = opaque_tid(), d = tid & 127, qq = tid >> 7;
    const bf16_t* kp = p.Kb() + ((size_t)h * S + 256 * j + qq * 64) * 128 + d;
    float s = 0.f;
    for (int t = 0; t < 64; ++t) s += __uint_as_float(((unsigned)kp[(size_t)t * 128]) << 16);
    __syncthreads();
    red[qq * 128 + d] = s;
    __syncthreads();
    if (tid < 128) p.kmean()[((size_t)h * 64 + j) * 128 + tid] = (red[tid] + red[128 + tid] + red[256 + tid] + red[384 + tid]) * (1.f / 256.f);
}

DEV void moba_gate_unit(const Params& p, int u, char* smem) {
    float* km = (float*)smem;
    int* cnt = (int*)(smem + 32768);
    const int tid = opaque_tid();
    {
        const int h = u & 3, t = u >> 2;
        __syncthreads();
        for (int i = tid; i < 8192; i += NTHREADS) km[i] = p.kmean()[(size_t)h * 8192 + i];
        if (tid < 64) cnt[tid] = 0;
        __syncthreads();
        const int q = t * 512 + tid, own = q >> 8;
        float qv[128];
        const u32x4* qp = (const u32x4*)(p.Qb() + ((size_t)h * S + q) * 128);
#pragma unroll
        for (int i = 0; i < 16; ++i) { const u32x4 v = qp[i]; qv[8 * i] = bflo(v.x); qv[8 * i + 1] = bfhi(v.x); qv[8 * i + 2] = bflo(v.y); qv[8 * i + 3] = bfhi(v.y); qv[8 * i + 4] = bflo(v.z); qv[8 * i + 5] = bfhi(v.z); qv[8 * i + 6] = bflo(v.w); qv[8 * i + 7] = bfhi(v.w); }
        float b0 = -__builtin_inff(), b1 = b0, b2 = b0; int i0 = 0, i1 = 0, i2 = 0;
        const int ownw = __builtin_amdgcn_readfirstlane(own);
        for (int j = 0; j < ownw; ++j) {
            float s = 0.f; const f32x4* kp = (const f32x4*)(km + j * 128);
#pragma unroll
            for (int d4 = 0; d4 < 32; ++d4) { const f32x4 kk = kp[d4]; s += qv[4 * d4] * kk[0] + qv[4 * d4 + 1] * kk[1] + qv[4 * d4 + 2] * kk[2] + qv[4 * d4 + 3] * kk[3]; }
            if (s > b0) { b2 = b1; i2 = i1; b1 = b0; i1 = i0; b0 = s; i0 = j; }
            else if (s > b1) { b2 = b1; i2 = i1; b1 = s; i1 = j; }
            else if (s > b2) { b2 = s; i2 = j; }
        }
        const int nsel = own < 3 ? own : 3;
        if (0 < nsel) { const int pos = atomicAdd(&cnt[i0], 1); p.lists()[(((size_t)h * 64 + i0) * 32 + t) * 512 + pos] = (q << 2) | 0; }
        if (1 < nsel) { const int pos = atomicAdd(&cnt[i1], 1); p.lists()[(((size_t)h * 64 + i1) * 32 + t) * 512 + pos] = (q << 2) | 1; }
        if (2 < nsel) { const int pos = atomicAdd(&cnt[i2], 1); p.lists()[(((size_t)h * 64 + i2) * 32 + t) * 512 + pos] = (q << 2) | 2; }
        __syncthreads();
        if (tid < 64) p.segcnt()[((size_t)h * 64 + tid) * 32 + t] = cnt[tid];
    }
}

DEV void moba_write_partial(const Params& p, int q, int h, int slot, const f32x16 (&o)[4], float m, float l, int hi) {
    bf16_t* pp = (bf16_t*)p.part() + (((size_t)q * 4 + h) * 4 + slot) * 128;
    const float il = 1.f / l;
#pragma unroll
    for (int dvt = 0; dvt < 4; ++dvt)
#pragma unroll
        for (int rg = 0; rg < 4; ++rg) {
            const int dv = 32 * dvt + 8 * rg + 4 * hi;
            st_bf4(pp + dv, (f32x4){o[dvt][4 * rg] * il, o[dvt][4 * rg + 1] * il, o[dvt][4 * rg + 2] * il, o[dvt][4 * rg + 3] * il});
        }
    if (hi == 0) { float* mp = p.ml() + (((size_t)q * 4 + h) * 4 + slot) * 2; mp[0] = m; mp[1] = l; }
}

constexpr int MB_KRS = 272, MB_VRS = 144, MB_KB = 64 * MB_KRS, MB_VB = 128 * MB_VRS, MB_TAB = 4 * MB_KB + 4 * MB_VB;
DEV int moba_tile_table(const Params& p, char* smem) {
    int* P = (int*)(smem + MB_TAB + 256);
    const int tid = opaque_tid();
    __syncthreads();
    if (tid < 256) {
        const int j = tid >> 2, h = tid & 3; int s = 0;
        const int* sc = p.segcnt() + ((size_t)h * 64 + j) * 32;
        for (int t = 0; t < 32; ++t) s += sc[t];
        const int ntiles = 1 + ((s + 255) >> 8);
        P[tid + 1] = (ntiles + 3) >> 2;
    }
    if (tid == 0) P[0] = 0;
    __syncthreads();
    if (tid == 0) { int s = 0; for (int i = 1; i <= 256; ++i) { s += P[i]; P[i] = s; } }
    __syncthreads();
    return P[256];
}
DEV void moba_attn_resident(const bf16_t* __restrict__ qrow, bool wactive, int qpos, int wqmin, int wqmax, int kb0, char* smem, f32x16 (&o)[4], float& mrun, float& lrun) {
    const int tid = opaque_tid(), lane = tid & 63, c = lane & 31, hi = lane >> 5;
    bf16x8 qf[8];
#pragma unroll
    for (int ks = 0; ks < 8; ++ks) qf[ks] = *(const bf16x8*)(qrow + 16 * ks + 8 * hi);
#pragma unroll
    for (int i = 0; i < 4; ++i)
#pragma unroll
        for (int rr = 0; rr < 16; ++rr) o[i][rr] = 0.f;
    mrun = -1e30f; lrun = 0.f;
    if (!wactive) return;
    float mnew_ = 0.f;
    auto qk = [&](int t, f32x16 (&sv)[2]) {
        const char* Ks = smem + t * MB_KB + c * MB_KRS + 16 * hi;
#pragma unroll
        for (int kt = 0; kt < 2; ++kt)
#pragma unroll
            for (int rr = 0; rr < 16; ++rr) sv[kt][rr] = 0.f;
#pragma unroll
        for (int ks = 0; ks < 8; ++ks) {
            sv[0] = mfma32(*(const bf16x8*)(Ks + 32 * ks), qf[ks], sv[0]);
            sv[1] = mfma32(*(const bf16x8*)(Ks + 32 * MB_KRS + 32 * ks), qf[ks], sv[1]);
        }
    };
    auto softmax_a = [&](int t, f32x16 (&sv)[2]) {
        const int kb = kb0 + t * 64;
        if (kb + 63 > wqmin) {
#pragma unroll
            for (int kt = 0; kt < 2; ++kt)
#pragma unroll
                for (int rr = 0; rr < 16; ++rr) { const int key = kb + 32 * kt + (rr & 3) + 8 * (rr >> 2) + 4 * hi; if (key > qpos) sv[kt][rr] = -__builtin_inff(); }
        }
        float tmax = sv[0][0];
#pragma unroll
        for (int rr = 1; rr < 16; ++rr) tmax = fmaxf(tmax, sv[0][rr]);
#pragma unroll
        for (int rr = 0; rr < 16; ++rr) tmax = fmaxf(tmax, sv[1][rr]);
        tmax = fmaxf(tmax, shx(tmax, 32, lane));
        const float mnew = fmaxf(mrun, tmax);
        const float alpha = ex2(mrun - mnew);
        mrun = mnew; mnew_ = mnew;
        lrun *= alpha;
        if (!__all(alpha == 1.f)) {
#pragma unroll
            for (int i = 0; i < 4; ++i)
#pragma unroll
                for (int rr = 0; rr < 16; ++rr) o[i][rr] *= alpha;
        }
    };
    auto softmax_b = [&](f32x16 (&sv)[2], bf16x8 (&pf)[2][2]) {
        const float mnew = mnew_;
        float ps = 0.f;
#pragma unroll
        for (int kt = 0; kt < 2; ++kt)
#pragma unroll
            for (int rr = 0; rr < 16; ++rr) { const float pv = ex2(sv[kt][rr] - mnew); sv[kt][rr] = pv; ps += pv; }
        lrun += ps;
#pragma unroll
        for (int kt = 0; kt < 2; ++kt)
#pragma unroll
            for (int s2 = 0; s2 < 2; ++s2) {
                u32x4 pw; pw.x = pk2(sv[kt][8 * s2 + 0], sv[kt][8 * s2 + 1]); pw.y = pk2(sv[kt][8 * s2 + 2], sv[kt][8 * s2 + 3]);
                pw.z = pk2(sv[kt][8 * s2 + 4], sv[kt][8 * s2 + 5]); pw.w = pk2(sv[kt][8 * s2 + 6], sv[kt][8 * s2 + 7]);
                pf[kt][s2] = *(const bf16x8*)&pw;
            }
    };
    auto pv = [&](int t, const bf16x8 (&pf)[2][2]) {
        const char* Vs = smem + 4 * MB_KB + t * MB_VB + c * MB_VRS + 16 * hi;
#pragma unroll
        for (int g = 0; g < 4; ++g)
#pragma unroll
            for (int dvt = 0; dvt < 4; ++dvt) o[dvt] = mfma32(*(const bf16x8*)(Vs + 32 * dvt * MB_VRS + 32 * g), pf[g >> 1][g & 1], o[dvt]);
    };
    auto fstep = [&](int t, f32x16 (&sc)[2], f32x16 (&sn)[2]) {
        constexpr int NA = 16, NG = 32;
        const char* Ks = smem + (t + 1) * MB_KB + c * MB_KRS + 16 * hi;
        const char* Vs = smem + 4 * MB_KB + t * MB_VB + c * MB_VRS + 16 * hi;
        const float mref = mnew_;
        const f32x16 zero16 = {0.f, 0.f, 0.f, 0.f, 0.f, 0.f, 0.f, 0.f, 0.f, 0.f, 0.f, 0.f, 0.f, 0.f, 0.f, 0.f};
        bf16x8 fr[5];
        u32x4 pf4[4];
        float ps0 = 0.f, ps1 = 0.f, plo = 0.f, d1 = 0.f, tmax = 0.f, alpha = 1.f;
        auto fread = [&](int G) -> bf16x8 {
            if (G < NA) return *(const bf16x8*)(Ks + (G & 1) * (32 * MB_KRS) + 32 * (G >> 1));
            return *(const bf16x8*)(Vs + 32 * ((G - NA) & 3) * MB_VRS + 32 * ((G - NA) >> 2));
        };
        auto expfill = [&](int E) {
            if ((E & 1) == 0) {
                const float d0 = sc[E >> 4][E & 15] - mref; d1 = sc[E >> 4][(E & 15) + 1] - mref;
                plo = ex2(d0);
                asm volatile("" : "+v"(plo), "+v"(d1));
            } else {
                const float phi = ex2(d1);
                ps0 += plo; ps1 += phi;
                unsigned wd = pk2(plo, phi);
                asm volatile("" : "+v"(wd), "+v"(ps0), "+v"(ps1));
                pf4[E >> 3][(E >> 1) & 3] = wd;
            }
        };
        auto filler = [&](int G) {
            if (G + 4 < 32) expfill(G + 4);
            const int i0 = G - NA;
            if (i0 >= 0 && i0 < 12) {
                const int first = i0 < 4 ? 2 * i0 : 4 + i0, cnt = i0 < 4 ? 2 : 1;
#pragma unroll
                for (int i = first; i < first + cnt; ++i) {
                    const int kt = i >> 3, r0 = 2 * (i & 7);
                    if (i == 0) tmax = fmaxf(sn[0][0], sn[0][1]); else tmax = fmaxf(fmaxf(tmax, sn[kt][r0]), sn[kt][r0 + 1]);
                }
                asm volatile("" : "+v"(tmax));
            }
            if (i0 == 12) {
                const unsigned tb = __float_as_uint(tmax);
                const auto sw = __builtin_amdgcn_permlane32_swap(tb, tb, false, false);
                tmax = fmaxf(__uint_as_float(sw[0]), __uint_as_float(sw[1]));
                asm volatile("" : "+v"(tmax));
            }
            if (i0 == 13) {
                const float mnew = fmaxf(mrun, tmax);
                alpha = ex2(mrun - mnew);
                mrun = mnew; mnew_ = mnew;
                lrun = (lrun + (ps0 + ps1)) * alpha;
                asm volatile("" : "+v"(alpha), "+v"(lrun));
            }
        };
#pragma unroll
        for (int G = 0; G < 4; ++G) fr[G] = fread(G);
#pragma unroll
        for (int E = 0; E < 4; ++E) expfill(E);
        __builtin_amdgcn_sched_barrier(0);
#pragma unroll
        for (int G = 0; G < NG; ++G) {
            if (G + 4 < NG) fr[(G + 4) % 5] = fread(G + 4);
            if (G < NA) {
                const int ks = G >> 1, kt = G & 1;
                if (ks == 0) sn[kt] = mfma32(fr[G % 5], qf[ks], zero16); else sn[kt] = mfma32(fr[G % 5], qf[ks], sn[kt]);
            } else {
                const int g = G - NA, gg = g >> 2, dvt = g & 3;
                o[dvt] = mfma32(fr[G % 5], *(const bf16x8*)&pf4[gg], o[dvt]);
            }
            filler(G);
            __builtin_amdgcn_sched_barrier(0);
        }
        if (!__all(alpha == 1.f)) {
#pragma unroll
            for (int i = 0; i < 4; ++i)
#pragma unroll
                for (int rr = 0; rr < 16; ++rr) o[i][rr] *= alpha;
        }
    };
    int nt_act = 4;
    if (wqmax != 0x7fffffff) { nt_act = ((wqmax - kb0) >> 6) + 1; if (nt_act > 4) nt_act = 4; }
    f32x16 sA[2], sB[2];
    qk(0, sA);
    if (wqmax == 0x7fffffff) {
        softmax_a(0, sA);
        fstep(0, sA, sB); fstep(1, sB, sA); fstep(2, sA, sB);
        bf16x8 pf[2][2];
        softmax_b(sB, pf); pv(3, pf);
        lrun += shx(lrun, 32, lane);
        return;
    }
    for (int t = 0; t < nt_act; t += 2) {
        {
            bf16x8 pf[2][2];
            softmax_a(t, sA);
            if (t + 1 < nt_act) { qk(t + 1, sB); softmax_b(sA, pf); pv(t, pf); asm volatile("; arm A1" ::: "memory"); }
            else { softmax_b(sA, pf); pv(t, pf); asm volatile("; arm A2" ::: "memory"); }
        }
        if (t + 1 < nt_act) {
            bf16x8 pf[2][2];
            softmax_a(t + 1, sB);
            if (t + 2 < nt_act) { qk(t + 2, sA); softmax_b(sB, pf); pv(t + 1, pf); asm volatile("; arm B1" ::: "memory"); }
            else { softmax_b(sB, pf); pv(t + 1, pf); asm volatile("; arm B2" ::: "memory"); }
        }
    }
    lrun += shx(lrun, 32, lane);
}
DEV void moba_subunit(const Params& p, int su, char* smem) {
    const int tid = opaque_tid(), lane = tid & 63, w = tid >> 6, c = lane & 31, hi = lane >> 5;
    int* pre = (int*)(smem + MB_TAB);
    const int* P = (const int*)(smem + MB_TAB + 256);
    int u = 0;
#pragma unroll
    for (int s = 128; s >= 1; s >>= 1) if (P[u + s] <= su) u += s;
    const int sidx = su - P[u], j = u >> 2, h = u & 3;
    const bf16_t* Kh = p.Kb() + ((size_t)h * S + 256 * j) * 128;
    const bf16_t* Vh = p.VbT() + ((size_t)h * 256 + 4 * j) * (128 * 64);
    __syncthreads();
    if (tid == 0) { int s = 0; for (int t = 0; t < 32; ++t) { pre[t] = s; s += p.segcnt()[((size_t)h * 64 + j) * 32 + t]; } pre[32] = s; }
#pragma unroll
    for (int i = 0; i < 8; ++i) {
        const int ch = tid + NTHREADS * i, row = ch >> 4, cc = ch & 15;
        *(u32x4*)(smem + (row >> 6) * MB_KB + (row & 63) * MB_KRS + cc * 16) = *(const u32x4*)((const char*)Kh + (size_t)ch * 16);
    }
#pragma unroll
    for (int i = 0; i < 8; ++i) {
        const int ch = tid + NTHREADS * i, t = ch >> 10, row = (ch >> 3) & 127, cc = ch & 7;
        const u32x4 v = *(const u32x4*)((const char*)Vh + (size_t)ch * 16);
        char* d = smem + 4 * MB_KB + t * MB_VB + row * MB_VRS + (cc >> 1) * 32 + (cc & 1) * 8;
        *(u32x2*)d = (u32x2){v.x, v.y}; *(u32x2*)(d + 16) = (u32x2){v.z, v.w};
    }
    __syncthreads();
    const int total = pre[32], ntiles = 1 + ((total + 255) >> 8);
    const int k_hi = (4 * sidx + 4) < ntiles ? (4 * sidx + 4) : ntiles;
    for (int k = 4 * sidx; k < k_hi; ++k) {
        const int k0 = (k - 1) * 256;
        int q, slot, qpos, wqmin, wqmax; bool valid, wact;
        if (k0 < 0) {
            q = 256 * j + 32 * w + c; slot = 3; qpos = q; wqmin = 256 * j + 32 * w; wqmax = wqmin + 31; valid = true; wact = true;
        } else {
            const int e = k0 + 32 * w + c; valid = e < total; q = 0; slot = 0;
            if (valid) {
                int seg = 0;
                for (int t = 1; t < 32; ++t) if (pre[t] <= e) seg = t;
                const int ent = p.lists()[(((size_t)h * 64 + j) * 32 + seg) * 512 + (e - pre[seg])];
                q = ent >> 2; slot = ent & 3;
            }
            qpos = 0x7fffffff; wqmin = 0x7fffffff; wqmax = 0x7fffffff; wact = (k0 + 32 * w) < total;
        }
        f32x16 o[4]; float m, l;
        moba_attn_resident(p.Qb() + ((size_t)h * S + q) * 128, wact, qpos, wqmin, wqmax, 256 * j, smem, o, m, l);
        if (valid) moba_write_partial(p, q, h, slot, o, m, l, hi);
    }
}

constexpr int GP_KN = 0, GP_KB = 17408, GP_QS = 34816, GP_RF = 52224, GP_LM = 117760, GP_KDT = 135168, GP_GC = 153600, GP_BT = 153856;
DEV void gdn_prep_unit(const Params& p, int li, int n, int h, char* smem) {
    const int tid = opaque_tid(), lane = tid & 63, w = tid >> 6, r = lane & 15, g = lane >> 4;
    char* Kn16 = smem + GP_KN; char* Kb16 = smem + GP_KB; char* Qs16 = smem + GP_QS;
    float* Rf = (float*)(smem + GP_RF); float* Lm = (float*)(smem + GP_LM); char* KdT = smem + GP_KDT;
    float* gc = (float*)(smem + GP_GC); float* bt = (float*)(smem + GP_BT);
    const size_t cb = (size_t)n * 4 + h;
    __syncthreads();
    if (w == 0) {
        const int tok = 64 * n + lane;
        const float a = p.ba()[(size_t)tok * 8 + 4 + h], bb = p.ba()[(size_t)tok * 8 + h];
        float gv = -expf(p.gdn_a_log[li * 4 + h]) * softplusf(a + p.gdn_dt_bias[li * 4 + h]);
#pragma unroll
        for (int o = 1; o < 64; o <<= 1) { const float t = __int_as_float(__builtin_amdgcn_ds_bpermute((lane - o) << 2, __float_as_int(gv))); if (lane >= o) gv += t; }
        gc[lane] = gv; bt[lane] = 1.f / (1.f + expf(-bb));
    }
    __syncthreads();
    const float glast = gc[63];
    {
        const int tok = tid >> 3, grp = tid & 7, gt = 64 * n + tok;
        const float gct = gc[tok], btt = bt[tok];
        const float egc = expf(gct), egl = expf(glast - gct);
        const float* cw = p.gdn_conv + (size_t)li * 4 * 1536;
#pragma unroll
        for (int part = 0; part < 3; ++part) {
            const int ch0 = part * 512 + h * 128 + grp * 16;
            float val[16];
#pragma unroll
            for (int i = 0; i < 16; ++i) val[i] = 0.f;
#pragma unroll
            for (int j = 0; j < 4; ++j) {
                const int ts = gt - 3 + j;
                if (ts >= 0) {
                    const u32x4* xp = (const u32x4*)(p.proj_a() + (size_t)ts * 1536 + ch0);
                    const u32x4 x0 = xp[0], x1 = xp[1];
                    const f32x4* wp = (const f32x4*)(cw + (size_t)j * 1536 + ch0);
                    const f32x4 w0 = wp[0], w1 = wp[1], w2 = wp[2], w3 = wp[3];
                    val[0] += bflo(x0.x) * w0[0]; val[1] += bfhi(x0.x) * w0[1]; val[2] += bflo(x0.y) * w0[2]; val[3] += bfhi(x0.y) * w0[3];
                    val[4] += bflo(x0.z) * w1[0]; val[5] += bfhi(x0.z) * w1[1]; val[6] += bflo(x0.w) * w1[2]; val[7] += bfhi(x0.w) * w1[3];
                    val[8] += bflo(x1.x) * w2[0]; val[9] += bfhi(x1.x) * w2[1]; val[10] += bflo(x1.y) * w2[2]; val[11] += bfhi(x1.y) * w2[3];
                    val[12] += bflo(x1.z) * w3[0]; val[13] += bfhi(x1.z) * w3[1]; val[14] += bflo(x1.w) * w3[2]; val[15] += bfhi(x1.w) * w3[3];
                }
            }
#pragma unroll
            for (int i = 0; i < 16; ++i) val[i] = siluf(val[i]);
            if (part < 2) {
                float ss = 0.f;
#pragma unroll
                for (int i = 0; i < 16; ++i) ss += val[i] * val[i];
                ss += shx(ss, 1, lane); ss += shx(ss, 2, lane); ss += shx(ss, 4, lane);
                const float rn = rsqrtf(ss + 1e-6f);
#pragma unroll
                for (int i = 0; i < 16; ++i) val[i] *= rn;
            }
            if (part == 0) {
                const float qs = 0.08838834764831845f;
                u32x4 a0, a1, d0, d1;
                a0.x = pk2(val[0] * qs, val[1] * qs); a0.y = pk2(val[2] * qs, val[3] * qs); a0.z = pk2(val[4] * qs, val[5] * qs); a0.w = pk2(val[6] * qs, val[7] * qs);
                a1.x = pk2(val[8] * qs, val[9] * qs); a1.y = pk2(val[10] * qs, val[11] * qs); a1.z = pk2(val[12] * qs, val[13] * qs); a1.w = pk2(val[14] * qs, val[15] * qs);
                *(u32x4*)(Qs16 + tok * 272 + grp * 32) = a0; *(u32x4*)(Qs16 + tok * 272 + grp * 32 + 16) = a1;
                const float qd = qs * egc;
                d0.x = pk2(val[0] * qd, val[1] * qd); d0.y = pk2(val[2] * qd, val[3] * qd); d0.z = pk2(val[4] * qd, val[5] * qd); d0.w = pk2(val[6] * qd, val[7] * qd);
                d1.x = pk2(val[8] * qd, val[9] * qd); d1.y = pk2(val[10] * qd, val[11] * qd); d1.z = pk2(val[12] * qd, val[13] * qd); d1.w = pk2(val[14] * qd, val[15] * qd);
                bf16_t* qo = p.qdec() + (((cb * 4 + (tok >> 4)) * 4 + (grp >> 1)) * 64 + (2 * (grp & 1)) * 16 + (tok & 15)) * 8;
                *(u32x4*)qo = d0; *(u32x4*)(qo + 16 * 8) = d1;
            } else if (part == 1) {
                u32x4 a0, a1, d0, d1;
                a0.x = pk2(val[0], val[1]); a0.y = pk2(val[2], val[3]); a0.z = pk2(val[4], val[5]); a0.w = pk2(val[6], val[7]);
                a1.x = pk2(val[8], val[9]); a1.y = pk2(val[10], val[11]); a1.z = pk2(val[12], val[13]); a1.w = pk2(val[14], val[15]);
                *(u32x4*)(Kn16 + tok * 272 + grp * 32) = a0; *(u32x4*)(Kn16 + tok * 272 + grp * 32 + 16) = a1;
                d0.x = pk2(val[0] * btt, val[1] * btt); d0.y = pk2(val[2] * btt, val[3] * btt); d0.z = pk2(val[4] * btt, val[5] * btt); d0.w = pk2(val[6] * btt, val[7] * btt);
                d1.x = pk2(val[8] * btt, val[9] * btt); d1.y = pk2(val[10] * btt, val[11] * btt); d1.z = pk2(val[12] * btt, val[13] * btt); d1.w = pk2(val[14] * btt, val[15] * btt);
                *(u32x4*)(Kb16 + tok * 272 + grp * 32) = d0; *(u32x4*)(Kb16 + tok * 272 + grp * 32 + 16) = d1;
                const float kb = btt * egc;
#pragma unroll
                for (int i = 0; i < 16; ++i) {
                    Rf[tok * 256 + 128 + grp * 16 + i] = val[i] * kb;
                    *(bf16_t*)(KdT + (grp * 16 + i) * 144 + tok * 2) = f2bf(val[i] * egl);
                }
            } else {
#pragma unroll
                for (int i = 0; i < 16; ++i) Rf[tok * 256 + grp * 16 + i] = val[i] * btt;
            }
        }
    }
    __syncthreads();
#pragma unroll
    for (int tt = 0; tt < 2; ++tt) {
        const int tile = 2 * w + tt, ct = tile >> 2, mt = tile & 3;
        f32x4 accL = {0.f, 0.f, 0.f, 0.f}, accQ = {0.f, 0.f, 0.f, 0.f};
#pragma unroll
        for (int ks = 0; ks < 4; ++ks) {
            const bf16x8 akb = *(const bf16x8*)(Kb16 + (16 * ct + r) * 272 + (32 * ks + 8 * g) * 2);
            const bf16x8 knm = *(const bf16x8*)(Kn16 + (16 * mt + r) * 272 + (32 * ks + 8 * g) * 2);
            const bf16x8 qsc = *(const bf16x8*)(Qs16 + (16 * ct + r) * 272 + (32 * ks + 8 * g) * 2);
            accL = mfma16(akb, knm, accL);
            accQ = mfma16(knm, qsc, accQ);
        }
#pragma unroll
        for (int jj = 0; jj < 4; ++jj) {
            const int ci = 16 * ct + 4 * g + jj, mi = 16 * mt + r;
            Lm[ci * 68 + mi] = (mi < ci) ? accL[jj] * expf(gc[ci] - gc[mi]) : 0.f;
        }
        {
            const int ci = 16 * ct + r;
            f32x4 v;
#pragma unroll
            for (int jj = 0; jj < 4; ++jj) { const int mi = 16 * mt + 4 * g + jj; v[jj] = (mi <= ci) ? accQ[jj] * expf(gc[ci] - gc[mi]) : 0.f; }
            { const int m0_ = 16 * mt + 4 * g;
              st_bf4(p.qk() + (((cb * 4 + ct) * 2 + (m0_ >> 5)) * 64 + ((m0_ >> 3) & 3) * 16 + r) * 8 + (m0_ & 7), v); }
        }
    }
#pragma unroll
    for (int i = 0; i < 2; ++i) {
        const int ch = tid + NTHREADS * i, row = ch >> 3, cc = ch & 7;
        *(u32x4*)(p.kdT() + (((cb * 8 + (row >> 4)) * 2 + (cc >> 2)) * 64 + (cc & 3) * 16 + (row & 15)) * 8) = *(const u32x4*)(KdT + row * 144 + cc * 16);
    }
    __syncthreads();
    if (w < 4) {
        const int col = tid;
        float x[64];
#pragma unroll
        for (int i = 0; i < 64; ++i) {
            float a = Rf[i * 256 + col];
#pragma unroll
            for (int j4 = 0; j4 < (i + 3) / 4; ++j4) {
                const f32x4 l4 = *(const f32x4*)(Lm + i * 68 + 4 * j4);
#pragma unroll
                for (int jj = 0; jj < 4; ++jj) if (4 * j4 + jj < i) a -= l4[jj] * x[4 * j4 + jj];
            }
            x[i] = a;
        }
        if (col < 128) {
#pragma unroll
            for (int i4 = 0; i4 < 16; ++i4) {
                float* up_ = p.u32() + ((((cb * 4 + (i4 >> 2)) * 8 + (col >> 4)) * 64 + (i4 & 3) * 16 + (col & 15)) * 4);
                *(f32x4*)up_ = (f32x4){x[4 * i4], x[4 * i4 + 1], x[4 * i4 + 2], x[4 * i4 + 3]};
            }
        } else {
#pragma unroll
            for (int i = 0; i < 64; ++i) { const int cc_ = col - 128; p.wneg()[(((cb * 4 + (i >> 4)) * 4 + (cc_ >> 5)) * 64 + ((cc_ >> 3) & 3) * 16 + (i & 15)) * 8 + (cc_ & 7)] = f2bf(-x[i]); }
        }
    }
    if (tid == 0) p.glast()[cb] = expf(glast);
}

struct ScanFr { bf16x8 af[4]; bf16x8 kdf[2]; u32x4 uq[2]; float eg; };
DEV void gdn_scan_seg(const Params& p, int sw, int seg, float* __restrict__ scanst, char* smem) {
    const int tid = opaque_tid(), lane = tid & 63, w = tid >> 6, r = lane & 15, g = lane >> 4;
    const int h = sw >> 2, dvb = (sw & 3) * 32;
    const bool lead = w < 4; const int mt = w & 3;
    char* S16 = smem; char* Vn16 = smem + 8704;
    const int nbeg = seg * 64, nend = nbeg + 64;
    float* stp = scanst + ((size_t)sw * NTHREADS + tid) * 8;
    __syncthreads();
    f32x4 sacc[2] = {{0.f, 0.f, 0.f, 0.f}, {0.f, 0.f, 0.f, 0.f}};
    if (seg > 0) { sacc[0] = *(const f32x4*)stp; sacc[1] = *(const f32x4*)(stp + 4); }
#pragma unroll
    for (int n2 = 0; n2 < 2; ++n2)
        *(u32x2*)(S16 + (16 * n2 + r) * 272 + (16 * w + 4 * g) * 2) = (u32x2){pk2(sacc[n2][0], sacc[n2][1]), pk2(sacc[n2][2], sacc[n2][3])};
    auto load = [&](int n, ScanFr& f) {
        const size_t cb = (size_t)n * 4 + h;
        const bf16_t* ap = (lead ? p.wneg() : p.qdec()) + ((cb * 4 + mt) * 4) * 512 + lane * 8;
#pragma unroll
        for (int ks = 0; ks < 4; ++ks) f.af[ks] = *(const bf16x8*)(ap + ks * 512);
        const bf16_t* kp = p.kdT() + ((cb * 8 + w) * 2) * 512 + lane * 8;
#pragma unroll
        for (int ks = 0; ks < 2; ++ks) f.kdf[ks] = *(const bf16x8*)(kp + ks * 512);
        {
            const char* up = lead ? (const char*)(p.u32() + (((cb * 4 + mt) * 8 + (dvb >> 4)) * 64 + lane) * 4) : (const char*)(p.qk() + ((cb * 4 + mt) * 2) * 512 + lane * 8);
            f.uq[0] = *(const u32x4*)up; f.uq[1] = *(const u32x4*)(up + 1024);
        }
        f.eg = p.glast()[cb];
    };
    ScanFr fA, fB, fC, fD; load(nbeg, fA); load(nbeg + 1, fB); load(nbeg + 2, fC);
    __syncthreads();
    auto step = [&](int n, ScanFr& cu, ScanFr& nx3) {
        f32x4 a[2];
        if (lead) { a[0] = *(const f32x4*)&cu.uq[0]; a[1] = *(const f32x4*)&cu.uq[1]; } else { a[0] = (f32x4){0.f, 0.f, 0.f, 0.f}; a[1] = a[0]; }
        {
            bf16x8 sf[4][2];
#pragma unroll
            for (int ks = 0; ks < 4; ++ks)
#pragma unroll
                for (int nt = 0; nt < 2; ++nt) sf[ks][nt] = *(const bf16x8*)(S16 + (16 * nt + r) * 272 + (32 * ks + 8 * g) * 2);
            __builtin_amdgcn_sched_barrier(0);
#pragma unroll
            for (int ks = 0; ks < 4; ++ks)
#pragma unroll
                for (int nt = 0; nt < 2; ++nt) a[nt] = mfma16(cu.af[ks], sf[ks][nt], a[nt]);
        }
        if (lead) {
#pragma unroll
            for (int nt = 0; nt < 2; ++nt)
                *(u32x2*)(Vn16 + (16 * nt + r) * 144 + (16 * mt + 4 * g) * 2) = (u32x2){pk2(a[nt][0], a[nt][1]), pk2(a[nt][2], a[nt][3])};
        }
        __builtin_amdgcn_sched_barrier(0);
        if (n + 3 < nend) load(n + 3, nx3);
        asm volatile("s_waitcnt lgkmcnt(0)" ::: "memory"); __builtin_amdgcn_s_barrier(); asm volatile("" ::: "memory");
        bf16x8 vf[2][2];
#pragma unroll
        for (int nt = 0; nt < 2; ++nt)
#pragma unroll
            for (int ks = 0; ks < 2; ++ks) vf[nt][ks] = *(const bf16x8*)(Vn16 + (16 * nt + r) * 144 + (32 * ks + 8 * g) * 2);
        if (!lead) {
#pragma unroll
            for (int nt = 0; nt < 2; ++nt) {
#pragma unroll
                for (int ks = 0; ks < 2; ++ks) a[nt] = mfma16(*(const bf16x8*)&cu.uq[ks], vf[nt][ks], a[nt]);
                *(f32x4*)(p.oa() + ((((size_t)n * 4 + mt) * 32 + (h * 8 + (dvb >> 4) + nt)) * 64 + lane) * 4) = a[nt];
            }
        }
#pragma unroll
        for (int n2 = 0; n2 < 2; ++n2) {
            sacc[n2] = sacc[n2] * cu.eg;
#pragma unroll
            for (int ks = 0; ks < 2; ++ks) sacc[n2] = mfma16(cu.kdf[ks], vf[n2][ks], sacc[n2]);
            *(u32x2*)(S16 + (16 * n2 + r) * 272 + (16 * w + 4 * g) * 2) = (u32x2){pk2(sacc[n2][0], sacc[n2][1]), pk2(sacc[n2][2], sacc[n2][3])};
        }
        asm volatile("s_waitcnt lgkmcnt(0)" ::: "memory"); __builtin_amdgcn_s_barrier(); asm volatile("" ::: "memory");
    };
    for (int n = nbeg; n < nend; n += 4) { step(n, fA, fD); step(n + 1, fB, fA); step(n + 2, fC, fB); step(n + 3, fD, fC); }
    *(f32x4*)stp = sacc[0]; *(f32x4*)(stp + 4) = sacc[1];
}

DEV void phase_even_combine(const Params& p, int li) {
    const int tid = opaque_tid(), lane = tid & 63, w = __builtin_amdgcn_readfirstlane(tid >> 6), hh = lane >> 4, d0 = (lane & 15) * 8;
    for (int tok = opaque_bid() * 8 + w; tok < S; tok += gridDim.x * 8) {
        {
            const int col0 = hh * 128 + d0;
            const float* op = p.oa() + (((((size_t)(tok >> 6)) * 4 + ((tok & 63) >> 4)) * 32 + (col0 >> 4)) * 64 + ((tok & 15) >> 2) * 16 + (col0 & 15)) * 4 + (tok & 3);
            const f32x4 a = {op[0], op[4], op[8], op[12]}, b = {op[16], op[20], op[24], op[28]};
            float ss = a[0] * a[0] + a[1] * a[1] + a[2] * a[2] + a[3] * a[3] + b[0] * b[0] + b[1] * b[1] + b[2] * b[2] + b[3] * b[3];
            ss += shx(ss, 1, lane); ss += shx(ss, 2, lane); ss += shx(ss, 4, lane); ss += shx(ss, 8, lane);
            const float rn = rsqrtf(ss * (1.f / 128.f) + 1e-6f);
            const u32x4 z = *(const u32x4*)(p.zbuf() + (size_t)tok * 512 + hh * 128 + d0);
            const f32x4 n0 = *(const f32x4*)(p.gdn_o_norm + li * 128 + d0), n1 = *(const f32x4*)(p.gdn_o_norm + li * 128 + d0 + 4);
            u32x4 o;
            o.x = pk2(a[0] * rn * n0[0] * siluf(bflo(z.x)), a[1] * rn * n0[1] * siluf(bfhi(z.x)));
            o.y = pk2(a[2] * rn * n0[2] * siluf(bflo(z.y)), a[3] * rn * n0[3] * siluf(bfhi(z.y)));
            o.z = pk2(b[0] * rn * n1[0] * siluf(bflo(z.z)), b[1] * rn * n1[1] * siluf(bfhi(z.z)));
            o.w = pk2(b[2] * rn * n1[2] * siluf(bflo(z.w)), b[3] * rn * n1[3] * siluf(bfhi(z.w)));
            *(u32x4*)(p.cat() + (size_t)tok * DM + hh * 128 + d0) = o;
        }
        {
            const int own = tok >> 8, nsel = own < 3 ? own : 3;
            const float* mlp = p.ml() + ((size_t)tok * 4 + hh) * 8;
            const bf16_t* pp = (const bf16_t*)p.part() + ((size_t)tok * 4 + hh) * 4 * 128 + d0;
            const float m3 = mlp[6], l3 = mlp[7];
            float ms[3], ls[3]; float mm = m3;
#pragma unroll
            for (int s = 0; s < 3; ++s) { ms[s] = -1e30f; ls[s] = 0.f; if (s < nsel) { ms[s] = mlp[2 * s]; ls[s] = mlp[2 * s + 1]; mm = fmaxf(mm, ms[s]); } }
            float wt = ex2(m3 - mm) * l3, den = wt;
            f32x4 a, b;
            { const u32x4 v = *(const u32x4*)(pp + 3 * 128); a = (f32x4){bflo(v.x), bfhi(v.x), bflo(v.y), bfhi(v.y)} * wt; b = (f32x4){bflo(v.z), bfhi(v.z), bflo(v.w), bfhi(v.w)} * wt; }
#pragma unroll
            for (int s = 0; s < 3; ++s) if (s < nsel) {
                wt = ex2(ms[s] - mm) * ls[s]; den += wt;
                const u32x4 v = *(const u32x4*)(pp + s * 128);
                a += (f32x4){bflo(v.x), bfhi(v.x), bflo(v.y), bfhi(v.y)} * wt; b += (f32x4){bflo(v.z), bfhi(v.z), bflo(v.w), bfhi(v.w)} * wt;
            }
            const float inv = 1.f / den;
            u32x4 o; o.x = pk2(a[0] * inv, a[1] * inv); o.y = pk2(a[2] * inv, a[3] * inv); o.z = pk2(b[0] * inv, b[1] * inv); o.w = pk2(b[2] * inv, b[3] * inv);
            *(u32x4*)(p.cat() + (size_t)tok * DM + 512 + hh * 128 + d0) = o;
        }
    }
}

DEV void phase_mla_cnorm(const Params& p, int li) {
    const int tid = opaque_tid(), lane = tid & 63, w = __builtin_amdgcn_readfirstlane(tid >> 6);
    for (int row = opaque_bid() * 8 + w; row < S; row += gridDim.x * 8) {
        const bf16_t* cp = p.cbuf() + (size_t)row * 768;
        const u32x4 qv = *(const u32x4*)(cp + lane * 8);
        const u32x2 kv = *(const u32x2*)(cp + 512 + lane * 4);
        float q[8] = {bflo(qv.x), bfhi(qv.x), bflo(qv.y), bfhi(qv.y), bflo(qv.z), bfhi(qv.z), bflo(qv.w), bfhi(qv.w)};
        float k[4] = {bflo(kv.x), bfhi(kv.x), bflo(kv.y), bfhi(kv.y)};
        float sq = 0.f, sk = 0.f;
#pragma unroll
        for (int i = 0; i < 8; ++i) sq += q[i] * q[i];
#pragma unroll
        for (int i = 0; i < 4; ++i) sk += k[i] * k[i];
        sq = wsum64(sq, lane); sk = wsum64(sk, lane);
        const float rq = rsqrtf(sq * (1.f / 512.f) + 1e-6f), rk = rsqrtf(sk * (1.f / 256.f) + 1e-6f);
        const float* qn = p.mla_q_norm + li * 512 + lane * 8; const float* kn = p.mla_kv_norm + li * 256 + lane * 4;
        u32x4 oq; oq.x = pk2(q[0] * rq * qn[0], q[1] * rq * qn[1]); oq.y = pk2(q[2] * rq * qn[2], q[3] * rq * qn[3]);
        oq.z = pk2(q[4] * rq * qn[4], q[5] * rq * qn[5]); oq.w = pk2(q[6] * rq * qn[6], q[7] * rq * qn[7]);
        *(u32x4*)(p.cqn() + (size_t)row * 512 + lane * 8) = oq;
        u32x2 ok; ok.x = pk2(k[0] * rk * kn[0], k[1] * rk * kn[1]); ok.y = pk2(k[2] * rk * kn[2], k[3] * rk * kn[3]);
        *(u32x2*)(p.ckvn() + (size_t)row * 256 + lane * 4) = ok;
    }
}

#define SORT16_NET(CE) CE(0,1) CE(2,3) CE(0,2) CE(1,3) CE(1,2) CE(4,5) CE(6,7) CE(4,6) CE(5,7) CE(5,6) CE(0,4) CE(2,6) CE(2,4) CE(1,5) CE(3,7) CE(3,5) CE(1,2) CE(3,4) CE(5,6) CE(8,9) CE(10,11) CE(8,10) CE(9,11) CE(9,10) CE(12,13) CE(14,15) CE(12,14) CE(13,15) CE(13,14) CE(8,12) CE(10,14) CE(10,12) CE(9,13) CE(11,15) CE(11,13) CE(9,10) CE(11,12) CE(13,14) CE(0,8) CE(4,12) CE(4,8) CE(2,10) CE(6,14) CE(6,10) CE(2,4) CE(6,8) CE(10,12) CE(1,9) CE(5,13) CE(5,9) CE(3,11) CE(7,15) CE(7,11) CE(3,5) CE(7,9) CE(11,13) CE(1,2) CE(3,4) CE(5,6) CE(7,8) CE(9,10) CE(11,12) CE(13,14)

template <int OFF> DEV void sort16(float (&v)[64]) {
#define CE_(a, b) { const float hi_ = fmaxf(v[OFF + a], v[OFF + b]), lo_ = fminf(v[OFF + a], v[OFF + b]); v[OFF + a] = hi_; v[OFF + b] = lo_; }
    SORT16_NET(CE_)
#undef CE_
}
template <int A> DEV void bitonic16(float (&v)[64]) {
#pragma unroll
    for (int d = 8; d >= 1; d >>= 1)
#pragma unroll
        for (int i = 0; i < 16; ++i) if ((i & d) == 0) { const float hi_ = fmaxf(v[A + i], v[A + i + d]), lo_ = fminf(v[A + i], v[A + i + d]); v[A + i] = hi_; v[A + i + d] = lo_; }
}
template <int A, int B> DEV void merge16(float (&v)[64]) {
#pragma unroll
    for (int i = 0; i < 16; ++i) v[A + i] = fmaxf(v[A + i], v[B + 15 - i]);
    bitonic16<A>(v);
}
DEV void top16_of_64(float (&v)[64]) {
    sort16<0>(v); sort16<16>(v); sort16<32>(v); sort16<48>(v);
    merge16<0, 16>(v); merge16<32, 48>(v); merge16<0, 32>(v);
}

DEV void phase_peer_topk(const Params& p, int layer, char* smem) {
    const int tid = opaque_tid(), lane = tid & 63, w = tid >> 6, c = lane & 31, hi = lane >> 5;
    char* SK = smem;
    constexpr int CI[50] = {0,0,0,0,0,0,0,0,0,0,0,0,0,0,0,0, 1,1,1,1,1,1,1,1, 2,2,2,2,2, 3,3,3,3, 4,4,4, 5,5, 6,6, 7,7, 8,9,10,11,12,13,14,15};
    constexpr int CJ[50] = {0,1,2,3,4,5,6,7,8,9,10,11,12,13,14,15, 0,1,2,3,4,5,6,7, 0,1,2,3,4, 0,1,2,3, 0,1,2, 0,1, 0,1, 0,1, 0,0,0,0,0,0,0,0};
    int loaded_h = -1;
    for (int u = opaque_bid(); u < 512; u += gridDim.x) {
        const int h = u & 7, tg = u >> 3;
        if (h != loaded_h) {
            __syncthreads();
#pragma unroll
            for (int i = 0; i < 8; ++i) {
                const int ch = tid + NTHREADS * i, pp = ch >> 11, rem = ch & 2047, row = rem >> 4, cc = rem & 15;
                *(u32x4*)(SK + pp * 34816 + row * 272 + cc * 16) = *(const u32x4*)(p.skb() + ((((size_t)layer * 8 + h) * 2 + pp) * 128 + row) * 128 + cc * 8);
            }
            __syncthreads();
            loaded_h = h;
        }
        const int token = tg * 256 + 32 * w + c;
        float s0[16], s1[16];
#pragma unroll
        for (int pp = 0; pp < 2; ++pp) {
            bf16x8 qf[8];
            const bf16_t* qp = p.qbuf() + (size_t)token * 2048 + (h * 2 + pp) * 128 + 8 * hi;
#pragma unroll
            for (int ks = 0; ks < 8; ++ks) qf[ks] = *(const bf16x8*)(qp + 16 * ks);
            float v[64];
#pragma unroll
            for (int kt = 0; kt < 4; ++kt) {
                f32x16 acc;
#pragma unroll
                for (int rr = 0; rr < 16; ++rr) acc[rr] = 0.f;
#pragma unroll
                for (int ks = 0; ks < 8; ++ks) acc = mfma32(*(const bf16x8*)(SK + pp * 34816 + (32 * kt + c) * 272 + (16 * ks + 8 * hi) * 2), qf[ks], acc);
#pragma unroll
                for (int rr = 0; rr < 16; ++rr) {
                    const unsigned idx = (unsigned)(32 * kt + (rr & 3) + 8 * (rr >> 2) + 4 * hi);
                    v[16 * kt + rr] = __uint_as_float((__float_as_uint(acc[rr]) & ~127u) | idx);
                }
            }
            top16_of_64(v);
#pragma unroll
            for (int i = 0; i < 16; ++i) v[16 + i] = shx(v[15 - i], 32, lane);
#pragma unroll
            for (int i = 0; i < 16; ++i) v[i] = fmaxf(v[i], v[16 + i]);
            bitonic16<0>(v);
#pragma unroll
            for (int i = 0; i < 16; ++i) { if (pp == 0) s0[i] = v[i]; else s1[i] = v[i]; }
        }
        float cv[64];
#pragma unroll
        for (int k = 0; k < 50; ++k) {
            const float a = s0[CI[k]], b = s1[CJ[k]];
            const unsigned id = ((__float_as_uint(a) & 127u) << 7) | (__float_as_uint(b) & 127u);
            cv[k] = __uint_as_float((__float_as_uint(a + b) & ~0x3FFFu) | id);
        }
#pragma unroll
        for (int k = 50; k < 64; ++k) cv[k] = -__builtin_inff();
        top16_of_64(cv);
        float e[16], sum = 0.f;
#pragma unroll
        for (int i = 0; i < 16; ++i) { e[i] = expf(cv[i] - cv[0]); sum += e[i]; }
        const float inv = 1.f / sum;
        if (hi == 0) {
            int* ep = p.expert() + (size_t)token * 128 + h * 16; float* gp = p.gate() + (size_t)token * 128 + h * 16;
#pragma unroll
            for (int i4 = 0; i4 < 4; ++i4) {
                i32x4 ev; ev.x = (int)(__float_as_uint(cv[4 * i4]) & 0x3FFFu); ev.y = (int)(__float_as_uint(cv[4 * i4 + 1]) & 0x3FFFu);
                ev.z = (int)(__float_as_uint(cv[4 * i4 + 2]) & 0x3FFFu); ev.w = (int)(__float_as_uint(cv[4 * i4 + 3]) & 0x3FFFu);
                *(i32x4*)(ep + 4 * i4) = ev;
                *(f32x4*)(gp + 4 * i4) = (f32x4){e[4 * i4] * inv, e[4 * i4 + 1] * inv, e[4 * i4 + 2] * inv, e[4 * i4 + 3] * inv};
            }
        }
    }
}

DEV void unpack_fp4x16(const u32x2& r, f32x2 (&f)[8]) {
#pragma unroll
    for (int q = 0; q < 2; ++q) {
        f[4 * q + 0] = __builtin_amdgcn_cvt_scalef32_pk_f32_fp4(r[q], 1.0f, 0);
        f[4 * q + 1] = __builtin_amdgcn_cvt_scalef32_pk_f32_fp4(r[q], 1.0f, 1);
        f[4 * q + 2] = __builtin_amdgcn_cvt_scalef32_pk_f32_fp4(r[q], 1.0f, 2);
        f[4 * q + 3] = __builtin_amdgcn_cvt_scalef32_pk_f32_fp4(r[q], 1.0f, 3);
    }
}

template <int NMODE>
DEV void phase_peer_gather(const Params& p, int layer, const float* __restrict__ g2, const float* __restrict__ xsrc, float* __restrict__ xdst,
                           const float* __restrict__ nw, const float* __restrict__ shv, const float* __restrict__ scv, const float* __restrict__ w8src, char* smem) {
    const int tid = opaque_tid(), lane = tid & 63, w = __builtin_amdgcn_readfirstlane(tid >> 6);
    float* W8 = (float*)smem;
    if (NMODE == 1) {
        for (int i = tid; i < 8192; i += NTHREADS) { const int k = i >> 3, c = i & 7; W8[c * 1024 + k] = w8src[(size_t)k * HY_IN + 2048 + c]; }
        __syncthreads();
    }
    f32x4 wm[4], sh[4];
#pragma unroll
    for (int i = 0; i < 4; ++i) {
        const f32x4 nv = *(const f32x4*)(nw + lane * 16 + 4 * i);
        if (NMODE == 2) { wm[i] = nv; sh[i] = (f32x4){0.f, 0.f, 0.f, 0.f}; }
        else { wm[i] = nv * (*(const f32x4*)(scv + lane * 16 + 4 * i) + 1.0f); sh[i] = *(const f32x4*)(shv + lane * 16 + 4 * i); }
    }
    const unsigned char* ub = p.ub() + (size_t)layer * 16384 * 512; const unsigned char* vb = p.vb() + (size_t)layer * 16384 * 512;
    const unsigned lo8 = (unsigned)lane * 8u;
    const int idxl = ((lane >> 5) & 1) * 8 + ((lane >> 4) & 1) * 4 + ((lane >> 3) & 1) * 2 + ((lane >> 2) & 1);
    for (int tok = opaque_bid() * 8 + w; tok < S; tok += gridDim.x * 8) {
        int hA0, hA1, hB0, hB1; float kh;
        {
            const u32x4 h0 = *(const u32x4*)(p.h() + (size_t)tok * DM + lane * 16), h1 = *(const u32x4*)(p.h() + (size_t)tok * DM + lane * 16 + 8);
            float hf[16] = {bflo(h0.x), bfhi(h0.x), bflo(h0.y), bfhi(h0.y), bflo(h0.z), bfhi(h0.z), bflo(h0.w), bfhi(h0.w),
                            bflo(h1.x), bfhi(h1.x), bflo(h1.y), bfhi(h1.y), bflo(h1.z), bfhi(h1.z), bflo(h1.w), bfhi(h1.w)};
            float mx = 0.f;
#pragma unroll
            for (int i = 0; i < 16; ++i) mx = fmaxf(mx, fabsf(hf[i]));
#pragma unroll
            for (int o = 32; o; o >>= 1) mx = fmaxf(mx, shx(mx, o, lane));
            kh = 119.f / fmaxf(mx, 1e-20f);
            unsigned a0 = 0, a1 = 0, b0 = 0, b1 = 0;
#pragma unroll
            for (int i = 0; i < 16; ++i) {
                const int h8 = (int)__builtin_rintf(hf[i] * kh);
                const int lo = ((h8 + 8) & 15) - 8, hi4 = (h8 - lo) >> 4;
                if (i < 8) { a0 |= ((unsigned)hi4 & 15u) << (4 * i); b0 |= ((unsigned)lo & 15u) << (4 * i); }
                else { a1 |= ((unsigned)hi4 & 15u) << (4 * (i - 8)); b1 |= ((unsigned)lo & 15u) << (4 * (i - 8)); }
            }
            hA0 = (int)a0; hA1 = (int)a1; hB0 = (int)b0; hB1 = (int)b1;
        }
        const int e0 = p.expert()[(size_t)tok * 128 + lane], e1 = p.expert()[(size_t)tok * 128 + 64 + lane];
        u32x2 rA[16], rB[16];
        auto req = [&](int bi, u32x2 (&rr)[16]) {
            const unsigned char* tb = bi < 8 ? ub : vb; const int b = bi & 7;
#pragma unroll
            for (int k = 0; k < 16; ++k) {
                const int e = __builtin_amdgcn_readlane(b < 4 ? e0 : e1, (b & 3) * 16 + k);
                rr[k] = *(const u32x2*)(tb + ((unsigned)e * 512u + lo8));
            }
        };
        float coef[8];
        f32x2 acc[8];
#pragma unroll
        for (int i = 0; i < 8; ++i) acc[i] = (f32x2){0.f, 0.f};
        auto use_u = [&](int b, const u32x2 (&rr)[16]) {
            float pt[16];
#pragma unroll
            for (int k = 0; k < 16; ++k) {
                int shi = __builtin_amdgcn_sdot8((int)rr[k].x, hA0, 0, false); shi = __builtin_amdgcn_sdot8((int)rr[k].y, hA1, shi, false);
                int slo = __builtin_amdgcn_sdot8((int)rr[k].x, hB0, 0, false); slo = __builtin_amdgcn_sdot8((int)rr[k].y, hB1, slo, false);
                pt[k] = (float)(16 * shi + slo);
            }
#pragma unroll
            for (int k = 0; k < 8; ++k) { const bool up = (lane & 32) != 0; const float send = up ? pt[k] : pt[k + 8], keep = up ? pt[k + 8] : pt[k]; pt[k] = keep + shx(send, 32, lane); }
#pragma unroll
            for (int k = 0; k < 4; ++k) { const bool up = (lane & 16) != 0; const float send = up ? pt[k] : pt[k + 4], keep = up ? pt[k + 4] : pt[k]; pt[k] = keep + shx(send, 16, lane); }
#pragma unroll
            for (int k = 0; k < 2; ++k) { const bool up = (lane & 8) != 0; const float send = up ? pt[k] : pt[k + 2], keep = up ? pt[k + 2] : pt[k]; pt[k] = keep + shx(send, 8, lane); }
            { const bool up = (lane & 4) != 0; const float send = up ? pt[0] : pt[1], keep = up ? pt[1] : pt[0]; pt[0] = keep + shx(send, 4, lane); }
            pt[0] += shx(pt[0], 2, lane); pt[0] += shx(pt[0], 1, lane);
            const float gv = p.gate()[(size_t)tok * 128 + b * 16 + idxl];
            const float d = pt[0] * (1.f / 96.f) / kh;
            coef[b] = gv * 0.5f * d * (1.f + erff(d * 0.70710678118654752f)) * 0.176776695f;
        };
        auto use_v = [&](int b, const u32x2 (&rr)[16]) {
#pragma unroll
            for (int k = 0; k < 16; ++k) {
                const int src = ((k >> 3) & 1) * 32 + ((k >> 2) & 1) * 16 + ((k >> 1) & 1) * 8 + (k & 1) * 4;
                const float cf = __uint_as_float((unsigned)__builtin_amdgcn_readlane((int)__float_as_uint(coef[b]), src));
                f32x2 f[8]; unpack_fp4x16(rr[k], f);
                const f32x2 cf2 = (f32x2){cf, cf};
#pragma unroll
                for (int i = 0; i < 8; ++i) acc[i] += cf2 * f[i];
            }
        };
        req(0, rA);
#pragma unroll
        for (int bi = 0; bi < 16; bi += 2) {
            req(bi + 1, rB);
            if (bi < 8) use_u(bi, rA); else use_v(bi - 8, rA);
            __builtin_amdgcn_sched_barrier(0);
            if (bi + 2 < 16) req(bi + 2, rA);
            if (bi + 1 < 8) use_u(bi + 1, rB); else use_v(bi + 1 - 8, rB);
            __builtin_amdgcn_sched_barrier(0);
        }
        const float* xp = xsrc + (size_t)tok * DM + lane * 16; float* xo = xdst + (size_t)tok * DM + lane * 16; const float* gp = g2 + lane * 16;
        f32x4 xn[4]; float ss = 0.f;
#pragma unroll
        for (int i4 = 0; i4 < 4; ++i4) {
            const f32x4 xv = *(const f32x4*)(xp + 4 * i4), gg = *(const f32x4*)(gp + 4 * i4);
            f32x4 o; o[0] = xv[0] + gg[0] * acc[2 * i4][0]; o[1] = xv[1] + gg[1] * acc[2 * i4][1]; o[2] = xv[2] + gg[2] * acc[2 * i4 + 1][0]; o[3] = xv[3] + gg[3] * acc[2 * i4 + 1][1];
            if (NMODE != 2) *(f32x4*)(xo + 4 * i4) = o;
            xn[i4] = o; ss += o[0] * o[0] + o[1] * o[1] + o[2] * o[2] + o[3] * o[3];
        }
        ss = wsum64(ss, lane);
        const float rn = rsqrtf(ss * (1.f / 1024.f) + 1e-6f);
#pragma unroll
        for (int i4 = 0; i4 < 4; ++i4) xn[i4] = xn[i4] * rn * wm[i4] + sh[i4];
        if (NMODE == 2) {
#pragma unroll
            for (int i4 = 0; i4 < 4; ++i4) *(f32x4*)(p.out + (size_t)tok * DM + lane * 16 + 4 * i4) = xn[i4];
        } else {
            u32x4 o0, o1;
            o0.x = pk2(xn[0][0], xn[0][1]); o0.y = pk2(xn[0][2], xn[0][3]); o0.z = pk2(xn[1][0], xn[1][1]); o0.w = pk2(xn[1][2], xn[1][3]);
            o1.x = pk2(xn[2][0], xn[2][1]); o1.y = pk2(xn[2][2], xn[2][3]); o1.z = pk2(xn[3][0], xn[3][1]); o1.w = pk2(xn[3][2], xn[3][3]);
            *(u32x4*)(p.h() + (size_t)tok * DM + lane * 16) = o0; *(u32x4*)(p.h() + (size_t)tok * DM + lane * 16 + 8) = o1;
        }
        if (NMODE == 1) {
            float pc[8];
#pragma unroll
            for (int c = 0; c < 8; ++c) {
                float a = 0.f;
#pragma unroll
                for (int i4 = 0; i4 < 4; ++i4) { const f32x4 ww = *(const f32x4*)(W8 + c * 1024 + lane * 16 + 4 * i4); a += xn[i4][0] * ww[0] + xn[i4][1] * ww[1] + xn[i4][2] * ww[2] + xn[i4][3] * ww[3]; }
                pc[c] = wsum64(a, lane);
            }
            if (lane == 0) { *(f32x4*)(p.ba() + (size_t)tok * 8) = (f32x4){pc[0], pc[1], pc[2], pc[3]}; *(f32x4*)(p.ba() + (size_t)tok * 8 + 4) = (f32x4){pc[4], pc[5], pc[6], pc[7]}; }
        }
    }
}

extern __shared__ __attribute__((aligned(16))) char smem_raw[];
DEV char* smem_user() { LAS char* q = (LAS char*)smem_raw + LDS_USER; asm volatile("" : "+s"(q)); return (char*)q; }
typedef const __attribute__((address_space(4))) Params* KParams;
DEV void load_params(Params& p) {
    auto kp0 = __builtin_amdgcn_kernarg_segment_ptr();
    asm volatile("" : "+s"(kp0));
    KParams kp = (KParams)kp0;
    p.x = kp->x;
    p.c = kp->c;
    p.pos = kp->pos;
    p.mod_w = kp->mod_w;
    p.mod_b = kp->mod_b;
    p.norm_mix = kp->norm_mix;
    p.norm_ffn = kp->norm_ffn;
    p.hy_w_in = kp->hy_w_in;
    p.gdn_conv = kp->gdn_conv;
    p.gdn_a_log = kp->gdn_a_log;
    p.gdn_dt_bias = kp->gdn_dt_bias;
    p.gdn_o_norm = kp->gdn_o_norm;
    p.hy_w_out = kp->hy_w_out;
    p.mla_w_in = kp->mla_w_in;
    p.mla_q_norm = kp->mla_q_norm;
    p.mla_kv_norm = kp->mla_kv_norm;
    p.mla_w_uq = kp->mla_w_uq;
    p.mla_w_ukv = kp->mla_w_ukv;
    p.mla_w_out = kp->mla_w_out;
    p.peer_w_q = kp->peer_w_q;
    p.peer_sub_keys = kp->peer_sub_keys;
    p.peer_u = kp->peer_u;
    p.peer_v = kp->peer_v;
    p.final_norm = kp->final_norm;
    p.out = kp->out;
    p.ws = kp->ws;
    p.ph_lo = kp->ph_lo;
    p.ph_hi = kp->ph_hi;
    p.use_bar = kp->use_bar;
    p.pad0 = kp->pad0;
}
#ifdef PH_NOINLINE
#define NOINL __device__ __noinline__
#else
#define NOINL __device__ __forceinline__
#endif

NOINL void f_prologue() { Params p; load_params(p);
#ifdef REP_P0
    phase_prologue(p, smem_user());
#endif
    phase_prologue(p, smem_user()); }
NOINL void f_norm_e0(int layer) {
    Params p; load_params(p); const float* mod = p.mod() + layer * 6144; const int li = layer >> 1;
    phase_norm<1>(layer == 0 ? p.x : p.xw(), p.norm_mix + layer * DM, mod, mod + 1024, p.h(), nullptr, p.hy_w_in + (size_t)li * 1024 * HY_IN, p.ba(), smem_user());
}
NOINL void f_norm_plain(int layer, int which) {
    Params p; load_params(p); const float* mod = p.mod() + layer * 6144;
    if (which == 0) phase_norm<0>(p.xw(), p.norm_mix + layer * DM, mod, mod + 1024, p.h(), nullptr, nullptr, nullptr, smem_user());
    else phase_norm<0>(p.xw(), p.norm_ffn + layer * DM, mod + 3072, mod + 4096, p.h(), nullptr, nullptr, nullptr, smem_user());
}
NOINL void f_final() { Params p; load_params(p); phase_norm<2>(
#ifdef DBG_SKIP_ALL
        p.x,
#else
        p.xw(),
#endif
 p.final_norm, nullptr, nullptr, nullptr, p.out, nullptr, nullptr, smem_user()); }
NOINL void f_gemm_hy_in(int li) {
    Params p; load_params(p);
    auto epi = [&](int m, int n, int n0, const f32x4& v) {
        if (n0 < 1536) st_bf4(p.proj_a() + (size_t)m * 1536 + n, v);
        else if (n0 < 2048) st_bf4(p.zbuf() + (size_t)m * 512 + (n - 1536), v);
        else if (n0 < 2560) { const int hd = (n - 2048) >> 7, dp = (n - 2048) & 127; const f32x4 rv = rope4(v, p.cosB() + (size_t)m * 64, p.sinB() + (size_t)m * 64, dp >> 1) * (0.08838834764831845f * 1.4426950408889634f); st_bf4(p.Qb() + ((size_t)hd * S + m) * 128 + dp, rv); }
        else if (n0 < 3072) { const int hd = (n - 2560) >> 7, dp = (n - 2560) & 127; const f32x4 rv = rope4(v, p.cosB() + (size_t)m * 64, p.sinB() + (size_t)m * 64, dp >> 1); st_bf4(p.Kb() + ((size_t)hd * S + m) * 128 + dp, rv); }
        else { const int hd = (n - 3072) >> 7, dv = (n - 3072) & 127; bf16_t* vp = p.VbT() + (((size_t)hd * 256 + (m >> 6)) * 128 + dv) * 64 + (m & 63); vp[0] = f2bf(v[0]); vp[64] = f2bf(v[1]); vp[128] = f2bf(v[2]); vp[192] = f2bf(v[3]); }
    };
#ifdef REP_GEMM
    gemm256(p.h(), p.w_hy_in() + (size_t)li * HYN * 1024, HYN, 1024, smem_user(), epi);
#endif
    gemm256(p.h(), p.w_hy_in() + (size_t)li * HYN * 1024, HYN, 1024, smem_user(), epi);
}
NOINL void f_gemm_resid(int layer) {
    Params p; load_params(p); const float* mod = p.mod() + layer * 6144; const int li = layer >> 1;
    const float* xin = layer == 0 ? p.x : p.xw(); float* xo = p.xw();
    auto epi = [&](int m, int n, int n0, const f32x4& v) {
        const f32x4 xv = *(const f32x4*)(xin + (size_t)m * DM + n), gg = *(const f32x4*)(mod + 2048 + n);
        *(f32x4*)(xo + (size_t)m * DM + n) = xv + gg * v;
    };
    const bf16_t* wt = (layer & 1) ? p.w_mla_out() + (size_t)li * 1024 * 1024 : p.w_hy_out() + (size_t)li * 1024 * 1024;
    gemm256(p.cat(), wt, 1024, 1024, smem_user(), epi);
}
NOINL void f_s0(int li) {
    Params p; load_params(p);
    for (int u = opaque_bid(); u < 512; u += gridDim.x) { if (u < 256) gdn_prep_unit(p, li, u >> 2, u & 3, smem_user()); else moba_kmean_unit(p, (u - 256) & 3, (u - 256) >> 2, smem_user()); }
}
NOINL void f_seg(int layer, int seg) {
    Params p; load_params(p);
    const int li = layer >> 1;
    float* scanst = (float*)(p.ws + SCANST_OFF);
    if (opaque_bid() < 16) { gdn_scan_seg(p, opaque_bid(), seg, scanst, smem_user()); return; }
    const int rank = opaque_bid() - 16, nwg = (int)gridDim.x - 16;
    const int nprep = seg < 3 ? 256 : 0;
    int cidx = rank;
    for (; cidx < nprep; cidx += nwg) gdn_prep_unit(p, li, 64 * (seg + 1) + (cidx >> 2), cidx & 3, smem_user());
    int lo = 0, hi = 0;
    if (seg == 0) hi = 128;
    else {
        const int T = moba_tile_table(p, smem_user());
        lo = seg == 1 ? 0 : (seg == 2 ? (T * 28) / 100 : (T * 56) / 100); hi = seg == 1 ? (T * 28) / 100 : (seg == 2 ? (T * 56) / 100 : T);
    }
    for (; cidx < nprep + (hi - lo); cidx += nwg) {
        if (seg == 0) moba_gate_unit(p, cidx - nprep, smem_user());
        else moba_subunit(p, lo + (cidx - nprep), smem_user());
    }
    if (layer == 0 && seg == 3) {
        convert_i4(p.peer_u, p.ub(), (size_t)4 * 16384 * 1024, 96.f, rank, nwg);
        convert_fp4(p.peer_v, p.vb(), (size_t)4 * 16384 * 1024, 5.65685425f, rank, nwg);
    }
}
NOINL void f_combine(int li) { Params p; load_params(p); phase_even_combine(p, li); }
NOINL void f_gemm_mla_in(int li) {
    Params p; load_params(p);
    auto epi = [&](int m, int n, int n0, const f32x4& v) {
        if (n0 < 768) st_bf4(p.cbuf() + (size_t)m * 768 + n, v);
        else if (n < 832) { const int dp = n - 768; const f32x4 rv = rope4(v, p.cosC() + (size_t)m * 32, p.sinC() + (size_t)m * 32, dp >> 1); st_bf4(p.Kr() + (size_t)m * 64 + dp, rv); }
    };
#ifdef REP_GEMM
    gemm256(p.h(), p.w_mla_in() + (size_t)li * 1024 * 1024, 1024, 1024, smem_user(), epi);
#endif
    gemm256(p.h(), p.w_mla_in() + (size_t)li * 1024 * 1024, 1024, 1024, smem_user(), epi);
}
NOINL void f_cnorm(int li) { Params p; load_params(p); phase_mla_cnorm(p, li); }
NOINL void f_gemm_uq(int li) {
    Params p; load_params(p);
    auto epi = [&](int m, int n, int n0, const f32x4& v0) {
        const float qs = 0.07216878364870322f * 1.4426950408889634f;
        const int hd = n / 192, d = n - hd * 192; f32x4 v = v0;
        if (d >= 128) v = rope4(v, p.cosC() + (size_t)m * 32, p.sinC() + (size_t)m * 32, (d - 128) >> 1);
        st_bf4(p.Qm() + ((size_t)hd * S + m) * 192 + d, v * qs);
    };
#ifdef REP_GEMM
    gemm256(p.cqn(), p.w_uq() + (size_t)li * 1536 * 512, 1536, 512, smem_user(), epi);
#endif
    gemm256(p.cqn(), p.w_uq() + (size_t)li * 1536 * 512, 1536, 512, smem_user(), epi);
}
NOINL void f_gemm_ukv(int li) {
    Params p; load_params(p);
    auto epi = [&](int m, int n, int n0, const f32x4& v) {
        if (n0 < 1024) { const int hd = n >> 7, d = n & 127; st_bf4(p.Kn() + ((size_t)hd * S + m) * 128 + d, v); }
        else { const int hd = (n - 1024) >> 7, dv = (n - 1024) & 127; bf16_t* vp = p.VmT() + (((size_t)hd * 256 + (m >> 6)) * 128 + dv) * 64 + (m & 63); vp[0] = f2bf(v[0]); vp[64] = f2bf(v[1]); vp[128] = f2bf(v[2]); vp[192] = f2bf(v[3]); }
    };
#ifdef REP_GEMM
    gemm256(p.ckvn(), p.w_ukv() + (size_t)li * 2048 * 256, 2048, 256, smem_user(), epi);
#endif
    gemm256(p.ckvn(), p.w_ukv() + (size_t)li * 2048 * 256, 2048, 256, smem_user(), epi);
}
NOINL void f_mla_attn() {
    Params p; load_params(p);
#ifdef REP_M4
    phase_mla_attn(p, smem_user());
#endif
    phase_mla_attn(p, smem_user());
}
NOINL void f_gemm_pq(int layer) {
    Params p; load_params(p);
    auto epi = [&](int m, int n, int n0, const f32x4& v) { st_bf4(p.qbuf() + (size_t)m * 2048 + n, v); };
#ifdef REP_GEMM
    gemm256(p.h(), p.w_pq() + (size_t)layer * 2048 * 1024, 2048, 1024, smem_user(), epi);
#endif
    gemm256(p.h(), p.w_pq() + (size_t)layer * 2048 * 1024, 2048, 1024, smem_user(), epi);
}
NOINL void f_topk(int layer) { Params p; load_params(p);
#ifdef REP_F2
    phase_peer_topk(p, layer, smem_user());
#endif
    phase_peer_topk(p, layer, smem_user()); }
NOINL void f_gather(int layer) {
    Params p; load_params(p);
    const float* g2 = p.mod() + layer * 6144 + 5120;
    if (layer == 3) phase_peer_gather<2>(p, layer, g2, p.xw(), p.xw(), p.final_norm, nullptr, nullptr, nullptr, smem_user());
    else {
        const float* modn = p.mod() + (layer + 1) * 6144;
        if (layer == 1) phase_peer_gather<1>(p, layer, g2, p.xw(), p.xw(), p.norm_mix + 2 * DM, modn, modn + 1024, p.hy_w_in + (size_t)1 * 1024 * HY_IN, smem_user());
        else phase_peer_gather<0>(p, layer, g2, p.xw(), p.xw(), p.norm_mix + (layer + 1) * DM, modn, modn + 1024, nullptr, smem_user());
    }
}

__device__ __noinline__ void grid_sync(unsigned* barw, unsigned x) {
    XcdBarrier b; b.bar = barw; b.x = x; b.st = (volatile LAS unsigned*)smem_raw;
    xcd_barrier(b);
}

__global__ void __launch_bounds__(NTHREADS) hybrid_forward(Params p) {
    if (threadIdx.x == 0) *(u32x4*)smem_raw = (u32x4){0u, 0u, 0u, 0u};
    __syncthreads();
    XcdBarrier bar; bar.bar = p.bar(); bar.x = 0; bar.st = (volatile LAS unsigned*)smem_raw;
    if (p.use_bar) bar = xcd_barrier_post(p.bar(), (volatile LAS unsigned*)smem_raw);
    int ph = 0;
#define RUN_PHASE(...) { if (ph >= p.ph_lo && ph < p.ph_hi) { __VA_ARGS__; if (p.use_bar && ph + 1 < p.ph_hi) grid_sync(bar.bar, bar.x); } ++ph; }

    RUN_PHASE(f_prologue());
    for (int layer = 0; layer < 4; ++layer) {
        const int li = layer >> 1;
        if ((layer & 1) == 0) {
            if (layer == 0) RUN_PHASE(f_norm_e0(layer));
            RUN_PHASE(f_gemm_hy_in(li));
            RUN_PHASE(f_s0(li));
            RUN_PHASE(f_seg(layer, 0));
            RUN_PHASE(f_seg(layer, 1));
            RUN_PHASE(f_seg(layer, 2));
            RUN_PHASE(f_seg(layer, 3));
            RUN_PHASE(f_combine(li));
            RUN_PHASE(f_gemm_resid(layer));
        } else {
            RUN_PHASE(f_gemm_mla_in(li));
            RUN_PHASE(f_cnorm(li));
            RUN_PHASE(f_gemm_uq(li); f_gemm_ukv(li));
            RUN_PHASE(f_mla_attn());
            RUN_PHASE(f_gemm_resid(layer));
        }
        RUN_PHASE(f_norm_plain(layer, 1));
        RUN_PHASE(f_gemm_pq(layer));
        RUN_PHASE(f_topk(layer));
        RUN_PHASE(f_gather(layer));
    }
}

constexpr int N_PHASES = 1 + 1 + 2 * 8 + 2 * 5 + 4 * 4;

extern "C" void kernel_launch(void* const* d_in, const int* in_sizes, int n_in, void* d_out, int out_size, void* d_ws, size_t ws_size, hipStream_t stream) {
    static int grid = 0;
    if (!grid) {
        int dev = 0, cus = 0, per_cu = 0;
        hipGetDevice(&dev);
        hipDeviceGetAttribute(&cus, hipDeviceAttributeMultiprocessorCount, dev);
        hipFuncSetAttribute((const void*)hybrid_forward, hipFuncAttributeMaxDynamicSharedMemorySize, LDS_BYTES);
        hipOccupancyMaxActiveBlocksPerMultiprocessor(&per_cu, hybrid_forward, NTHREADS, LDS_BYTES);
        if (per_cu < 1) per_cu = 1;
        grid = cus;
        if (grid > 256) grid = 256;
    }
    Params p; memset(&p, 0, sizeof(p));
    p.x = (const float*)d_in[0]; p.c = (const float*)d_in[1]; p.pos = (const int*)d_in[2]; p.mod_w = (const float*)d_in[3]; p.mod_b = (const float*)d_in[4];
    p.norm_mix = (const float*)d_in[5]; p.norm_ffn = (const float*)d_in[6]; p.hy_w_in = (const float*)d_in[7]; p.gdn_conv = (const float*)d_in[8];
    p.gdn_a_log = (const float*)d_in[9]; p.gdn_dt_bias = (const float*)d_in[10]; p.gdn_o_norm = (const float*)d_in[11]; p.hy_w_out = (const float*)d_in[12];
    p.mla_w_in = (const float*)d_in[13]; p.mla_q_norm = (const float*)d_in[14]; p.mla_kv_norm = (const float*)d_in[15]; p.mla_w_uq = (const float*)d_in[16];
    p.mla_w_ukv = (const float*)d_in[17]; p.mla_w_out = (const float*)d_in[18]; p.peer_w_q = (const float*)d_in[19]; p.peer_sub_keys = (const float*)d_in[20];
    p.peer_u = (const float*)d_in[21]; p.peer_v = (const float*)d_in[22]; p.final_norm = (const float*)d_in[23];
    p.out = (float*)d_out;
    p.ws = (char*)d_ws;
    if (WS_NEED > ws_size) { fprintf(stderr, "workspace too small: need %zu have %zu\n", (size_t)WS_NEED, ws_size); return; }
    hipMemsetAsync(p.ws, 0, 16384, stream);
#ifndef ONE_LAUNCH
    for (int ph = 0; ph < N_PHASES; ++ph) {
#ifdef DBG_SKIP_ALL
        if (ph != N_PHASES - 1) continue;
#endif
        p.ph_lo = ph; p.ph_hi = ph + 1; p.use_bar = 0;
        hipLaunchKernelGGL(hybrid_forward, dim3(grid), dim3(NTHREADS), LDS_BYTES, stream, p);
    }
#else
    p.ph_lo = 0; p.ph_hi = N_PHASES; p.use_bar = 1;
    hipLaunchKernelGGL(hybrid_forward, dim3(grid), dim3(NTHREADS), LDS_BYTES, stream, p);
#endif
}
```
